# Optimizing an MI355X kernel written in HIP

```python
import math
import jax, jax.numpy as jnp
from jax import lax
import numpy as np

D_MODEL = 1024
BATCH = 8
SEQ = 8192
DEPTH = 4

GRID_W = 64
CTX_LEN = 256
N_EVEN = (DEPTH + 1) // 2
N_ODD = DEPTH // 2
EPS = 1e-6
ROPE_BASE = 10000.0

LRU_WIDTH = D_MODEL // 2
LRU_BLOCKS = 8
LRU_BLOCK = LRU_WIDTH // LRU_BLOCKS
CONV_W = 4
CONV_LEFT = CONV_W // 2
LRU_C = 8.0
RET_HEADS = 4
RET_DK = 128
RET_DV = 128
RET_CHUNK = 128
EVEN_SPLITS = (LRU_WIDTH, LRU_WIDTH, RET_HEADS * RET_DK, RET_HEADS * RET_DK,
               RET_HEADS * RET_DV, RET_HEADS * RET_DV)
EVEN_IN = sum(EVEN_SPLITS)
EVEN_OUT = LRU_WIDTH + RET_HEADS * RET_DV
S5_WIDTH = D_MODEL // 4
S5_GROUP = 16
S5_GROUPS = S5_WIDTH // S5_GROUP
S5_STATE = 64
DT_MIN = 0.001
DT_MAX = 0.1
DIFF_HEADS = 6
DIFF_DH = 64
DIFF_DV = 2 * DIFF_DH
Q_BLOCK = 128
ODD_SPLITS = (S5_WIDTH, DIFF_HEADS * 2 * DIFF_DH, DIFF_HEADS * 2 * DIFF_DH, DIFF_HEADS * DIFF_DV)
ODD_IN = sum(ODD_SPLITS)
ODD_OUT = S5_WIDTH + DIFF_HEADS * DIFF_DV
D_FF = 3584
N_EXPERTS = 8
TOP_K = 2

kernel_name = "hybrid_lru_retention_s5_diffattn_moe_dit"

F32 = jnp.float32


def rmsnorm(x, g):
    xf = x.astype(F32)
    y = xf * lax.rsqrt(jnp.mean(xf * xf, axis=-1, keepdims=True) + EPS)
    return (y * g.astype(F32)).astype(x.dtype)


def modulate(h, shift, scale):
    return h * (1.0 + scale) + shift


def head_norm(y, g, center):
    if center:
        y = y - jnp.mean(y, axis=-1, keepdims=True)
    y = y * lax.rsqrt(jnp.mean(y * y, axis=-1, keepdims=True) + EPS)
    return y * g.astype(F32).reshape(y.shape[-2], y.shape[-1])


def split_cols(z, sizes):
    out, start = [], 0
    for s in sizes:
        out.append(z[..., start:start + s])
        start += s
    return out


def axial_rope(n_rows, dim):
    t = jnp.arange(n_rows * GRID_W)
    rows = (t // GRID_W).astype(F32)
    cols = (t % GRID_W).astype(F32)
    quarter = dim // 4
    inv = ROPE_BASE ** (-jnp.arange(quarter, dtype=F32) / quarter)
    ang = jnp.concatenate([rows[:, None] * inv, cols[:, None] * inv], axis=-1)
    return jnp.cos(ang), jnp.sin(ang)


def apply_rope(x, cos, sin):
    half = x.shape[-1] // 2
    shp = (cos.shape[0],) + (1,) * (x.ndim - 3) + (half,)
    c, s = cos.reshape(shp).astype(x.dtype), sin.reshape(shp).astype(x.dtype)
    x1, x2 = x[..., :half], x[..., half:]
    return jnp.concatenate([x1 * c - x2 * s, x1 * s + x2 * c], axis=-1)


def dwconv(u, w, b):
    T = u.shape[1]
    up = jnp.pad(u, ((0, 0), (CONV_LEFT, CONV_W - 1 - CONV_LEFT), (0, 0)))
    out = b
    for k in range(CONV_W):
        out = out + up[:, k:k + T] * w[k]
    return out


def linear_scan(a, b, h0):
    b = b.at[:, 0].add(a[:, 0] * h0)

    def combine(l, r):
        return (r[0] * l[0], r[0] * l[1] + r[1])

    _, h = lax.associative_scan(combine, (a, b), axis=1)
    return h


def flip_t(t):
    return None if t is None else jnp.flip(t, axis=1)


def run_bidirectional(dir_fn, c_in, x_in, p_fwd, p_bwd, ctx_out):
    yc_f, yx_f = dir_fn(c_in, x_in, p_fwd, ctx_out)
    yc_b, yx_b = dir_fn(tuple(flip_t(t) for t in c_in), tuple(flip_t(t) for t in x_in), p_bwd, ctx_out)
    yx = yx_f + flip_t(yx_b)
    yc = (yc_f + flip_t(yc_b)) if ctx_out else None
    return yc, yx


def rglru_coeffs(u, gate_w, gate_b, lam):
    ub = u.reshape(u.shape[0], u.shape[1], LRU_BLOCKS, LRU_BLOCK)
    g = jnp.einsum('btnk,gnkj->gbtnj', ub, gate_w.astype(F32)).reshape((2,) + u.shape)
    g = g + gate_b.astype(F32)[:, None, None, :]
    r = jax.nn.sigmoid(g[0])
    i = jax.nn.sigmoid(g[1])
    log_a = -LRU_C * r * jax.nn.softplus(-lam.astype(F32))
    a = jnp.exp(log_a)
    b = jnp.sqrt(-jnp.expm1(2.0 * log_a)) * (i * u)
    return a, b


def rglru_direction(c_in, x_in, p, ctx_out):
    gate_w, gate_b, lam = p
    (uc,), (ux,) = c_in, x_in
    a_c, b_c = rglru_coeffs(uc, gate_w, gate_b, lam)
    h_c = linear_scan(a_c, b_c, jnp.zeros_like(b_c[:, 0]))
    a_x, b_x = rglru_coeffs(ux, gate_w, gate_b, lam)
    h_x = linear_scan(a_x, b_x, h_c[:, -1])
    return (h_c if ctx_out else None), h_x


def retention_chunks(q, k, v, log_g, s0, with_output):
    Bn, T, H, dk = q.shape
    dv = v.shape[-1]
    C = RET_CHUNK
    N = T // C
    q = q.reshape(Bn, N, C, H, dk)
    k = k.reshape(Bn, N, C, H, dk)
    v = v.reshape(Bn, N, C, H, dv)
    j = jnp.arange(C, dtype=F32)
    k_dec = k * jnp.exp((C - 1 - j)[:, None] * log_g[None, :])[None, None, :, :, None]
    kv = jnp.einsum('bnjhd,bnjhe->nbhde', k_dec, v)
    g_C = jnp.exp(C * log_g)[None, :, None, None]

    def step(s, kv_n):
        return g_C * s + kv_n, s

    s_final, s_start = lax.scan(step, s0, kv)
    if not with_output:
        return None, s_final
    diff = j[:, None] - j[None, :]
    inner_decay = jnp.where(diff >= 0, jnp.exp(jnp.maximum(diff, 0.0)[None] * log_g[:, None, None]), 0.0)
    scores = jnp.einsum('bnihd,bnjhd->bnhij', q, k) * inner_decay[None, None]
    inner = jnp.einsum('bnhij,bnjhe->bnihe', scores, v)
    q_dec = q * jnp.exp((j + 1.0)[:, None] * log_g[None, :])[None, None, :, :, None]
    cross = jnp.einsum('bnihd,nbhde->bnihe', q_dec, s_start)
    return (inner + cross).reshape(Bn, T, H, dv), s_final


def retention_direction(c_in, x_in, theta, ctx_out):
    log_g = jax.nn.log_sigmoid(theta.astype(F32))
    qc = c_in[0]
    s0 = jnp.zeros((qc.shape[0], RET_HEADS, RET_DK, RET_DV), F32)
    y_c, s_c = retention_chunks(*c_in, log_g, s0, ctx_out)
    y_x, _ = retention_chunks(*x_in, log_g, s_c, True)
    return y_c, y_x


def s5_direction(c_in, x_in, p, ctx_out):
    lam_re, lam_im, log_dt, b_re, b_im, c_re, c_im = p
    lam = lax.complex(lam_re.astype(F32), lam_im.astype(F32))
    dt = jnp.exp(log_dt.astype(F32))[:, None]
    a_bar = jnp.exp(lam * dt)
    b_bar = ((a_bar - 1.0) / lam)[..., None] * lax.complex(b_re.astype(F32), b_im.astype(F32))
    c_mat = lax.complex(c_re.astype(F32), c_im.astype(F32))

    def states(u, h0):
        bu = jnp.einsum('gpi,btgi->btgp', b_bar, u.astype(jnp.complex64))
        a = jnp.broadcast_to(a_bar, (1, u.shape[1]) + a_bar.shape)
        return linear_scan(a, bu, h0)

    def readout(h):
        return jnp.einsum('gop,btgp->btgo', c_mat, h).real

    (uc,), (ux,) = c_in, x_in
    h_c = states(uc, jnp.zeros((uc.shape[0], S5_GROUPS, S5_STATE), jnp.complex64))
    h_x = states(ux, h_c[:, -1])
    return (readout(h_c) if ctx_out else None), readout(h_x)


def diff_attn(qb, k_all, v_all, lam):
    s = jnp.einsum('bqhmd,bkhmd->bhmqk', qb, k_all) * (DIFF_DH ** -0.5)
    p = jax.nn.softmax(s, axis=-1)
    w = p[:, :, 0] - lam * p[:, :, 1]
    return jnp.einsum('bhqk,bkhe->bqhe', w, v_all)


def swiglu(h, w_gate, w_up, w_down):
    return (jax.nn.silu(h @ w_gate) * (h @ w_up)) @ w_down


def moe_ffn(h, router_w, router_b, w_gate, w_up, w_down):
    logits = (h @ router_w).astype(F32) + router_b.astype(F32)
    top_v, top_i = lax.top_k(logits, TOP_K)
    top_p = jax.nn.softmax(top_v, axis=-1)
    gates = jnp.sum(jax.nn.one_hot(top_i, N_EXPERTS, dtype=F32) * top_p[..., None], axis=-2)
    out = jnp.zeros(h.shape, F32)
    for e in range(N_EXPERTS):
        out = out + gates[..., e:e + 1] * swiglu(h, w_gate[e], w_up[e], w_down[e]).astype(F32)
    return out.astype(h.dtype)


def even_mixer(hc, hx, cos, sin, w_in, conv_w, conv_b, gate_w, gate_b, lam, theta, gn, w_out, ctx_out):
    uc, gc, qc, kc, vc, oc = split_cols(hc @ w_in, EVEN_SPLITS)
    ux, gx, qx, kx, vx, ox = split_cols(hx @ w_in, EVEN_SPLITS)
    uc = dwconv(uc, conv_w, conv_b).astype(F32)
    ux = dwconv(ux, conv_w, conv_b).astype(F32)
    lru_c, lru_x = run_bidirectional(rglru_direction, (uc,), (ux,),
                                     (gate_w[0], gate_b[0], lam[0]), (gate_w[1], gate_b[1], lam[1]), ctx_out)

    def heads(t, d):
        return t.reshape(t.shape[0], t.shape[1], RET_HEADS, d).astype(F32)

    ks = RET_DK ** -0.5
    q_x = apply_rope(heads(qx, RET_DK), cos, sin)
    k_x = apply_rope(heads(kx, RET_DK), cos, sin) * ks
    ret_c, ret_x = run_bidirectional(retention_direction,
                                     (heads(qc, RET_DK), heads(kc, RET_DK) * ks, heads(vc, RET_DV)),
                                     (q_x, k_x, heads(vx, RET_DV)), theta[0], theta[1], ctx_out)

    def merge(h_lru, g_lru, ret, g_ret):
        a = h_lru * jax.nn.gelu(g_lru.astype(F32))
        r = head_norm(ret, gn, True)
        r = r.reshape(r.shape[0], r.shape[1], -1) * jax.nn.silu(g_ret.astype(F32))
        return jnp.concatenate([a, r], axis=-1).astype(hx.dtype) @ w_out

    mx = merge(lru_x, gx, ret_x, ox)
    mc = merge(lru_c, gc, ret_c, oc) if ctx_out else None
    return mc, mx


def odd_mixer(hc, hx, cos, sin, w_in, lam_re, lam_im, log_dt, b_re, b_im, c_re, c_im,
              d_skip, glu_w, glu_b, lam_p, gn, w_out, lam_init, ctx_out):
    uc, qc, kc, vc = split_cols(hc @ w_in, ODD_SPLITS)
    ux, qx, kx, vx = split_cols(hx @ w_in, ODD_SPLITS)

    def groups(u):
        return u.reshape(u.shape[0], u.shape[1], S5_GROUPS, S5_GROUP).astype(F32)

    def s5p(d):
        return (lam_re[d], lam_im[d], log_dt[d], b_re[d], b_im[d], c_re[d], c_im[d])

    s5_c, s5_x = run_bidirectional(s5_direction, (groups(uc),), (groups(ux),), s5p(0), s5p(1), ctx_out)

    def s5_out(y, u):
        y = y.reshape(u.shape) + d_skip.astype(F32) * u.astype(F32)
        z = jax.nn.gelu(y)
        return z * jax.nn.sigmoid(z @ glu_w.astype(F32) + glu_b.astype(F32))

    lp = lam_p.astype(F32)
    lam = jnp.exp(jnp.sum(lp[0] * lp[1])) - jnp.exp(jnp.sum(lp[2] * lp[3])) + lam_init

    def qk(t):
        return t.reshape(t.shape[0], t.shape[1], DIFF_HEADS, 2, DIFF_DH).astype(F32)

    def vh(t):
        return t.reshape(t.shape[0], t.shape[1], DIFF_HEADS, DIFF_DV).astype(F32)

    q_c, k_c, v_c = qk(qc), qk(kc), vh(vc)
    q_x = apply_rope(qk(qx), cos, sin)
    k_x = apply_rope(qk(kx), cos, sin)
    k_all = jnp.concatenate([k_c, k_x], axis=1)
    v_all = jnp.concatenate([v_c, vh(vx)], axis=1)
    Bn, T = q_x.shape[:2]
    qb = jnp.swapaxes(q_x.reshape(Bn, T // Q_BLOCK, Q_BLOCK, DIFF_HEADS, 2, DIFF_DH), 0, 1)
    att_x = lax.map(lambda blk: diff_attn(blk, k_all, v_all, lam), qb)
    att_x = jnp.swapaxes(att_x, 0, 1).reshape(Bn, T, DIFF_HEADS, DIFF_DV)

    def merge(y_s5, u, att):
        a = head_norm(att, gn, False) * (1.0 - lam_init)
        a = a.reshape(a.shape[0], a.shape[1], -1)
        return jnp.concatenate([s5_out(y_s5, u), a], axis=-1).astype(hx.dtype) @ w_out

    mx = merge(s5_x, ux, att_x)
    mc = merge(s5_c, uc, diff_attn(q_c, k_c, v_c, lam)) if ctx_out else None
    return mc, mx


def setup_inputs(seed: int = 0) -> dict:
    key = jax.random.key(seed)
    ks = iter(jax.random.split(key, 64))
    D = D_MODEL

    def nrm(shape, scale):
        return scale * jax.random.normal(next(ks), shape, F32)

    x = nrm((BATCH, SEQ, D), 1.0)
    c = nrm((BATCH, D), 1.0)
    ctx = nrm((BATCH, CTX_LEN, D), 1.0)
    c_ctx = nrm((D,), 1.0)
    mod_w = nrm((DEPTH, D, 6 * D), 0.5 * D ** -0.5)
    mod_b = nrm((DEPTH, 6 * D), 0.02)
    norm_g = 1.0 + nrm((DEPTH, 4, D), 0.02)
    ev_w_in = nrm((N_EVEN, D, EVEN_IN), D ** -0.5)
    ev_conv_w = nrm((N_EVEN, CONV_W, LRU_WIDTH), CONV_W ** -0.5)
    ev_conv_b = nrm((N_EVEN, LRU_WIDTH), 0.02)
    lru_gate_w = nrm((N_EVEN, 2, 2, LRU_BLOCKS, LRU_BLOCK, LRU_BLOCK), LRU_BLOCK ** -0.5)
    lru_gate_b = nrm((N_EVEN, 2, 2, LRU_WIDTH), 0.02)
    a_c = jax.random.uniform(next(ks), (N_EVEN, 2, LRU_WIDTH), F32, 0.9, 0.999)
    s = a_c ** (1.0 / LRU_C)
    lru_lam = jnp.log(s) - jnp.log1p(-s)
    hh = jnp.arange(RET_HEADS, dtype=F32)
    ret_theta = jnp.log(2.0 ** (5.0 + hh) - 1.0) + nrm((N_EVEN, 2, RET_HEADS), 0.01)
    ret_gn = 1.0 + nrm((N_EVEN, RET_HEADS * RET_DV), 0.02)
    ev_w_out = nrm((N_EVEN, EVEN_OUT, D), EVEN_OUT ** -0.5)
    ffd_w_gate = nrm((N_EVEN, D, D_FF), D ** -0.5)
    ffd_w_up = nrm((N_EVEN, D, D_FF), D ** -0.5)
    ffd_w_down = nrm((N_EVEN, D_FF, D), D_FF ** -0.5)
    od_w_in = nrm((N_ODD, D, ODD_IN), D ** -0.5)
    nn_ = jnp.arange(S5_STATE, dtype=F32)
    s5_lam_re = -0.5 + nrm((N_ODD, 2, S5_GROUPS, S5_STATE), 0.01)
    s5_lam_im = math.pi * nn_ + nrm((N_ODD, 2, S5_GROUPS, S5_STATE), 0.01)
    s5_log_dt = jax.random.uniform(next(ks), (N_ODD, 2, S5_GROUPS), F32, math.log(DT_MIN), math.log(DT_MAX))
    s5_b_re = nrm((N_ODD, 2, S5_GROUPS, S5_STATE, S5_GROUP), (2 * S5_GROUP) ** -0.5)
    s5_b_im = nrm((N_ODD, 2, S5_GROUPS, S5_STATE, S5_GROUP), (2 * S5_GROUP) ** -0.5)
    s5_c_re = nrm((N_ODD, 2, S5_GROUPS, S5_GROUP, S5_STATE), (2 * S5_STATE) ** -0.5)
    s5_c_im = nrm((N_ODD, 2, S5_GROUPS, S5_GROUP, S5_STATE), (2 * S5_STATE) ** -0.5)
    s5_d = nrm((N_ODD, S5_WIDTH), 1.0)
    s5_glu_w = nrm((N_ODD, S5_WIDTH, S5_WIDTH), S5_WIDTH ** -0.5)
    s5_glu_b = nrm((N_ODD, S5_WIDTH), 0.02)
    diff_lam = nrm((N_ODD, 4, DIFF_DH), 0.1)
    diff_gn = 1.0 + nrm((N_ODD, DIFF_HEADS * DIFF_DV), 0.02)
    od_w_out = nrm((N_ODD, ODD_OUT, D), ODD_OUT ** -0.5)
    moe_router_w = nrm((N_ODD, D, N_EXPERTS), D ** -0.5)
    moe_router_b = nrm((N_ODD, N_EXPERTS), 0.01)
    moe_w_gate = nrm((N_ODD, N_EXPERTS, D, D_FF), D ** -0.5)
    moe_w_up = nrm((N_ODD, N_EXPERTS, D, D_FF), D ** -0.5)
    moe_w_down = nrm((N_ODD, N_EXPERTS, D_FF, D), D_FF ** -0.5)
    return {"x": x, "c": c, "ctx": ctx, "c_ctx": c_ctx, "mod_w": mod_w, "mod_b": mod_b, "norm_g": norm_g,
            "ev_w_in": ev_w_in, "ev_conv_w": ev_conv_w, "ev_conv_b": ev_conv_b,
            "lru_gate_w": lru_gate_w, "lru_gate_b": lru_gate_b, "lru_lam": lru_lam,
            "ret_theta": ret_theta, "ret_gn": ret_gn, "ev_w_out": ev_w_out,
            "ffd_w_gate": ffd_w_gate, "ffd_w_up": ffd_w_up, "ffd_w_down": ffd_w_down,
            "od_w_in": od_w_in, "s5_lam_re": s5_lam_re, "s5_lam_im": s5_lam_im, "s5_log_dt": s5_log_dt,
            "s5_b_re": s5_b_re, "s5_b_im": s5_b_im, "s5_c_re": s5_c_re, "s5_c_im": s5_c_im,
            "s5_d": s5_d, "s5_glu_w": s5_glu_w, "s5_glu_b": s5_glu_b, "diff_lam": diff_lam,
            "diff_gn": diff_gn, "od_w_out": od_w_out, "moe_router_w": moe_router_w,
            "moe_router_b": moe_router_b, "moe_w_gate": moe_w_gate, "moe_w_up": moe_w_up,
            "moe_w_down": moe_w_down}


def reference(x, c, ctx, c_ctx, mod_w, mod_b, norm_g,
              ev_w_in, ev_conv_w, ev_conv_b, lru_gate_w, lru_gate_b, lru_lam, ret_theta, ret_gn, ev_w_out,
              ffd_w_gate, ffd_w_up, ffd_w_down,
              od_w_in, s5_lam_re, s5_lam_im, s5_log_dt, s5_b_re, s5_b_im, s5_c_re, s5_c_im,
              s5_d, s5_glu_w, s5_glu_b, diff_lam, diff_gn, od_w_out,
              moe_router_w, moe_router_b, moe_w_gate, moe_w_up, moe_w_down):
    ROWS = x.shape[1] // GRID_W
    cos_r, sin_r = axial_rope(ROWS, RET_DK)
    cos_d, sin_d = axial_rope(ROWS, DIFF_DH)

    def channel_mixer(l, i, h):
        if l % 2 == 0:
            return swiglu(h, ffd_w_gate[i], ffd_w_up[i], ffd_w_down[i])
        return moe_ffn(h, moe_router_w[i], moe_router_b[i], moe_w_gate[i], moe_w_up[i], moe_w_down[i])

    xx, xc = x, ctx
    for l in range(DEPTH):
        i = l // 2
        ctx_out = l < DEPTH - 1
        mod_x = jnp.split((jax.nn.silu(c) @ mod_w[l] + mod_b[l])[:, None, :], 6, axis=-1)
        mod_c = jnp.split((jax.nn.silu(c_ctx) @ mod_w[l] + mod_b[l])[None, None, :], 6, axis=-1)
        hx = modulate(rmsnorm(xx, norm_g[l, 0]), mod_x[0], mod_x[1])
        hc = modulate(rmsnorm(xc, norm_g[l, 0]), mod_c[0], mod_c[1])
        if l % 2 == 0:
            yc, yx = even_mixer(hc, hx, cos_r, sin_r, ev_w_in[i], ev_conv_w[i], ev_conv_b[i],
                                lru_gate_w[i], lru_gate_b[i], lru_lam[i], ret_theta[i], ret_gn[i],
                                ev_w_out[i], ctx_out)
        else:
            lam_init = 0.8 - 0.6 * math.exp(-0.3 * l)
            yc, yx = odd_mixer(hc, hx, cos_d, sin_d, od_w_in[i], s5_lam_re[i], s5_lam_im[i], s5_log_dt[i],
                               s5_b_re[i], s5_b_im[i], s5_c_re[i], s5_c_im[i], s5_d[i], s5_glu_w[i],
                               s5_glu_b[i], diff_lam[i], diff_gn[i], od_w_out[i], lam_init, ctx_out)
        xx = xx + mod_x[2] * rmsnorm(yx, norm_g[l, 1])
        hx = modulate(rmsnorm(xx, norm_g[l, 2]), mod_x[3], mod_x[4])
        xx = xx + mod_x[5] * rmsnorm(channel_mixer(l, i, hx), norm_g[l, 3])
        if ctx_out:
            xc = xc + mod_c[2] * rmsnorm(yc, norm_g[l, 1])
            hc = modulate(rmsnorm(xc, norm_g[l, 2]), mod_c[3], mod_c[4])
            xc = xc + mod_c[5] * rmsnorm(channel_mixer(l, i, hc), norm_g[l, 3])
    return xx
```

```cpp
#include <hip/hip_runtime.h>
#include <cstdio>
#include <cstdint>
#include <cmath>
#define DBG_SCAN 0
namespace pg8 {
#define PG8_LAS __attribute__((address_space(3)))
typedef unsigned short bf16_t;
typedef short bf16x8 __attribute__((ext_vector_type(8)));
typedef float f32x4 __attribute__((ext_vector_type(4)));
typedef unsigned u32x4 __attribute__((ext_vector_type(4)));
constexpr int BM = 256, BK = 64, HALF = 128, HTB = HALF * BK * 2  , STAGE_BYTES = 8 * HTB, NXCD = 8, WGM = 8;

__host__ __device__ __forceinline__ int lds_byte(int r, int c) { const int st = (r >> 4) * 2 + (c >> 5), rr = r & 15, cc = c & 31, ob = rr * 64 + cc * 2; return st * 1024 + (ob ^ (((ob >> 9) & 1) << 5)); }
__host__ __device__ __forceinline__ void stage_rc(int b, int& R, int& C) { const int st = b / 1024, sb = b % 1024, swz = sb ^ (((sb >> 9) & 1) << 5); R = (st >> 1) * 16 + swz / 64; C = (st & 1) * 32 + (swz % 64) / 2; }
__host__ __device__ __forceinline__ int perm32(int rho) { const int n = rho >> 4, i = rho & 15; return 8 * (i >> 2) + 4 * n + (i & 3); }

struct Unit { int pm, pn; };
struct Gemm { const bf16_t* A; const bf16_t* Bt; int M, N, K; };

typedef float f32x2_cv __attribute__((ext_vector_type(2))); typedef __bf16 bf16x2_cv __attribute__((ext_vector_type(2)));
__device__ __forceinline__ unsigned cvt_pk_bf16(float lo, float hi) { const f32x2_cv v = {lo, hi}; const bf16x2_cv b = __builtin_convertvector(v, bf16x2_cv); return __builtin_bit_cast(unsigned, b); }
struct StaticOrder {
    int nM, nN, nwg, G, c;
    __host__ __device__ void init(int M, int N, int G_, int c_) { nM = M / BM; nN = N / BM; nwg = nM * nN; G = G_; c = c_; }
    __host__ __device__ bool next(int i, Unit& u) const {
        const long L = (long)i * G + c; if (L >= nwg) return false;
        int wgid = (int)L; { const int q = nwg / NXCD, r = nwg % NXCD, xcd = wgid % NXCD, off = wgid / NXCD; wgid = (xcd < r ? xcd * (q + 1) : r * (q + 1) + (xcd - r) * q) + off; }
        const int nig = WGM * nN, gid = wgid / nig, fm = gid * WGM, gsz = (nM - fm) < WGM ? (nM - fm) : WGM;
        u.pm = fm + ((wgid % nig) % gsz); u.pn = (wgid % nig) / gsz; return true;
    }
    __device__ __forceinline__ const char* bptr(const Gemm& g, const Unit& u) const { return (const char*)g.Bt + (size_t)u.pn * ((size_t)BM * g.K * 2); }
    __device__ __forceinline__ void a_ready(const Unit&) const {}
    __device__ __forceinline__ void done(const Unit&) const {}
};
struct ExpertOrder : StaticOrder {
    const int* pexp; size_t estride;
    __device__ __forceinline__ const char* bptr(const Gemm& g, const Unit& u) const { return (const char*)g.Bt + (size_t)pexp[u.pm] * estride + (size_t)u.pn * ((size_t)BM * g.K * 2); }
};
__device__ __forceinline__ float fast_sigmoid(float x) { return __builtin_amdgcn_rcpf(1.0f + __builtin_amdgcn_exp2f(-1.4426950408889634f * x)); }
__device__ __forceinline__ float bflo(unsigned w) { return __uint_as_float(w << 16); }
__device__ __forceinline__ float bfhi(unsigned w) { return __uint_as_float(w & 0xffff0000u); }
struct EpiPlain {
    static constexpr bool PERM = true, AFTER_DRAIN = false;
    bf16_t* O; int ldc;
    __device__ __forceinline__ void operator()(const f32x4 (&acc)[2][2][4][2], const Unit& u, int wr, int wc, int fr, int fq) const {
        const int row0 = u.pm * BM + wr * 64 + fr, col0 = u.pn * BM + wc * 32 + 8 * fq;
#pragma unroll
        for (int ai = 0; ai < 2; ++ai)
#pragma unroll
            for (int m = 0; m < 4; ++m) { bf16_t* rowp = O + (size_t)(row0 + ai * HALF + m * 16) * ldc + col0;
#pragma unroll
                for (int bj = 0; bj < 2; ++bj) { const f32x4 v0 = acc[ai][bj][m][0], v1 = acc[ai][bj][m][1];
                    u32x4 w; w.x = cvt_pk_bf16(v0[0], v0[1]); w.y = cvt_pk_bf16(v0[2], v0[3]); w.z = cvt_pk_bf16(v1[0], v1[1]); w.w = cvt_pk_bf16(v1[2], v1[3]);
                    *(u32x4*)(rowp + bj * HALF) = w; } }
    }
};
struct EpiSwiGLU {
    static constexpr bool PERM = true, AFTER_DRAIN = false;
    bf16_t* O; int ldc;
    __device__ __forceinline__ void operator()(const f32x4 (&acc)[2][2][4][2], const Unit& u, int wr, int wc, int fr, int fq) const {
        const int row0 = u.pm * BM + wr * 64 + fr, col0 = u.pn * HALF + wc * 32 + 8 * fq;
#pragma unroll
        for (int ai = 0; ai < 2; ++ai)
#pragma unroll
            for (int m = 0; m < 4; ++m) { bf16_t* rowp = O + (size_t)(row0 + ai * HALF + m * 16) * ldc + col0;
                float o[8];
#pragma unroll
                for (int n = 0; n < 2; ++n)
#pragma unroll
                    for (int i = 0; i < 4; ++i) { const float g = acc[ai][0][m][n][i], up = acc[ai][1][m][n][i]; o[n * 4 + i] = g * fast_sigmoid(g) * up; }
                u32x4 w; w.x = cvt_pk_bf16(o[0], o[1]); w.y = cvt_pk_bf16(o[2], o[3]); w.z = cvt_pk_bf16(o[4], o[5]); w.w = cvt_pk_bf16(o[6], o[7]);
                *(u32x4*)rowp = w; }
    }
};
struct EpiGLU {
    static constexpr bool PERM = true, AFTER_DRAIN = false;
    bf16_t* O; int ldc; const bf16_t* Z; int ldz; const float* bias;
    __device__ __forceinline__ void operator()(const f32x4 (&acc)[2][2][4][2], const Unit& u, int wr, int wc, int fr, int fq) const {
        const int row0 = u.pm * BM + wr * 64 + fr, col0 = u.pn * BM + wc * 32 + 8 * fq;
#pragma unroll
        for (int bj = 0; bj < 2; ++bj) { const f32x4 b0 = *(const f32x4*)(bias + col0 + bj * HALF), b1 = *(const f32x4*)(bias + col0 + bj * HALF + 4);
#pragma unroll
            for (int ai = 0; ai < 2; ++ai)
#pragma unroll
                for (int m = 0; m < 4; ++m) { const size_t r = (size_t)(row0 + ai * HALF + m * 16);
                    const u32x4 zz = *(const u32x4*)(Z + r * ldz + col0 + bj * HALF);
                    const f32x4 v0 = acc[ai][bj][m][0] + b0, v1 = acc[ai][bj][m][1] + b1;
                    u32x4 w; w.x = cvt_pk_bf16(bflo(zz.x) * fast_sigmoid(v0[0]), bfhi(zz.x) * fast_sigmoid(v0[1])); w.y = cvt_pk_bf16(bflo(zz.y) * fast_sigmoid(v0[2]), bfhi(zz.y) * fast_sigmoid(v0[3]));
                    w.z = cvt_pk_bf16(bflo(zz.z) * fast_sigmoid(v1[0]), bfhi(zz.z) * fast_sigmoid(v1[1])); w.w = cvt_pk_bf16(bflo(zz.w) * fast_sigmoid(v1[2]), bfhi(zz.w) * fast_sigmoid(v1[3]));
                    *(u32x4*)(O + r * ldc + col0 + bj * HALF) = w; } }
    }
};
struct RouteEnt { int tok; int slot; float w; int pad; };
struct EpiScatter {
    static constexpr bool PERM = true, AFTER_DRAIN = false;
    const RouteEnt* L; bf16_t* Y; size_t slot_stride; int ldc;
    __device__ __forceinline__ void operator()(const f32x4 (&acc)[2][2][4][2], const Unit& u, int wr, int wc, int fr, int fq) const {
        const int row0 = u.pm * BM + wr * 64 + fr, col0 = u.pn * BM + wc * 32 + 8 * fq;
#pragma unroll
        for (int ai = 0; ai < 2; ++ai)
#pragma unroll
            for (int m = 0; m < 4; ++m) { const RouteEnt e = L[row0 + ai * HALF + m * 16];
                if (e.tok >= 0) { bf16_t* rowp = Y + (size_t)e.slot * slot_stride + (size_t)e.tok * ldc + col0;
#pragma unroll
                    for (int bj = 0; bj < 2; ++bj) { const f32x4 v0 = acc[ai][bj][m][0] * e.w, v1 = acc[ai][bj][m][1] * e.w;
                        u32x4 w; w.x = cvt_pk_bf16(v0[0], v0[1]); w.y = cvt_pk_bf16(v0[2], v0[3]); w.z = cvt_pk_bf16(v1[0], v1[1]); w.w = cvt_pk_bf16(v1[2], v1[3]);
                        *(u32x4*)(rowp + bj * HALF) = w; } } }
    }
};
template <class Epi, class Sched, bool ALIGN_EPI = false, bool SP2 = false>
__device__ __forceinline__ void gemm_phase(PG8_LAS unsigned char* lds, const Gemm g, const Sched& S, const Epi& E, const int tid) {
    const int wid = __builtin_amdgcn_readfirstlane(tid >> 6), lane = tid & 63, wr = wid >> 2, wc = wid & 3, fr = lane & 15, fq = lane >> 4;
    const int K = g.K, nt = K / BK;
    unsigned voffA[2], voffB[2];
#pragma unroll
    for (int i = 0; i < 2; ++i) { int R, C; stage_rc(tid * 16 + i * 8192, R, C); const int Rb = Epi::PERM ? ((R & ~31) + perm32(R & 31)) : R;
        voffA[i] = (unsigned)(R * K + C) * 2u; voffB[i] = (unsigned)(Rb * K + C) * 2u; }
    const size_t kstep = (size_t)(BK * 2);
    const size_t hstep = (size_t)HALF * K * 2;
    const size_t tstep = 2 * hstep;
    const unsigned ldsw = (unsigned)wid * 1024u;
    const int aoff = lds_byte(wr * 64 + fr, fq * 8), boff = lds_byte(wc * 32 + fr, fq * 8);
#define PG8_SA(b, h) (((b) * 2 + (h)) * HTB)
#define PG8_SB(b, h) ((4 + (b) * 2 + (h)) * HTB)
#define PG8_STAGE(bufoff, gbase, voff) do { _Pragma("unroll") for (int _i = 0; _i < 2; ++_i) \
        __builtin_amdgcn_global_load_lds((const unsigned*)((const char*)(gbase) + (voff)[_i]), (PG8_LAS unsigned*)(lds + (bufoff) + ldsw + _i * 8192), 16, 0, 0); } while (0)
#define PG8_LDA(dst, b, h) do { _Pragma("unroll") for (int m = 0; m < 4; ++m) _Pragma("unroll") for (int k = 0; k < 2; ++k) dst[m][k] = *(const PG8_LAS bf16x8*)(lds + PG8_SA(b, h) + aoff + m * 2048 + k * 1024); } while (0)
#define PG8_LDB(dst, b, h) do { _Pragma("unroll") for (int n = 0; n < 2; ++n) _Pragma("unroll") for (int k = 0; k < 2; ++k) dst[n][k] = *(const PG8_LAS bf16x8*)(lds + PG8_SB(b, h) + boff + n * 2048 + k * 1024); } while (0)
#define PG8_MMA(ai, bj, At, Bt) do { __builtin_amdgcn_s_setprio(1); _Pragma("unroll") for (int m = 0; m < 4; ++m) _Pragma("unroll") for (int n = 0; n < 2; ++n) _Pragma("unroll") for (int k = 0; k < 2; ++k) \
        acc[ai][bj][m][n] = __builtin_amdgcn_mfma_f32_16x16x32_bf16(Bt[n][k], At[m][k], acc[ai][bj][m][n], 0, 0, 0); __builtin_amdgcn_s_setprio(0); } while (0)
#define PG8_WAIT_V(n) asm volatile("s_waitcnt vmcnt(" #n ")" ::: "memory")
#define PG8_WAIT_L(n) asm volatile("s_waitcnt lgkmcnt(" #n ")" ::: "memory")
#define PG8_BAR __builtin_amdgcn_s_barrier()
#define PG8_SCHED __builtin_amdgcn_sched_barrier(0)
    Unit cur, nxt; int ui = 0;
    if (!S.next(0, cur)) return;
    f32x4 acc[2][2][4][2];
#pragma unroll
    for (int a = 0; a < 2; ++a)
#pragma unroll
        for (int b = 0; b < 2; ++b)
#pragma unroll
            for (int m = 0; m < 4; ++m)
#pragma unroll
                for (int n = 0; n < 2; ++n) acc[a][b][m][n] = (f32x4){0.f, 0.f, 0.f, 0.f};
    bf16x8 At[4][2], B0[2][2], B1[2][2];
    const char* cA = (const char*)g.A + (size_t)cur.pm * tstep; const char* cB = S.bptr(g, cur);
    S.a_ready(cur);
    if constexpr (SP2) {
        PG8_STAGE(PG8_SB(0, 0), cB, voffB); PG8_STAGE(PG8_SB(0, 1), cB + hstep, voffB); PG8_STAGE(PG8_SA(0, 0), cA, voffA); PG8_STAGE(PG8_SA(0, 1), cA + hstep, voffA);
        if (wr == 1) PG8_BAR;
        PG8_WAIT_V(2); PG8_BAR;
        PG8_STAGE(PG8_SB(1, 0), cB + kstep, voffB); PG8_STAGE(PG8_SA(1, 0), cA + kstep, voffA); PG8_STAGE(PG8_SB(1, 1), cB + hstep + kstep, voffB);
        PG8_WAIT_V(6); PG8_BAR;
    } else {
        PG8_STAGE(PG8_SB(0, 0), cB, voffB); PG8_STAGE(PG8_SA(0, 0), cA, voffA); PG8_STAGE(PG8_SB(0, 1), cB + hstep, voffB); PG8_STAGE(PG8_SA(0, 1), cA + hstep, voffA);
        if (wr == 1) PG8_BAR;
        PG8_WAIT_V(4); PG8_BAR;
        PG8_STAGE(PG8_SB(1, 0), cB + kstep, voffB); PG8_STAGE(PG8_SA(1, 0), cA + kstep, voffA); PG8_STAGE(PG8_SB(1, 1), cB + hstep + kstep, voffB);
        PG8_WAIT_V(6); PG8_BAR;
    }
    for (;;) {
        const bool has_next = S.next(ui + 1, nxt);
        const char* nA = has_next ? (const char*)g.A + (size_t)nxt.pm * tstep : cA; const char* nB = has_next ? S.bptr(g, nxt) : cB;
        for (int t = 0; t < nt; t += 2) {
            const bool last = (t == nt - 2);
            const char* a1 = cA + (size_t)(t + 1) * kstep;
            const char* a2 = last ? nA : cA + (size_t)(t + 2) * kstep; const char* b2 = last ? nB : cB + (size_t)(t + 2) * kstep;
            const char* a3 = a2 + kstep; const char* b3 = b2 + kstep;
            if (last && has_next) S.a_ready(nxt);
            if constexpr (SP2) {
            PG8_LDB(B0, 0, 0); PG8_LDB(B1, 0, 1); PG8_SCHED; PG8_LDA(At, 0, 0); PG8_STAGE(PG8_SA(1, 1), a1 + hstep, voffA);
            PG8_WAIT_V(8); PG8_WAIT_L(0); PG8_BAR; PG8_MMA(0, 0, At, B0); PG8_MMA(0, 1, At, B1); PG8_BAR; PG8_SCHED;
            PG8_LDA(At, 0, 1); PG8_STAGE(PG8_SB(0, 0), b2, voffB); PG8_STAGE(PG8_SB(0, 1), b2 + hstep, voffB); PG8_STAGE(PG8_SA(0, 0), a2, voffA);
            PG8_WAIT_V(8); PG8_WAIT_L(0); PG8_BAR; PG8_MMA(1, 0, At, B0); PG8_MMA(1, 1, At, B1); PG8_BAR; PG8_SCHED;
            PG8_LDB(B0, 1, 0); PG8_LDB(B1, 1, 1); PG8_SCHED; PG8_LDA(At, 1, 0); PG8_STAGE(PG8_SA(0, 1), a2 + hstep, voffA);
            PG8_WAIT_V(8); PG8_WAIT_L(0); PG8_BAR; PG8_MMA(0, 0, At, B0); PG8_MMA(0, 1, At, B1); PG8_BAR; PG8_SCHED;
            PG8_LDA(At, 1, 1); PG8_STAGE(PG8_SB(1, 0), b3, voffB); PG8_STAGE(PG8_SB(1, 1), b3 + hstep, voffB); PG8_STAGE(PG8_SA(1, 0), a3, voffA);
            PG8_WAIT_V(8); PG8_WAIT_L(0); PG8_BAR; PG8_MMA(1, 0, At, B0); PG8_MMA(1, 1, At, B1); PG8_BAR; PG8_SCHED;
            } else {
            PG8_LDB(B0, 0, 0); PG8_SCHED; PG8_LDA(At, 0, 0); PG8_STAGE(PG8_SA(1, 1), a1 + hstep, voffA);
            PG8_WAIT_L(8); PG8_BAR; PG8_WAIT_L(0); PG8_MMA(0, 0, At, B0); PG8_BAR; PG8_SCHED;
            PG8_LDB(B1, 0, 1); PG8_STAGE(PG8_SB(0, 0), b2, voffB);
            PG8_BAR; PG8_WAIT_L(0); PG8_MMA(0, 1, At, B1); PG8_BAR;
            PG8_LDA(At, 0, 1); PG8_STAGE(PG8_SA(0, 0), a2, voffA);
            PG8_BAR; PG8_WAIT_L(0); PG8_MMA(1, 0, At, B0); PG8_BAR; PG8_SCHED;
            PG8_STAGE(PG8_SB(0, 1), b2 + hstep, voffB);
            PG8_WAIT_V(6); PG8_BAR; PG8_MMA(1, 1, At, B1); PG8_BAR;
            PG8_LDB(B0, 1, 0); PG8_SCHED; PG8_LDA(At, 1, 0); PG8_STAGE(PG8_SA(0, 1), a2 + hstep, voffA);
            PG8_WAIT_L(8); PG8_BAR; PG8_WAIT_L(0); PG8_MMA(0, 0, At, B0); PG8_BAR; PG8_SCHED;
            PG8_LDB(B1, 1, 1); PG8_STAGE(PG8_SB(1, 0), b3, voffB);
            PG8_BAR; PG8_WAIT_L(0); PG8_MMA(0, 1, At, B1); PG8_BAR;
            PG8_LDA(At, 1, 1); PG8_STAGE(PG8_SA(1, 0), a3, voffA);
            PG8_BAR; PG8_WAIT_L(0); PG8_MMA(1, 0, At, B0); PG8_BAR; PG8_SCHED;
            PG8_STAGE(PG8_SB(1, 1), b3 + hstep, voffB);
            PG8_WAIT_V(6); PG8_BAR; PG8_MMA(1, 1, At, B1); PG8_BAR;
            }
        }
        if constexpr (ALIGN_EPI) { if (wr == 0) PG8_BAR; }
        if constexpr (!Epi::AFTER_DRAIN) { E(acc, cur, wr, wc, fr, fq); S.done(cur); }
        if (!has_next) break;
#pragma unroll
        for (int a = 0; a < 2; ++a)
#pragma unroll
            for (int b = 0; b < 2; ++b)
#pragma unroll
                for (int m = 0; m < 4; ++m)
#pragma unroll
                    for (int n = 0; n < 2; ++n) acc[a][b][m][n] = (f32x4){0.f, 0.f, 0.f, 0.f};
        cur = nxt; cA = nA; cB = nB; ++ui;
        if constexpr (ALIGN_EPI) { if (wr == 1) PG8_BAR; }
    }
    PG8_WAIT_V(0);
    if constexpr (!ALIGN_EPI) { if (wr == 0) PG8_BAR; }
    PG8_BAR;
    if constexpr (Epi::AFTER_DRAIN) { E.fused(acc, cur, wr, wc, fr, fq, lds, wid, lane); S.done(cur); }
#undef PG8_SA
#undef PG8_SB
#undef PG8_STAGE
#undef PG8_LDA
#undef PG8_LDB
#undef PG8_MMA
#undef PG8_WAIT_V
#undef PG8_WAIT_L
#undef PG8_BAR
#undef PG8_SCHED
}
}

#define GAS __attribute__((address_space(1)))
#define LAS __attribute__((address_space(3)))
#define XB_TMO      128
#define XB_XCNT(j)  (256  + 64 * (j))
#define XB_XSUB(j)  (1280 + 64 * (j))
#define XB_XGEN(j)  (2304 + 64 * (j))
#define XB_TOP      3328
#define XB_TOPGEN   3392
#define XCD_BAR_WORDS 3456
#define XB_SPIN_CAP (1u << 18)

__device__ __forceinline__ unsigned xb_ld(unsigned* p)              { return __hip_atomic_load(p, __ATOMIC_RELAXED, __HIP_MEMORY_SCOPE_AGENT); }
__device__ __forceinline__ unsigned xb_add(unsigned* p, unsigned v) { return __hip_atomic_fetch_add(p, v, __ATOMIC_RELAXED, __HIP_MEMORY_SCOPE_AGENT); }
__device__ __forceinline__ unsigned xb_xcc_id() { return (unsigned)__builtin_amdgcn_s_getreg((3 << 11) | 20) & 0xFu; }
#define XB_SPIN(cond, bar) do { unsigned _sp = 0; while (cond) { __builtin_amdgcn_s_sleep(1); \
    if ((++_sp & 255u) == 0u) { if (xb_ld(&(bar)[XB_TMO])) break; if (_sp > XB_SPIN_CAP) { atomicAdd(&(bar)[XB_TMO], 1u); break; } } } } while (0)

struct XcdBarrier {
    unsigned* bar; unsigned x;
    volatile LAS unsigned* st;
};

__device__ __forceinline__ XcdBarrier xcd_barrier_post(unsigned* bar, volatile LAS unsigned* st) {
    XcdBarrier b; b.bar = bar; b.x = xb_xcc_id(); b.st = st;
    if (threadIdx.x == 0) (void)xb_add(&bar[XB_XCNT(b.x)], 1u);
    return b;
}
__device__ __forceinline__ void xcd_barrier_complete(unsigned* bar, unsigned x, unsigned& nloc, unsigned& nx) {
    const unsigned G = gridDim.x * gridDim.y * gridDim.z;
    unsigned sum, cnt, mine, sp = 0u;
    for (;;) {
        sum = 0u; cnt = 0u; mine = 0u;
#pragma unroll
        for (unsigned j = 0; j < 16; ++j) { const unsigned c = xb_ld(&bar[XB_XCNT(j)]); sum += c; cnt += (c > 0u) ? 1u : 0u; mine = (j == x) ? c : mine; }
        if (sum == G) break;
        __builtin_amdgcn_s_sleep(1);
        if ((++sp & 255u) == 0u) { if (xb_ld(&bar[XB_TMO])) break; if (sp > XB_SPIN_CAP) { atomicAdd(&bar[XB_TMO], 1u); break; } }
    }
    nloc = mine > 0u ? mine : 1u; nx = cnt > 0u ? cnt : 1u;
}

__device__ __forceinline__ void xcd_barrier(const XcdBarrier& b) {
    asm volatile("s_waitcnt vmcnt(0)" ::: "memory");
    __syncthreads();
    if (threadIdx.x == 0) {
        unsigned* bar = b.bar;
        __builtin_amdgcn_s_waitcnt(0);
        unsigned nloc = b.st[0], nx = b.st[1];
        if (nloc == 0u) { xcd_barrier_complete(bar, b.x, nloc, nx); b.st[0] = nloc; b.st[1] = nx; }
        const unsigned old = xb_add(&bar[XB_XSUB(b.x)], 1u);
        const unsigned gen = old / nloc;
        if (old + 1u == (gen + 1u) * nloc) {
            __builtin_amdgcn_fence(__ATOMIC_RELEASE, "agent");
            asm volatile("s_waitcnt vmcnt(0)" ::: "memory");
            const unsigned og = xb_add(&bar[XB_TOP], 1u);
            const unsigned tg = og / nx;
            if (og + 1u == (tg + 1u) * nx) xb_add(&bar[XB_TOPGEN], 1u);
            else XB_SPIN(xb_ld(&bar[XB_TOPGEN]) == tg, bar);
            __builtin_amdgcn_fence(__ATOMIC_ACQUIRE, "agent");
            xb_add(&bar[XB_XGEN(b.x)], 1u);
            asm volatile("s_waitcnt vmcnt(0)" ::: "memory");
        } else {
            XB_SPIN(xb_ld(&bar[XB_XGEN(b.x)]) == gen, bar);
            __builtin_amdgcn_fence(__ATOMIC_ACQUIRE, "agent");
            asm volatile("s_waitcnt vmcnt(0)" ::: "memory");
        }
    }
    __syncthreads();
}
constexpr int D = 1024, NB = 8, SEQ = 8192, CTXL = 256, TB = SEQ + CTXL, M = NB * TB;
constexpr int EV_IN = 3072, OD_IN = 2560, DFF = 3584, NE = 8, NLAYER = 4;
constexpr int NPANEL = M / 256;
constexpr int PW = 179, MAXP = 3 * PW;
constexpr float EPS = 1e-6f;
constexpr size_t MiB = 1u << 20;
constexpr size_t WS_CTL = 0, CTL_ZERO_BYTES = 1 * MiB;
constexpr size_t WS_MOD = 1 * MiB;
constexpr size_t WS_ROPE_R = 2 * MiB, WS_ROPE_D = 2 * MiB + 65536;
constexpr size_t WS_ROUTE = 3 * MiB;
constexpr size_t WS_WGCNT = 5 * MiB;
constexpr size_t WS_PEXP = 5 * MiB + 65536;
constexpr size_t WS_LIST = 6 * MiB;
constexpr size_t WS_XC = 10 * MiB;
constexpr size_t WS_W = 20 * MiB;
constexpr size_t WS_H = 198 * MiB;
constexpr size_t WS_Y = 330 * MiB;
constexpr size_t WS_BIG = 594 * MiB;
constexpr size_t WS_END = 1056 * MiB;
constexpr size_t W_IN = 0, W_OUT = 6 * MiB, W_GU = 8 * MiB, W_DN = 22 * MiB;
constexpr size_t W_GLU = 8 * MiB, W_MGU = 9 * MiB, W_MDN = 121 * MiB;
constexpr size_t Y_SLOT = (size_t)M * 1024 * 2;
constexpr size_t T_HALF = (size_t)M * 512 * 2;
constexpr size_t T_QUART = (size_t)M * 256 * 2;
constexpr size_t BIG_ACT = 0, BIG_HG = 314 * MiB;
constexpr int CW_TMO = 0, CW_BAR = 4096;
constexpr int RING_BYTES = 131072, LDSCTL_OFF = RING_BYTES + 8192, MISC_OFF = LDSCTL_OFF + 320, LDS_BYTES = 147456;
typedef unsigned short bf16;
typedef unsigned v4u __attribute__((ext_vector_type(4)));
typedef unsigned v2u __attribute__((ext_vector_type(2)));
typedef float f32x4 __attribute__((ext_vector_type(4)));
typedef float f32x16 __attribute__((ext_vector_type(16)));
typedef short bf16x8 __attribute__((ext_vector_type(8)));
typedef short s16x4 __attribute__((ext_vector_type(4)));
#define RLX_AGENT __ATOMIC_RELAXED, __HIP_MEMORY_SCOPE_AGENT
using pg8::cvt_pk_bf16; using pg8::bflo; using pg8::bfhi; using pg8::RouteEnt;
struct RouteRow { int e1, e2; float p1, p2; };
__device__ __forceinline__ float bf2f(bf16 v) { return __uint_as_float((unsigned)v << 16); }
__device__ __forceinline__ float wave_sum(float v) {
#pragma unroll
    for (int o = 1; o < 64; o <<= 1) v += __shfl_xor(v, o);
    return v;
}
__device__ __forceinline__ float gelu_tanh(float x) {
    const float u = 0.7978845608028654f * (x + 0.044715f * x * x * x);
    return x * __builtin_amdgcn_rcpf(1.0f + __builtin_amdgcn_exp2f(-2.0f * 1.4426950408889634f * u));
}
__device__ __forceinline__ float sigmoidf_(float x) { return __builtin_amdgcn_rcpf(1.0f + __builtin_amdgcn_exp2f(-1.4426950408889634f * x)); }
struct Args { const float* in[38]; float* out; unsigned char* ws; int ph_lo, ph_hi; };
typedef __attribute__((address_space(4))) const Args KArgs;
#define INP(k) ((const float*)F.A->in[k])
#define OUTP ((float*)F.A->out)
#define FMOD ((float*)(F.ws + WS_MOD))
#define FXC ((float*)(F.ws + WS_XC))
#define FH ((bf16*)(F.ws + WS_H))
#define FWB ((bf16*)(F.ws + WS_W))
#define FYB (F.ws + WS_Y)
#define FBIG (F.ws + WS_BIG)
#define LAUNDER(F) do { asm volatile("" : "+s"(F.ws), "+s"(F.A), "+v"(F.tid), "+s"(F.bid), "+s"(F.G)); F.lane = F.tid & 63; F.wave = __builtin_amdgcn_readfirstlane(F.tid >> 6); } while (0)
struct Frame {
    LAS unsigned char* lds; unsigned char* ws;
    int tid, lane, wave, G, bid;
    const KArgs* A;
};
#define LDS_WAIT() asm volatile("s_waitcnt lgkmcnt(0)" ::: "memory")

__device__ __forceinline__ void ph_prologue(Frame& F) {
    LAS float* SL = (LAS float*)F.lds;
    LAS float* RED = (LAS float*)(F.lds + 40960);
    const float* c = INP(1); const float* cc = INP(3); const float* mod_w = INP(4); const float* mod_b = INP(5);
    for (int i = F.tid; i < 9 * 1024; i += 512) { const float v = (i < 8192) ? c[i] : cc[i - 8192]; SL[i] = v * sigmoidf_(v); }
    __syncthreads();
    for (int blk = F.bid; blk < 4 * 96; blk += F.G) {
        const int l = blk / 96, n0 = (blk % 96) * 64;
        const float* wp = mod_w + ((size_t)l * 1024 + (size_t)F.wave * 128) * 6144 + n0 + F.lane;
        float acc[9];
#pragma unroll
        for (int j = 0; j < 9; ++j) acc[j] = 0.f;
        for (int k = 0; k < 128; ++k) { const float w = wp[(size_t)k * 6144];
#pragma unroll
            for (int j = 0; j < 9; ++j) acc[j] += SL[j * 1024 + F.wave * 128 + k] * w; }
#pragma unroll
        for (int j = 0; j < 9; ++j) RED[(F.wave * 9 + j) * 64 + F.lane] = acc[j];
        __syncthreads();
        for (int i = F.tid; i < 9 * 64; i += 512) { const int j = i >> 6, ln = i & 63; float s = mod_b[l * 6144 + n0 + ln];
#pragma unroll
            for (int w = 0; w < 8; ++w) s += RED[(w * 9 + j) * 64 + ln];
            FMOD[((size_t)l * 9 + j) * 6144 + n0 + ln] = s; }
        __syncthreads();
    }
    const int gt = F.bid * 512 + F.tid;
    if (gt < 128 * 32) { const int pos = gt >> 5, dq = gt & 31; const float inv = powf(10000.0f, -(float)dq / 32.0f); float s, cs; sincosf((float)pos * inv, &s, &cs);
        float* T = (float*)(F.ws + WS_ROPE_R); T[gt * 2] = cs; T[gt * 2 + 1] = s; }
    else if (gt < 128 * 32 + 128 * 16) { const int g2 = gt - 128 * 32, pos = g2 >> 4, dq = g2 & 15; const float inv = powf(10000.0f, -(float)dq / 16.0f); float s, cs; sincosf((float)pos * inv, &s, &cs);
        float* T = (float*)(F.ws + WS_ROPE_D); T[g2 * 2] = cs; T[g2 * 2 + 1] = s; }
}

__device__ __forceinline__ void transpose_item(const float* W, int K, int N, bf16* WT, int drow0, int k0, int n0, LAS float* scr, int lane) {
#pragma unroll 8
    for (int i = 0; i < 32; ++i) { const int kk = 2 * i + (lane >> 5); scr[kk * 33 + (lane & 31)] = W[(size_t)(k0 + kk) * N + n0 + (lane & 31)]; }
    LDS_WAIT(); asm volatile("" ::: "memory");
    const int c = lane & 7;
#pragma unroll
    for (int j = 0; j < 4; ++j) { const int n = (lane >> 3) + 8 * j; const LAS float* s = scr + (8 * c) * 33 + n;
        v4u o; o.x = cvt_pk_bf16(s[0 * 33], s[1 * 33]); o.y = cvt_pk_bf16(s[2 * 33], s[3 * 33]); o.z = cvt_pk_bf16(s[4 * 33], s[5 * 33]); o.w = cvt_pk_bf16(s[6 * 33], s[7 * 33]);
        *(v4u*)(WT + (size_t)(drow0 + n) * K + k0 + 8 * c) = o; }
    LDS_WAIT(); asm volatile("" ::: "memory");
}
__device__ __forceinline__ void convert_job(Frame& F, const float* W, int K, int N, bf16* WT, int mode) {
    LAS float* scr = (LAS float*)(F.lds + F.wave * 16384);
    const int gw = F.bid * 8 + F.wave, NGW = F.G * 8, nblk = N / 32, nit = (K / 64) * nblk;
    for (int it = gw; it < nit; it += NGW) { const int kb = it / nblk, nb = it % nblk, n0 = nb * 32;
        const int drow0 = mode == 0 ? n0 : ((n0 >> 7) * 256 + (n0 & 127) + (mode == 2 ? 128 : 0));
        transpose_item(W, K, N, WT, drow0, kb * 64, n0, scr, F.lane); }
}
__device__ __forceinline__ void ph_convert(Frame& F, int l) {
    const int i = l >> 1; bf16* Wb = FWB;
    if ((l & 1) == 0) {
        convert_job(F, INP(7) + (size_t)i * D * EV_IN, D, EV_IN, Wb + W_IN / 2, 0);
        convert_job(F, INP(15) + (size_t)i * D * D, D, D, Wb + W_OUT / 2, 0);
        convert_job(F, INP(16) + (size_t)i * D * DFF, D, DFF, Wb + W_GU / 2, 1);
        convert_job(F, INP(17) + (size_t)i * D * DFF, D, DFF, Wb + W_GU / 2, 2);
        convert_job(F, INP(18) + (size_t)i * DFF * D, DFF, D, Wb + W_DN / 2, 0);
    } else {
        convert_job(F, INP(19) + (size_t)i * D * OD_IN, D, OD_IN, Wb + W_IN / 2, 0);
        convert_job(F, INP(32) + (size_t)i * D * D, D, D, Wb + W_OUT / 2, 0);
        convert_job(F, INP(28) + (size_t)i * 256 * 256, 256, 256, Wb + W_GLU / 2, 0);
        for (int e = 0; e < NE; ++e) {
            convert_job(F, INP(35) + ((size_t)i * NE + e) * D * DFF, D, DFF, Wb + W_MGU / 2 + (size_t)e * 7168 * 1024, 1);
            convert_job(F, INP(36) + ((size_t)i * NE + e) * D * DFF, D, DFF, Wb + W_MGU / 2 + (size_t)e * 7168 * 1024, 2);
            convert_job(F, INP(37) + ((size_t)i * NE + e) * DFF * D, DFF, D, Wb + W_MDN / 2 + (size_t)e * 1024 * 3584, 0);
        }
    }
}

struct NormArgs {
    int xin_input, has_y, two, write_x, final_, do_h, do_route;
    const float* gate; const float* gy;
    const float* gh; const float* shift; const float* scale;
    const float* rw; const float* rb;
};
__device__ __forceinline__ void ph_norm(Frame& F, const NormArgs& a) {
    LAS float* RWT = (LAS float*)F.lds;
    LAS int* cnt = (LAS int*)(F.lds + 32768);
    if (a.do_route) {
        for (int idx = F.tid; idx < 8192; idx += 512) RWT[(idx & 7) * 1024 + (idx >> 3)] = a.rw[idx];
        if (F.tid < 8) cnt[F.tid] = 0;
        __syncthreads();
    }
    const int r0 = (int)((long)M * F.bid / F.G), r1 = (int)((long)M * (F.bid + 1) / F.G);
    const bf16* Y0 = (const bf16*)FYB; const bf16* Y1 = (const bf16*)(FYB + Y_SLOT);
    for (int m = r0 + F.wave; m < r1; m += 8) {
        const int b = m / TB, t = m - b * TB; const bool isctx = t < CTXL; const int midx = isctx ? 8 : b;
        const size_t off = isctx ? ((size_t)(b * CTXL + t) * D) : ((size_t)(b * SEQ + t - CTXL) * D);
        const float* xin = isctx ? ((a.xin_input ? INP(2) : FXC) + off) : ((a.xin_input ? INP(0) : OUTP) + off);
        float* xres = isctx ? (FXC + off) : (OUTP + off);
        f32x4 x[4];
#pragma unroll
        for (int j = 0; j < 4; ++j) x[j] = *(const f32x4*)(xin + 4 * F.lane + 256 * j);
        if (a.has_y) {
            f32x4 y[4]; float ss = 0.f;
#pragma unroll
            for (int j = 0; j < 4; ++j) { const v2u w = *(const v2u*)(Y0 + (size_t)m * D + 4 * F.lane + 256 * j); y[j] = (f32x4){bflo(w.x), bfhi(w.x), bflo(w.y), bfhi(w.y)};
                if (a.two) { const v2u w2 = *(const v2u*)(Y1 + (size_t)m * D + 4 * F.lane + 256 * j); y[j] += (f32x4){bflo(w2.x), bfhi(w2.x), bflo(w2.y), bfhi(w2.y)}; }
                ss += (y[j].x * y[j].x + y[j].y * y[j].y) + (y[j].z * y[j].z + y[j].w * y[j].w); }
            const float rs = 1.0f / sqrtf(wave_sum(ss) * (1.0f / D) + EPS);
#pragma unroll
            for (int j = 0; j < 4; ++j) { const int c = 4 * F.lane + 256 * j; const f32x4 g = *(const f32x4*)(a.gate + (size_t)midx * 6144 + c), gg = *(const f32x4*)(a.gy + c);
                x[j] += g * (y[j] * rs * gg); }
        }
        if (a.write_x && !(a.final_ && isctx)) {
#pragma unroll
            for (int j = 0; j < 4; ++j) *(f32x4*)(xres + 4 * F.lane + 256 * j) = x[j];
        }
        if (a.do_h) {
            float ss = 0.f;
#pragma unroll
            for (int j = 0; j < 4; ++j) ss += (x[j].x * x[j].x + x[j].y * x[j].y) + (x[j].z * x[j].z + x[j].w * x[j].w);
            const float rs = 1.0f / sqrtf(wave_sum(ss) * (1.0f / D) + EPS);
            f32x4 h[4];
#pragma unroll
            for (int j = 0; j < 4; ++j) { const int c = 4 * F.lane + 256 * j; const f32x4 g = *(const f32x4*)(a.gh + c), sh = *(const f32x4*)(a.shift + (size_t)midx * 6144 + c), sc = *(const f32x4*)(a.scale + (size_t)midx * 6144 + c);
                h[j] = (x[j] * rs * g) * (sc + 1.0f) + sh;
                v2u w; w.x = cvt_pk_bf16(h[j].x, h[j].y); w.y = cvt_pk_bf16(h[j].z, h[j].w); *(v2u*)(FH + (size_t)m * D + c) = w; }
            if (a.do_route) {
                float lg[8];
#pragma unroll
                for (int e = 0; e < 8; ++e) { float s = 0.f;
#pragma unroll
                    for (int j = 0; j < 4; ++j) { const f32x4 w = *(const LAS f32x4*)(RWT + e * 1024 + 4 * F.lane + 256 * j); s += (h[j].x * w.x + h[j].y * w.y) + (h[j].z * w.z + h[j].w * w.w); }
                    lg[e] = wave_sum(s) + a.rb[e]; }
                int e1 = 0; float v1 = lg[0];
#pragma unroll
                for (int e = 1; e < 8; ++e) if (lg[e] > v1) { v1 = lg[e]; e1 = e; }
                int e2 = -1; float v2 = -3.0e38f;
#pragma unroll
                for (int e = 0; e < 8; ++e) if (e != e1 && lg[e] > v2) { v2 = lg[e]; e2 = e; }
                const float p1 = 1.0f / (1.0f + expf(v2 - v1));
                if (F.lane == 0) { RouteRow rr; rr.e1 = e1; rr.e2 = e2; rr.p1 = p1; rr.p2 = 1.0f - p1; ((RouteRow*)(F.ws + WS_ROUTE))[m] = rr;
                    atomicAdd((int*)&cnt[e1], 1); atomicAdd((int*)&cnt[e2], 1); }
            }
        }
    }
    if (a.do_route) { __syncthreads(); if (F.tid < 8) ((int*)(F.ws + WS_WGCNT))[F.bid * 8 + F.tid] = cnt[F.tid]; }
}

__device__ __forceinline__ void ph_assign(Frame& F) {
    LAS int* part = (LAS int*)F.lds;
    LAS int* tot = (LAS int*)(F.lds + 32768);
    const int* WC = (const int*)(F.ws + WS_WGCNT);
    int st[8], sb[8];
#pragma unroll
    for (int e = 0; e < 8; ++e) { st[e] = 0; sb[e] = 0; }
    for (int w = F.tid; w < F.G; w += 512) {
#pragma unroll
        for (int e = 0; e < 8; ++e) { const int c = WC[w * 8 + e]; st[e] += c; if (w < F.bid) sb[e] += c; } }
    if (F.tid < 32) tot[F.tid] = 0;
    __syncthreads();
#pragma unroll
    for (int e = 0; e < 8; ++e) { if (st[e]) atomicAdd((int*)&tot[e], st[e]); if (sb[e]) atomicAdd((int*)&tot[8 + e], sb[e]); }
    __syncthreads();
    if (F.tid == 0) { int o = 0; for (int e = 0; e < 8; ++e) { tot[16 + e] = o; o += (tot[e] + 255) & ~255; }
        if (F.bid == 0) { int* PE = (int*)(F.ws + WS_PEXP); int p = 0; for (int e = 0; e < 8; ++e) { const int np = (tot[e] + 255) >> 8; for (int q = 0; q < np; ++q) PE[p++] = e; } PE[MAXP] = p; } }
    __syncthreads();
    RouteEnt* L = (RouteEnt*)(F.ws + WS_LIST);
    if (F.bid == 0) {
        for (int e = 0; e < 8; ++e) { const int lo = tot[16 + e] + tot[e], hi = tot[16 + e] + ((tot[e] + 255) & ~255);
            for (int p = lo + F.tid; p < hi; p += 512) { RouteEnt z; z.tok = -1; z.slot = 0; z.w = 0.f; z.pad = 0; L[p] = z; } }
    }
    const RouteRow* RR = (const RouteRow*)(F.ws + WS_ROUTE);
    const int r0 = (int)((long)M * F.bid / F.G), r1 = (int)((long)M * (F.bid + 1) / F.G);
    for (int m = r0 + F.tid; m < r1; m += 512) { const RouteRow rr = RR[m];
        { const int p = tot[16 + rr.e1] + tot[8 + rr.e1] + atomicAdd((int*)&tot[24 + rr.e1], 1); RouteEnt z; z.tok = m; z.slot = 0; z.w = rr.p1; z.pad = 0; L[p] = z; }
        { const int p = tot[16 + rr.e2] + tot[8 + rr.e2] + atomicAdd((int*)&tot[24 + rr.e2], 1); RouteEnt z; z.tok = m; z.slot = 1; z.w = rr.p2; z.pad = 0; L[p] = z; } }
}
__device__ __forceinline__ void ph_gather(Frame& F, int p0, int p1) {
    const RouteEnt* L = (const RouteEnt*)(F.ws + WS_LIST); bf16* HG = (bf16*)(FBIG + BIG_HG);
    const int gw = F.bid * 8 + F.wave, NGW = F.G * 8, n = (p1 - p0) * 256;
    for (int r = gw; r < n; r += NGW) { const int tok = L[(size_t)p0 * 256 + r].tok;
        v4u a = (v4u){0u, 0u, 0u, 0u}, b = a;
        if (tok >= 0) { const v4u* s = (const v4u*)(FH + (size_t)tok * D); a = s[F.lane]; b = s[64 + F.lane]; }
        v4u* d = (v4u*)(HG + (size_t)r * D); d[F.lane] = a; d[64 + F.lane] = b; }
}
__device__ __forceinline__ void rope8(v4u& a, v4u& b, const float* cs, float sc) {
    unsigned* pa = (unsigned*)&a; unsigned* pb = (unsigned*)&b;
#pragma unroll
    for (int k = 0; k < 4; ++k) {
        float x1l = bflo(pa[k]), x1h = bfhi(pa[k]), x2l = bflo(pb[k]), x2h = bfhi(pb[k]);
        float c0 = 1.f, s0 = 0.f, c1 = 1.f, s1 = 0.f;
        if (cs) { c0 = cs[4 * k]; s0 = cs[4 * k + 1]; c1 = cs[4 * k + 2]; s1 = cs[4 * k + 3]; }
        const float o1l = (x1l * c0 - x2l * s0) * sc, o2l = (x1l * s0 + x2l * c0) * sc, o1h = (x1h * c1 - x2h * s1) * sc, o2h = (x1h * s1 + x2h * c1) * sc;
        pa[k] = cvt_pk_bf16(o1l, o1h); pb[k] = cvt_pk_bf16(o2l, o2h);
    }
}
__device__ __forceinline__ void ph_rope(Frame& F, int odd) {
    const int gw = F.bid * 8 + F.wave, NGW = F.G * 8;
    bf16* Z = (bf16*)FBIG;
    if (!odd) {
        const float* T = (const float*)(F.ws + WS_ROPE_R);
        const int tensor = F.lane >> 5, head = (F.lane >> 3) & 3, d0 = (F.lane & 7) * 8;
        const float sc = tensor ? 0.08838834764831845f : 1.0f;
        for (int m = gw; m < M; m += NGW) { const int t = m % TB;
            bf16* p = Z + (size_t)m * EV_IN + 1024 + tensor * 512 + head * 128 + d0;
            v4u a = *(v4u*)p, b = *(v4u*)(p + 64);
            if (t >= CTXL) { const int tl = t - CTXL, pos = d0 < 32 ? (tl >> 6) : (tl & 63), dq = d0 & 31; rope8(a, b, T + (pos * 32 + dq) * 2, sc); }
            else { if (!tensor) continue; rope8(a, b, nullptr, sc); }
            *(v4u*)p = a; *(v4u*)(p + 64) = b; }
    } else {
        const float* T = (const float*)(F.ws + WS_ROPE_D);
        for (int m = gw; m < M; m += NGW) { const int t = m % TB; if (t < CTXL) continue;
            const int tl = t - CTXL;
            for (int it = F.lane; it < 96; it += 64) { const int tensor = it / 48, r = it % 48, hm = r >> 2, d0 = (r & 3) * 8;
                bf16* p = Z + (size_t)m * OD_IN + 256 + tensor * 768 + hm * 64 + d0;
                v4u a = *(v4u*)p, b = *(v4u*)(p + 32);
                const int pos = d0 < 16 ? (tl >> 6) : (tl & 63), dq = d0 & 15; rope8(a, b, T + (pos * 16 + dq) * 2, 1.0f);
                *(v4u*)p = a; *(v4u*)(p + 32) = b; } }
    }
}
__device__ __forceinline__ void unpack8(const v4u& w, float* f) { f[0] = bflo(w.x); f[1] = bfhi(w.x); f[2] = bflo(w.y); f[3] = bfhi(w.y); f[4] = bflo(w.z); f[5] = bfhi(w.z); f[6] = bflo(w.w); f[7] = bfhi(w.w); }
__device__ __forceinline__ v4u pack8(const float* f) { v4u w; w.x = cvt_pk_bf16(f[0], f[1]); w.y = cvt_pk_bf16(f[2], f[3]); w.z = cvt_pk_bf16(f[4], f[5]); w.w = cvt_pk_bf16(f[6], f[7]); return w; }
__device__ __forceinline__ void ph_merge_even(Frame& F, int i) {
    const int gw = F.bid * 8 + F.wave, NGW = F.G * 8;
    const bf16* Z = (const bf16*)FBIG; const bf16* HF = (const bf16*)FYB; const bf16* HB = (const bf16*)(FYB + T_HALF);
    const bf16* RF = (const bf16*)(FYB + 2 * T_HALF); const bf16* RB = (const bf16*)(FYB + 3 * T_HALF);
    const float* gn = INP(14) + (size_t)i * 512; const int c0 = 8 * F.lane;
    float gnv[8];
#pragma unroll
    for (int k = 0; k < 8; ++k) gnv[k] = gn[c0 + k];
    for (int m = gw; m < M; m += NGW) {
        float a[8], b[8], g[8], o[8];
        unpack8(*(const v4u*)(HF + (size_t)m * 512 + c0), a); unpack8(*(const v4u*)(HB + (size_t)m * 512 + c0), b); unpack8(*(const v4u*)(Z + (size_t)m * EV_IN + 512 + c0), g);
#pragma unroll
        for (int k = 0; k < 8; ++k) o[k] = (a[k] + b[k]) * gelu_tanh(g[k]);
        *(v4u*)(FH + (size_t)m * D + c0) = pack8(o);
        unpack8(*(const v4u*)(RF + (size_t)m * 512 + c0), a); unpack8(*(const v4u*)(RB + (size_t)m * 512 + c0), b); unpack8(*(const v4u*)(Z + (size_t)m * EV_IN + 2560 + c0), g);
        float s = 0.f;
#pragma unroll
        for (int k = 0; k < 8; ++k) { a[k] += b[k]; s += a[k]; }
        s += __shfl_xor(s, 1); s += __shfl_xor(s, 2); s += __shfl_xor(s, 4); s += __shfl_xor(s, 8);
        const float mean = s * (1.0f / 128.0f); float q = 0.f;
#pragma unroll
        for (int k = 0; k < 8; ++k) { a[k] -= mean; q += a[k] * a[k]; }
        q += __shfl_xor(q, 1); q += __shfl_xor(q, 2); q += __shfl_xor(q, 4); q += __shfl_xor(q, 8);
        const float rs = 1.0f / sqrtf(q * (1.0f / 128.0f) + EPS);
#pragma unroll
        for (int k = 0; k < 8; ++k) o[k] = a[k] * rs * gnv[k] * (g[k] * sigmoidf_(g[k]));
        *(v4u*)(FH + (size_t)m * D + 512 + c0) = pack8(o);
    }
}
__device__ __forceinline__ void ph_zpass(Frame& F, int i) {
    const int gw = F.bid * 8 + F.wave, NGW = F.G * 8;
    const bf16* ZI = (const bf16*)FBIG; const bf16* YF = (const bf16*)FYB; const bf16* YB = (const bf16*)(FYB + T_QUART); bf16* ZO = (bf16*)(FYB + 2 * T_QUART);
    const float* dsk = INP(27) + (size_t)i * 256; const int c0 = 4 * F.lane;
    const f32x4 dv = *(const f32x4*)(dsk + c0);
    for (int m = gw; m < M; m += NGW) {
        const v2u a = *(const v2u*)(YF + (size_t)m * 256 + c0), b = *(const v2u*)(YB + (size_t)m * 256 + c0), u = *(const v2u*)(ZI + (size_t)m * OD_IN + c0);
        const float y0 = bflo(a.x) + bflo(b.x) + dv.x * bflo(u.x), y1 = bfhi(a.x) + bfhi(b.x) + dv.y * bfhi(u.x), y2 = bflo(a.y) + bflo(b.y) + dv.z * bflo(u.y), y3 = bfhi(a.y) + bfhi(b.y) + dv.w * bfhi(u.y);
        v2u w; w.x = cvt_pk_bf16(gelu_tanh(y0), gelu_tanh(y1)); w.y = cvt_pk_bf16(gelu_tanh(y2), gelu_tanh(y3));
        *(v2u*)(ZO + (size_t)m * 256 + c0) = w; }
}
__device__ __forceinline__ int chunk_tlo(int dir, int c) { return dir == 0 ? 128 * c : (c < 2 ? 128 * (1 - c) : 8576 - 128 * c); }

__device__ __forceinline__ void lru_item(Frame& F, int i, int b, int dir, int blk) {
    LAS unsigned char* lds = F.lds;
    LAS float* UR = (LAS float*)(lds);
    LAS float* AA = (LAS float*)(lds);
    LAS float* U = (LAS float*)(lds + 36864);
    LAS float* BB = U;
    LAS bf16* UB = (LAS bf16*)(lds + 69632);
    LAS float* SEG = (LAS float*)(lds + 88064);
    LAS float* PRM = (LAS float*)(lds + 92160);
    const int tid = F.tid, lane = F.lane, wave = F.wave, ch = tid & 63, seg = tid >> 6;
    const bf16* Z = (const bf16*)FBIG; bf16* OUT = (bf16*)(FYB + (size_t)dir * T_HALF);
    const float* conv_w = INP(8) + (size_t)i * 4 * 512; const float* conv_b = INP(9) + (size_t)i * 512;
    const float* gate_w = INP(10) + (((size_t)i * 2 + dir) * 2) * 8 * 64 * 64;
    const float* gate_b = INP(11) + (((size_t)i * 2 + dir) * 2) * 512;
    const float* lam = INP(12) + ((size_t)i * 2 + dir) * 512;
    __syncthreads();
    if (tid < 64) { const int cg = blk * 64 + tid;
        PRM[0 * 64 + tid] = conv_w[0 * 512 + cg]; PRM[1 * 64 + tid] = conv_w[1 * 512 + cg]; PRM[2 * 64 + tid] = conv_w[2 * 512 + cg]; PRM[3 * 64 + tid] = conv_w[3 * 512 + cg];
        PRM[4 * 64 + tid] = conv_b[cg]; const float lm = lam[cg]; PRM[5 * 64 + tid] = (-lm > 20.f) ? -lm : log1pf(expf(-lm));
        PRM[6 * 64 + tid] = gate_b[cg]; PRM[7 * 64 + tid] = gate_b[512 + cg]; }
    const int fr = lane & 15, fq = lane >> 4;
    bf16x8 wf[8][2];
#pragma unroll
    for (int nt = 0; nt < 8; ++nt)
#pragma unroll
        for (int ks = 0; ks < 2; ++ks) { const int col = 16 * nt + fr, gate = col >> 6, j = col & 63; const float* wp = gate_w + (((size_t)gate * 8 + blk) * 64 + (32 * ks + 8 * fq)) * 64 + j;
            v4u w; w.x = cvt_pk_bf16(wp[0], wp[64]); w.y = cvt_pk_bf16(wp[128], wp[192]); w.z = cvt_pk_bf16(wp[256], wp[320]); w.w = cvt_pk_bf16(wp[384], wp[448]);
            wf[nt][ks] = __builtin_bit_cast(bf16x8, w); }
    float carry = 0.f;
    __syncthreads();
    for (int c = 0; c < 66; ++c) {
        const int t_lo = chunk_tlo(dir, c), seq_lo = t_lo < CTXL ? 0 : CTXL, seq_hi = t_lo < CTXL ? CTXL : TB;
        const size_t rowbase = (size_t)b * TB;
        for (int it = tid; it < 131 * 8; it += 512) { const int r = it >> 3, cc = it & 7, t = t_lo - 2 + r; float f[8];
            if (t >= seq_lo && t < seq_hi) unpack8(*(const v4u*)(Z + (rowbase + t) * EV_IN + blk * 64 + cc * 8), f);
            else {
#pragma unroll
                for (int k = 0; k < 8; ++k) f[k] = 0.f; }
            *(LAS f32x4*)(UR + r * 64 + cc * 8) = (f32x4){f[0], f[1], f[2], f[3]}; *(LAS f32x4*)(UR + r * 64 + cc * 8 + 4) = (f32x4){f[4], f[5], f[6], f[7]}; }
        __syncthreads();
        { const float w0 = PRM[ch], w1 = PRM[64 + ch], w2 = PRM[128 + ch], w3 = PRM[192 + ch], cb = PRM[256 + ch];
#pragma unroll 4
          for (int k = 0; k < 16; ++k) { const int r = seg * 16 + k; const float u = cb + w0 * UR[r * 64 + ch] + w1 * UR[(r + 1) * 64 + ch] + w2 * UR[(r + 2) * 64 + ch] + w3 * UR[(r + 3) * 64 + ch];
              U[r * 64 + ch] = u; UB[r * 72 + ch] = (bf16)(cvt_pk_bf16(u, 0.f) & 0xffffu); } }
        __syncthreads();
        { f32x4 acc[8];
#pragma unroll
          for (int nt = 0; nt < 8; ++nt) acc[nt] = (f32x4){0.f, 0.f, 0.f, 0.f};
          const bf16x8 a0 = *(const LAS bf16x8*)(UB + (16 * wave + fr) * 72 + 8 * fq), a1 = *(const LAS bf16x8*)(UB + (16 * wave + fr) * 72 + 32 + 8 * fq);
#pragma unroll
          for (int nt = 0; nt < 8; ++nt) { acc[nt] = __builtin_amdgcn_mfma_f32_16x16x32_bf16(a0, wf[nt][0], acc[nt], 0, 0, 0); acc[nt] = __builtin_amdgcn_mfma_f32_16x16x32_bf16(a1, wf[nt][1], acc[nt], 0, 0, 0); }
#pragma unroll
          for (int nt = 0; nt < 4; ++nt) { const int cch = 16 * nt + fr; const float br = PRM[6 * 64 + cch], bi = PRM[7 * 64 + cch], sp = PRM[5 * 64 + cch];
#pragma unroll
              for (int rg = 0; rg < 4; ++rg) { const int r = 16 * wave + 4 * fq + rg; const float rgate = sigmoidf_(acc[nt][rg] + br), igate = sigmoidf_(acc[nt + 4][rg] + bi);
                  const float la = -8.0f * rgate * sp, av = expf(la), bv = sqrtf(-expm1f(2.0f * la)) * (igate * U[r * 64 + cch]);
                  AA[r * 64 + cch] = av; BB[r * 64 + cch] = bv; } } }
        __syncthreads();
        float hl[16], ca[16];
        { float h = 0.f, p = 1.f;
#pragma unroll
          for (int k = 0; k < 16; ++k) { const int ip = seg * 16 + k, r = dir == 0 ? ip : 127 - ip; const float av = AA[r * 64 + ch], bv = BB[r * 64 + ch]; h = av * h + bv; p *= av; hl[k] = h; ca[k] = p; }
          SEG[seg * 64 + ch] = p; SEG[512 + seg * 64 + ch] = h; }
        __syncthreads();
        float hin = carry, myin = 0.f;
#pragma unroll
        for (int s = 0; s < 8; ++s) { if (s == seg) myin = hin; hin = SEG[s * 64 + ch] * hin + SEG[512 + s * 64 + ch]; }
        carry = hin;
#pragma unroll
        for (int k = 0; k < 16; ++k) { const int ip = seg * 16 + k, r = dir == 0 ? ip : 127 - ip; const float h = hl[k] + ca[k] * myin;
            OUT[(rowbase + t_lo + r) * 512 + blk * 64 + ch] = (bf16)(cvt_pk_bf16(h, 0.f) & 0xffffu); }
        __syncthreads();
    }
}
__device__ __forceinline__ unsigned off_b(unsigned row, unsigned ch) { return 256u * row + 16u * (ch ^ (((row & 3) << 2) | ((row >> 2) & 3))); }
__device__ __forceinline__ unsigned row_read_addr(unsigned lane, unsigned rb, unsigned s) { return off_b(32 * rb + (lane & 31), 2 * s + (lane >> 5)); }
__device__ __forceinline__ unsigned tr_read_addr(unsigned lane, unsigned c, unsigned ks, unsigned t) {
    const unsigned h = lane >> 5, blk = (lane >> 4) & 1, q = (lane & 15) >> 2, p = lane & 3;
    return off_b(16 * ks + 8 * h + 4 * t + q, 4 * c + 2 * blk + (p >> 1)) + 8 * (p & 1);
}
typedef short v4i16_t __attribute__((ext_vector_type(4)));
__device__ __forceinline__ bf16x8 tr_frag(LAS unsigned char* tile, unsigned lane, unsigned c, unsigned ks) {
    const s16x4 lo = __builtin_bit_cast(s16x4, __builtin_amdgcn_ds_read_tr16_b64_v4i16((LAS v4i16_t*)(tile + tr_read_addr(lane, c, ks, 0))));
    const s16x4 hi = __builtin_bit_cast(s16x4, __builtin_amdgcn_ds_read_tr16_b64_v4i16((LAS v4i16_t*)(tile + tr_read_addr(lane, c, ks, 1))));
    return (bf16x8){lo[0], lo[1], lo[2], lo[3], hi[0], hi[1], hi[2], hi[3]};
}
__device__ __forceinline__ bf16x8 row_frag(LAS unsigned char* tile, unsigned lane, unsigned rb, unsigned s) { return *(const LAS bf16x8*)(tile + row_read_addr(lane, rb, s)); }
#define MFMA32(a, b, c) __builtin_amdgcn_mfma_f32_32x32x16_bf16((a), (b), (c), 0, 0, 0)

constexpr unsigned RT_KB = 0, RT_T2 = 32768, RT_QB = 65536, RT_VB = 98304;
__device__ __forceinline__ s16x4 ds_tr(LAS unsigned char* p) { return __builtin_bit_cast(s16x4, __builtin_amdgcn_ds_read_tr16_b64_v4i16((LAS v4i16_t*)p)); }
#define TRF(base0, base1, off) ({ const s16x4 lo_ = ds_tr(F.lds + (base0) + (off)), hi_ = ds_tr(F.lds + (base1) + (off)); (bf16x8){lo_[0], lo_[1], lo_[2], lo_[3], hi_[0], hi_[1], hi_[2], hi_[3]}; })
#define RWF(base, off) (*(const LAS bf16x8*)(F.lds + (base) + (off)))
__device__ __forceinline__ void ret_item(Frame& F, int li, int b, int head, int dir) {
    const int tid = F.tid, lane = F.lane, wave = F.wave, ib = wave & 3, eh = wave >> 2, r = lane & 31, h = lane >> 5;
    const bf16* Z = (const bf16*)FBIG; bf16* OUT = (bf16*)(FYB + (size_t)(2 + dir) * T_HALF);
    const float theta = INP(13)[((size_t)li * 2 + dir) * 4 + head];
    const float log_g = -((-theta > 20.f) ? -theta : log1pf(expf(-theta)));
    const float g1 = expf(log_g), g127 = expf(127.0f * log_g);
    const size_t rowbase = (size_t)b * TB;
    unsigned xsI[8], xsE[8];
    { const unsigned swz = ((r & 3) << 2) | ((r >> 2) & 3);
#pragma unroll
      for (int s = 0; s < 8; ++s) { const unsigned x = 256u * r + 16u * ((unsigned)(2 * s + h) ^ swz); xsI[s] = x + 8192u * ib + RT_QB; xsE[s] = x + 16384u * eh; } }
    const unsigned tK0 = RT_KB + tr_read_addr(lane, ib, 0, 0), tK1 = RT_KB + tr_read_addr(lane, ib, 0, 1);
    const unsigned tV00 = RT_VB + tr_read_addr(lane, 2 * eh, 0, 0), tV01 = RT_VB + tr_read_addr(lane, 2 * eh, 0, 1), tV10 = RT_VB + tr_read_addr(lane, 2 * eh + 1, 0, 0), tV11 = RT_VB + tr_read_addr(lane, 2 * eh + 1, 0, 1);
    __syncthreads();
    for (int it = tid; it < 2048; it += 512) *(LAS v4u*)(F.lds + RT_T2 + it * 16) = (v4u){0u, 0u, 0u, 0u};
    f32x16 SA[2]; SA[0] = f32x16{}; SA[1] = f32x16{};
    v4u pq[4], pk[4], pv[4];
#define RET_LOAD(c_) do { const int tl_ = chunk_tlo(dir, (c_)); _Pragma("unroll") for (int n_ = 0; n_ < 4; ++n_) { const int it_ = tid + 512 * n_, row_ = it_ >> 4, cn_ = it_ & 15; \
        const bf16* p_ = Z + (rowbase + tl_ + (dir == 0 ? row_ : 127 - row_)) * EV_IN + 1024 + head * 128 + cn_ * 8; pq[n_] = *(const v4u*)p_; pk[n_] = *(const v4u*)(p_ + 512); pv[n_] = *(const v4u*)(p_ + 1024); } } while (0)
    RET_LOAD(0);
#pragma nounroll
    for (int c = 0; c < 66; ++c) {
        const int t_lo = chunk_tlo(dir, c);
        __syncthreads();
#pragma unroll
        for (int n = 0; n < 4; ++n) { const int it = tid + 512 * n, row = it >> 4, cn = it & 15; const float sc = expf(-(float)row * log_g); const unsigned wo = off_b(row, cn);
            float f[8]; unpack8(pk[n], f);
#pragma unroll
            for (int k = 0; k < 8; ++k) f[k] *= sc;
            *(LAS v4u*)(F.lds + RT_QB + wo) = pq[n]; *(LAS v4u*)(F.lds + RT_KB + wo) = pack8(f); *(LAS v4u*)(F.lds + RT_VB + wo) = pv[n]; }
        if (c + 1 < 66) RET_LOAD(c + 1);
        __syncthreads();
        f32x16 OT[2], ST[2];
        OT[0] = f32x16{}; OT[1] = f32x16{}; ST[0] = f32x16{}; ST[1] = f32x16{};
#pragma unroll
        for (int s = 0; s < 8; ++s) { const bf16x8 qf = RWF(xsI[s], 0);
            OT[0] = MFMA32(RWF(xsE[s], RT_T2), qf, OT[0]); OT[1] = MFMA32(RWF(xsE[s], RT_T2 + 8192), qf, OT[1]);
            if (2 * eh <= ib) ST[0] = MFMA32(RWF(xsE[s], RT_KB), qf, ST[0]);
            if (2 * eh + 1 <= ib) ST[1] = MFMA32(RWF(xsE[s], RT_KB + 8192), qf, ST[1]); }
#pragma unroll
        for (int x = 0; x < 2; ++x)
#pragma unroll
            for (int q = 0; q < 16; ++q) SA[x][q] *= g1;
#pragma unroll
        for (int ks = 0; ks < 8; ++ks) { const bf16x8 kf = TRF(tK0, tK1, ks * 4096);
            SA[0] = MFMA32(kf, TRF(tV00, tV01, ks * 4096), SA[0]); SA[1] = MFMA32(kf, TRF(tV10, tV11, ks * 4096), SA[1]); }
#pragma unroll
        for (int x = 0; x < 2; ++x)
#pragma unroll
            for (int q = 0; q < 16; ++q) SA[x][q] *= g127;
        __syncthreads();
        const int irow = 32 * ib + r;
#pragma unroll
        for (int y = 0; y < 2; ++y) { const int jb = 2 * eh + y;
#pragma unroll
            for (int gq = 0; gq < 4; ++gq) { const int j0 = 32 * jb + 8 * gq + 4 * h; float p0 = ST[y][4 * gq], p1 = ST[y][4 * gq + 1], p2 = ST[y][4 * gq + 2], p3 = ST[y][4 * gq + 3];
                if (j0 > irow) p0 = 0.f; if (j0 + 1 > irow) p1 = 0.f; if (j0 + 2 > irow) p2 = 0.f; if (j0 + 3 > irow) p3 = 0.f;
                v2u w; w.x = cvt_pk_bf16(p0, p1); w.y = cvt_pk_bf16(p2, p3);
                *(LAS v2u*)(F.lds + RT_QB + off_b(irow, 4 * jb + gq) + 8 * h) = w; } }
#pragma unroll
        for (int x = 0; x < 2; ++x) { const int erow = 32 * (2 * eh + x) + r;
#pragma unroll
            for (int gq = 0; gq < 4; ++gq) { v2u w; w.x = cvt_pk_bf16(SA[x][4 * gq] * g1, SA[x][4 * gq + 1] * g1); w.y = cvt_pk_bf16(SA[x][4 * gq + 2] * g1, SA[x][4 * gq + 3] * g1);
                *(LAS v2u*)(F.lds + RT_T2 + off_b(erow, 4 * ib + gq) + 8 * h) = w; } }
        __syncthreads();
#pragma unroll
        for (int s = 0; s < 8; ++s) { const bf16x8 pf = RWF(xsI[s], 0);
            OT[0] = MFMA32(TRF(tV00, tV01, s * 4096), pf, OT[0]); OT[1] = MFMA32(TRF(tV10, tV11, s * 4096), pf, OT[1]); }
        { const float gi = expf((float)irow * log_g); const int t = t_lo + (dir == 0 ? irow : 127 - irow);
          bf16* op = OUT + (rowbase + t) * 512 + head * 128;
#pragma unroll
          for (int x = 0; x < 2; ++x)
#pragma unroll
              for (int gq = 0; gq < 4; ++gq) { v2u w; w.x = cvt_pk_bf16(OT[x][4 * gq] * gi, OT[x][4 * gq + 1] * gi); w.y = cvt_pk_bf16(OT[x][4 * gq + 2] * gi, OT[x][4 * gq + 3] * gi);
                  *(v2u*)(op + 32 * (2 * eh + x) + 8 * gq + 4 * h) = w; } }
    }
#undef RET_LOAD
}
#undef TRF
#undef RWF
#if DBG_SCAN
#define DBGCHK(stage, v) do { if (!(fabsf(v) < 1e30f)) atomicMax((unsigned*)(F.ws + WS_CTL) + 2049, 100u - (unsigned)(stage)); } while (0)
#else
#define DBGCHK(stage, v) do {} while (0)
#endif
__device__ __forceinline__ void s5_item(Frame& F, int li, int b, int dir, int g) {
    LAS unsigned char* lds = F.lds;
    LAS float* U = (LAS float*)lds;
    LAS float* SEG = (LAS float*)(lds + 8192);
    LAS bf16* HS = (LAS bf16*)(lds + 12288);
    const int tid = F.tid, lane = F.lane, wave = F.wave, p = tid & 63, seg = tid >> 6, fr = lane & 15, fq = lane >> 4;
    const bf16* Z = (const bf16*)FBIG; bf16* OUT = (bf16*)(FYB + (size_t)dir * T_QUART);
    const size_t pb = ((size_t)li * 2 + dir) * 16 + g;
    const float lre = INP(20)[pb * 64 + p], lim = INP(21)[pb * 64 + p], dt = expf(INP(22)[pb]);
    const float x = lre * dt, y = lim * dt, ex = expf(x); float sy, cy; sincosf(y, &sy, &cy);
    const float ar = ex * cy, ai = ex * sy;
    const float sh = sinf(0.5f * y), am1r = expm1f(x) * cy - 2.0f * sh * sh, am1i = ai;
    const float den = 1.0f / (lre * lre + lim * lim), cr = (am1r * lre + am1i * lim) * den, ci = (am1i * lre - am1r * lim) * den;
    float bbr[16], bbi[16];
#pragma unroll
    for (int k = 0; k < 16; ++k) { const float br = INP(23)[(pb * 64 + p) * 16 + k], bi = INP(24)[(pb * 64 + p) * 16 + k]; bbr[k] = cr * br - ci * bi; bbi[k] = cr * bi + ci * br; }
    DBGCHK(1, ar); DBGCHK(1, ai); DBGCHK(2, cr); DBGCHK(2, ci); DBGCHK(3, bbr[0] + bbi[0] + bbr[15] + bbi[15]);
    float a16r = ar, a16i = ai;
#pragma unroll
    for (int k = 0; k < 4; ++k) { const float tr_ = a16r * a16r - a16i * a16i, ti_ = 2.0f * a16r * a16i; a16r = tr_; a16i = ti_; }
    bf16x8 cf[4];
#pragma unroll
    for (int ks = 0; ks < 4; ++ks) { float v[8];
#pragma unroll
        for (int j = 0; j < 8; ++j) { const int k = 32 * ks + 8 * fq + j; v[j] = k < 64 ? INP(25)[(pb * 16 + fr) * 64 + k] : -INP(26)[(pb * 16 + fr) * 64 + (k - 64)]; }
        cf[ks] = __builtin_bit_cast(bf16x8, pack8(v)); }
    float hr = 0.f, hi = 0.f;
    const size_t rowbase = (size_t)b * TB;
    v4u pu = (v4u){0u, 0u, 0u, 0u};
#define S5_LOAD(c_) do { if (tid < 256) { const int tl_ = chunk_tlo(dir, (c_)), row_ = tid >> 1; pu = *(const v4u*)(Z + (rowbase + tl_ + (dir == 0 ? row_ : 127 - row_)) * OD_IN + g * 16 + (tid & 1) * 8); } } while (0)
    S5_LOAD(0);
    for (int c = 0; c < 66; ++c) {
        const int t_lo = chunk_tlo(dir, c);
        __syncthreads();
        if (tid < 256) { float f[8]; unpack8(pu, f); *(LAS f32x4*)(U + (tid >> 1) * 16 + (tid & 1) * 8) = (f32x4){f[0], f[1], f[2], f[3]}; *(LAS f32x4*)(U + (tid >> 1) * 16 + (tid & 1) * 8 + 4) = (f32x4){f[4], f[5], f[6], f[7]}; }
        if (c + 1 < 66) S5_LOAD(c + 1);
        __syncthreads();
        float lr[16], lim_[16];
        { float sr = 0.f, si = 0.f;
#pragma unroll
          for (int k = 0; k < 16; ++k) { const LAS f32x4* up = (const LAS f32x4*)(U + (seg * 16 + k) * 16); const f32x4 u0 = up[0], u1 = up[1], u2 = up[2], u3 = up[3];
              float br = bbr[0] * u0.x + bbr[1] * u0.y + bbr[2] * u0.z + bbr[3] * u0.w + bbr[4] * u1.x + bbr[5] * u1.y + bbr[6] * u1.z + bbr[7] * u1.w
                       + bbr[8] * u2.x + bbr[9] * u2.y + bbr[10] * u2.z + bbr[11] * u2.w + bbr[12] * u3.x + bbr[13] * u3.y + bbr[14] * u3.z + bbr[15] * u3.w;
              float bi = bbi[0] * u0.x + bbi[1] * u0.y + bbi[2] * u0.z + bbi[3] * u0.w + bbi[4] * u1.x + bbi[5] * u1.y + bbi[6] * u1.z + bbi[7] * u1.w
                       + bbi[8] * u2.x + bbi[9] * u2.y + bbi[10] * u2.z + bbi[11] * u2.w + bbi[12] * u3.x + bbi[13] * u3.y + bbi[14] * u3.z + bbi[15] * u3.w;
              const float nr = ar * sr - ai * si + br, ni = ar * si + ai * sr + bi; sr = nr; si = ni; lr[k] = sr; lim_[k] = si; }
          DBGCHK(4, sr + si); SEG[(seg * 64 + p) * 2] = sr; SEG[(seg * 64 + p) * 2 + 1] = si; }
        __syncthreads();
        float inr = 0.f, ini = 0.f;
#pragma unroll
        for (int s = 0; s < 8; ++s) { if (s == seg) { inr = hr; ini = hi; } const float er = SEG[(s * 64 + p) * 2], ei = SEG[(s * 64 + p) * 2 + 1];
            const float nr = a16r * hr - a16i * hi + er, ni = a16r * hi + a16i * hr + ei; hr = nr; hi = ni; }
        DBGCHK(5, hr + hi + inr + ini);
        { float pr = ar, pi = ai;
#pragma unroll
          for (int k = 0; k < 16; ++k) { const float vr = lr[k] + pr * inr - pi * ini, vi = lim_[k] + pr * ini + pi * inr;
              HS[(seg * 16 + k) * 136 + p] = (bf16)(cvt_pk_bf16(vr, 0.f) & 0xffffu); HS[(seg * 16 + k) * 136 + 64 + p] = (bf16)(cvt_pk_bf16(vi, 0.f) & 0xffffu);
              const float npr = pr * ar - pi * ai, npi = pr * ai + pi * ar; pr = npr; pi = npi; } }
        __syncthreads();
        { pg8::f32x4 acc = (pg8::f32x4){0.f, 0.f, 0.f, 0.f};
#pragma unroll
          for (int ks = 0; ks < 4; ++ks) { const bf16x8 af = *(const LAS bf16x8*)(HS + (16 * wave + fr) * 136 + 32 * ks + 8 * fq); acc = __builtin_amdgcn_mfma_f32_16x16x32_bf16(cf[ks], af, acc, 0, 0, 0); }
          DBGCHK(6, acc[0] + acc[1] + acc[2] + acc[3]);
          const int ip = 16 * wave + fr, t = t_lo + (dir == 0 ? ip : 127 - ip);
          v2u w; w.x = cvt_pk_bf16(acc[0], acc[1]); w.y = cvt_pk_bf16(acc[2], acc[3]);
          *(v2u*)(OUT + (rowbase + t) * 256 + g * 16 + 4 * fq) = w; }
    }
#undef S5_LOAD
}
namespace att {
constexpr int KVBLK = 64, LD = OD_IN;
constexpr float SCALE = 0.125f, THR = 8.f;
constexpr size_t SHM_V = KVBLK * 128 * 2, SHM_K = KVBLK * 128 * 2;
#define KSWZ(row, colB) ((row) * 256 + ((colB) ^ (((row) & 7) << 4)))
#define SBAR() __builtin_amdgcn_sched_barrier(0)
__device__ __forceinline__ int crow(int r, int hi) { return (r & 3) + 8 * (r >> 2) + 4 * hi; }
__device__ __forceinline__ void partialSM(f32x16& p0, f32x16& p1, float& m_reg, float& mn, float& alpha) {
  constexpr float C = SCALE * 1.4426950408889634f;
  float pmax = p0[0];
#pragma unroll
  for (int r = 1; r < 16; ++r) pmax = fmaxf(pmax, p0[r]);
#pragma unroll
  for (int r = 0; r < 16; ++r) pmax = fmaxf(pmax, p1[r]);
  { auto rr = __builtin_amdgcn_permlane32_swap(__float_as_uint(pmax), __float_as_uint(pmax), false, false);
    pmax = fmaxf(__uint_as_float(rr[0]), __uint_as_float(rr[1])); }
  if (__builtin_expect(__all(pmax - m_reg <= THR / SCALE), 1)) { mn = m_reg; alpha = 1.f; }
  else { mn = fmaxf(m_reg, pmax); alpha = __builtin_amdgcn_exp2f((m_reg - mn) * C); m_reg = mn; }
  const float mnC = -mn * C;
#pragma unroll
  for (int r = 0; r < 16; ++r) p0[r] = fmaf(p0[r], C, mnC);
#pragma unroll
  for (int r = 0; r < 16; ++r) p1[r] = fmaf(p1[r], C, mnC);
#pragma unroll
  for (int r = 0; r < 16; ++r) p0[r] = __builtin_amdgcn_exp2f(p0[r]);
}
__device__ __forceinline__ void finishSM(f32x16& p0, f32x16& p1, float alpha, float& l_reg, bf16x8& pa0, bf16x8& pa1, bf16x8& pa2, bf16x8& pa3) {
#pragma unroll
  for (int r = 0; r < 16; ++r) p1[r] = __builtin_amdgcn_exp2f(p1[r]);
  float ps = 0;
#pragma unroll
  for (int r = 0; r < 16; ++r) ps += p0[r];
#pragma unroll
  for (int r = 0; r < 16; ++r) ps += p1[r];
  { auto rr = __builtin_amdgcn_permlane32_swap(__float_as_uint(ps), __float_as_uint(ps), false, false);
    ps = __uint_as_float(rr[0]) + __uint_as_float(rr[1]); }
  l_reg = l_reg * alpha + ps;
#define PK4(P, BASE, OUT) do { unsigned a0 = cvt_pk_bf16(P[BASE + 0], P[BASE + 1]), a1 = cvt_pk_bf16(P[BASE + 2], P[BASE + 3]);   \
    unsigned b0 = cvt_pk_bf16(P[BASE + 4], P[BASE + 5]), b1 = cvt_pk_bf16(P[BASE + 6], P[BASE + 7]);                              \
    auto r0 = __builtin_amdgcn_permlane32_swap(a0, b0, false, false); auto r1 = __builtin_amdgcn_permlane32_swap(a1, b1, false, false); \
    v4u w = {r0[0], r1[0], r0[1], r1[1]}; OUT = __builtin_bit_cast(bf16x8, w); } while (0)
  PK4(p0, 0, pa0); PK4(p0, 8, pa1); PK4(p1, 0, pa2); PK4(p1, 8, pa3);
#undef PK4
}
__device__ __forceinline__ void qkt(f32x16& p0, f32x16& p1, const char* Ks, const bf16x8* qr, int r32, int hi, int mapoff) {
  p0 = f32x16{}; p1 = f32x16{};
#pragma unroll
  for (int d0 = 0; d0 < 4; ++d0) { const int cb = mapoff + (d0 * 16 + hi * 8) * 2;
    const bf16x8 b0 = *reinterpret_cast<const bf16x8*>(Ks + KSWZ(r32, cb));
    const bf16x8 b1 = *reinterpret_cast<const bf16x8*>(Ks + KSWZ(32 + r32, cb));
    p0 = __builtin_amdgcn_mfma_f32_32x32x16_bf16(b0, qr[d0], p0, 0, 0, 0);
    p1 = __builtin_amdgcn_mfma_f32_32x32x16_bf16(b1, qr[d0], p1, 0, 0, 0); }
}
__device__ __forceinline__ int v_st(int k, int c) { const int kk = (k & ~0xC) | ((k & 4) << 1) | ((k & 8) >> 1); return ((kk >> 3) * 4 + (c >> 5)) * 512 + ((kk & 7) * 32 + (c & 31)) * 2; }
__device__ __forceinline__ int v_rd_base(int lane) { return ((lane & 3) << 3) | (((lane >> 2) & 3) << 6) | (((lane >> 4) & 1) << 5) | (((lane >> 5) & 1) << 8); }
constexpr int v_rd_off(int d0, int ks, int half) { return d0 * 512 + ks * 4096 + half * 2048; }
template <int OFF> __device__ __forceinline__ s16x4 tr_read(int vb) {
  s16x4 r; asm volatile("ds_read_b64_tr_b16 %0, %1 offset:%2" : "=&v"(r) : "v"(vb), "i"(OFF) : "memory"); return r;
}
template <int D0> __device__ __forceinline__ void pv_one(f32x16& od, int vb, bf16x8 pa0, bf16x8 pa1, bf16x8 pa2, bf16x8 pa3) {
  const s16x4 l0 = tr_read<v_rd_off(D0, 0, 0)>(vb), h0 = tr_read<v_rd_off(D0, 0, 1)>(vb), l1 = tr_read<v_rd_off(D0, 1, 0)>(vb), h1 = tr_read<v_rd_off(D0, 1, 1)>(vb);
  const s16x4 l2 = tr_read<v_rd_off(D0, 2, 0)>(vb), h2 = tr_read<v_rd_off(D0, 2, 1)>(vb), l3 = tr_read<v_rd_off(D0, 3, 0)>(vb), h3 = tr_read<v_rd_off(D0, 3, 1)>(vb);
  asm volatile("s_waitcnt lgkmcnt(0)" ::: "memory"); SBAR();
#define PK(L, H) (bf16x8){L[0], L[1], L[2], L[3], H[0], H[1], H[2], H[3]}
  od = __builtin_amdgcn_mfma_f32_32x32x16_bf16(pa0, PK(l0, h0), od, 0, 0, 0);
  od = __builtin_amdgcn_mfma_f32_32x32x16_bf16(pa1, PK(l1, h1), od, 0, 0, 0);
  od = __builtin_amdgcn_mfma_f32_32x32x16_bf16(pa2, PK(l2, h2), od, 0, 0, 0);
  od = __builtin_amdgcn_mfma_f32_32x32x16_bf16(pa3, PK(l3, h3), od, 0, 0, 0);
#undef PK
}
__device__ __forceinline__ void pv_d0(f32x16* o, int vb, bf16x8 pa0, bf16x8 pa1, bf16x8 pa2, bf16x8 pa3) {
  pv_one<0>(o[0], vb, pa0, pa1, pa2, pa3); pv_one<1>(o[1], vb, pa0, pa1, pa2, pa3); pv_one<2>(o[2], vb, pa0, pa1, pa2, pa3); pv_one<3>(o[3], vb, pa0, pa1, pa2, pa3);
}
__device__ __forceinline__ void unit(const bf16* __restrict__ Qb, const bf16* __restrict__ Kh, const bf16* __restrict__ Vh, bf16* __restrict__ Ob, int seq, char* lds,
                                     float lam, float gsc, const float* __restrict__ gn, const int tid) {
  const int wid = tid >> 6, lane = tid & 63, r32 = lane & 31, hi = lane >> 5, map = wid >> 2, wq = wid & 3;
  char* V_lds = lds; char* K_lds = lds + 2 * SHM_V;
  float* ws = (float*)(lds + 2 * SHM_V + 2 * SHM_K) + wid * 64; float* li_l = ws; float* al_l = ws + 32;
  float m_reg = -1e30f, l_reg = 0; f32x16 o[4] = {}; bf16x8 qr[4];
  const bf16* Qw = Qb + (long)(wq * 32 + r32) * LD + map * 64 + hi * 8;
#pragma unroll
  for (int d0 = 0; d0 < 4; ++d0) qr[d0] = *reinterpret_cast<const bf16x8*>(Qw + d0 * 16);
  const int sr = tid >> 4, sc = (tid & 15) * 8, vst0 = v_st(sr, sc), vst1 = v_st(32 + sr, sc);
  const int vb0 = (int)(uintptr_t)V_lds + v_rd_base(lane);
  const int mapoff = map * 128;
  struct { bf16x8 vs0, vs1, ks0, ks1; } sr_[1];
  const unsigned go0 = (unsigned)(sr * LD + sc) * 2u, go1 = (unsigned)((32 + sr) * LD + sc) * 2u;
#define SLOAD(i, k0) do { const char* vb_ = (const char*)Vh + (size_t)(k0) * (LD * 2); const char* kb_ = (const char*)Kh + (size_t)(k0) * (LD * 2); \
    sr_[i].vs0 = *reinterpret_cast<const bf16x8*>(vb_ + go0); sr_[i].vs1 = *reinterpret_cast<const bf16x8*>(vb_ + go1); \
    sr_[i].ks0 = *reinterpret_cast<const bf16x8*>(kb_ + go0); sr_[i].ks1 = *reinterpret_cast<const bf16x8*>(kb_ + go1); } while (0)
#define SWRITE(b, i) do { *(bf16x8*)(V_lds + (b) * SHM_V + vst0) = sr_[i].vs0;          \
    *(bf16x8*)(V_lds + (b) * SHM_V + vst1) = sr_[i].vs1; const int kc = sc * 2;               \
    *(bf16x8*)(K_lds + (b) * SHM_K + KSWZ(sr, kc)) = sr_[i].ks0;                       \
    *(bf16x8*)(K_lds + (b) * SHM_K + KSWZ(32 + sr, kc)) = sr_[i].ks1; } while (0)
#define SWAIT() asm volatile("s_waitcnt vmcnt(0)" ::: "memory")
#define RESC(a) do { if (__any((a) < 1.f)) { if (hi == 0) al_l[r32] = (a); asm volatile("s_waitcnt lgkmcnt(0)" ::: "memory"); \
    _Pragma("unroll") for (int d = 0; d < 4; ++d) _Pragma("unroll") for (int r = 0; r < 16; ++r) o[d][r] *= al_l[crow(r, hi)]; } } while (0)
  f32x16 pA0, pA1, pB0, pB1; float mnA, mnB, alA, alB; bf16x8 pa0, pa1, pa2, pa3; const int NT = seq / KVBLK;
  constexpr int SE = 0, SO = 0;
  SLOAD(SE, 0); asm volatile("s_waitcnt vmcnt(0)" ::: "memory"); SWRITE(0, SE); __syncthreads();
  qkt(pA0, pA1, K_lds, qr, r32, hi, mapoff); partialSM(pA0, pA1, m_reg, mnA, alA);
  SLOAD(SO, KVBLK);
  SWAIT(); SWRITE(1, SO); __syncthreads();
  for (int j = 1; j + 1 < NT; j += 2) {
    SBAR(); qkt(pB0, pB1, K_lds + SHM_K, qr, r32, hi, mapoff);
    finishSM(pA0, pA1, alA, l_reg, pa0, pa1, pa2, pa3); SBAR();
    SLOAD(SO, (j + 1) * KVBLK); SBAR();
    pv_d0(o, vb0, pa0, pa1, pa2, pa3); partialSM(pB0, pB1, m_reg, mnB, alB);
    __syncthreads(); SWAIT(); SWRITE(0, SE);
    RESC(alB); __syncthreads();
    SBAR(); qkt(pA0, pA1, K_lds, qr, r32, hi, mapoff);
    finishSM(pB0, pB1, alB, l_reg, pa0, pa1, pa2, pa3); SBAR();
    SLOAD(SE, (j + 2) * KVBLK); SBAR();
    pv_d0(o, vb0 + (int)SHM_V, pa0, pa1, pa2, pa3); partialSM(pA0, pA1, m_reg, mnA, alA);
    __syncthreads(); SWAIT(); SWRITE(1, SO);
    RESC(alA); __syncthreads();
  }
  SBAR(); qkt(pB0, pB1, K_lds + SHM_K, qr, r32, hi, mapoff);
  finishSM(pA0, pA1, alA, l_reg, pa0, pa1, pa2, pa3); SBAR();
  pv_d0(o, vb0, pa0, pa1, pa2, pa3); partialSM(pB0, pB1, m_reg, mnB, alB);
  __syncthreads(); RESC(alB);
  finishSM(pB0, pB1, alB, l_reg, pa0, pa1, pa2, pa3); SBAR();
  pv_d0(o, vb0 + (int)SHM_V, pa0, pa1, pa2, pa3);
  if (hi == 0) li_l[r32] = l_reg; asm volatile("s_waitcnt lgkmcnt(0)" ::: "memory");
  float rli[16];
#pragma unroll
  for (int r = 0; r < 16; ++r) rli[r] = __builtin_amdgcn_rcpf(li_l[crow(r, hi)]);
  __syncthreads();
  int zz = 0; asm volatile("" : "+v"(zz));
  float* EX = (float*)lds;
  const int eb = wq * 4096 + lane + zz;
  if (map == 1) {
#pragma unroll
    for (int d0 = 0; d0 < 4; ++d0)
#pragma unroll
      for (int r = 0; r < 16; ++r) EX[eb + (d0 * 16 + r) * 64] = -lam * o[d0][r] * rli[r];
  }
  __syncthreads();
  if (map == 0) {
    float ss[16];
#pragma unroll
    for (int r = 0; r < 16; ++r) ss[r] = 0.f;
#pragma unroll
    for (int d0 = 0; d0 < 4; ++d0)
#pragma unroll
      for (int r = 0; r < 16; ++r) { const float v = o[d0][r] * rli[r] + EX[eb + (d0 * 16 + r) * 64]; o[d0][r] = v; ss[r] += v * v; }
#pragma unroll
    for (int r = 0; r < 16; ++r) { float s = ss[r]; s += __shfl_xor(s, 1); s += __shfl_xor(s, 2); s += __shfl_xor(s, 4); s += __shfl_xor(s, 8); s += __shfl_xor(s, 16);
      ss[r] = gsc / sqrtf(s * (1.0f / 128.0f) + EPS); }
    bf16* Ow = Ob + (long)(wq * 32 + 4 * hi) * 1024 + r32 + zz;
#pragma unroll
    for (int d0 = 0; d0 < 4; ++d0) { const float gv = gn[d0 * 32 + r32];
#pragma unroll
      for (int r = 0; r < 16; ++r) Ow[((r & 3) + 8 * (r >> 2)) * 1024 + d0 * 32] = (bf16)(cvt_pk_bf16(o[d0][r] * ss[r] * gv, 0.f) & 0xffffu); }
  }
  __syncthreads();
#undef SLOAD
#undef SWRITE
#undef SWAIT
#undef RESC
}
#undef KSWZ
#undef SBAR
}
__device__ __forceinline__ void ph_mix_even(Frame& F, int i) {
    for (int it = F.bid; it < 192; it += F.G) { LAUNDER(F);
#ifndef NO_RET
        if (it < 64) ret_item(F, i, it >> 3, (it >> 1) & 3, it & 1);
#endif
#ifndef NO_LRU
        if (it >= 64) { const int j = it - 64; lru_item(F, i, j >> 4, (j >> 3) & 1, j & 7); }
#endif
        __syncthreads();
    }
}
__device__ __forceinline__ void ph_mix_odd(Frame& F, int l, int ctx_out) {
    const int i = l >> 1;
#ifndef NO_S5
    for (int it = F.bid; it < 256; it += F.G) { LAUNDER(F); s5_item(F, i, it >> 5, (it >> 4) & 1, it & 15); __syncthreads(); }
#endif
    const float* lp = INP(30) + (size_t)i * 256;
    const float s01 = wave_sum(lp[F.lane] * lp[64 + F.lane]), s23 = wave_sum(lp[128 + F.lane] * lp[192 + F.lane]);
    const float lam_init = 0.8f - 0.6f * expf(-0.3f * (float)l), lam = expf(s01) - expf(s23) + lam_init, gsc = 1.0f - lam_init;
    const bf16* Z = (const bf16*)FBIG; const float* gn = INP(31) + (size_t)i * 768;
    const int vcu = (F.G % 8 == 0) ? (F.bid % 8) * (F.G / 8) + F.bid / 8 : F.bid;
    const int nx = NB * 6 * 64, nc = ctx_out ? NB * 6 * 2 : 0;
    for (int u = vcu; u < nx + nc; u += F.G) { LAUNDER(F);
        int bh, qb, row0, seq;
        if (u < nx) { bh = u >> 6; qb = u & 63; row0 = (bh / 6) * TB + CTXL + 128 * qb; seq = TB; }
        else { const int v = u - nx; bh = v >> 1; qb = v & 1; row0 = (bh / 6) * TB + 128 * qb; seq = CTXL; }
        const int b = bh / 6, h = bh % 6;
#ifndef NO_ATTN
        att::unit(Z + (size_t)row0 * OD_IN + 256 + h * 128, Z + (size_t)b * TB * OD_IN + 1024 + h * 128, Z + (size_t)b * TB * OD_IN + 1792 + h * 128,
                  FH + (size_t)row0 * D + 256 + h * 128, seq, (char*)F.lds, lam, gsc, gn + h * 128, F.tid);
#endif
    }
}

constexpr int PH_PER_LAYER = 18, PH_TOTAL = 2 + NLAYER * PH_PER_LAYER;
#define IN(k) (lo <= (k) && (k) < hi)
#define SEAM(k) do { if (IN((k) + 1)) xcd_barrier(bar); } while (0)
template <int l> __device__ __forceinline__ void run_layer(Frame& F, const XcdBarrier& bar, const int lo, const int hi) {
        constexpr int P = 1 + PH_PER_LAYER * l, i = l >> 1; constexpr bool odd = l & 1; constexpr int ctx_out = l < NLAYER - 1;
        const float* MODl = FMOD + (size_t)l * 9 * 6144; const float* ng = INP(6) + (size_t)l * 4 * 1024;
        if (IN(P + 0)) { LAUNDER(F);
            ph_convert(F, l);
            NormArgs a{}; a.xin_input = (l == 0); a.has_y = (l > 0); a.two = (l > 0) && ((l - 1) & 1); a.write_x = (l > 0); a.final_ = 0; a.do_h = 1; a.do_route = 0;
            if (l > 0) { a.gate = FMOD + (size_t)(l - 1) * 9 * 6144 + 5 * 1024; a.gy = INP(6) + (size_t)(l - 1) * 4 * 1024 + 3 * 1024; }
            a.gh = ng; a.shift = MODl; a.scale = MODl + 1024;
            __syncthreads(); ph_norm(F, a); SEAM(P + 0);
        }
        if (IN(P + 1)) { LAUNDER(F);
            const int N = odd ? OD_IN : EV_IN;
            pg8::Gemm g{FH, FWB + W_IN / 2, M, N, D}; pg8::StaticOrder S; S.init(M, N, F.G, F.bid);
            pg8::EpiPlain E{(bf16*)FBIG, N};
            pg8::gemm_phase<pg8::EpiPlain, pg8::StaticOrder, true, true>(F.lds, g, S, E, F.tid);
            SEAM(P + 1);
        }
        if (IN(P + 2)) { LAUNDER(F); ph_rope(F, odd); SEAM(P + 2); }
        if (IN(P + 3)) { LAUNDER(F); if (!odd) ph_mix_even(F, i); else ph_mix_odd(F, l, ctx_out); SEAM(P + 3); }
        if (IN(P + 4)) { LAUNDER(F); if (!odd) ph_merge_even(F, i); else ph_zpass(F, i); SEAM(P + 4); }
        if (odd && IN(P + 5)) { LAUNDER(F);
            int kglu = 256; asm volatile("" : "+s"(kglu));
            pg8::Gemm g{(const bf16*)(FYB + 2 * T_QUART), FWB + W_GLU / 2, M, 256, kglu}; pg8::StaticOrder S; S.init(M, 256, F.G, F.bid);
            pg8::EpiGLU E{FH, D, (const bf16*)(FYB + 2 * T_QUART), 256, INP(29) + (size_t)i * 256};
            pg8::gemm_phase<pg8::EpiGLU, pg8::StaticOrder, true, true>(F.lds, g, S, E, F.tid);
            SEAM(P + 5);
        }
        if (IN(P + 6)) { LAUNDER(F);
            pg8::Gemm g{FH, FWB + W_OUT / 2, M, D, D}; pg8::StaticOrder S; S.init(M, D, F.G, F.bid);
            pg8::EpiPlain E{(bf16*)FYB, D};
            pg8::gemm_phase<pg8::EpiPlain, pg8::StaticOrder, true, true>(F.lds, g, S, E, F.tid);
            SEAM(P + 6);
        }
        if (IN(P + 7)) { LAUNDER(F);
            NormArgs a{}; a.xin_input = (l == 0); a.has_y = 1; a.two = 0; a.write_x = 1; a.final_ = 0; a.do_h = 1; a.do_route = odd;
            a.gate = MODl + 2 * 1024; a.gy = ng + 1024; a.gh = ng + 2 * 1024; a.shift = MODl + 3 * 1024; a.scale = MODl + 4 * 1024;
            a.rw = INP(33) + (size_t)i * 8192; a.rb = INP(34) + (size_t)i * 8;
            ph_norm(F, a); SEAM(P + 7);
        }
        if (!odd) {
            if (IN(P + 9)) { LAUNDER(F);
                pg8::Gemm g{FH, FWB + W_GU / 2, M, 2 * DFF, D}; pg8::StaticOrder S; S.init(M, 2 * DFF, F.G, F.bid);
                pg8::EpiSwiGLU E{(bf16*)(FBIG + BIG_ACT), DFF};
                pg8::gemm_phase<pg8::EpiSwiGLU, pg8::StaticOrder, true, true>(F.lds, g, S, E, F.tid);
                SEAM(P + 9);
            }
            if (IN(P + 10)) { LAUNDER(F);
                pg8::Gemm g{(const bf16*)(FBIG + BIG_ACT), FWB + W_DN / 2, M, D, DFF}; pg8::StaticOrder S; S.init(M, D, F.G, F.bid);
                pg8::EpiPlain E{(bf16*)FYB, D};
                pg8::gemm_phase<pg8::EpiPlain, pg8::StaticOrder, true, true>(F.lds, g, S, E, F.tid);
                SEAM(P + 10);
            }
        } else {
            if (IN(P + 8)) { LAUNDER(F); ph_assign(F); SEAM(P + 8); }
#pragma nounroll
            for (int w = 0; w < 3; ++w) {
                const int* PE = (const int*)(F.ws + WS_PEXP);
                if (IN(P + 9 + 3 * w)) { LAUNDER(F); const int np = PE[MAXP], p0 = min(np, PW * w), p1 = min(np, PW * (w + 1)); ph_gather(F, p0, p1); SEAM(P + 9 + 3 * w); }
                if (IN(P + 10 + 3 * w)) { LAUNDER(F); const int np = PE[MAXP], p0 = min(np, PW * w), p1 = min(np, PW * (w + 1));
                    pg8::Gemm g{(const bf16*)(FBIG + BIG_HG), FWB + W_MGU / 2, (p1 - p0) * 256, 2 * DFF, D};
                    pg8::ExpertOrder S; S.init((p1 - p0) * 256, 2 * DFF, F.G, F.bid); S.pexp = PE + p0; S.estride = (size_t)7168 * 1024 * 2;
                    pg8::EpiSwiGLU E{(bf16*)(FBIG + BIG_ACT), DFF};
                    pg8::gemm_phase<pg8::EpiSwiGLU, pg8::ExpertOrder, true, true>(F.lds, g, S, E, F.tid);
                    SEAM(P + 10 + 3 * w); }
                if (IN(P + 11 + 3 * w)) { LAUNDER(F); const int np = PE[MAXP], p0 = min(np, PW * w), p1 = min(np, PW * (w + 1));
                    pg8::Gemm g{(const bf16*)(FBIG + BIG_ACT), FWB + W_MDN / 2, (p1 - p0) * 256, D, DFF};
                    pg8::ExpertOrder S; S.init((p1 - p0) * 256, D, F.G, F.bid); S.pexp = PE + p0; S.estride = (size_t)1024 * 3584 * 2;
                    pg8::EpiScatter E{(const RouteEnt*)(F.ws + WS_LIST) + (size_t)p0 * 256, (bf16*)FYB, (size_t)M * 1024, D};
                    pg8::gemm_phase<pg8::EpiScatter, pg8::ExpertOrder, true, true>(F.lds, g, S, E, F.tid);
                    SEAM(P + 11 + 3 * w); }
            }
        }
    }
#undef IN
#undef SEAM
__global__ void __launch_bounds__(512, 2) hybrid_fwd(Args args) {
    extern __shared__ __attribute__((aligned(16))) unsigned char lds_raw[];
    Frame F;
    F.lds = (LAS unsigned char*)lds_raw; F.ws = args.ws;
    F.tid = threadIdx.x; F.lane = F.tid & 63; F.wave = __builtin_amdgcn_readfirstlane(F.tid >> 6); F.G = gridDim.x; F.bid = blockIdx.x;
    F.A = (KArgs*)__builtin_amdgcn_kernarg_segment_ptr();
    volatile LAS unsigned* MISC = (volatile LAS unsigned*)(F.lds + MISC_OFF);
    for (int u = F.tid; u < (LDS_BYTES - LDSCTL_OFF) / 4; u += 512) ((LAS unsigned*)(F.lds + LDSCTL_OFF))[u] = 0u;
    __syncthreads();
    const int lo = args.ph_lo, hi = args.ph_hi;
    const bool multi = (hi - lo) > 1;
    unsigned* ctl = (unsigned*)(args.ws + WS_CTL);
    XcdBarrier bar; bar.bar = ctl + CW_BAR; bar.x = 0; bar.st = nullptr;
    if (multi) bar = xcd_barrier_post(ctl + CW_BAR, MISC + 8);
#define IN(k) (lo <= (k) && (k) < hi)
#define SEAM(k) do { if (IN((k) + 1)) xcd_barrier(bar); } while (0)
    if (IN(0)) { LAUNDER(F); ph_prologue(F); SEAM(0); }
    run_layer<0>(F, bar, lo, hi); run_layer<1>(F, bar, lo, hi); run_layer<2>(F, bar, lo, hi); run_layer<3>(F, bar, lo, hi);
    if (IN(PH_TOTAL - 1)) { LAUNDER(F);
        NormArgs a{}; a.xin_input = 0; a.has_y = 1; a.two = 1; a.write_x = 1; a.final_ = 1; a.do_h = 0; a.do_route = 0;
        a.gate = FMOD + (size_t)3 * 9 * 6144 + 5 * 1024; a.gy = INP(6) + (size_t)3 * 4 * 1024 + 3 * 1024;
        ph_norm(F, a);
    }
#undef IN
#undef SEAM
}


#ifndef DBG_SCAN
#define DBG_SCAN 0
#endif
#if DBG_SCAN
constexpr int CW_DBG = 2048;
__global__ void __launch_bounds__(256) dbg_scan(unsigned char* ws, const float* out, int phase) {
    unsigned* flag = (unsigned*)(ws + WS_CTL) + CW_DBG; bool bad = false;
    const size_t gt = (size_t)blockIdx.x * 256 + threadIdx.x, gs = (size_t)gridDim.x * 256;
    { const uint4* p = (const uint4*)(ws + WS_W); const size_t n = (WS_END - WS_W) / 16;
      for (size_t i = gt; i < n; i += gs) { const uint4 v = p[i]; const unsigned w[4] = {v.x, v.y, v.z, v.w};
#pragma unroll
          for (int k = 0; k < 4; ++k) { if ((w[k] & 0x7F80u) == 0x7F80u || (w[k] & 0x7F800000u) == 0x7F800000u) bad = true; } } }
    { const uint4* p = (const uint4*)(ws + WS_XC); const size_t n = (size_t)NB * CTXL * D / 4;
      for (size_t i = gt; i < n; i += gs) { const uint4 v = p[i]; if ((v.x & 0x7F800000u) == 0x7F800000u || (v.y & 0x7F800000u) == 0x7F800000u || (v.z & 0x7F800000u) == 0x7F800000u || (v.w & 0x7F800000u) == 0x7F800000u) bad = true; } }
    { const uint4* p = (const uint4*)out; const size_t n = (size_t)NB * SEQ * D / 4;
      for (size_t i = gt; i < n; i += gs) { const uint4 v = p[i]; if ((v.x & 0x7F800000u) == 0x7F800000u || (v.y & 0x7F800000u) == 0x7F800000u || (v.z & 0x7F800000u) == 0x7F800000u || (v.w & 0x7F800000u) == 0x7F800000u) bad = true; } }
    { const unsigned* p = (const unsigned*)(ws + WS_MOD); const size_t n = 4 * 9 * 6144;
      for (size_t i = gt; i < n; i += gs) if ((p[i] & 0x7F800000u) == 0x7F800000u) bad = true; }
    if (bad) atomicMax(flag, 1000u - (unsigned)phase);
}
__global__ void __launch_bounds__(256) dbg_emit(unsigned char* ws, float* out) {
    const unsigned f = ((const unsigned*)(ws + WS_CTL))[CW_DBG], f2 = ((const unsigned*)(ws + WS_CTL))[CW_DBG + 1]; if (f == 0u && f2 == 0u) return;
    const int p = f2 ? 40 + (100 - (int)f2) : 1000 - (int)f;
    const size_t n = (size_t)NB * SEQ * D;
    for (size_t i = (size_t)blockIdx.x * 256 + threadIdx.x; i < n; i += (size_t)gridDim.x * 256) out[i] = (i == 0) ? ldexpf(1.0f, 14 + p) : 0.f;
}
#endif
static bool phase_exists(int ph) {
    if (ph == 0 || ph == PH_TOTAL - 1) return true;
    const int l = (ph - 1) / PH_PER_LAYER, k = (ph - 1) % PH_PER_LAYER; const bool odd = l & 1;
    if (odd) return true;
    return k <= 4 || k == 6 || k == 7 || k == 9 || k == 10;
}
#ifndef MK_ONE_LAUNCH
#define MK_ONE_LAUNCH 0
#endif
extern "C" void kernel_launch(void* const* d_in, const int* in_sizes, int n_in, void* d_out, int out_size, void* d_ws, size_t ws_size, hipStream_t stream) {
    static int grid = 0;
    if (grid == 0) {
        if (n_in != 38 || in_sizes[0] != NB * SEQ * D || out_size != NB * SEQ * D || ws_size < WS_END) { fprintf(stderr, "kernel_launch: unexpected shapes / workspace (%d inputs, ws %zu)\n", n_in, ws_size); grid = -1; return; }
        int dev = 0, cus = 0, per_cu = 0;
        if (hipGetDevice(&dev) != hipSuccess || hipDeviceGetAttribute(&cus, hipDeviceAttributeMultiprocessorCount, dev) != hipSuccess) { grid = -1; return; }
        if (hipFuncSetAttribute((const void*)hybrid_fwd, hipFuncAttributeMaxDynamicSharedMemorySize, LDS_BYTES) != hipSuccess) { fprintf(stderr, "kernel_launch: hipFuncSetAttribute failed\n"); grid = -1; return; }
        if (hipOccupancyMaxActiveBlocksPerMultiprocessor(&per_cu, (const void*)hybrid_fwd, 512, LDS_BYTES) != hipSuccess || per_cu < 1) fprintf(stderr, "kernel_launch: occupancy query reports %d workgroups per CU\n", per_cu);
        (void)hipGetLastError();
        grid = cus;
    }
    if (grid < 0) return;
    if (hipMemsetAsync((char*)d_ws + WS_CTL, 0, CTL_ZERO_BYTES, stream) != hipSuccess) return;
#if DBG_SCAN
    (void)hipMemsetAsync(d_ws, 0, WS_END, stream); (void)hipMemsetAsync(d_out, 0, (size_t)out_size * 4, stream);
#endif
    Args a{};
    for (int i = 0; i < 38; ++i) a.in[i] = (const float*)d_in[i];
    a.out = (float*)d_out; a.ws = (unsigned char*)d_ws;
    if (MK_ONE_LAUNCH) { a.ph_lo = 0; a.ph_hi = PH_TOTAL; hipLaunchKernelGGL(hybrid_fwd, dim3(grid), dim3(512), LDS_BYTES, stream, a); }
    else for (int ph = 0; ph < PH_TOTAL; ++ph) { if (!phase_exists(ph)) continue; a.ph_lo = ph; a.ph_hi = ph + 1; hipLaunchKernelGGL(hybrid_fwd, dim3(grid), dim3(512), LDS_BYTES, stream, a);
#if DBG_SCAN
        hipLaunchKernelGGL(dbg_scan, dim3(2048), dim3(256), 0, stream, (unsigned char*)d_ws, (const float*)d_out, ph);
#endif
    }
#if DBG_SCAN
    hipLaunchKernelGGL(dbg_emit, dim3(2048), dim3(256), 0, stream, (unsigned char*)d_ws, (float*)d_out);
#endif
    const hipError_t le = hipPeekAtLastError();
    if (le != hipSuccess) fprintf(stderr, "kernel_launch: launch failed: %s\n", hipGetErrorName(le));
}
```

```cpp
#include <hip/hip_runtime.h>
#include <cstdio>
#include <cstdint>
#include <cmath>
#define DBG_SCAN 0
namespace pg8 {
#define PG8_LAS __attribute__((address_space(3)))
typedef unsigned short bf16_t;
typedef short bf16x8 __attribute__((ext_vector_type(8)));
typedef float f32x4 __attribute__((ext_vector_type(4)));
typedef unsigned u32x4 __attribute__((ext_vector_type(4)));
constexpr int BM = 256, BK = 64, HALF = 128, HTB = HALF * BK * 2  , STAGE_BYTES = 8 * HTB, NXCD = 8, WGM = 8;

__host__ __device__ __forceinline__ int lds_byte(int r, int c) { const int st = (r >> 4) * 2 + (c >> 5), rr = r & 15, cc = c & 31, ob = rr * 64 + cc * 2; return st * 1024 + (ob ^ (((ob >> 9) & 1) << 5)); }
__host__ __device__ __forceinline__ void stage_rc(int b, int& R, int& C) { const int st = b / 1024, sb = b % 1024, swz = sb ^ (((sb >> 9) & 1) << 5); R = (st >> 1) * 16 + swz / 64; C = (st & 1) * 32 + (swz % 64) / 2; }
__host__ __device__ __forceinline__ int perm32(int rho) { const int n = rho >> 4, i = rho & 15; return 8 * (i >> 2) + 4 * n + (i & 3); }

struct Unit { int pm, pn; };
struct Gemm { const bf16_t* A; const bf16_t* Bt; int M, N, K; };

typedef float f32x2_cv __attribute__((ext_vector_type(2))); typedef __bf16 bf16x2_cv __attribute__((ext_vector_type(2)));
__device__ __forceinline__ unsigned cvt_pk_bf16(float lo, float hi) { const f32x2_cv v = {lo, hi}; const bf16x2_cv b = __builtin_convertvector(v, bf16x2_cv); return __builtin_bit_cast(unsigned, b); }
struct StaticOrder {
    int nM, nN, nwg, G, c;
    __host__ __device__ void init(int M, int N, int G_, int c_) { nM = M / BM; nN = N / BM; nwg = nM * nN; G = G_; c = c_; }
    __host__ __device__ bool next(int i, Unit& u) const {
        const long L = (long)i * G + c; if (L >= nwg) return false;
        int wgid = (int)L; { const int q = nwg / NXCD, r = nwg % NXCD, xcd = wgid % NXCD, off = wgid / NXCD; wgid = (xcd < r ? xcd * (q + 1) : r * (q + 1) + (xcd - r) * q) + off; }
        const int nig = WGM * nN, gid = wgid / nig, fm = gid * WGM, gsz = (nM - fm) < WGM ? (nM - fm) : WGM;
        u.pm = fm + ((wgid % nig) % gsz); u.pn = (wgid % nig) / gsz; return true;
    }
    __device__ __forceinline__ const char* bptr(const Gemm& g, const Unit& u) const { return (const char*)g.Bt + (size_t)u.pn * ((size_t)BM * g.K * 2); }
    __device__ __forceinline__ void a_ready(const Unit&) const {}
    __device__ __forceinline__ void done(const Unit&) const {}
};
struct ExpertOrder : StaticOrder {
    const int* pexp; size_t estride;
    __device__ __forceinline__ const char* bptr(const Gemm& g, const Unit& u) const { return (const char*)g.Bt + (size_t)pexp[u.pm] * estride + (size_t)u.pn * ((size_t)BM * g.K * 2); }
};
__device__ __forceinline__ float fast_sigmoid(float x) { return __builtin_amdgcn_rcpf(1.0f + __builtin_amdgcn_exp2f(-1.4426950408889634f * x)); }
__device__ __forceinline__ float bflo(unsigned w) { return __uint_as_float(w << 16); }
__device__ __forceinline__ float bfhi(unsigned w) { return __uint_as_float(w & 0xffff0000u); }
struct EpiPlain {
    static constexpr bool PERM = true, AFTER_DRAIN = false;
    bf16_t* O; int ldc;
    __device__ __forceinline__ void operator()(const f32x4 (&acc)[2][2][4][2], const Unit& u, int wr, int wc, int fr, int fq) const {
        const int row0 = u.pm * BM + wr * 64 + fr, col0 = u.pn * BM + wc * 32 + 8 * fq;
#pragma unroll
        for (int ai = 0; ai < 2; ++ai)
#pragma unroll
            for (int m = 0; m < 4; ++m) { bf16_t* rowp = O + (size_t)(row0 + ai * HALF + m * 16) * ldc + col0;
#pragma unroll
                for (int bj = 0; bj < 2; ++bj) { const f32x4 v0 = acc[ai][bj][m][0], v1 = acc[ai][bj][m][1];
                    u32x4 w; w.x = cvt_pk_bf16(v0[0], v0[1]); w.y = cvt_pk_bf16(v0[2], v0[3]); w.z = cvt_pk_bf16(v1[0], v1[1]); w.w = cvt_pk_bf16(v1[2], v1[3]);
                    *(u32x4*)(rowp + bj * HALF) = w; } }
    }
};
struct EpiSwiGLU {
    static constexpr bool PERM = true, AFTER_DRAIN = false;
    bf16_t* O; int ldc;
    __device__ __forceinline__ void operator()(const f32x4 (&acc)[2][2][4][2], const Unit& u, int wr, int wc, int fr, int fq) const {
        const int row0 = u.pm * BM + wr * 64 + fr, col0 = u.pn * HALF + wc * 32 + 8 * fq;
#pragma unroll
        for (int ai = 0; ai < 2; ++ai)
#pragma unroll
            for (int m = 0; m < 4; ++m) { bf16_t* rowp = O + (size_t)(row0 + ai * HALF + m * 16) * ldc + col0;
                float o[8];
#pragma unroll
                for (int n = 0; n < 2; ++n)
#pragma unroll
                    for (int i = 0; i < 4; ++i) { const float g = acc[ai][0][m][n][i], up = acc[ai][1][m][n][i]; o[n * 4 + i] = g * fast_sigmoid(g) * up; }
                u32x4 w; w.x = cvt_pk_bf16(o[0], o[1]); w.y = cvt_pk_bf16(o[2], o[3]); w.z = cvt_pk_bf16(o[4], o[5]); w.w = cvt_pk_bf16(o[6], o[7]);
                *(u32x4*)rowp = w; }
    }
};
struct EpiGLU {
    static constexpr bool PERM = true, AFTER_DRAIN = false;
    bf16_t* O; int ldc; const bf16_t* Z; int ldz; const float* bias;
    __device__ __forceinline__ void operator()(const f32x4 (&acc)[2][2][4][2], const Unit& u, int wr, int wc, int fr, int fq) const {
        const int row0 = u.pm * BM + wr * 64 + fr, col0 = u.pn * BM + wc * 32 + 8 * fq;
#pragma unroll
        for (int bj = 0; bj < 2; ++bj) { const f32x4 b0 = *(const f32x4*)(bias + col0 + bj * HALF), b1 = *(const f32x4*)(bias + col0 + bj * HALF + 4);
#pragma unroll
            for (int ai = 0; ai < 2; ++ai)
#pragma unroll
                for (int m = 0; m < 4; ++m) { const size_t r = (size_t)(row0 + ai * HALF + m * 16);
                    const u32x4 zz = *(const u32x4*)(Z + r * ldz + col0 + bj * HALF);
                    const f32x4 v0 = acc[ai][bj][m][0] + b0, v1 = acc[ai][bj][m][1] + b1;
                    u32x4 w; w.x = cvt_pk_bf16(bflo(zz.x) * fast_sigmoid(v0[0]), bfhi(zz.x) * fast_sigmoid(v0[1])); w.y = cvt_pk_bf16(bflo(zz.y) * fast_sigmoid(v0[2]), bfhi(zz.y) * fast_sigmoid(v0[3]));
                    w.z = cvt_pk_bf16(bflo(zz.z) * fast_sigmoid(v1[0]), bfhi(zz.z) * fast_sigmoid(v1[1])); w.w = cvt_pk_bf16(bflo(zz.w) * fast_sigmoid(v1[2]), bfhi(zz.w) * fast_sigmoid(v1[3]));
                    *(u32x4*)(O + r * ldc + col0 + bj * HALF) = w; } }
    }
};
struct RouteEnt { int tok; int slot; float w; int pad; };
struct EpiScatter {
    static constexpr bool PERM = true, AFTER_DRAIN = false;
    const RouteEnt* L; bf16_t* Y; size_t slot_stride; int ldc;
    __device__ __forceinline__ void operator()(const f32x4 (&acc)[2][2][4][2], const Unit& u, int wr, int wc, int fr, int fq) const {
        const int row0 = u.pm * BM + wr * 64 + fr, col0 = u.pn * BM + wc * 32 + 8 * fq;
#pragma unroll
        for (int ai = 0; ai < 2; ++ai)
#pragma unroll
            for (int m = 0; m < 4; ++m) { const RouteEnt e = L[row0 + ai * HALF + m * 16];
                if (e.tok >= 0) { bf16_t* rowp = Y + (size_t)e.slot * slot_stride + (size_t)e.tok * ldc + col0;
#pragma unroll
                    for (int bj = 0; bj < 2; ++bj) { const f32x4 v0 = acc[ai][bj][m][0] * e.w, v1 = acc[ai][bj][m][1] * e.w;
                        u32x4 w; w.x = cvt_pk_bf16(v0[0], v0[1]); w.y = cvt_pk_bf16(v0[2], v0[3]); w.z = cvt_pk_bf16(v1[0], v1[1]); w.w = cvt_pk_bf16(v1[2], v1[3]);
                        *(u32x4*)(rowp + bj * HALF) = w; } } }
    }
};
template <class Epi, class Sched, bool ALIGN_EPI = false, bool SP2 = false>
__device__ __forceinline__ void gemm_phase(PG8_LAS unsigned char* lds, const Gemm g, const Sched& S, const Epi& E, const int tid) {
    const int wid = __builtin_amdgcn_readfirstlane(tid >> 6), lane = tid & 63, wr = wid >> 2, wc = wid & 3, fr = lane & 15, fq = lane >> 4;
    const int K = g.K, nt = K / BK;
    unsigned voffA[2], voffB[2];
#pragma unroll
    for (int i = 0; i < 2; ++i) { int R, C; stage_rc(tid * 16 + i * 8192, R, C); const int Rb = Epi::PERM ? ((R & ~31) + perm32(R & 31)) : R;
        voffA[i] = (unsigned)(R * K + C) * 2u; voffB[i] = (unsigned)(Rb * K + C) * 2u; }
    const size_t kstep = (size_t)(BK * 2);
    const size_t hstep = (size_t)HALF * K * 2;
    const size_t tstep = 2 * hstep;
    const unsigned ldsw = (unsigned)wid * 1024u;
    const int aoff = lds_byte(wr * 64 + fr, fq * 8), boff = lds_byte(wc * 32 + fr, fq * 8);
#define PG8_SA(b, h) (((b) * 2 + (h)) * HTB)
#define PG8_SB(b, h) ((4 + (b) * 2 + (h)) * HTB)
#define PG8_STAGE(bufoff, gbase, voff) do { _Pragma("unroll") for (int _i = 0; _i < 2; ++_i) \
        __builtin_amdgcn_global_load_lds((const unsigned*)((const char*)(gbase) + (voff)[_i]), (PG8_LAS unsigned*)(lds + (bufoff) + ldsw + _i * 8192), 16, 0, 0); } while (0)
#define PG8_LDA(dst, b, h) do { _Pragma("unroll") for (int m = 0; m < 4; ++m) _Pragma("unroll") for (int k = 0; k < 2; ++k) dst[m][k] = *(const PG8_LAS bf16x8*)(lds + PG8_SA(b, h) + aoff + m * 2048 + k * 1024); } while (0)
#define PG8_LDB(dst, b, h) do { _Pragma("unroll") for (int n = 0; n < 2; ++n) _Pragma("unroll") for (int k = 0; k < 2; ++k) dst[n][k] = *(const PG8_LAS bf16x8*)(lds + PG8_SB(b, h) + boff + n * 2048 + k * 1024); } while (0)
#define PG8_MMA(ai, bj, At, Bt) do { __builtin_amdgcn_s_setprio(1); _Pragma("unroll") for (int m = 0; m < 4; ++m) _Pragma("unroll") for (int n = 0; n < 2; ++n) _Pragma("unroll") for (int k = 0; k < 2; ++k) \
        acc[ai][bj][m][n] = __builtin_amdgcn_mfma_f32_16x16x32_bf16(Bt[n][k], At[m][k], acc[ai][bj][m][n], 0, 0, 0); __builtin_amdgcn_s_setprio(0); } while (0)
#define PG8_WAIT_V(n) asm volatile("s_waitcnt vmcnt(" #n ")" ::: "memory")
#define PG8_WAIT_L(n) asm volatile("s_waitcnt lgkmcnt(" #n ")" ::: "memory")
#define PG8_BAR __builtin_amdgcn_s_barrier()
#define PG8_SCHED __builtin_amdgcn_sched_barrier(0)
    Unit cur, nxt; int ui = 0;
    if (!S.next(0, cur)) return;
    f32x4 acc[2][2][4][2];
#pragma unroll
    for (int a = 0; a < 2; ++a)
#pragma unroll
        for (int b = 0; b < 2; ++b)
#pragma unroll
            for (int m = 0; m < 4; ++m)
#pragma unroll
                for (int n = 0; n < 2; ++n) acc[a][b][m][n] = (f32x4){0.f, 0.f, 0.f, 0.f};
    bf16x8 At[4][2], B0[2][2], B1[2][2];
    const char* cA = (const char*)g.A + (size_t)cur.pm * tstep; const char* cB = S.bptr(g, cur);
    S.a_ready(cur);
    if constexpr (SP2) {
        PG8_STAGE(PG8_SB(0, 0), cB, voffB); PG8_STAGE(PG8_SB(0, 1), cB + hstep, voffB); PG8_STAGE(PG8_SA(0, 0), cA, voffA); PG8_STAGE(PG8_SA(0, 1), cA + hstep, voffA);
        if (wr == 1) PG8_BAR;
        PG8_WAIT_V(2); PG8_BAR;
        PG8_STAGE(PG8_SB(1, 0), cB + kstep, voffB); PG8_STAGE(PG8_SA(1, 0), cA + kstep, voffA); PG8_STAGE(PG8_SB(1, 1), cB + hstep + kstep, voffB);
        PG8_WAIT_V(6); PG8_BAR;
    } else {
        PG8_STAGE(PG8_SB(0, 0), cB, voffB); PG8_STAGE(PG8_SA(0, 0), cA, voffA); PG8_STAGE(PG8_SB(0, 1), cB + hstep, voffB); PG8_STAGE(PG8_SA(0, 1), cA + hstep, voffA);
        if (wr == 1) PG8_BAR;
        PG8_WAIT_V(4); PG8_BAR;
        PG8_STAGE(PG8_SB(1, 0), cB + kstep, voffB); PG8_STAGE(PG8_SA(1, 0), cA + kstep, voffA); PG8_STAGE(PG8_SB(1, 1), cB + hstep + kstep, voffB);
        PG8_WAIT_V(6); PG8_BAR;
    }
    for (;;) {
        const bool has_next = S.next(ui + 1, nxt);
        const char* nA = has_next ? (const char*)g.A + (size_t)nxt.pm * tstep : cA; const char* nB = has_next ? S.bptr(g, nxt) : cB;
        for (int t = 0; t < nt; t += 2) {
            const bool last = (t == nt - 2);
            const char* a1 = cA + (size_t)(t + 1) * kstep;
            const char* a2 = last ? nA : cA + (size_t)(t + 2) * kstep; const char* b2 = last ? nB : cB + (size_t)(t + 2) * kstep;
            const char* a3 = a2 + kstep; const char* b3 = b2 + kstep;
            if (last && has_next) S.a_ready(nxt);
            if constexpr (SP2) {
            PG8_LDB(B0, 0, 0); PG8_LDB(B1, 0, 1); PG8_SCHED; PG8_LDA(At, 0, 0); PG8_STAGE(PG8_SA(1, 1), a1 + hstep, voffA);
            PG8_WAIT_V(8); PG8_WAIT_L(0); PG8_BAR; PG8_MMA(0, 0, At, B0); PG8_MMA(0, 1, At, B1); PG8_BAR; PG8_SCHED;
            PG8_LDA(At, 0, 1); PG8_STAGE(PG8_SB(0, 0), b2, voffB); PG8_STAGE(PG8_SB(0, 1), b2 + hstep, voffB); PG8_STAGE(PG8_SA(0, 0), a2, voffA);
            PG8_WAIT_V(8); PG8_WAIT_L(0); PG8_BAR; PG8_MMA(1, 0, At, B0); PG8_MMA(1, 1, At, B1); PG8_BAR; PG8_SCHED;
            PG8_LDB(B0, 1, 0); PG8_LDB(B1, 1, 1); PG8_SCHED; PG8_LDA(At, 1, 0); PG8_STAGE(PG8_SA(0, 1), a2 + hstep, voffA);
            PG8_WAIT_V(8); PG8_WAIT_L(0); PG8_BAR; PG8_MMA(0, 0, At, B0); PG8_MMA(0, 1, At, B1); PG8_BAR; PG8_SCHED;
            PG8_LDA(At, 1, 1); PG8_STAGE(PG8_SB(1, 0), b3, voffB); PG8_STAGE(PG8_SB(1, 1), b3 + hstep, voffB); PG8_STAGE(PG8_SA(1, 0), a3, voffA);
            PG8_WAIT_V(8); PG8_WAIT_L(0); PG8_BAR; PG8_MMA(1, 0, At, B0); PG8_MMA(1, 1, At, B1); PG8_BAR; PG8_SCHED;
            } else {
            PG8_LDB(B0, 0, 0); PG8_SCHED; PG8_LDA(At, 0, 0); PG8_STAGE(PG8_SA(1, 1), a1 + hstep, voffA);
            PG8_WAIT_L(8); PG8_BAR; PG8_WAIT_L(0); PG8_MMA(0, 0, At, B0); PG8_BAR; PG8_SCHED;
            PG8_LDB(B1, 0, 1); PG8_STAGE(PG8_SB(0, 0), b2, voffB);
            PG8_BAR; PG8_WAIT_L(0); PG8_MMA(0, 1, At, B1); PG8_BAR;
            PG8_LDA(At, 0, 1); PG8_STAGE(PG8_SA(0, 0), a2, voffA);
            PG8_BAR; PG8_WAIT_L(0); PG8_MMA(1, 0, At, B0); PG8_BAR; PG8_SCHED;
            PG8_STAGE(PG8_SB(0, 1), b2 + hstep, voffB);
            PG8_WAIT_V(6); PG8_BAR; PG8_MMA(1, 1, At, B1); PG8_BAR;
            PG8_LDB(B0, 1, 0); PG8_SCHED; PG8_LDA(At, 1, 0); PG8_STAGE(PG8_SA(0, 1), a2 + hstep, voffA);
            PG8_WAIT_L(8); PG8_BAR; PG8_WAIT_L(0); PG8_MMA(0, 0, At, B0); PG8_BAR; PG8_SCHED;
            PG8_LDB(B1, 1, 1); PG8_STAGE(PG8_SB(1, 0), b3, voffB);
            PG8_BAR; PG8_WAIT_L(0); PG8_MMA(0, 1, At, B1); PG8_BAR;
            PG8_LDA(At, 1, 1); PG8_STAGE(PG8_SA(1, 0), a3, voffA);
            PG8_BAR; PG8_WAIT_L(0); PG8_MMA(1, 0, At, B0); PG8_BAR; PG8_SCHED;
            PG8_STAGE(PG8_SB(1, 1), b3 + hstep, voffB);
            PG8_WAIT_V(6); PG8_BAR; PG8_MMA(1, 1, At, B1); PG8_BAR;
            }
        }
        if constexpr (ALIGN_EPI) { if (wr == 0) PG8_BAR; }
        if constexpr (!Epi::AFTER_DRAIN) { E(acc, cur, wr, wc, fr, fq); S.done(cur); }
        if (!has_next) break;
#pragma unroll
        for (int a = 0; a < 2; ++a)
#pragma unroll
            for (int b = 0; b < 2; ++b)
#pragma unroll
                for (int m = 0; m < 4; ++m)
#pragma unroll
                    for (int n = 0; n < 2; ++n) acc[a][b][m][n] = (f32x4){0.f, 0.f, 0.f, 0.f};
        cur = nxt; cA = nA; cB = nB; ++ui;
        if constexpr (ALIGN_EPI) { if (wr == 1) PG8_BAR; }
    }
    PG8_WAIT_V(0);
    if constexpr (!ALIGN_EPI) { if (wr == 0) PG8_BAR; }
    PG8_BAR;
    if constexpr (Epi::AFTER_DRAIN) { E.fused(acc, cur, wr, wc, fr, fq, lds, wid, lane); S.done(cur); }
#undef PG8_SA
#undef PG8_SB
#undef PG8_STAGE
#undef PG8_LDA
#undef PG8_LDB
#undef PG8_MMA
#undef PG8_WAIT_V
#undef PG8_WAIT_L
#undef PG8_BAR
#undef PG8_SCHED
}
}

#define GAS __attribute__((address_space(1)))
#define LAS __attribute__((address_space(3)))
#define XB_TMO      128
#define XB_XCNT(j)  (256  + 64 * (j))
#define XB_XSUB(j)  (1280 + 64 * (j))
#define XB_XGEN(j)  (2304 + 64 * (j))
#define XB_TOP      3328
#define XB_TOPGEN   3392
#define XCD_BAR_WORDS 3456
#define XB_SPIN_CAP (1u << 18)

__device__ __forceinline__ unsigned xb_ld(unsigned* p)              { return __hip_atomic_load(p, __ATOMIC_RELAXED, __HIP_MEMORY_SCOPE_AGENT); }
__device__ __forceinline__ unsigned xb_add(unsigned* p, unsigned v) { return __hip_atomic_fetch_add(p, v, __ATOMIC_RELAXED, __HIP_MEMORY_SCOPE_AGENT); }
__device__ __forceinline__ unsigned xb_xcc_id() { return (unsigned)__builtin_amdgcn_s_getreg((3 << 11) | 20) & 0xFu; }
#define XB_SPIN(cond, bar) do { unsigned _sp = 0; while (cond) { __builtin_amdgcn_s_sleep(1); \
    if ((++_sp & 255u) == 0u) { if (xb_ld(&(bar)[XB_TMO])) break; if (_sp > XB_SPIN_CAP) { atomicAdd(&(bar)[XB_TMO], 1u); break; } } } } while (0)

struct XcdBarrier {
    unsigned* bar; unsigned x;
    volatile LAS unsigned* st;
};

__device__ __forceinline__ XcdBarrier xcd_barrier_post(unsigned* bar, volatile LAS unsigned* st) {
    XcdBarrier b; b.bar = bar; b.x = xb_xcc_id(); b.st = st;
    if (threadIdx.x == 0) (void)xb_add(&bar[XB_XCNT(b.x)], 1u);
    return b;
}
__device__ __forceinline__ void xcd_barrier_complete(unsigned* bar, unsigned x, unsigned& nloc, unsigned& nx) {
    const unsigned G = gridDim.x * gridDim.y * gridDim.z;
    unsigned sum, cnt, mine, sp = 0u;
    for (;;) {
        sum = 0u; cnt = 0u; mine = 0u;
#pragma unroll
        for (unsigned j = 0; j < 16; ++j) { const unsigned c = xb_ld(&bar[XB_XCNT(j)]); sum += c; cnt += (c > 0u) ? 1u : 0u; mine = (j == x) ? c : mine; }
        if (sum == G) break;
        __builtin_amdgcn_s_sleep(1);
        if ((++sp & 255u) == 0u) { if (xb_ld(&bar[XB_TMO])) break; if (sp > XB_SPIN_CAP) { atomicAdd(&bar[XB_TMO], 1u); break; } }
    }
    nloc = mine > 0u ? mine : 1u; nx = cnt > 0u ? cnt : 1u;
}

__device__ __forceinline__ void xcd_barrier(const XcdBarrier& b) {
    asm volatile("s_waitcnt vmcnt(0)" ::: "memory");
    __syncthreads();
    if (threadIdx.x == 0) {
        unsigned* bar = b.bar;
        __builtin_amdgcn_s_waitcnt(0);
        unsigned nloc = b.st[0], nx = b.st[1];
        if (nloc == 0u) { xcd_barrier_complete(bar, b.x, nloc, nx); b.st[0] = nloc; b.st[1] = nx; }
        const unsigned old = xb_add(&bar[XB_XSUB(b.x)], 1u);
        const unsigned gen = old / nloc;
        if (old + 1u == (gen + 1u) * nloc) {
            __builtin_amdgcn_fence(__ATOMIC_RELEASE, "agent");
            asm volatile("s_waitcnt vmcnt(0)" ::: "memory");
            const unsigned og = xb_add(&bar[XB_TOP], 1u);
            const unsigned tg = og / nx;
            if (og + 1u == (tg + 1u) * nx) xb_add(&bar[XB_TOPGEN], 1u);
            else XB_SPIN(xb_ld(&bar[XB_TOPGEN]) == tg, bar);
            __builtin_amdgcn_fence(__ATOMIC_ACQUIRE, "agent");
            xb_add(&bar[XB_XGEN(b.x)], 1u);
            asm volatile("s_waitcnt vmcnt(0)" ::: "memory");
        } else {
            XB_SPIN(xb_ld(&bar[XB_XGEN(b.x)]) == gen, bar);
            __builtin_amdgcn_fence(__ATOMIC_ACQUIRE, "agent");
            asm volatile("s_waitcnt vmcnt(0)" ::: "memory");
        }
    }
    __syncthreads();
}
constexpr int D = 1024, NB = 8, SEQ = 8192, CTXL = 256, TB = SEQ + CTXL, M = NB * TB;
constexpr int EV_IN = 3072, OD_IN = 2560, DFF = 3584, NE = 8, NLAYER = 4;
constexpr int NPANEL = M / 256;
constexpr int PW = 179, MAXP = 3 * PW;
constexpr float EPS = 1e-6f;
constexpr size_t MiB = 1u << 20;
constexpr size_t WS_CTL = 0, CTL_ZERO_BYTES = 1 * MiB;
constexpr size_t WS_MOD = 1 * MiB;
constexpr size_t WS_ROPE_R = 2 * MiB, WS_ROPE_D = 2 * MiB + 65536;
constexpr size_t WS_ROUTE = 3 * MiB;
constexpr size_t WS_WGCNT = 5 * MiB;
constexpr size_t WS_PEXP = 5 * MiB + 65536;
constexpr size_t WS_LIST = 6 * MiB;
constexpr size_t WS_XC = 10 * MiB;
constexpr size_t WS_W = 20 * MiB;
constexpr size_t WS_H = 198 * MiB;
constexpr size_t WS_Y = 330 * MiB;
constexpr size_t WS_BIG = 594 * MiB;
constexpr size_t WS_END = 1056 * MiB;
constexpr size_t W_IN = 0, W_OUT = 6 * MiB, W_GU = 8 * MiB, W_DN = 22 * MiB;
constexpr size_t W_GLU = 8 * MiB, W_MGU = 9 * MiB, W_MDN = 121 * MiB;
constexpr size_t Y_SLOT = (size_t)M * 1024 * 2;
constexpr size_t T_HALF = (size_t)M * 512 * 2;
constexpr size_t T_QUART = (size_t)M * 256 * 2;
constexpr size_t BIG_ACT = 0, BIG_HG = 314 * MiB;
constexpr int CW_TMO = 0, CW_BAR = 4096;
constexpr int RING_BYTES = 131072, LDSCTL_OFF = RING_BYTES + 8192, MISC_OFF = LDSCTL_OFF + 320, LDS_BYTES = 147456;
typedef unsigned short bf16;
typedef unsigned v4u __attribute__((ext_vector_type(4)));
typedef unsigned v2u __attribute__((ext_vector_type(2)));
typedef float f32x4 __attribute__((ext_vector_type(4)));
typedef float f32x16 __attribute__((ext_vector_type(16)));
typedef short bf16x8 __attribute__((ext_vector_type(8)));
typedef short s16x4 __attribute__((ext_vector_type(4)));
#define RLX_AGENT __ATOMIC_RELAXED, __HIP_MEMORY_SCOPE_AGENT
using pg8::cvt_pk_bf16; using pg8::bflo; using pg8::bfhi; using pg8::RouteEnt;
struct RouteRow { int e1, e2; float p1, p2; };
__device__ __forceinline__ float bf2f(bf16 v) { return __uint_as_float((unsigned)v << 16); }
__device__ __forceinline__ float wave_sum(float v) {
#pragma unroll
    for (int o = 1; o < 64; o <<= 1) v += __shfl_xor(v, o);
    return v;
}
__device__ __forceinline__ float gelu_tanh(float x) {
    const float u = 0.7978845608028654f * (x + 0.044715f * x * x * x);
    return x * __builtin_amdgcn_rcpf(1.0f + __builtin_amdgcn_exp2f(-2.0f * 1.4426950408889634f * u));
}
__device__ __forceinline__ float sigmoidf_(float x) { return __builtin_amdgcn_rcpf(1.0f + __builtin_amdgcn_exp2f(-1.4426950408889634f * x)); }
struct Args { const float* in[38]; float* out; unsigned char* ws; int ph_lo, ph_hi; };
typedef __attribute__((address_space(4))) const Args KArgs;
#define INP(k) ((const float*)F.A->in[k])
#define OUTP ((float*)F.A->out)
#define FMOD ((float*)(F.ws + WS_MOD))
#define FXC ((float*)(F.ws + WS_XC))
#define FH ((bf16*)(F.ws + WS_H))
#define FWB ((bf16*)(F.ws + WS_W))
#define FYB (F.ws + WS_Y)
#define FBIG (F.ws + WS_BIG)
#define LAUNDER(F) do { asm volatile("" : "+s"(F.ws), "+s"(F.A), "+v"(F.tid), "+s"(F.bid), "+s"(F.G)); F.lane = F.tid & 63; F.wave = __builtin_amdgcn_readfirstlane(F.tid >> 6); } while (0)
struct Frame {
    LAS unsigned char* lds; unsigned char* ws;
    int tid, lane, wave, G, bid;
    const KArgs* A;
};
#define LDS_WAIT() asm volatile("s_waitcnt lgkmcnt(0)" ::: "memory")

__device__ __forceinline__ void ph_prologue(Frame& F) {
    LAS float* SL = (LAS float*)F.lds;
    LAS float* RED = (LAS float*)(F.lds + 40960);
    const float* c = INP(1); const float* cc = INP(3); const float* mod_w = INP(4); const float* mod_b = INP(5);
    for (int i = F.tid; i < 9 * 1024; i += 512) { const float v = (i < 8192) ? c[i] : cc[i - 8192]; SL[i] = v * sigmoidf_(v); }
    __syncthreads();
    for (int blk = F.bid; blk < 4 * 96; blk += F.G) {
        const int l = blk / 96, n0 = (blk % 96) * 64;
        const float* wp = mod_w + ((size_t)l * 1024 + (size_t)F.wave * 128) * 6144 + n0 + F.lane;
        float acc[9];
#pragma unroll
        for (int j = 0; j < 9; ++j) acc[j] = 0.f;
        for (int k = 0; k < 128; ++k) { const float w = wp[(size_t)k * 6144];
#pragma unroll
            for (int j = 0; j < 9; ++j) acc[j] += SL[j * 1024 + F.wave * 128 + k] * w; }
#pragma unroll
        for (int j = 0; j < 9; ++j) RED[(F.wave * 9 + j) * 64 + F.lane] = acc[j];
        __syncthreads();
        for (int i = F.tid; i < 9 * 64; i += 512) { const int j = i >> 6, ln = i & 63; float s = mod_b[l * 6144 + n0 + ln];
#pragma unroll
            for (int w = 0; w < 8; ++w) s += RED[(w * 9 + j) * 64 + ln];
            FMOD[((size_t)l * 9 + j) * 6144 + n0 + ln] = s; }
        __syncthreads();
    }
    const int gt = F.bid * 512 + F.tid;
    if (gt < 128 * 32) { const int pos = gt >> 5, dq = gt & 31; const float inv = powf(10000.0f, -(float)dq / 32.0f); float s, cs; sincosf((float)pos * inv, &s, &cs);
        float* T = (float*)(F.ws + WS_ROPE_R); T[gt * 2] = cs; T[gt * 2 + 1] = s; }
    else if (gt < 128 * 32 + 128 * 16) { const int g2 = gt - 128 * 32, pos = g2 >> 4, dq = g2 & 15; const float inv = powf(10000.0f, -(float)dq / 16.0f); float s, cs; sincosf((float)pos * inv, &s, &cs);
        float* T = (float*)(F.ws + WS_ROPE_D); T[g2 * 2] = cs; T[g2 * 2 + 1] = s; }
}

__device__ __forceinline__ void transpose_item(const float* W, int K, int N, bf16* WT, int drow0, int k0, int n0, LAS float* scr, int lane) {
#pragma unroll 8
    for (int i = 0; i < 32; ++i) { const int kk = 2 * i + (lane >> 5); scr[kk * 33 + (lane & 31)] = W[(size_t)(k0 + kk) * N + n0 + (lane & 31)]; }
    LDS_WAIT(); asm volatile("" ::: "memory");
    const int c = lane & 7;
#pragma unroll
    for (int j = 0; j < 4; ++j) { const int n = (lane >> 3) + 8 * j; const LAS float* s = scr + (8 * c) * 33 + n;
        v4u o; o.x = cvt_pk_bf16(s[0 * 33], s[1 * 33]); o.y = cvt_pk_bf16(s[2 * 33], s[3 * 33]); o.z = cvt_pk_bf16(s[4 * 33], s[5 * 33]); o.w = cvt_pk_bf16(s[6 * 33], s[7 * 33]);
        *(v4u*)(WT + (size_t)(drow0 + n) * K + k0 + 8 * c) = o; }
    LDS_WAIT(); asm volatile("" ::: "memory");
}
__device__ __forceinline__ void convert_job(Frame& F, const float* W, int K, int N, bf16* WT, int mode) {
    LAS float* scr = (LAS float*)(F.lds + F.wave * 16384);
    const int gw = F.bid * 8 + F.wave, NGW = F.G * 8, nblk = N / 32, nit = (K / 64) * nblk;
    for (int it = gw; it < nit; it += NGW) { const int kb = it / nblk, nb = it % nblk, n0 = nb * 32;
        const int drow0 = mode == 0 ? n0 : ((n0 >> 7) * 256 + (n0 & 127) + (mode == 2 ? 128 : 0));
        transpose_item(W, K, N, WT, drow0, kb * 64, n0, scr, F.lane); }
}
__device__ __forceinline__ void ph_convert(Frame& F, int l) {
    const int i = l >> 1; bf16* Wb = FWB;
    if ((l & 1) == 0) {
        convert_job(F, INP(7) + (size_t)i * D * EV_IN, D, EV_IN, Wb + W_IN / 2, 0);
        convert_job(F, INP(15) + (size_t)i * D * D, D, D, Wb + W_OUT / 2, 0);
        convert_job(F, INP(16) + (size_t)i * D * DFF, D, DFF, Wb + W_GU / 2, 1);
        convert_job(F, INP(17) + (size_t)i * D * DFF, D, DFF, Wb + W_GU / 2, 2);
        convert_job(F, INP(18) + (size_t)i * DFF * D, DFF, D, Wb + W_DN / 2, 0);
    } else {
        convert_job(F, INP(19) + (size_t)i * D * OD_IN, D, OD_IN, Wb + W_IN / 2, 0);
        convert_job(F, INP(32) + (size_t)i * D * D, D, D, Wb + W_OUT / 2, 0);
        convert_job(F, INP(28) + (size_t)i * 256 * 256, 256, 256, Wb + W_GLU / 2, 0);
        for (int e = 0; e < NE; ++e) {
            convert_job(F, INP(35) + ((size_t)i * NE + e) * D * DFF, D, DFF, Wb + W_MGU / 2 + (size_t)e * 7168 * 1024, 1);
            convert_job(F, INP(36) + ((size_t)i * NE + e) * D * DFF, D, DFF, Wb + W_MGU / 2 + (size_t)e * 7168 * 1024, 2);
            convert_job(F, INP(37) + ((size_t)i * NE + e) * DFF * D, DFF, D, Wb + W_MDN / 2 + (size_t)e * 1024 * 3584, 0);
        }
    }
}

struct NormArgs {
    int xin_input, has_y, two, write_x, final_, do_h, do_route;
    const float* gate; const float* gy;
    const float* gh; const float* shift; const float* scale;
    const float* rw; const float* rb;
};
__device__ __forceinline__ void ph_norm(Frame& F, const NormArgs& a) {
    LAS float* RWT = (LAS float*)F.lds;
    LAS int* cnt = (LAS int*)(F.lds + 32768);
    if (a.do_route) {
        for (int idx = F.tid; idx < 8192; idx += 512) RWT[(idx & 7) * 1024 + (idx >> 3)] = a.rw[idx];
        if (F.tid < 8) cnt[F.tid] = 0;
        __syncthreads();
    }
    const int r0 = (int)((long)M * F.bid / F.G), r1 = (int)((long)M * (F.bid + 1) / F.G);
    const bf16* Y0 = (const bf16*)FYB; const bf16* Y1 = (const bf16*)(FYB + Y_SLOT);
    for (int m = r0 + F.wave; m < r1; m += 8) {
        const int b = m / TB, t = m - b * TB; const bool isctx = t < CTXL; const int midx = isctx ? 8 : b;
        const size_t off = isctx ? ((size_t)(b * CTXL + t) * D) : ((size_t)(b * SEQ + t - CTXL) * D);
        const float* xin = isctx ? ((a.xin_input ? INP(2) : FXC) + off) : ((a.xin_input ? INP(0) : OUTP) + off);
        float* xres = isctx ? (FXC + off) : (OUTP + off);
        f32x4 x[4];
#pragma unroll
        for (int j = 0; j < 4; ++j) x[j] = *(const f32x4*)(xin + 4 * F.lane + 256 * j);
        if (a.has_y) {
            f32x4 y[4]; float ss = 0.f;
#pragma unroll
            for (int j = 0; j < 4; ++j) { const v2u w = *(const v2u*)(Y0 + (size_t)m * D + 4 * F.lane + 256 * j); y[j] = (f32x4){bflo(w.x), bfhi(w.x), bflo(w.y), bfhi(w.y)};
                if (a.two) { const v2u w2 = *(const v2u*)(Y1 + (size_t)m * D + 4 * F.lane + 256 * j); y[j] += (f32x4){bflo(w2.x), bfhi(w2.x), bflo(w2.y), bfhi(w2.y)}; }
                ss += (y[j].x * y[j].x + y[j].y * y[j].y) + (y[j].z * y[j].z + y[j].w * y[j].w); }
            const float rs = 1.0f / sqrtf(wave_sum(ss) * (1.0f / D) + EPS);
#pragma unroll
            for (int j = 0; j < 4; ++j) { const int c = 4 * F.lane + 256 * j; const f32x4 g = *(const f32x4*)(a.gate + (size_t)midx * 6144 + c), gg = *(const f32x4*)(a.gy + c);
                x[j] += g * (y[j] * rs * gg); }
        }
        if (a.write_x && !(a.final_ && isctx)) {
#pragma unroll
            for (int j = 0; j < 4; ++j) *(f32x4*)(xres + 4 * F.lane + 256 * j) = x[j];
        }
        if (a.do_h) {
            float ss = 0.f;
#pragma unroll
            for (int j = 0; j < 4; ++j) ss += (x[j].x * x[j].x + x[j].y * x[j].y) + (x[j].z * x[j].z + x[j].w * x[j].w);
            const float rs = 1.0f / sqrtf(wave_sum(ss) * (1.0f / D) + EPS);
            f32x4 h[4];
#pragma unroll
            for (int j = 0; j < 4; ++j) { const int c = 4 * F.lane + 256 * j; const f32x4 g = *(const f32x4*)(a.gh + c), sh = *(const f32x4*)(a.shift + (size_t)midx * 6144 + c), sc = *(const f32x4*)(a.scale + (size_t)midx * 6144 + c);
                h[j] = (x[j] * rs * g) * (sc + 1.0f) + sh;
                v2u w; w.x = cvt_pk_bf16(h[j].x, h[j].y); w.y = cvt_pk_bf16(h[j].z, h[j].w); *(v2u*)(FH + (size_t)m * D + c) = w; }
            if (a.do_route) {
                float lg[8];
#pragma unroll
                for (int e = 0; e < 8; ++e) { float s = 0.f;
#pragma unroll
                    for (int j = 0; j < 4; ++j) { const f32x4 w = *(const LAS f32x4*)(RWT + e * 1024 + 4 * F.lane + 256 * j); s += (h[j].x * w.x + h[j].y * w.y) + (h[j].z * w.z + h[j].w * w.w); }
                    lg[e] = wave_sum(s) + a.rb[e]; }
                int e1 = 0; float v1 = lg[0];
#pragma unroll
                for (int e = 1; e < 8; ++e) if (lg[e] > v1) { v1 = lg[e]; e1 = e; }
                int e2 = -1; float v2 = -3.0e38f;
#pragma unroll
                for (int e = 0; e < 8; ++e) if (e != e1 && lg[e] > v2) { v2 = lg[e]; e2 = e; }
                const float p1 = 1.0f / (1.0f + expf(v2 - v1));
                if (F.lane == 0) { RouteRow rr; rr.e1 = e1; rr.e2 = e2; rr.p1 = p1; rr.p2 = 1.0f - p1; ((RouteRow*)(F.ws + WS_ROUTE))[m] = rr;
                    atomicAdd((int*)&cnt[e1], 1); atomicAdd((int*)&cnt[e2], 1); }
            }
        }
    }
    if (a.do_route) { __syncthreads(); if (F.tid < 8) ((int*)(F.ws + WS_WGCNT))[F.bid * 8 + F.tid] = cnt[F.tid]; }
}

__device__ __forceinline__ void ph_assign(Frame& F) {
    LAS int* part = (LAS int*)F.lds;
    LAS int* tot = (LAS int*)(F.lds + 32768);
    const int* WC = (const int*)(F.ws + WS_WGCNT);
    int st[8], sb[8];
#pragma unroll
    for (int e = 0; e < 8; ++e) { st[e] = 0; sb[e] = 0; }
    for (int w = F.tid; w < F.G; w += 512) {
#pragma unroll
        for (int e = 0; e < 8; ++e) { const int c = WC[w * 8 + e]; st[e] += c; if (w < F.bid) sb[e] += c; } }
    if (F.tid < 32) tot[F.tid] = 0;
    __syncthreads();
#pragma unroll
    for (int e = 0; e < 8; ++e) { if (st[e]) atomicAdd((int*)&tot[e], st[e]); if (sb[e]) atomicAdd((int*)&tot[8 + e], sb[e]); }
    __syncthreads();
    if (F.tid == 0) { int o = 0; for (int e = 0; e < 8; ++e) { tot[16 + e] = o; o += (tot[e] + 255) & ~255; }
        if (F.bid == 0) { int* PE = (int*)(F.ws + WS_PEXP); int p = 0; for (int e = 0; e < 8; ++e) { const int np = (tot[e] + 255) >> 8; for (int q = 0; q < np; ++q) PE[p++] = e; } PE[MAXP] = p; } }
    __syncthreads();
    RouteEnt* L = (RouteEnt*)(F.ws + WS_LIST);
    if (F.bid == 0) {
        for (int e = 0; e < 8; ++e) { const int lo = tot[16 + e] + tot[e], hi = tot[16 + e] + ((tot[e] + 255) & ~255);
            for (int p = lo + F.tid; p < hi; p += 512) { RouteEnt z; z.tok = -1; z.slot = 0; z.w = 0.f; z.pad = 0; L[p] = z; } }
    }
    const RouteRow* RR = (const RouteRow*)(F.ws + WS_ROUTE);
    const int r0 = (int)((long)M * F.bid / F.G), r1 = (int)((long)M * (F.bid + 1) / F.G);
    for (int m = r0 + F.tid; m < r1; m += 512) { const RouteRow rr = RR[m];
        { const int p = tot[16 + rr.e1] + tot[8 + rr.e1] + atomicAdd((int*)&tot[24 + rr.e1], 1); RouteEnt z; z.tok = m; z.slot = 0; z.w = rr.p1; z.pad = 0; L[p] = z; }
        { const int p = tot[16 + rr.e2] + tot[8 + rr.e2] + atomicAdd((int*)&tot[24 + rr.e2], 1); RouteEnt z; z.tok = m; z.slot = 1; z.w = rr.p2; z.pad = 0; L[p] = z; } }
}
__device__ __forceinline__ void ph_gather(Frame& F, int p0, int p1) {
    const RouteEnt* L = (const RouteEnt*)(F.ws + WS_LIST); bf16* HG = (bf16*)(FBIG + BIG_HG);
    const int gw = F.bid * 8 + F.wave, NGW = F.G * 8, n = (p1 - p0) * 256;
    for (int r = gw; r < n; r += NGW) { const int tok = L[(size_t)p0 * 256 + r].tok;
        v4u a = (v4u){0u, 0u, 0u, 0u}, b = a;
        if (tok >= 0) { const v4u* s = (const v4u*)(FH + (size_t)tok * D); a = s[F.lane]; b = s[64 + F.lane]; }
        v4u* d = (v4u*)(HG + (size_t)r * D); d[F.lane] = a; d[64 + F.lane] = b; }
}
__device__ __forceinline__ void rope8(v4u& a, v4u& b, const float* cs, float sc) {
    unsigned* pa = (unsigned*)&a; unsigned* pb = (unsigned*)&b;
#pragma unroll
    for (int k = 0; k < 4; ++k) {
        float x1l = bflo(pa[k]), x1h = bfhi(pa[k]), x2l = bflo(pb[k]), x2h = bfhi(pb[k]);
        float c0 = 1.f, s0 = 0.f, c1 = 1.f, s1 = 0.f;
        if (cs) { c0 = cs[4 * k]; s0 = cs[4 * k + 1]; c1 = cs[4 * k + 2]; s1 = cs[4 * k + 3]; }
        const float o1l = (x1l * c0 - x2l * s0) * sc, o2l = (x1l * s0 + x2l * c0) * sc, o1h = (x1h * c1 - x2h * s1) * sc, o2h = (x1h * s1 + x2h * c1) * sc;
        pa[k] = cvt_pk_bf16(o1l, o1h); pb[k] = cvt_pk_bf16(o2l, o2h);
    }
}
__device__ __forceinline__ void ph_rope(Frame& F, int odd) {
    const int gw = F.bid * 8 + F.wave, NGW = F.G * 8;
    bf16* Z = (bf16*)FBIG;
    if (!odd) {
        const float* T = (const float*)(F.ws + WS_ROPE_R);
        const int tensor = F.lane >> 5, head = (F.lane >> 3) & 3, d0 = (F.lane & 7) * 8;
        const float sc = tensor ? 0.08838834764831845f : 1.0f;
        for (int m = gw; m < M; m += NGW) { const int t = m % TB;
            bf16* p = Z + (size_t)m * EV_IN + 1024 + tensor * 512 + head * 128 + d0;
            v4u a = *(v4u*)p, b = *(v4u*)(p + 64);
            if (t >= CTXL) { const int tl = t - CTXL, pos = d0 < 32 ? (tl >> 6) : (tl & 63), dq = d0 & 31; rope8(a, b, T + (pos * 32 + dq) * 2, sc); }
            else { if (!tensor) continue; rope8(a, b, nullptr, sc); }
            *(v4u*)p = a; *(v4u*)(p + 64) = b; }
    } else {
        const float* T = (const float*)(F.ws + WS_ROPE_D);
        for (int m = gw; m < M; m += NGW) { const int t = m % TB; if (t < CTXL) continue;
            const int tl = t - CTXL;
            for (int it = F.lane; it < 96; it += 64) { const int tensor = it / 48, r = it % 48, hm = r >> 2, d0 = (r & 3) * 8;
                bf16* p = Z + (size_t)m * OD_IN + 256 + tensor * 768 + hm * 64 + d0;
                v4u a = *(v4u*)p, b = *(v4u*)(p + 32);
                const int pos = d0 < 16 ? (tl >> 6) : (tl & 63), dq = d0 & 15; rope8(a, b, T + (pos * 16 + dq) * 2, 1.0f);
                *(v4u*)p = a; *(v4u*)(p + 32) = b; } }
    }
}
__device__ __forceinline__ void unpack8(const v4u& w, float* f) { f[0] = bflo(w.x); f[1] = bfhi(w.x); f[2] = bflo(w.y); f[3] = bfhi(w.y); f[4] = bflo(w.z); f[5] = bfhi(w.z); f[6] = bflo(w.w); f[7] = bfhi(w.w); }
__device__ __forceinline__ v4u pack8(const float* f) { v4u w; w.x = cvt_pk_bf16(f[0], f[1]); w.y = cvt_pk_bf16(f[2], f[3]); w.z = cvt_pk_bf16(f[4], f[5]); w.w = cvt_pk_bf16(f[6], f[7]); return w; }
__device__ __forceinline__ void ph_merge_even(Frame& F, int i) {
    const int gw = F.bid * 8 + F.wave, NGW = F.G * 8;
    const bf16* Z = (const bf16*)FBIG; const bf16* HF = (const bf16*)FYB; const bf16* HB = (const bf16*)(FYB + T_HALF);
    const bf16* RF = (const bf16*)(FYB + 2 * T_HALF); const bf16* RB = (const bf16*)(FYB + 3 * T_HALF);
    const float* gn = INP(14) + (size_t)i * 512; const int c0 = 8 * F.lane;
    float gnv[8];
#pragma unroll
    for (int k = 0; k < 8; ++k) gnv[k] = gn[c0 + k];
    for (int m = gw; m < M; m += NGW) {
        float a[8], b[8], g[8], o[8];
        unpack8(*(const v4u*)(HF + (size_t)m * 512 + c0), a); unpack8(*(const v4u*)(HB + (size_t)m * 512 + c0), b); unpack8(*(const v4u*)(Z + (size_t)m * EV_IN + 512 + c0), g);
#pragma unroll
        for (int k = 0; k < 8; ++k) o[k] = (a[k] + b[k]) * gelu_tanh(g[k]);
        *(v4u*)(FH + (size_t)m * D + c0) = pack8(o);
        unpack8(*(const v4u*)(RF + (size_t)m * 512 + c0), a); unpack8(*(const v4u*)(RB + (size_t)m * 512 + c0), b); unpack8(*(const v4u*)(Z + (size_t)m * EV_IN + 2560 + c0), g);
        float s = 0.f;
#pragma unroll
        for (int k = 0; k < 8; ++k) { a[k] += b[k]; s += a[k]; }
        s += __shfl_xor(s, 1); s += __shfl_xor(s, 2); s += __shfl_xor(s, 4); s += __shfl_xor(s, 8);
        const float mean = s * (1.0f / 128.0f); float q = 0.f;
#pragma unroll
        for (int k = 0; k < 8; ++k) { a[k] -= mean; q += a[k] * a[k]; }
        q += __shfl_xor(q, 1); q += __shfl_xor(q, 2); q += __shfl_xor(q, 4); q += __shfl_xor(q, 8);
        const float rs = 1.0f / sqrtf(q * (1.0f / 128.0f) + EPS);
#pragma unroll
        for (int k = 0; k < 8; ++k) o[k] = a[k] * rs * gnv[k] * (g[k] * sigmoidf_(g[k]));
        *(v4u*)(FH + (size_t)m * D + 512 + c0) = pack8(o);
    }
}
__device__ __forceinline__ void ph_zpass(Frame& F, int i) {
    const int gw = F.bid * 8 + F.wave, NGW = F.G * 8;
    const bf16* ZI = (const bf16*)FBIG; const bf16* YF = (const bf16*)FYB; const bf16* YB = (const bf16*)(FYB + T_QUART); bf16* ZO = (bf16*)(FYB + 2 * T_QUART);
    const float* dsk = INP(27) + (size_t)i * 256; const int c0 = 4 * F.lane;
    const f32x4 dv = *(const f32x4*)(dsk + c0);
    for (int m = gw; m < M; m += NGW) {
        const v2u a = *(const v2u*)(YF + (size_t)m * 256 + c0), b = *(const v2u*)(YB + (size_t)m * 256 + c0), u = *(const v2u*)(ZI + (size_t)m * OD_IN + c0);
        const float y0 = bflo(a.x) + bflo(b.x) + dv.x * bflo(u.x), y1 = bfhi(a.x) + bfhi(b.x) + dv.y * bfhi(u.x), y2 = bflo(a.y) + bflo(b.y) + dv.z * bflo(u.y), y3 = bfhi(a.y) + bfhi(b.y) + dv.w * bfhi(u.y);
        v2u w; w.x = cvt_pk_bf16(gelu_tanh(y0), gelu_tanh(y1)); w.y = cvt_pk_bf16(gelu_tanh(y2), gelu_tanh(y3));
        *(v2u*)(ZO + (size_t)m * 256 + c0) = w; }
}
__device__ __forceinline__ int chunk_tlo(int dir, int c) { return dir == 0 ? 128 * c : (c < 2 ? 128 * (1 - c) : 8576 - 128 * c); }

__device__ __forceinline__ void lru_item(Frame& F, int i, int b, int dir, int blk) {
    LAS unsigned char* lds = F.lds;
    LAS float* UR = (LAS float*)(lds);
    LAS float* AA = (LAS float*)(lds);
    LAS float* U = (LAS float*)(lds + 36864);
    LAS float* BB = U;
    LAS bf16* UB = (LAS bf16*)(lds + 69632);
    LAS float* SEG = (LAS float*)(lds + 88064);
    LAS float* PRM = (LAS float*)(lds + 92160);
    const int tid = F.tid, lane = F.lane, wave = F.wave, ch = tid & 63, seg = tid >> 6;
    const bf16* Z = (const bf16*)FBIG; bf16* OUT = (bf16*)(FYB + (size_t)dir * T_HALF);
    const float* conv_w = INP(8) + (size_t)i * 4 * 512; const float* conv_b = INP(9) + (size_t)i * 512;
    const float* gate_w = INP(10) + (((size_t)i * 2 + dir) * 2) * 8 * 64 * 64;
    const float* gate_b = INP(11) + (((size_t)i * 2 + dir) * 2) * 512;
    const float* lam = INP(12) + ((size_t)i * 2 + dir) * 512;
    __syncthreads();
    if (tid < 64) { const int cg = blk * 64 + tid;
        PRM[0 * 64 + tid] = conv_w[0 * 512 + cg]; PRM[1 * 64 + tid] = conv_w[1 * 512 + cg]; PRM[2 * 64 + tid] = conv_w[2 * 512 + cg]; PRM[3 * 64 + tid] = conv_w[3 * 512 + cg];
        PRM[4 * 64 + tid] = conv_b[cg]; const float lm = lam[cg]; PRM[5 * 64 + tid] = (-lm > 20.f) ? -lm : log1pf(expf(-lm));
        PRM[6 * 64 + tid] = gate_b[cg]; PRM[7 * 64 + tid] = gate_b[512 + cg]; }
    const int fr = lane & 15, fq = lane >> 4;
    bf16x8 wf[8][2];
#pragma unroll
    for (int nt = 0; nt < 8; ++nt)
#pragma unroll
        for (int ks = 0; ks < 2; ++ks) { const int col = 16 * nt + fr, gate = col >> 6, j = col & 63; const float* wp = gate_w + (((size_t)gate * 8 + blk) * 64 + (32 * ks + 8 * fq)) * 64 + j;
            v4u w; w.x = cvt_pk_bf16(wp[0], wp[64]); w.y = cvt_pk_bf16(wp[128], wp[192]); w.z = cvt_pk_bf16(wp[256], wp[320]); w.w = cvt_pk_bf16(wp[384], wp[448]);
            wf[nt][ks] = __builtin_bit_cast(bf16x8, w); }
    float carry = 0.f;
    __syncthreads();
    for (int c = 0; c < 66; ++c) {
        const int t_lo = chunk_tlo(dir, c), seq_lo = t_lo < CTXL ? 0 : CTXL, seq_hi = t_lo < CTXL ? CTXL : TB;
        const size_t rowbase = (size_t)b * TB;
        for (int it = tid; it < 131 * 8; it += 512) { const int r = it >> 3, cc = it & 7, t = t_lo - 2 + r; float f[8];
            if (t >= seq_lo && t < seq_hi) unpack8(*(const v4u*)(Z + (rowbase + t) * EV_IN + blk * 64 + cc * 8), f);
            else {
#pragma unroll
                for (int k = 0; k < 8; ++k) f[k] = 0.f; }
            *(LAS f32x4*)(UR + r * 64 + cc * 8) = (f32x4){f[0], f[1], f[2], f[3]}; *(LAS f32x4*)(UR + r * 64 + cc * 8 + 4) = (f32x4){f[4], f[5], f[6], f[7]}; }
        __syncthreads();
        { const float w0 = PRM[ch], w1 = PRM[64 + ch], w2 = PRM[128 + ch], w3 = PRM[192 + ch], cb = PRM[256 + ch];
#pragma unroll 4
          for (int k = 0; k < 16; ++k) { const int r = seg * 16 + k; const float u = cb + w0 * UR[r * 64 + ch] + w1 * UR[(r + 1) * 64 + ch] + w2 * UR[(r + 2) * 64 + ch] + w3 * UR[(r + 3) * 64 + ch];
              U[r * 64 + ch] = u; UB[r * 72 + ch] = (bf16)(cvt_pk_bf16(u, 0.f) & 0xffffu); } }
        __syncthreads();
        { f32x4 acc[8];
#pragma unroll
          for (int nt = 0; nt < 8; ++nt) acc[nt] = (f32x4){0.f, 0.f, 0.f, 0.f};
          const bf16x8 a0 = *(const LAS bf16x8*)(UB + (16 * wave + fr) * 72 + 8 * fq), a1 = *(const LAS bf16x8*)(UB + (16 * wave + fr) * 72 + 32 + 8 * fq);
#pragma unroll
          for (int nt = 0; nt < 8; ++nt) { acc[nt] = __builtin_amdgcn_mfma_f32_16x16x32_bf16(a0, wf[nt][0], acc[nt], 0, 0, 0); acc[nt] = __builtin_amdgcn_mfma_f32_16x16x32_bf16(a1, wf[nt][1], acc[nt], 0, 0, 0); }
#pragma unroll
          for (int nt = 0; nt < 4; ++nt) { const int cch = 16 * nt + fr; const float br = PRM[6 * 64 + cch], bi = PRM[7 * 64 + cch], sp = PRM[5 * 64 + cch];
#pragma unroll
              for (int rg = 0; rg < 4; ++rg) { const int r = 16 * wave + 4 * fq + rg; const float rgate = sigmoidf_(acc[nt][rg] + br), igate = sigmoidf_(acc[nt + 4][rg] + bi);
                  const float la = -8.0f * rgate * sp, av = expf(la), bv = sqrtf(-expm1f(2.0f * la)) * (igate * U[r * 64 + cch]);
                  AA[r * 64 + cch] = av; BB[r * 64 + cch] = bv; } } }
        __syncthreads();
        float hl[16], ca[16];
        { float h = 0.f, p = 1.f;
#pragma unroll
          for (int k = 0; k < 16; ++k) { const int ip = seg * 16 + k, r = dir == 0 ? ip : 127 - ip; const float av = AA[r * 64 + ch], bv = BB[r * 64 + ch]; h = av * h + bv; p *= av; hl[k] = h; ca[k] = p; }
          SEG[seg * 64 + ch] = p; SEG[512 + seg * 64 + ch] = h; }
        __syncthreads();
        float hin = carry, myin = 0.f;
#pragma unroll
        for (int s = 0; s < 8; ++s) { if (s == seg) myin = hin; hin = SEG[s * 64 + ch] * hin + SEG[512 + s * 64 + ch]; }
        carry = hin;
#pragma unroll
        for (int k = 0; k < 16; ++k) { const int ip = seg * 16 + k, r = dir == 0 ? ip : 127 - ip; const float h = hl[k] + ca[k] * myin;
            OUT[(rowbase + t_lo + r) * 512 + blk * 64 + ch] = (bf16)(cvt_pk_bf16(h, 0.f) & 0xffffu); }
        __syncthreads();
    }
}
__device__ __forceinline__ unsigned off_b(unsigned row, unsigned ch) { return 256u * row + 16u * (ch ^ (((row & 3) << 2) | ((row >> 2) & 3))); }
__device__ __forceinline__ unsigned row_read_addr(unsigned lane, unsigned rb, unsigned s) { return off_b(32 * rb + (lane & 31), 2 * s + (lane >> 5)); }
__device__ __forceinline__ unsigned tr_read_addr(unsigned lane, unsigned c, unsigned ks, unsigned t) {
    const unsigned h = lane >> 5, blk = (lane >> 4) & 1, q = (lane & 15) >> 2, p = lane & 3;
    return off_b(16 * ks + 8 * h + 4 * t + q, 4 * c + 2 * blk + (p >> 1)) + 8 * (p & 1);
}
typedef short v4i16_t __attribute__((ext_vector_type(4)));
__device__ __forceinline__ bf16x8 tr_frag(LAS unsigned char* tile, unsigned lane, unsigned c, unsigned ks) {
    const s16x4 lo = __builtin_bit_cast(s16x4, __builtin_amdgcn_ds_read_tr16_b64_v4i16((LAS v4i16_t*)(tile + tr_read_addr(lane, c, ks, 0))));
    const s16x4 hi = __builtin_bit_cast(s16x4, __builtin_amdgcn_ds_read_tr16_b64_v4i16((LAS v4i16_t*)(tile + tr_read_addr(lane, c, ks, 1))));
    return (bf16x8){lo[0], lo[1], lo[2], lo[3], hi[0], hi[1], hi[2], hi[3]};
}
__device__ __forceinline__ bf16x8 row_frag(LAS unsigned char* tile, unsigned lane, unsigned rb, unsigned s) { return *(const LAS bf16x8*)(tile + row_read_addr(lane, rb, s)); }
#define MFMA32(a, b, c) __builtin_amdgcn_mfma_f32_32x32x16_bf16((a), (b), (c), 0, 0, 0)

constexpr unsigned RT_KB = 0, RT_T2 = 32768, RT_QB = 65536, RT_VB = 98304;
__device__ __forceinline__ s16x4 ds_tr(LAS unsigned char* p) { return __builtin_bit_cast(s16x4, __builtin_amdgcn_ds_read_tr16_b64_v4i16((LAS v4i16_t*)p)); }
#define TRF(base0, base1, off) ({ const s16x4 lo_ = ds_tr(F.lds + (base0) + (off)), hi_ = ds_tr(F.lds + (base1) + (off)); (bf16x8){lo_[0], lo_[1], lo_[2], lo_[3], hi_[0], hi_[1], hi_[2], hi_[3]}; })
#define RWF(base, off) (*(const LAS bf16x8*)(F.lds + (base) + (off)))
__device__ __forceinline__ void ret_item(Frame& F, int li, int b, int head, int dir) {
    const int tid = F.tid, lane = F.lane, wave = F.wave, ib = wave & 3, eh = wave >> 2, r = lane & 31, h = lane >> 5;
    const bf16* Z = (const bf16*)FBIG; bf16* OUT = (bf16*)(FYB + (size_t)(2 + dir) * T_HALF);
    const float theta = INP(13)[((size_t)li * 2 + dir) * 4 + head];
    const float log_g = -((-theta > 20.f) ? -theta : log1pf(expf(-theta)));
    const float g1 = expf(log_g), g127 = expf(127.0f * log_g);
    const size_t rowbase = (size_t)b * TB;
    unsigned xsI[8], xsE[8];
    { const unsigned swz = ((r & 3) << 2) | ((r >> 2) & 3);
#pragma unroll
      for (int s = 0; s < 8; ++s) { const unsigned x = 256u * r + 16u * ((unsigned)(2 * s + h) ^ swz); xsI[s] = x + 8192u * ib + RT_QB; xsE[s] = x + 16384u * eh; } }
    const unsigned tK0 = RT_KB + tr_read_addr(lane, ib, 0, 0), tK1 = RT_KB + tr_read_addr(lane, ib, 0, 1);
    const unsigned tV00 = RT_VB + tr_read_addr(lane, 2 * eh, 0, 0), tV01 = RT_VB + tr_read_addr(lane, 2 * eh, 0, 1), tV10 = RT_VB + tr_read_addr(lane, 2 * eh + 1, 0, 0), tV11 = RT_VB + tr_read_addr(lane, 2 * eh + 1, 0, 1);
    __syncthreads();
    for (int it = tid; it < 2048; it += 512) *(LAS v4u*)(F.lds + RT_T2 + it * 16) = (v4u){0u, 0u, 0u, 0u};
    f32x16 SA[2]; SA[0] = f32x16{}; SA[1] = f32x16{};
    v4u pq[4], pk[4], pv[4];
#define RET_LOAD(c_) do { const int tl_ = chunk_tlo(dir, (c_)); _Pragma("unroll") for (int n_ = 0; n_ < 4; ++n_) { const int it_ = tid + 512 * n_, row_ = it_ >> 4, cn_ = it_ & 15; \
        const bf16* p_ = Z + (rowbase + tl_ + (dir == 0 ? row_ : 127 - row_)) * EV_IN + 1024 + head * 128 + cn_ * 8; pq[n_] = *(const v4u*)p_; pk[n_] = *(const v4u*)(p_ + 512); pv[n_] = *(const v4u*)(p_ + 1024); } } while (0)
    RET_LOAD(0);
#pragma nounroll
    for (int c = 0; c < 66; ++c) {
        const int t_lo = chunk_tlo(dir, c);
        __syncthreads();
#pragma unroll
        for (int n = 0; n < 4; ++n) { const int it = tid + 512 * n, row = it >> 4, cn = it & 15; const float sc = expf(-(float)row * log_g); const unsigned wo = off_b(row, cn);
            float f[8]; unpack8(pk[n], f);
#pragma unroll
            for (int k = 0; k < 8; ++k) f[k] *= sc;
            *(LAS v4u*)(F.lds + RT_QB + wo) = pq[n]; *(LAS v4u*)(F.lds + RT_KB + wo) = pack8(f); *(LAS v4u*)(F.lds + RT_VB + wo) = pv[n]; }
        if (c + 1 < 66) RET_LOAD(c + 1);
        __syncthreads();
        f32x16 OT[2], ST[2];
        OT[0] = f32x16{}; OT[1] = f32x16{}; ST[0] = f32x16{}; ST[1] = f32x16{};
#pragma unroll
        for (int s = 0; s < 8; ++s) { const bf16x8 qf = RWF(xsI[s], 0);
            OT[0] = MFMA32(RWF(xsE[s], RT_T2), qf, OT[0]); OT[1] = MFMA32(RWF(xsE[s], RT_T2 + 8192), qf, OT[1]);
            if (2 * eh <= ib) ST[0] = MFMA32(RWF(xsE[s], RT_KB), qf, ST[0]);
            if (2 * eh + 1 <= ib) ST[1] = MFMA32(RWF(xsE[s], RT_KB + 8192), qf, ST[1]); }
#pragma unroll
        for (int x = 0; x < 2; ++x)
#pragma unroll
            for (int q = 0; q < 16; ++q) SA[x][q] *= g1;
#pragma unroll
        for (int ks = 0; ks < 8; ++ks) { const bf16x8 kf = TRF(tK0, tK1, ks * 4096);
            SA[0] = MFMA32(kf, TRF(tV00, tV01, ks * 4096), SA[0]); SA[1] = MFMA32(kf, TRF(tV10, tV11, ks * 4096), SA[1]); }
#pragma unroll
        for (int x = 0; x < 2; ++x)
#pragma unroll
            for (int q = 0; q < 16; ++q) SA[x][q] *= g127;
        __syncthreads();
        const int irow = 32 * ib + r;
#pragma unroll
        for (int y = 0; y < 2; ++y) { const int jb = 2 * eh + y;
#pragma unroll
            for (int gq = 0; gq < 4; ++gq) { const int j0 = 32 * jb + 8 * gq + 4 * h; float p0 = ST[y][4 * gq], p1 = ST[y][4 * gq + 1], p2 = ST[y][4 * gq + 2], p3 = ST[y][4 * gq + 3];
                if (j0 > irow) p0 = 0.f; if (j0 + 1 > irow) p1 = 0.f; if (j0 + 2 > irow) p2 = 0.f; if (j0 + 3 > irow) p3 = 0.f;
                v2u w; w.x = cvt_pk_bf16(p0, p1); w.y = cvt_pk_bf16(p2, p3);
                *(LAS v2u*)(F.lds + RT_QB + off_b(irow, 4 * jb + gq) + 8 * h) = w; } }
#pragma unroll
        for (int x = 0; x < 2; ++x) { const int erow = 32 * (2 * eh + x) + r;
#pragma unroll
            for (int gq = 0; gq < 4; ++gq) { v2u w; w.x = cvt_pk_bf16(SA[x][4 * gq] * g1, SA[x][4 * gq + 1] * g1); w.y = cvt_pk_bf16(SA[x][4 * gq + 2] * g1, SA[x][4 * gq + 3] * g1);
                *(LAS v2u*)(F.lds + RT_T2 + off_b(erow, 4 * ib + gq) + 8 * h) = w; } }
        __syncthreads();
#pragma unroll
        for (int s = 0; s < 8; ++s) { const bf16x8 pf = RWF(xsI[s], 0);
            OT[0] = MFMA32(TRF(tV00, tV01, s * 4096), pf, OT[0]); OT[1] = MFMA32(TRF(tV10, tV11, s * 4096), pf, OT[1]); }
        { const float gi = expf((float)irow * log_g); const int t = t_lo + (dir == 0 ? irow : 127 - irow);
          bf16* op = OUT + (rowbase + t) * 512 + head * 128;
#pragma unroll
          for (int x = 0; x < 2; ++x)
#pragma unroll
              for (int gq = 0; gq < 4; ++gq) { v2u w; w.x = cvt_pk_bf16(OT[x][4 * gq] * gi, OT[x][4 * gq + 1] * gi); w.y = cvt_pk_bf16(OT[x][4 * gq + 2] * gi, OT[x][4 * gq + 3] * gi);
                  *(v2u*)(op + 32 * (2 * eh + x) + 8 * gq + 4 * h) = w; } }
    }
#undef RET_LOAD
}
#undef TRF
#undef RWF
#if DBG_SCAN
#define DBGCHK(stage, v) do { if (!(fabsf(v) < 1e30f)) atomicMax((unsigned*)(F.ws + WS_CTL) + 2049, 100u - (unsigned)(stage)); } while (0)
#else
#define DBGCHK(stage, v) do {} while (0)
#endif
__device__ __forceinline__ void s5_item(Frame& F, int li, int b, int dir, int g) {
    LAS unsigned char* lds = F.lds;
    LAS float* U = (LAS float*)lds;
    LAS float* SEG = (LAS float*)(lds + 8192);
    LAS bf16* HS = (LAS bf16*)(lds + 12288);
    const int tid = F.tid, lane = F.lane, wave = F.wave, p = tid & 63, seg = tid >> 6, fr = lane & 15, fq = lane >> 4;
    const bf16* Z = (const bf16*)FBIG; bf16* OUT = (bf16*)(FYB + (size_t)dir * T_QUART);
    const size_t pb = ((size_t)li * 2 + dir) * 16 + g;
    const float lre = INP(20)[pb * 64 + p], lim = INP(21)[pb * 64 + p], dt = expf(INP(22)[pb]);
    const float x = lre * dt, y = lim * dt, ex = expf(x); float sy, cy; sincosf(y, &sy, &cy);
    const float ar = ex * cy, ai = ex * sy;
    const float sh = sinf(0.5f * y), am1r = expm1f(x) * cy - 2.0f * sh * sh, am1i = ai;
    const float den = 1.0f / (lre * lre + lim * lim), cr = (am1r * lre + am1i * lim) * den, ci = (am1i * lre - am1r * lim) * den;
    float bbr[16], bbi[16];
#pragma unroll
    for (int k = 0; k < 16; ++k) { const float br = INP(23)[(pb * 64 + p) * 16 + k], bi = INP(24)[(pb * 64 + p) * 16 + k]; bbr[k] = cr * br - ci * bi; bbi[k] = cr * bi + ci * br; }
    DBGCHK(1, ar); DBGCHK(1, ai); DBGCHK(2, cr); DBGCHK(2, ci); DBGCHK(3, bbr[0] + bbi[0] + bbr[15] + bbi[15]);
    float a16r = ar, a16i = ai;
#pragma unroll
    for (int k = 0; k < 4; ++k) { const float tr_ = a16r * a16r - a16i * a16i, ti_ = 2.0f * a16r * a16i; a16r = tr_; a16i = ti_; }
    bf16x8 cf[4];
#pragma unroll
    for (int ks = 0; ks < 4; ++ks) { float v[8];
#pragma unroll
        for (int j = 0; j < 8; ++j) { const int k = 32 * ks + 8 * fq + j; v[j] = k < 64 ? INP(25)[(pb * 16 + fr) * 64 + k] : -INP(26)[(pb * 16 + fr) * 64 + (k - 64)]; }
        cf[ks] = __builtin_bit_cast(bf16x8, pack8(v)); }
    float hr = 0.f, hi = 0.f;
    const size_t rowbase = (size_t)b * TB;
    v4u pu = (v4u){0u, 0u, 0u, 0u};
#define S5_LOAD(c_) do { if (tid < 256) { const int tl_ = chunk_tlo(dir, (c_)), row_ = tid >> 1; pu = *(const v4u*)(Z + (rowbase + tl_ + (dir == 0 ? row_ : 127 - row_)) * OD_IN + g * 16 + (tid & 1) * 8); } } while (0)
    S5_LOAD(0);
    for (int c = 0; c < 66; ++c) {
        const int t_lo = chunk_tlo(dir, c);
        __syncthreads();
        if (tid < 256) { float f[8]; unpack8(pu, f); *(LAS f32x4*)(U + (tid >> 1) * 16 + (tid & 1) * 8) = (f32x4){f[0], f[1], f[2], f[3]}; *(LAS f32x4*)(U + (tid >> 1) * 16 + (tid & 1) * 8 + 4) = (f32x4){f[4], f[5], f[6], f[7]}; }
        if (c + 1 < 66) S5_LOAD(c + 1);
        __syncthreads();
        float lr[16], lim_[16];
        { float sr = 0.f, si = 0.f;
#pragma unroll
          for (int k = 0; k < 16; ++k) { const LAS f32x4* up = (const LAS f32x4*)(U + (seg * 16 + k) * 16); const f32x4 u0 = up[0], u1 = up[1], u2 = up[2], u3 = up[3];
              float br = bbr[0] * u0.x + bbr[1] * u0.y + bbr[2] * u0.z + bbr[3] * u0.w + bbr[4] * u1.x + bbr[5] * u1.y + bbr[6] * u1.z + bbr[7] * u1.w
                       + bbr[8] * u2.x + bbr[9] * u2.y + bbr[10] * u2.z + bbr[11] * u2.w + bbr[12] * u3.x + bbr[13] * u3.y + bbr[14] * u3.z + bbr[15] * u3.w;
              float bi = bbi[0] * u0.x + bbi[1] * u0.y + bbi[2] * u0.z + bbi[3] * u0.w + bbi[4] * u1.x + bbi[5] * u1.y + bbi[6] * u1.z + bbi[7] * u1.w
                       + bbi[8] * u2.x + bbi[9] * u2.y + bbi[10] * u2.z + bbi[11] * u2.w + bbi[12] * u3.x + bbi[13] * u3.y + bbi[14] * u3.z + bbi[15] * u3.w;
              const float nr = ar * sr - ai * si + br, ni = ar * si + ai * sr + bi; sr = nr; si = ni; lr[k] = sr; lim_[k] = si; }
          DBGCHK(4, sr + si); SEG[(seg * 64 + p) * 2] = sr; SEG[(seg * 64 + p) * 2 + 1] = si; }
        __syncthreads();
        float inr = 0.f, ini = 0.f;
#pragma unroll
        for (int s = 0; s < 8; ++s) { if (s == seg) { inr = hr; ini = hi; } const float er = SEG[(s * 64 + p) * 2], ei = SEG[(s * 64 + p) * 2 + 1];
            const float nr = a16r * hr - a16i * hi + er, ni = a16r * hi + a16i * hr + ei; hr = nr; hi = ni; }
        DBGCHK(5, hr + hi + inr + ini);
        { float pr = ar, pi = ai;
#pragma unroll
          for (int k = 0; k < 16; ++k) { const float vr = lr[k] + pr * inr - pi * ini, vi = lim_[k] + pr * ini + pi * inr;
              HS[(seg * 16 + k) * 136 + p] = (bf16)(cvt_pk_bf16(vr, 0.f) & 0xffffu); HS[(seg * 16 + k) * 136 + 64 + p] = (bf16)(cvt_pk_bf16(vi, 0.f) & 0xffffu);
              const float npr = pr * ar - pi * ai, npi = pr * ai + pi * ar; pr = npr; pi = npi; } }
        __syncthreads();
        { pg8::f32x4 acc = (pg8::f32x4){0.f, 0.f, 0.f, 0.f};
#pragma unroll
          for (int ks = 0; ks < 4; ++ks) { const bf16x8 af = *(const LAS bf16x8*)(HS + (16 * wave + fr) * 136 + 32 * ks + 8 * fq); acc = __builtin_amdgcn_mfma_f32_16x16x32_bf16(cf[ks], af, acc, 0, 0, 0); }
          DBGCHK(6, acc[0] + acc[1] + acc[2] + acc[3]);
          const int ip = 16 * wave + fr, t = t_lo + (dir == 0 ? ip : 127 - ip);
          v2u w; w.x = cvt_pk_bf16(acc[0], acc[1]); w.y = cvt_pk_bf16(acc[2], acc[3]);
          *(v2u*)(OUT + (rowbase + t) * 256 + g * 16 + 4 * fq) = w; }
    }
#undef S5_LOAD
}
namespace att {
constexpr int KVBLK = 64, LD = OD_IN;
constexpr float SCALE = 0.125f, THR = 8.f;
constexpr size_t SHM_V = KVBLK * 128 * 2, SHM_K = KVBLK * 128 * 2;
#define KSWZ(row, colB) ((row) * 256 + ((colB) ^ (((row) & 7) << 4)))
#define SBAR() __builtin_amdgcn_sched_barrier(0)
__device__ __forceinline__ int crow(int r, int hi) { return (r & 3) + 8 * (r >> 2) + 4 * hi; }
__device__ __forceinline__ void partialSM(f32x16& p0, f32x16& p1, float& m_reg, float& mn, float& alpha) {
  constexpr float C = SCALE * 1.4426950408889634f;
  float pmax = p0[0];
#pragma unroll
  for (int r = 1; r < 16; ++r) pmax = fmaxf(pmax, p0[r]);
#pragma unroll
  for (int r = 0; r < 16; ++r) pmax = fmaxf(pmax, p1[r]);
  { auto rr = __builtin_amdgcn_permlane32_swap(__float_as_uint(pmax), __float_as_uint(pmax), false, false);
    pmax = fmaxf(__uint_as_float(rr[0]), __uint_as_float(rr[1])); }
  if (__builtin_expect(__all(pmax - m_reg <= THR / SCALE), 1)) { mn = m_reg; alpha = 1.f; }
  else { mn = fmaxf(m_reg, pmax); alpha = __builtin_amdgcn_exp2f((m_reg - mn) * C); m_reg = mn; }
  const float mnC = -mn * C;
#pragma unroll
  for (int r = 0; r < 16; ++r) p0[r] = fmaf(p0[r], C, mnC);
#pragma unroll
  for (int r = 0; r < 16; ++r) p1[r] = fmaf(p1[r], C, mnC);
#pragma unroll
  for (int r = 0; r < 16; ++r) p0[r] = __builtin_amdgcn_exp2f(p0[r]);
}
__device__ __forceinline__ void finishSM(f32x16& p0, f32x16& p1, float alpha, float& l_reg, bf16x8& pa0, bf16x8& pa1, bf16x8& pa2, bf16x8& pa3) {
#pragma unroll
  for (int r = 0; r < 16; ++r) p1[r] = __builtin_amdgcn_exp2f(p1[r]);
  float ps = 0;
#pragma unroll
  for (int r = 0; r < 16; ++r) ps += p0[r];
#pragma unroll
  for (int r = 0; r < 16; ++r) ps += p1[r];
  { auto rr = __builtin_amdgcn_permlane32_swap(__float_as_uint(ps), __float_as_uint(ps), false, false);
    ps = __uint_as_float(rr[0]) + __uint_as_float(rr[1]); }
  l_reg = l_reg * alpha + ps;
#define PK4(P, BASE, OUT) do { unsigned a0 = cvt_pk_bf16(P[BASE + 0], P[BASE + 1]), a1 = cvt_pk_bf16(P[BASE + 2], P[BASE + 3]);   \
    unsigned b0 = cvt_pk_bf16(P[BASE + 4], P[BASE + 5]), b1 = cvt_pk_bf16(P[BASE + 6], P[BASE + 7]);                              \
    auto r0 = __builtin_amdgcn_permlane32_swap(a0, b0, false, false); auto r1 = __builtin_amdgcn_permlane32_swap(a1, b1, false, false); \
    v4u w = {r0[0], r1[0], r0[1], r1[1]}; OUT = __builtin_bit_cast(bf16x8, w); } while (0)
  PK4(p0, 0, pa0); PK4(p0, 8, pa1); PK4(p1, 0, pa2); PK4(p1, 8, pa3);
#undef PK4
}
__device__ __forceinline__ void qkt(f32x16& p0, f32x16& p1, const char* Ks, const bf16x8* qr, int r32, int hi, int mapoff) {
  p0 = f32x16{}; p1 = f32x16{};
#pragma unroll
  for (int d0 = 0; d0 < 4; ++d0) { const int cb = mapoff + (d0 * 16 + hi * 8) * 2;
    const bf16x8 b0 = *reinterpret_cast<const bf16x8*>(Ks + KSWZ(r32, cb));
    const bf16x8 b1 = *reinterpret_cast<const bf16x8*>(Ks + KSWZ(32 + r32, cb));
    p0 = __builtin_amdgcn_mfma_f32_32x32x16_bf16(b0, qr[d0], p0, 0, 0, 0);
    p1 = __builtin_amdgcn_mfma_f32_32x32x16_bf16(b1, qr[d0], p1, 0, 0, 0); }
}
__device__ __forceinline__ int v_st(int k, int c) { const int kk = (k & ~0xC) | ((k & 4) << 1) | ((k & 8) >> 1); return ((kk >> 3) * 4 + (c >> 5)) * 512 + ((kk & 7) * 32 + (c & 31)) * 2; }
__device__ __forceinline__ int v_rd_base(int lane) { return ((lane & 3) << 3) | (((lane >> 2) & 3) << 6) | (((lane >> 4) & 1) << 5) | (((lane >> 5) & 1) << 8); }
constexpr int v_rd_off(int d0, int ks, int half) { return d0 * 512 + ks * 4096 + half * 2048; }
template <int OFF> __device__ __forceinline__ s16x4 tr_read(int vb) {
  s16x4 r; asm volatile("ds_read_b64_tr_b16 %0, %1 offset:%2" : "=&v"(r) : "v"(vb), "i"(OFF) : "memory"); return r;
}
template <int D0> __device__ __forceinline__ void pv_one(f32x16& od, int vb, bf16x8 pa0, bf16x8 pa1, bf16x8 pa2, bf16x8 pa3) {
  const s16x4 l0 = tr_read<v_rd_off(D0, 0, 0)>(vb), h0 = tr_read<v_rd_off(D0, 0, 1)>(vb), l1 = tr_read<v_rd_off(D0, 1, 0)>(vb), h1 = tr_read<v_rd_off(D0, 1, 1)>(vb);
  const s16x4 l2 = tr_read<v_rd_off(D0, 2, 0)>(vb), h2 = tr_read<v_rd_off(D0, 2, 1)>(vb), l3 = tr_read<v_rd_off(D0, 3, 0)>(vb), h3 = tr_read<v_rd_off(D0, 3, 1)>(vb);
  asm volatile("s_waitcnt lgkmcnt(0)" ::: "memory"); SBAR();
#define PK(L, H) (bf16x8){L[0], L[1], L[2], L[3], H[0], H[1], H[2], H[3]}
  od = __builtin_amdgcn_mfma_f32_32x32x16_bf16(pa0, PK(l0, h0), od, 0, 0, 0);
  od = __builtin_amdgcn_mfma_f32_32x32x16_bf16(pa1, PK(l1, h1), od, 0, 0, 0);
  od = __builtin_amdgcn_mfma_f32_32x32x16_bf16(pa2, PK(l2, h2), od, 0, 0, 0);
  od = __builtin_amdgcn_mfma_f32_32x32x16_bf16(pa3, PK(l3, h3), od, 0, 0, 0);
#undef PK
}
__device__ __forceinline__ void pv_d0(f32x16* o, int vb, bf16x8 pa0, bf16x8 pa1, bf16x8 pa2, bf16x8 pa3) {
  pv_one<0>(o[0], vb, pa0, pa1, pa2, pa3); pv_one<1>(o[1], vb, pa0, pa1, pa2, pa3); pv_one<2>(o[2], vb, pa0, pa1, pa2, pa3); pv_one<3>(o[3], vb, pa0, pa1, pa2, pa3);
}
__device__ __forceinline__ void unit(const bf16* __restrict__ Qb, const bf16* __restrict__ Kh, const bf16* __restrict__ Vh, bf16* __restrict__ Ob, int seq, char* lds,
                                     float lam, float gsc, const float* __restrict__ gn, const int tid) {
  const int wid = tid >> 6, lane = tid & 63, r32 = lane & 31, hi = lane >> 5, map = wid >> 2, wq = wid & 3;
  char* V_lds = lds; char* K_lds = lds + 2 * SHM_V;
  float* ws = (float*)(lds + 2 * SHM_V + 2 * SHM_K) + wid * 64; float* li_l = ws; float* al_l = ws + 32;
  float m_reg = -1e30f, l_reg = 0; f32x16 o[4] = {}; bf16x8 qr[4];
  const bf16* Qw = Qb + (long)(wq * 32 + r32) * LD + map * 64 + hi * 8;
#pragma unroll
  for (int d0 = 0; d0 < 4; ++d0) qr[d0] = *reinterpret_cast<const bf16x8*>(Qw + d0 * 16);
  const int sr = tid >> 4, sc = (tid & 15) * 8, vst0 = v_st(sr, sc), vst1 = v_st(32 + sr, sc);
  const int vb0 = (int)(uintptr_t)V_lds + v_rd_base(lane);
  const int mapoff = map * 128;
  struct { bf16x8 vs0, vs1, ks0, ks1; } sr_[1];
  const unsigned go0 = (unsigned)(sr * LD + sc) * 2u, go1 = (unsigned)((32 + sr) * LD + sc) * 2u;
#define SLOAD(i, k0) do { const char* vb_ = (const char*)Vh + (size_t)(k0) * (LD * 2); const char* kb_ = (const char*)Kh + (size_t)(k0) * (LD * 2); \
    sr_[i].vs0 = *reinterpret_cast<const bf16x8*>(vb_ + go0); sr_[i].vs1 = *reinterpret_cast<const bf16x8*>(vb_ + go1); \
    sr_[i].ks0 = *reinterpret_cast<const bf16x8*>(kb_ + go0); sr_[i].ks1 = *reinterpret_cast<const bf16x8*>(kb_ + go1); } while (0)
#define SWRITE(b, i) do { *(bf16x8*)(V_lds + (b) * SHM_V + vst0) = sr_[i].vs0;          \
    *(bf16x8*)(V_lds + (b) * SHM_V + vst1) = sr_[i].vs1; const int kc = sc * 2;               \
    *(bf16x8*)(K_lds + (b) * SHM_K + KSWZ(sr, kc)) = sr_[i].ks0;                       \
    *(bf16x8*)(K_lds + (b) * SHM_K + KSWZ(32 + sr, kc)) = sr_[i].ks1; } while (0)
#define SWAIT() asm volatile("s_waitcnt vmcnt(0)" ::: "memory")
#define RESC(a) do { if (__any((a) < 1.f)) { if (hi == 0) al_l[r32] = (a); asm volatile("s_waitcnt lgkmcnt(0)" ::: "memory"); \
    _Pragma("unroll") for (int d = 0; d < 4; ++d) _Pragma("unroll") for (int r = 0; r < 16; ++r) o[d][r] *= al_l[crow(r, hi)]; } } while (0)
  f32x16 pA0, pA1, pB0, pB1; float mnA, mnB, alA, alB; bf16x8 pa0, pa1, pa2, pa3; const int NT = seq / KVBLK;
  constexpr int SE = 0, SO = 0;
  SLOAD(SE, 0); asm volatile("s_waitcnt vmcnt(0)" ::: "memory"); SWRITE(0, SE); __syncthreads();
  qkt(pA0, pA1, K_lds, qr, r32, hi, mapoff); partialSM(pA0, pA1, m_reg, mnA, alA);
  SLOAD(SO, KVBLK);
  SWAIT(); SWRITE(1, SO); __syncthreads();
  for (int j = 1; j + 1 < NT; j += 2) {
    SBAR(); qkt(pB0, pB1, K_lds + SHM_K, qr, r32, hi, mapoff);
    finishSM(pA0, pA1, alA, l_reg, pa0, pa1, pa2, pa3); SBAR();
    SLOAD(SO, (j + 1) * KVBLK); SBAR();
    pv_d0(o, vb0, pa0, pa1, pa2, pa3); partialSM(pB0, pB1, m_reg, mnB, alB);
    __syncthreads(); SWAIT(); SWRITE(0, SE);
    RESC(alB); __syncthreads();
    SBAR(); qkt(pA0, pA1, K_lds, qr, r32, hi, mapoff);
    finishSM(pB0, pB1, alB, l_reg, pa0, pa1, pa2, pa3); SBAR();
    SLOAD(SE, (j + 2) * KVBLK); SBAR();
    pv_d0(o, vb0 + (int)SHM_V, pa0, pa1, pa2, pa3); partialSM(pA0, pA1, m_reg, mnA, alA);
    __syncthreads(); SWAIT(); SWRITE(1, SO);
    RESC(alA); __syncthreads();
  }
  SBAR(); qkt(pB0, pB1, K_lds + SHM_K, qr, r32, hi, mapoff);
  finishSM(pA0, pA1, alA, l_reg, pa0, pa1, pa2, pa3); SBAR();
  pv_d0(o, vb0, pa0, pa1, pa2, pa3); partialSM(pB0, pB1, m_reg, mnB, alB);
  __syncthreads(); RESC(alB);
  finishSM(pB0, pB1, alB, l_reg, pa0, pa1, pa2, pa3); SBAR();
  pv_d0(o, vb0 + (int)SHM_V, pa0, pa1, pa2, pa3);
  if (hi == 0) li_l[r32] = l_reg; asm volatile("s_waitcnt lgkmcnt(0)" ::: "memory");
  float rli[16];
#pragma unroll
  for (int r = 0; r < 16; ++r) rli[r] = __builtin_amdgcn_rcpf(li_l[crow(r, hi)]);
  __syncthreads();
  int zz = 0; asm volatile("" : "+v"(zz));
  float* EX = (float*)lds;
  const int eb = wq * 4096 + lane + zz;
  if (map == 1) {
#pragma unroll
    for (int d0 = 0; d0 < 4; ++d0)
#pragma unroll
      for (int r = 0; r < 16; ++r) EX[eb + (d0 * 16 + r) * 64] = -lam * o[d0][r] * rli[r];
  }
  __syncthreads();
  if (map == 0) {
    float ss[16];
#pragma unroll
    for (int r = 0; r < 16; ++r) ss[r] = 0.f;
#pragma unroll
    for (int d0 = 0; d0 < 4; ++d0)
#pragma unroll
      for (int r = 0; r < 16; ++r) { const float v = o[d0][r] * rli[r] + EX[eb + (d0 * 16 + r) * 64]; o[d0][r] = v; ss[r] += v * v; }
#pragma unroll
    for (int r = 0; r < 16; ++r) { float s = ss[r]; s += __shfl_xor(s, 1); s += __shfl_xor(s, 2); s += __shfl_xor(s, 4); s += __shfl_xor(s, 8); s += __shfl_xor(s, 16);
      ss[r] = gsc / sqrtf(s * (1.0f / 128.0f) + EPS); }
    bf16* Ow = Ob + (long)(wq * 32 + 4 * hi) * 1024 + r32 + zz;
#pragma unroll
    for (int d0 = 0; d0 < 4; ++d0) { const float gv = gn[d0 * 32 + r32];
#pragma unroll
      for (int r = 0; r < 16; ++r) Ow[((r & 3) + 8 * (r >> 2)) * 1024 + d0 * 32] = (bf16)(cvt_pk_bf16(o[d0][r] * ss[r] * gv, 0.f) & 0xffffu); }
  }
  __syncthreads();
#undef SLOAD
#undef SWRITE
#undef SWAIT
#undef RESC
}
#undef KSWZ
#undef SBAR
}
__device__ __forceinline__ void ph_mix_even(Frame& F, int i) {
    for (int it = F.bid; it < 192; it += F.G) { LAUNDER(F);
#ifndef NO_RET
        if (it < 64) ret_item(F, i, it >> 3, (it >> 1) & 3, it & 1);
#endif
#ifndef NO_LRU
        if (it >= 64) { const int j = it - 64; lru_item(F, i, j >> 4, (j >> 3) & 1, j & 7); }
#endif
        __syncthreads();
    }
}
__device__ __forceinline__ void ph_mix_odd(Frame& F, int l, int ctx_out) {
    const int i = l >> 1;
#ifndef NO_S5
    for (int it = F.bid; it < 256; it += F.G) { LAUNDER(F); s5_item(F, i, it >> 5, (it >> 4) & 1, it & 15); __syncthreads(); }
#endif
    const float* lp = INP(30) + (size_t)i * 256;
    const float s01 = wave_sum(lp[F.lane] * lp[64 + F.lane]), s23 = wave_sum(lp[128 + F.lane] * lp[192 + F.lane]);
    const float lam_init = 0.8f - 0.6f * expf(-0.3f * (float)l), lam = expf(s01) - expf(s23) + lam_init, gsc = 1.0f - lam_init;
    const bf16* Z = (const bf16*)FBIG; const float* gn = INP(31) + (size_t)i * 768;
    const int vcu = (F.G % 8 == 0) ? (F.bid % 8) * (F.G / 8) + F.bid / 8 : F.bid;
    const int nx = NB * 6 * 64, nc = ctx_out ? NB * 6 * 2 : 0;
    for (int u = vcu; u < nx + nc; u += F.G) { LAUNDER(F);
        int bh, qb, row0, seq;
        if (u < nx) { bh = u >> 6; qb = u & 63; row0 = (bh / 6) * TB + CTXL + 128 * qb; seq = TB; }
        else { const int v = u - nx; bh = v >> 1; qb = v & 1; row0 = (bh / 6) * TB + 128 * qb; seq = CTXL; }
        const int b = bh / 6, h = bh % 6;
#ifndef NO_ATTN
        att::unit(Z + (size_t)row0 * OD_IN + 256 + h * 128, Z + (size_t)b * TB * OD_IN + 1024 + h * 128, Z + (size_t)b * TB * OD_IN + 1792 + h * 128,
                  FH + (size_t)row0 * D + 256 + h * 128, seq, (char*)F.lds, lam, gsc, gn + h * 128, F.tid);
#endif
    }
}

constexpr int PH_PER_LAYER = 18, PH_TOTAL = 2 + NLAYER * PH_PER_LAYER;
#define IN(k) (lo <= (k) && (k) < hi)
#define SEAM(k) do { if (IN((k) + 1)) xcd_barrier(bar); } while (0)
template <int l> __device__ __forceinline__ void run_layer(Frame& F, const XcdBarrier& bar, const int lo, const int hi) {
        constexpr int P = 1 + PH_PER_LAYER * l, i = l >> 1; constexpr bool odd = l & 1; constexpr int ctx_out = l < NLAYER - 1;
        const float* MODl = FMOD + (size_t)l * 9 * 6144; const float* ng = INP(6) + (size_t)l * 4 * 1024;
        if (IN(P + 0)) { LAUNDER(F);
            ph_convert(F, l);
            NormArgs a{}; a.xin_input = (l == 0); a.has_y = (l > 0); a.two = (l > 0) && ((l - 1) & 1); a.write_x = (l > 0); a.final_ = 0; a.do_h = 1; a.do_route = 0;
            if (l > 0) { a.gate = FMOD + (size_t)(l - 1) * 9 * 6144 + 5 * 1024; a.gy = INP(6) + (size_t)(l - 1) * 4 * 1024 + 3 * 1024; }
            a.gh = ng; a.shift = MODl; a.scale = MODl + 1024;
            __syncthreads(); ph_norm(F, a); SEAM(P + 0);
        }
        if (IN(P + 1)) { LAUNDER(F);
            const int N = odd ? OD_IN : EV_IN;
            pg8::Gemm g{FH, FWB + W_IN / 2, M, N, D}; pg8::StaticOrder S; S.init(M, N, F.G, F.bid);
            pg8::EpiPlain E{(bf16*)FBIG, N};
            pg8::gemm_phase<pg8::EpiPlain, pg8::StaticOrder, true, true>(F.lds, g, S, E, F.tid);
            SEAM(P + 1);
        }
        if (IN(P + 2)) { LAUNDER(F); ph_rope(F, odd); SEAM(P + 2); }
        if (IN(P + 3)) { LAUNDER(F); if (!odd) ph_mix_even(F, i); else ph_mix_odd(F, l, ctx_out); SEAM(P + 3); }
        if (IN(P + 4)) { LAUNDER(F); if (!odd) ph_merge_even(F, i); else ph_zpass(F, i); SEAM(P + 4); }
        if (odd && IN(P + 5)) { LAUNDER(F);
            int kglu = 256; asm volatile("" : "+s"(kglu));
            pg8::Gemm g{(const bf16*)(FYB + 2 * T_QUART), FWB + W_GLU / 2, M, 256, kglu}; pg8::StaticOrder S; S.init(M, 256, F.G, F.bid);
            pg8::EpiGLU E{FH, D, (const bf16*)(FYB + 2 * T_QUART), 256, INP(29) + (size_t)i * 256};
            pg8::gemm_phase<pg8::EpiGLU, pg8::StaticOrder, true, true>(F.lds, g, S, E, F.tid);
            SEAM(P + 5);
        }
        if (IN(P + 6)) { LAUNDER(F);
            pg8::Gemm g{FH, FWB + W_OUT / 2, M, D, D}; pg8::StaticOrder S; S.init(M, D, F.G, F.bid);
            pg8::EpiPlain E{(bf16*)FYB, D};
            pg8::gemm_phase<pg8::EpiPlain, pg8::StaticOrder, true, true>(F.lds, g, S, E, F.tid);
            SEAM(P + 6);
        }
        if (IN(P + 7)) { LAUNDER(F);
            NormArgs a{}; a.xin_input = (l == 0); a.has_y = 1; a.two = 0; a.write_x = 1; a.final_ = 0; a.do_h = 1; a.do_route = odd;
            a.gate = MODl + 2 * 1024; a.gy = ng + 1024; a.gh = ng + 2 * 1024; a.shift = MODl + 3 * 1024; a.scale = MODl + 4 * 1024;
            a.rw = INP(33) + (size_t)i * 8192; a.rb = INP(34) + (size_t)i * 8;
            ph_norm(F, a); SEAM(P + 7);
        }
        if (!odd) {
            if (IN(P + 9)) { LAUNDER(F);
                pg8::Gemm g{FH, FWB + W_GU / 2, M, 2 * DFF, D}; pg8::StaticOrder S; S.init(M, 2 * DFF, F.G, F.bid);
                pg8::EpiSwiGLU E{(bf16*)(FBIG + BIG_ACT), DFF};
                pg8::gemm_phase<pg8::EpiSwiGLU, pg8::StaticOrder, true, true>(F.lds, g, S, E, F.tid);
                SEAM(P + 9);
            }
            if (IN(P + 10)) { LAUNDER(F);
                pg8::Gemm g{(const bf16*)(FBIG + BIG_ACT), FWB + W_DN / 2, M, D, DFF}; pg8::StaticOrder S; S.init(M, D, F.G, F.bid);
                pg8::EpiPlain E{(bf16*)FYB, D};
                pg8::gemm_phase<pg8::EpiPlain, pg8::StaticOrder, true, true>(F.lds, g, S, E, F.tid);
                SEAM(P + 10);
            }
        } else {
            if (IN(P + 8)) { LAUNDER(F); ph_assign(F); SEAM(P + 8); }
#pragma nounroll
            for (int w = 0; w < 3; ++w) {
                const int* PE = (const int*)(F.ws + WS_PEXP);
                if (IN(P + 9 + 3 * w)) { LAUNDER(F); const int np = PE[MAXP], p0 = min(np, PW * w), p1 = min(np, PW * (w + 1)); ph_gather(F, p0, p1); SEAM(P + 9 + 3 * w); }
                if (IN(P + 10 + 3 * w)) { LAUNDER(F); const int np = PE[MAXP], p0 = min(np, PW * w), p1 = min(np, PW * (w + 1));
                    pg8::Gemm g{(const bf16*)(FBIG + BIG_HG), FWB + W_MGU / 2, (p1 - p0) * 256, 2 * DFF, D};
                    pg8::ExpertOrder S; S.init((p1 - p0) * 256, 2 * DFF, F.G, F.bid); S.pexp = PE + p0; S.estride = (size_t)7168 * 1024 * 2;
                    pg8::EpiSwiGLU E{(bf16*)(FBIG + BIG_ACT), DFF};
                    pg8::gemm_phase<pg8::EpiSwiGLU, pg8::ExpertOrder, true, true>(F.lds, g, S, E, F.tid);
                    SEAM(P + 10 + 3 * w); }
                if (IN(P + 11 + 3 * w)) { LAUNDER(F); const int np = PE[MAXP], p0 = min(np, PW * w), p1 = min(np, PW * (w + 1));
                    pg8::Gemm g{(const bf16*)(FBIG + BIG_ACT), FWB + W_MDN / 2, (p1 - p0) * 256, D, DFF};
                    pg8::ExpertOrder S; S.init((p1 - p0) * 256, D, F.G, F.bid); S.pexp = PE + p0; S.estride = (size_t)1024 * 3584 * 2;
                    pg8::EpiScatter E{(const RouteEnt*)(F.ws + WS_LIST) + (size_t)p0 * 256, (bf16*)FYB, (size_t)M * 1024, D};
                    pg8::gemm_phase<pg8::EpiScatter, pg8::ExpertOrder, true, true>(F.lds, g, S, E, F.tid);
                    SEAM(P + 11 + 3 * w); }
            }
        }
    }
#undef IN
#undef SEAM
__global__ void __launch_bounds__(512, 2) hybrid_fwd(Args args) {
    extern __shared__ __attribute__((aligned(16))) unsigned char lds_raw[];
    Frame F;
    F.lds = (LAS unsigned char*)lds_raw; F.ws = args.ws;
    F.tid = threadIdx.x; F.lane = F.tid & 63; F.wave = __builtin_amdgcn_readfirstlane(F.tid >> 6); F.G = gridDim.x; F.bid = blockIdx.x;
    F.A = (KArgs*)__builtin_amdgcn_kernarg_segment_ptr();
    volatile LAS unsigned* MISC = (volatile LAS unsigned*)(F.lds + MISC_OFF);
    for (int u = F.tid; u < (LDS_BYTES - LDSCTL_OFF) / 4; u += 512) ((LAS unsigned*)(F.lds + LDSCTL_OFF))[u] = 0u;
    __syncthreads();
    const int lo = args.ph_lo, hi = args.ph_hi;
    const bool multi = (hi - lo) > 1;
    unsigned* ctl = (unsigned*)(args.ws + WS_CTL);
    XcdBarrier bar; bar.bar = ctl + CW_BAR; bar.x = 0; bar.st = nullptr;
    if (multi) bar = xcd_barrier_post(ctl + CW_BAR, MISC + 8);
#define IN(k) (lo <= (k) && (k) < hi)
#define SEAM(k) do { if (IN((k) + 1)) xcd_barrier(bar); } while (0)
    if (IN(0)) { LAUNDER(F); ph_prologue(F); SEAM(0); }
    run_layer<0>(F, bar, lo, hi); run_layer<1>(F, bar, lo, hi); run_layer<2>(F, bar, lo, hi); run_layer<3>(F, bar, lo, hi);
    if (IN(PH_TOTAL - 1)) { LAUNDER(F);
        NormArgs a{}; a.xin_input = 0; a.has_y = 1; a.two = 1; a.write_x = 1; a.final_ = 1; a.do_h = 0; a.do_route = 0;
        a.gate = FMOD + (size_t)3 * 9 * 6144 + 5 * 1024; a.gy = INP(6) + (size_t)3 * 4 * 1024 + 3 * 1024;
        ph_norm(F, a);
    }
#undef IN
#undef SEAM
}


#ifndef DBG_SCAN
#define DBG_SCAN 0
#endif
#if DBG_SCAN
constexpr int CW_DBG = 2048;
__global__ void __launch_bounds__(256) dbg_scan(unsigned char* ws, const float* out, int phase) {
    unsigned* flag = (unsigned*)(ws + WS_CTL) + CW_DBG; bool bad = false;
    const size_t gt = (size_t)blockIdx.x * 256 + threadIdx.x, gs = (size_t)gridDim.x * 256;
    { const uint4* p = (const uint4*)(ws + WS_W); const size_t n = (WS_END - WS_W) / 16;
      for (size_t i = gt; i < n; i += gs) { const uint4 v = p[i]; const unsigned w[4] = {v.x, v.y, v.z, v.w};
#pragma unroll
          for (int k = 0; k < 4; ++k) { if ((w[k] & 0x7F80u) == 0x7F80u || (w[k] & 0x7F800000u) == 0x7F800000u) bad = true; } } }
    { const uint4* p = (const uint4*)(ws + WS_XC); const size_t n = (size_t)NB * CTXL * D / 4;
      for (size_t i = gt; i < n; i += gs) { const uint4 v = p[i]; if ((v.x & 0x7F800000u) == 0x7F800000u || (v.y & 0x7F800000u) == 0x7F800000u || (v.z & 0x7F800000u) == 0x7F800000u || (v.w & 0x7F800000u) == 0x7F800000u) bad = true; } }
    { const uint4* p = (const uint4*)out; const size_t n = (size_t)NB * SEQ * D / 4;
      for (size_t i = gt; i < n; i += gs) { const uint4 v = p[i]; if ((v.x & 0x7F800000u) == 0x7F800000u || (v.y & 0x7F800000u) == 0x7F800000u || (v.z & 0x7F800000u) == 0x7F800000u || (v.w & 0x7F800000u) == 0x7F800000u) bad = true; } }
    { const unsigned* p = (const unsigned*)(ws + WS_MOD); const size_t n = 4 * 9 * 6144;
      for (size_t i = gt; i < n; i += gs) if ((p[i] & 0x7F800000u) == 0x7F800000u) bad = true; }
    if (bad) atomicMax(flag, 1000u - (unsigned)phase);
}
__global__ void __launch_bounds__(256) dbg_emit(unsigned char* ws, float* out) {
    const unsigned f = ((const unsigned*)(ws + WS_CTL))[CW_DBG], f2 = ((const unsigned*)(ws + WS_CTL))[CW_DBG + 1]; if (f == 0u && f2 == 0u) return;
    const int p = f2 ? 40 + (100 - (int)f2) : 1000 - (int)f;
    const size_t n = (size_t)NB * SEQ * D;
    for (size_t i = (size_t)blockIdx.x * 256 + threadIdx.x; i < n; i += (size_t)gridDim.x * 256) out[i] = (i == 0) ? ldexpf(1.0f, 14 + p) : 0.f;
}
#endif
static bool phase_exists(int ph) {
    if (ph == 0 || ph == PH_TOTAL - 1) return true;
    const int l = (ph - 1) / PH_PER_LAYER, k = (ph - 1) % PH_PER_LAYER; const bool odd = l & 1;
    if (odd) return true;
    return k <= 4 || k == 6 || k == 7 || k == 9 || k == 10;
}
#ifndef MK_ONE_LAUNCH
#define MK_ONE_LAUNCH 1
#endif
extern "C" void kernel_launch(void* const* d_in, const int* in_sizes, int n_in, void* d_out, int out_size, void* d_ws, size_t ws_size, hipStream_t stream) {
    static int grid = 0;
    if (grid == 0) {
        if (n_in != 38 || in_sizes[0] != NB * SEQ * D || out_size != NB * SEQ * D || ws_size < WS_END) { fprintf(stderr, "kernel_launch: unexpected shapes / workspace (%d inputs, ws %zu)\n", n_in, ws_size); grid = -1; return; }
        int dev = 0, cus = 0, per_cu = 0;
        if (hipGetDevice(&dev) != hipSuccess || hipDeviceGetAttribute(&cus, hipDeviceAttributeMultiprocessorCount, dev) != hipSuccess) { grid = -1; return; }
        if (hipFuncSetAttribute((const void*)hybrid_fwd, hipFuncAttributeMaxDynamicSharedMemorySize, LDS_BYTES) != hipSuccess) { fprintf(stderr, "kernel_launch: hipFuncSetAttribute failed\n"); grid = -1; return; }
        if (hipOccupancyMaxActiveBlocksPerMultiprocessor(&per_cu, (const void*)hybrid_fwd, 512, LDS_BYTES) != hipSuccess || per_cu < 1) fprintf(stderr, "kernel_launch: occupancy query reports %d workgroups per CU\n", per_cu);
        (void)hipGetLastError();
        grid = cus;
    }
    if (grid < 0) return;
    if (hipMemsetAsync((char*)d_ws + WS_CTL, 0, CTL_ZERO_BYTES, stream) != hipSuccess) return;
#if DBG_SCAN
    (void)hipMemsetAsync(d_ws, 0, WS_END, stream); (void)hipMemsetAsync(d_out, 0, (size_t)out_size * 4, stream);
#endif
    Args a{};
    for (int i = 0; i < 38; ++i) a.in[i] = (const float*)d_in[i];
    a.out = (float*)d_out; a.ws = (unsigned char*)d_ws;
    if (MK_ONE_LAUNCH) { a.ph_lo = 0; a.ph_hi = PH_TOTAL; hipLaunchKernelGGL(hybrid_fwd, dim3(grid), dim3(512), LDS_BYTES, stream, a); }
    else for (int ph = 0; ph < PH_TOTAL; ++ph) { if (!phase_exists(ph)) continue; a.ph_lo = ph; a.ph_hi = ph + 1; hipLaunchKernelGGL(hybrid_fwd, dim3(grid), dim3(512), LDS_BYTES, stream, a);
#if DBG_SCAN
        hipLaunchKernelGGL(dbg_scan, dim3(2048), dim3(256), 0, stream, (unsigned char*)d_ws, (const float*)d_out, ph);
#endif
    }
#if DBG_SCAN
    hipLaunchKernelGGL(dbg_emit, dim3(2048), dim3(256), 0, stream, (unsigned char*)d_ws, (float*)d_out);
#endif
    const hipError_t le = hipPeekAtLastError();
    if (le != hipSuccess) fprintf(stderr, "kernel_launch: launch failed: %s\n", hipGetErrorName(le));
}
```

```cpp
#include <hip/hip_runtime.h>
#include <cstdio>
#include <cstdint>
#include <cmath>
#define DBG_SCAN 0
namespace pg8 {
#define PG8_LAS __attribute__((address_space(3)))
typedef unsigned short bf16_t;
typedef short bf16x8 __attribute__((ext_vector_type(8)));
typedef float f32x4 __attribute__((ext_vector_type(4)));
typedef unsigned u32x4 __attribute__((ext_vector_type(4)));
constexpr int BM = 256, BK = 64, HALF = 128, HTB = HALF * BK * 2  , STAGE_BYTES = 8 * HTB, NXCD = 8, WGM = 8;

__host__ __device__ __forceinline__ int lds_byte(int r, int c) { const int st = (r >> 4) * 2 + (c >> 5), rr = r & 15, cc = c & 31, ob = rr * 64 + cc * 2; return st * 1024 + (ob ^ (((ob >> 9) & 1) << 5)); }
__host__ __device__ __forceinline__ void stage_rc(int b, int& R, int& C) { const int st = b / 1024, sb = b % 1024, swz = sb ^ (((sb >> 9) & 1) << 5); R = (st >> 1) * 16 + swz / 64; C = (st & 1) * 32 + (swz % 64) / 2; }
__host__ __device__ __forceinline__ int perm32(int rho) { const int n = rho >> 4, i = rho & 15; return 8 * (i >> 2) + 4 * n + (i & 3); }

struct Unit { int pm, pn; };
struct Gemm { const bf16_t* A; const bf16_t* Bt; int M, N, K; };

typedef float f32x2_cv __attribute__((ext_vector_type(2))); typedef __bf16 bf16x2_cv __attribute__((ext_vector_type(2)));
__device__ __forceinline__ unsigned cvt_pk_bf16(float lo, float hi) { const f32x2_cv v = {lo, hi}; const bf16x2_cv b = __builtin_convertvector(v, bf16x2_cv); return __builtin_bit_cast(unsigned, b); }
struct StaticOrder {
    int nM, nN, nwg, G, c;
    __host__ __device__ void init(int M, int N, int G_, int c_) { nM = M / BM; nN = N / BM; nwg = nM * nN; G = G_; c = c_; }
    __host__ __device__ bool next(int i, Unit& u) const {
        const long L = (long)i * G + c; if (L >= nwg) return false;
        int wgid = (int)L; { const int q = nwg / NXCD, r = nwg % NXCD, xcd = wgid % NXCD, off = wgid / NXCD; wgid = (xcd < r ? xcd * (q + 1) : r * (q + 1) + (xcd - r) * q) + off; }
        const int nig = WGM * nN, gid = wgid / nig, fm = gid * WGM, gsz = (nM - fm) < WGM ? (nM - fm) : WGM;
        u.pm = fm + ((wgid % nig) % gsz); u.pn = (wgid % nig) / gsz; return true;
    }
    __device__ __forceinline__ const char* bptr(const Gemm& g, const Unit& u) const { return (const char*)g.Bt + (size_t)u.pn * ((size_t)BM * g.K * 2); }
    __device__ __forceinline__ void a_ready(const Unit&) const {}
    __device__ __forceinline__ void done(const Unit&) const {}
};
struct ExpertOrder : StaticOrder {
    const int* pexp; size_t estride;
    __device__ __forceinline__ const char* bptr(const Gemm& g, const Unit& u) const { return (const char*)g.Bt + (size_t)pexp[u.pm] * estride + (size_t)u.pn * ((size_t)BM * g.K * 2); }
};
__device__ __forceinline__ float fast_sigmoid(float x) { return __builtin_amdgcn_rcpf(1.0f + __builtin_amdgcn_exp2f(-1.4426950408889634f * x)); }
__device__ __forceinline__ float bflo(unsigned w) { return __uint_as_float(w << 16); }
__device__ __forceinline__ float bfhi(unsigned w) { return __uint_as_float(w & 0xffff0000u); }
struct EpiPlain {
    static constexpr bool PERM = true, AFTER_DRAIN = false;
    bf16_t* O; int ldc;
    __device__ __forceinline__ void operator()(const f32x4 (&acc)[2][2][4][2], const Unit& u, int wr, int wc, int fr, int fq) const {
        const int row0 = u.pm * BM + wr * 64 + fr, col0 = u.pn * BM + wc * 32 + 8 * fq;
#pragma unroll
        for (int ai = 0; ai < 2; ++ai)
#pragma unroll
            for (int m = 0; m < 4; ++m) { bf16_t* rowp = O + (size_t)(row0 + ai * HALF + m * 16) * ldc + col0;
#pragma unroll
                for (int bj = 0; bj < 2; ++bj) { const f32x4 v0 = acc[ai][bj][m][0], v1 = acc[ai][bj][m][1];
                    u32x4 w; w.x = cvt_pk_bf16(v0[0], v0[1]); w.y = cvt_pk_bf16(v0[2], v0[3]); w.z = cvt_pk_bf16(v1[0], v1[1]); w.w = cvt_pk_bf16(v1[2], v1[3]);
                    *(u32x4*)(rowp + bj * HALF) = w; } }
    }
};
struct EpiSwiGLU {
    static constexpr bool PERM = true, AFTER_DRAIN = false;
    bf16_t* O; int ldc;
    __device__ __forceinline__ void operator()(const f32x4 (&acc)[2][2][4][2], const Unit& u, int wr, int wc, int fr, int fq) const {
        const int row0 = u.pm * BM + wr * 64 + fr, col0 = u.pn * HALF + wc * 32 + 8 * fq;
#pragma unroll
        for (int ai = 0; ai < 2; ++ai)
#pragma unroll
            for (int m = 0; m < 4; ++m) { bf16_t* rowp = O + (size_t)(row0 + ai * HALF + m * 16) * ldc + col0;
                float o[8];
#pragma unroll
                for (int n = 0; n < 2; ++n)
#pragma unroll
                    for (int i = 0; i < 4; ++i) { const float g = acc[ai][0][m][n][i], up = acc[ai][1][m][n][i]; o[n * 4 + i] = g * fast_sigmoid(g) * up; }
                u32x4 w; w.x = cvt_pk_bf16(o[0], o[1]); w.y = cvt_pk_bf16(o[2], o[3]); w.z = cvt_pk_bf16(o[4], o[5]); w.w = cvt_pk_bf16(o[6], o[7]);
                *(u32x4*)rowp = w; }
    }
};
struct EpiGLU {
    static constexpr bool PERM = true, AFTER_DRAIN = false;
    bf16_t* O; int ldc; const bf16_t* Z; int ldz; const float* bias;
    __device__ __forceinline__ void operator()(const f32x4 (&acc)[2][2][4][2], const Unit& u, int wr, int wc, int fr, int fq) const {
        const int row0 = u.pm * BM + wr * 64 + fr, col0 = u.pn * BM + wc * 32 + 8 * fq;
#pragma unroll
        for (int bj = 0; bj < 2; ++bj) { const f32x4 b0 = *(const f32x4*)(bias + col0 + bj * HALF), b1 = *(const f32x4*)(bias + col0 + bj * HALF + 4);
#pragma unroll
            for (int ai = 0; ai < 2; ++ai)
#pragma unroll
                for (int m = 0; m < 4; ++m) { const size_t r = (size_t)(row0 + ai * HALF + m * 16);
                    const u32x4 zz = *(const u32x4*)(Z + r * ldz + col0 + bj * HALF);
                    const f32x4 v0 = acc[ai][bj][m][0] + b0, v1 = acc[ai][bj][m][1] + b1;
                    u32x4 w; w.x = cvt_pk_bf16(bflo(zz.x) * fast_sigmoid(v0[0]), bfhi(zz.x) * fast_sigmoid(v0[1])); w.y = cvt_pk_bf16(bflo(zz.y) * fast_sigmoid(v0[2]), bfhi(zz.y) * fast_sigmoid(v0[3]));
                    w.z = cvt_pk_bf16(bflo(zz.z) * fast_sigmoid(v1[0]), bfhi(zz.z) * fast_sigmoid(v1[1])); w.w = cvt_pk_bf16(bflo(zz.w) * fast_sigmoid(v1[2]), bfhi(zz.w) * fast_sigmoid(v1[3]));
                    *(u32x4*)(O + r * ldc + col0 + bj * HALF) = w; } }
    }
};
struct RouteEnt { int tok; int slot; float w; int pad; };
struct EpiScatter {
    static constexpr bool PERM = true, AFTER_DRAIN = false;
    const RouteEnt* L; bf16_t* Y; size_t slot_stride; int ldc;
    __device__ __forceinline__ void operator()(const f32x4 (&acc)[2][2][4][2], const Unit& u, int wr, int wc, int fr, int fq) const {
        const int row0 = u.pm * BM + wr * 64 + fr, col0 = u.pn * BM + wc * 32 + 8 * fq;
#pragma unroll
        for (int ai = 0; ai < 2; ++ai)
#pragma unroll
            for (int m = 0; m < 4; ++m) { const RouteEnt e = L[row0 + ai * HALF + m * 16];
                if (e.tok >= 0) { bf16_t* rowp = Y + (size_t)e.slot * slot_stride + (size_t)e.tok * ldc + col0;
#pragma unroll
                    for (int bj = 0; bj < 2; ++bj) { const f32x4 v0 = acc[ai][bj][m][0] * e.w, v1 = acc[ai][bj][m][1] * e.w;
                        u32x4 w; w.x = cvt_pk_bf16(v0[0], v0[1]); w.y = cvt_pk_bf16(v0[2], v0[3]); w.z = cvt_pk_bf16(v1[0], v1[1]); w.w = cvt_pk_bf16(v1[2], v1[3]);
                        *(u32x4*)(rowp + bj * HALF) = w; } } }
    }
};
template <class Epi, class Sched, bool ALIGN_EPI = false, bool SP2 = false>
__device__ __forceinline__ void gemm_phase(PG8_LAS unsigned char* lds, const Gemm g, const Sched& S, const Epi& E, const int tid) {
    const int wid = __builtin_amdgcn_readfirstlane(tid >> 6), lane = tid & 63, wr = wid >> 2, wc = wid & 3, fr = lane & 15, fq = lane >> 4;
    const int K = g.K, nt = K / BK;
    unsigned voffA[2], voffB[2];
#pragma unroll
    for (int i = 0; i < 2; ++i) { int R, C; stage_rc(tid * 16 + i * 8192, R, C); const int Rb = Epi::PERM ? ((R & ~31) + perm32(R & 31)) : R;
        voffA[i] = (unsigned)(R * K + C) * 2u; voffB[i] = (unsigned)(Rb * K + C) * 2u; }
    const size_t kstep = (size_t)(BK * 2);
    const size_t hstep = (size_t)HALF * K * 2;
    const size_t tstep = 2 * hstep;
    const unsigned ldsw = (unsigned)wid * 1024u;
    const int aoff = lds_byte(wr * 64 + fr, fq * 8), boff = lds_byte(wc * 32 + fr, fq * 8);
#define PG8_SA(b, h) (((b) * 2 + (h)) * HTB)
#define PG8_SB(b, h) ((4 + (b) * 2 + (h)) * HTB)
#define PG8_STAGE(bufoff, gbase, voff) do { _Pragma("unroll") for (int _i = 0; _i < 2; ++_i) \
        __builtin_amdgcn_global_load_lds((const unsigned*)((const char*)(gbase) + (voff)[_i]), (PG8_LAS unsigned*)(lds + (bufoff) + ldsw + _i * 8192), 16, 0, 0); } while (0)
#define PG8_LDA(dst, b, h) do { _Pragma("unroll") for (int m = 0; m < 4; ++m) _Pragma("unroll") for (int k = 0; k < 2; ++k) dst[m][k] = *(const PG8_LAS bf16x8*)(lds + PG8_SA(b, h) + aoff + m * 2048 + k * 1024); } while (0)
#define PG8_LDB(dst, b, h) do { _Pragma("unroll") for (int n = 0; n < 2; ++n) _Pragma("unroll") for (int k = 0; k < 2; ++k) dst[n][k] = *(const PG8_LAS bf16x8*)(lds + PG8_SB(b, h) + boff + n * 2048 + k * 1024); } while (0)
#define PG8_MMA(ai, bj, At, Bt) do { __builtin_amdgcn_s_setprio(1); _Pragma("unroll") for (int m = 0; m < 4; ++m) _Pragma("unroll") for (int n = 0; n < 2; ++n) _Pragma("unroll") for (int k = 0; k < 2; ++k) \
        acc[ai][bj][m][n] = __builtin_amdgcn_mfma_f32_16x16x32_bf16(Bt[n][k], At[m][k], acc[ai][bj][m][n], 0, 0, 0); __builtin_amdgcn_s_setprio(0); } while (0)
#define PG8_WAIT_V(n) asm volatile("s_waitcnt vmcnt(" #n ")" ::: "memory")
#define PG8_WAIT_L(n) asm volatile("s_waitcnt lgkmcnt(" #n ")" ::: "memory")
#define PG8_BAR __builtin_amdgcn_s_barrier()
#define PG8_SCHED __builtin_amdgcn_sched_barrier(0)
    Unit cur, nxt; int ui = 0;
    if (!S.next(0, cur)) return;
    f32x4 acc[2][2][4][2];
#pragma unroll
    for (int a = 0; a < 2; ++a)
#pragma unroll
        for (int b = 0; b < 2; ++b)
#pragma unroll
            for (int m = 0; m < 4; ++m)
#pragma unroll
                for (int n = 0; n < 2; ++n) acc[a][b][m][n] = (f32x4){0.f, 0.f, 0.f, 0.f};
    bf16x8 At[4][2], B0[2][2], B1[2][2];
    const char* cA = (const char*)g.A + (size_t)cur.pm * tstep; const char* cB = S.bptr(g, cur);
    S.a_ready(cur);
    if constexpr (SP2) {
        PG8_STAGE(PG8_SB(0, 0), cB, voffB); PG8_STAGE(PG8_SB(0, 1), cB + hstep, voffB); PG8_STAGE(PG8_SA(0, 0), cA, voffA); PG8_STAGE(PG8_SA(0, 1), cA + hstep, voffA);
        if (wr == 1) PG8_BAR;
        PG8_WAIT_V(2); PG8_BAR;
        PG8_STAGE(PG8_SB(1, 0), cB + kstep, voffB); PG8_STAGE(PG8_SA(1, 0), cA + kstep, voffA); PG8_STAGE(PG8_SB(1, 1), cB + hstep + kstep, voffB);
        PG8_WAIT_V(6); PG8_BAR;
    } else {
        PG8_STAGE(PG8_SB(0, 0), cB, voffB); PG8_STAGE(PG8_SA(0, 0), cA, voffA); PG8_STAGE(PG8_SB(0, 1), cB + hstep, voffB); PG8_STAGE(PG8_SA(0, 1), cA + hstep, voffA);
        if (wr == 1) PG8_BAR;
        PG8_WAIT_V(4); PG8_BAR;
        PG8_STAGE(PG8_SB(1, 0), cB + kstep, voffB); PG8_STAGE(PG8_SA(1, 0), cA + kstep, voffA); PG8_STAGE(PG8_SB(1, 1), cB + hstep + kstep, voffB);
        PG8_WAIT_V(6); PG8_BAR;
    }
    for (;;) {
        const bool has_next = S.next(ui + 1, nxt);
        const char* nA = has_next ? (const char*)g.A + (size_t)nxt.pm * tstep : cA; const char* nB = has_next ? S.bptr(g, nxt) : cB;
        for (int t = 0; t < nt; t += 2) {
            const bool last = (t == nt - 2);
            const char* a1 = cA + (size_t)(t + 1) * kstep;
            const char* a2 = last ? nA : cA + (size_t)(t + 2) * kstep; const char* b2 = last ? nB : cB + (size_t)(t + 2) * kstep;
            const char* a3 = a2 + kstep; const char* b3 = b2 + kstep;
            if (last && has_next) S.a_ready(nxt);
            if constexpr (SP2) {
            PG8_LDB(B0, 0, 0); PG8_LDB(B1, 0, 1); PG8_SCHED; PG8_LDA(At, 0, 0); PG8_STAGE(PG8_SA(1, 1), a1 + hstep, voffA);
            PG8_WAIT_V(8); PG8_WAIT_L(0); PG8_BAR; PG8_MMA(0, 0, At, B0); PG8_MMA(0, 1, At, B1); PG8_BAR; PG8_SCHED;
            PG8_LDA(At, 0, 1); PG8_STAGE(PG8_SB(0, 0), b2, voffB); PG8_STAGE(PG8_SB(0, 1), b2 + hstep, voffB); PG8_STAGE(PG8_SA(0, 0), a2, voffA);
            PG8_WAIT_V(8); PG8_WAIT_L(0); PG8_BAR; PG8_MMA(1, 0, At, B0); PG8_MMA(1, 1, At, B1); PG8_BAR; PG8_SCHED;
            PG8_LDB(B0, 1, 0); PG8_LDB(B1, 1, 1); PG8_SCHED; PG8_LDA(At, 1, 0); PG8_STAGE(PG8_SA(0, 1), a2 + hstep, voffA);
            PG8_WAIT_V(8); PG8_WAIT_L(0); PG8_BAR; PG8_MMA(0, 0, At, B0); PG8_MMA(0, 1, At, B1); PG8_BAR; PG8_SCHED;
            PG8_LDA(At, 1, 1); PG8_STAGE(PG8_SB(1, 0), b3, voffB); PG8_STAGE(PG8_SB(1, 1), b3 + hstep, voffB); PG8_STAGE(PG8_SA(1, 0), a3, voffA);
            PG8_WAIT_V(8); PG8_WAIT_L(0); PG8_BAR; PG8_MMA(1, 0, At, B0); PG8_MMA(1, 1, At, B1); PG8_BAR; PG8_SCHED;
            } else {
            PG8_LDB(B0, 0, 0); PG8_SCHED; PG8_LDA(At, 0, 0); PG8_STAGE(PG8_SA(1, 1), a1 + hstep, voffA);
            PG8_WAIT_L(8); PG8_BAR; PG8_WAIT_L(0); PG8_MMA(0, 0, At, B0); PG8_BAR; PG8_SCHED;
            PG8_LDB(B1, 0, 1); PG8_STAGE(PG8_SB(0, 0), b2, voffB);
            PG8_BAR; PG8_WAIT_L(0); PG8_MMA(0, 1, At, B1); PG8_BAR;
            PG8_LDA(At, 0, 1); PG8_STAGE(PG8_SA(0, 0), a2, voffA);
            PG8_BAR; PG8_WAIT_L(0); PG8_MMA(1, 0, At, B0); PG8_BAR; PG8_SCHED;
            PG8_STAGE(PG8_SB(0, 1), b2 + hstep, voffB);
            PG8_WAIT_V(6); PG8_BAR; PG8_MMA(1, 1, At, B1); PG8_BAR;
            PG8_LDB(B0, 1, 0); PG8_SCHED; PG8_LDA(At, 1, 0); PG8_STAGE(PG8_SA(0, 1), a2 + hstep, voffA);
            PG8_WAIT_L(8); PG8_BAR; PG8_WAIT_L(0); PG8_MMA(0, 0, At, B0); PG8_BAR; PG8_SCHED;
            PG8_LDB(B1, 1, 1); PG8_STAGE(PG8_SB(1, 0), b3, voffB);
            PG8_BAR; PG8_WAIT_L(0); PG8_MMA(0, 1, At, B1); PG8_BAR;
            PG8_LDA(At, 1, 1); PG8_STAGE(PG8_SA(1, 0), a3, voffA);
            PG8_BAR; PG8_WAIT_L(0); PG8_MMA(1, 0, At, B0); PG8_BAR; PG8_SCHED;
            PG8_STAGE(PG8_SB(1, 1), b3 + hstep, voffB);
            PG8_WAIT_V(6); PG8_BAR; PG8_MMA(1, 1, At, B1); PG8_BAR;
            }
        }
        if constexpr (ALIGN_EPI) { if (wr == 0) PG8_BAR; }
        if constexpr (!Epi::AFTER_DRAIN) { E(acc, cur, wr, wc, fr, fq); S.done(cur); }
        if (!has_next) break;
#pragma unroll
        for (int a = 0; a < 2; ++a)
#pragma unroll
            for (int b = 0; b < 2; ++b)
#pragma unroll
                for (int m = 0; m < 4; ++m)
#pragma unroll
                    for (int n = 0; n < 2; ++n) acc[a][b][m][n] = (f32x4){0.f, 0.f, 0.f, 0.f};
        cur = nxt; cA = nA; cB = nB; ++ui;
        if constexpr (ALIGN_EPI) { if (wr == 1) PG8_BAR; }
    }
    PG8_WAIT_V(0);
    if constexpr (!ALIGN_EPI) { if (wr == 0) PG8_BAR; }
    PG8_BAR;
    if constexpr (Epi::AFTER_DRAIN) { E.fused(acc, cur, wr, wc, fr, fq, lds, wid, lane); S.done(cur); }
#undef PG8_SA
#undef PG8_SB
#undef PG8_STAGE
#undef PG8_LDA
#undef PG8_LDB
#undef PG8_MMA
#undef PG8_WAIT_V
#undef PG8_WAIT_L
#undef PG8_BAR
#undef PG8_SCHED
}
}

#define GAS __attribute__((address_space(1)))
#define LAS __attribute__((address_space(3)))
#define XB_TMO      128
#define XB_XCNT(j)  (256  + 64 * (j))
#define XB_XSUB(j)  (1280 + 64 * (j))
#define XB_XGEN(j)  (2304 + 64 * (j))
#define XB_TOP      3328
#define XB_TOPGEN   3392
#define XCD_BAR_WORDS 3456
#define XB_SPIN_CAP (1u << 18)

__device__ __forceinline__ unsigned xb_ld(unsigned* p)              { return __hip_atomic_load(p, __ATOMIC_RELAXED, __HIP_MEMORY_SCOPE_AGENT); }
__device__ __forceinline__ unsigned xb_add(unsigned* p, unsigned v) { return __hip_atomic_fetch_add(p, v, __ATOMIC_RELAXED, __HIP_MEMORY_SCOPE_AGENT); }
__device__ __forceinline__ unsigned xb_xcc_id() { return (unsigned)__builtin_amdgcn_s_getreg((3 << 11) | 20) & 0xFu; }
#define XB_SPIN(cond, bar) do { unsigned _sp = 0; while (cond) { __builtin_amdgcn_s_sleep(1); \
    if ((++_sp & 255u) == 0u) { if (xb_ld(&(bar)[XB_TMO])) break; if (_sp > XB_SPIN_CAP) { atomicAdd(&(bar)[XB_TMO], 1u); break; } } } } while (0)

struct XcdBarrier {
    unsigned* bar; unsigned x;
    volatile LAS unsigned* st;
};

__device__ __forceinline__ XcdBarrier xcd_barrier_post(unsigned* bar, volatile LAS unsigned* st) {
    XcdBarrier b; b.bar = bar; b.x = xb_xcc_id(); b.st = st;
    if (threadIdx.x == 0) (void)xb_add(&bar[XB_XCNT(b.x)], 1u);
    return b;
}
__device__ __forceinline__ void xcd_barrier_complete(unsigned* bar, unsigned x, unsigned& nloc, unsigned& nx) {
    const unsigned G = gridDim.x * gridDim.y * gridDim.z;
    unsigned sum, cnt, mine, sp = 0u;
    for (;;) {
        sum = 0u; cnt = 0u; mine = 0u;
#pragma unroll
        for (unsigned j = 0; j < 16; ++j) { const unsigned c = xb_ld(&bar[XB_XCNT(j)]); sum += c; cnt += (c > 0u) ? 1u : 0u; mine = (j == x) ? c : mine; }
        if (sum == G) break;
        __builtin_amdgcn_s_sleep(1);
        if ((++sp & 255u) == 0u) { if (xb_ld(&bar[XB_TMO])) break; if (sp > XB_SPIN_CAP) { atomicAdd(&bar[XB_TMO], 1u); break; } }
    }
    nloc = mine > 0u ? mine : 1u; nx = cnt > 0u ? cnt : 1u;
}

__device__ __forceinline__ void xcd_barrier(const XcdBarrier& b) {
    asm volatile("s_waitcnt vmcnt(0)" ::: "memory");
    __syncthreads();
    if (threadIdx.x == 0) {
        unsigned* bar = b.bar;
        __builtin_amdgcn_s_waitcnt(0);
        unsigned nloc = b.st[0], nx = b.st[1];
        if (nloc == 0u) { xcd_barrier_complete(bar, b.x, nloc, nx); b.st[0] = nloc; b.st[1] = nx; }
        const unsigned old = xb_add(&bar[XB_XSUB(b.x)], 1u);
        const unsigned gen = old / nloc;
        if (old + 1u == (gen + 1u) * nloc) {
            __builtin_amdgcn_fence(__ATOMIC_RELEASE, "agent");
            asm volatile("s_waitcnt vmcnt(0)" ::: "memory");
            const unsigned og = xb_add(&bar[XB_TOP], 1u);
            const unsigned tg = og / nx;
            if (og + 1u == (tg + 1u) * nx) xb_add(&bar[XB_TOPGEN], 1u);
            else XB_SPIN(xb_ld(&bar[XB_TOPGEN]) == tg, bar);
            __builtin_amdgcn_fence(__ATOMIC_ACQUIRE, "agent");
            xb_add(&bar[XB_XGEN(b.x)], 1u);
            asm volatile("s_waitcnt vmcnt(0)" ::: "memory");
        } else {
            XB_SPIN(xb_ld(&bar[XB_XGEN(b.x)]) == gen, bar);
            __builtin_amdgcn_fence(__ATOMIC_ACQUIRE, "agent");
            asm volatile("s_waitcnt vmcnt(0)" ::: "memory");
        }
    }
    __syncthreads();
}
constexpr int D = 1024, NB = 8, SEQ = 8192, CTXL = 256, TB = SEQ + CTXL, M = NB * TB;
constexpr int EV_IN = 3072, OD_IN = 2560, DFF = 3584, NE = 8, NLAYER = 4;
constexpr int NPANEL = M / 256;
constexpr int PW = 179, MAXP = 3 * PW;
constexpr float EPS = 1e-6f;
constexpr size_t MiB = 1u << 20;
constexpr size_t WS_CTL = 0, CTL_ZERO_BYTES = 1 * MiB;
constexpr size_t WS_MOD = 1 * MiB;
constexpr size_t WS_ROPE_R = 2 * MiB, WS_ROPE_D = 2 * MiB + 65536;
constexpr size_t WS_ROUTE = 3 * MiB;
constexpr size_t WS_WGCNT = 5 * MiB;
constexpr size_t WS_PEXP = 5 * MiB + 65536;
constexpr size_t WS_LIST = 6 * MiB;
constexpr size_t WS_XC = 10 * MiB;
constexpr size_t WS_W = 20 * MiB;
constexpr size_t WS_H = 198 * MiB;
constexpr size_t WS_Y = 330 * MiB;
constexpr size_t WS_BIG = 594 * MiB;
constexpr size_t WS_END = 1056 * MiB;
constexpr size_t W_IN = 0, W_OUT = 6 * MiB, W_GU = 8 * MiB, W_DN = 22 * MiB;
constexpr size_t W_GLU = 8 * MiB, W_MGU = 9 * MiB, W_MDN = 121 * MiB;
constexpr size_t Y_SLOT = (size_t)M * 1024 * 2;
constexpr size_t T_HALF = (size_t)M * 512 * 2;
constexpr size_t T_QUART = (size_t)M * 256 * 2;
constexpr size_t BIG_ACT = 0, BIG_HG = 314 * MiB;
constexpr int CW_TMO = 0, CW_BAR = 4096;
constexpr int RING_BYTES = 131072, LDSCTL_OFF = RING_BYTES + 8192, MISC_OFF = LDSCTL_OFF + 320, LDS_BYTES = 147456;
typedef unsigned short bf16;
typedef unsigned v4u __attribute__((ext_vector_type(4)));
typedef unsigned v2u __attribute__((ext_vector_type(2)));
typedef float f32x4 __attribute__((ext_vector_type(4)));
typedef float f32x16 __attribute__((ext_vector_type(16)));
typedef short bf16x8 __attribute__((ext_vector_type(8)));
typedef short s16x4 __attribute__((ext_vector_type(4)));
#define RLX_AGENT __ATOMIC_RELAXED, __HIP_MEMORY_SCOPE_AGENT
using pg8::cvt_pk_bf16; using pg8::bflo; using pg8::bfhi; using pg8::RouteEnt;
struct RouteRow { int e1, e2; float p1, p2; };
__device__ __forceinline__ float bf2f(bf16 v) { return __uint_as_float((unsigned)v << 16); }
__device__ __forceinline__ float wave_sum(float v) {
#pragma unroll
    for (int o = 1; o < 64; o <<= 1) v += __shfl_xor(v, o);
    return v;
}
__device__ __forceinline__ float gelu_tanh(float x) {
    const float u = 0.7978845608028654f * (x + 0.044715f * x * x * x);
    return x * __builtin_amdgcn_rcpf(1.0f + __builtin_amdgcn_exp2f(-2.0f * 1.4426950408889634f * u));
}
__device__ __forceinline__ float sigmoidf_(float x) { return __builtin_amdgcn_rcpf(1.0f + __builtin_amdgcn_exp2f(-1.4426950408889634f * x)); }
struct Args { const float* in[38]; float* out; unsigned char* ws; int ph_lo, ph_hi, mode, pad; };
struct ArgsI { unsigned long long in[38]; unsigned long long out, ws; int ph_lo, ph_hi, mode, pad; };
typedef __attribute__((address_space(4))) const ArgsI KArgs;
#define INP(k) ((const float*)(GAS const float*)F.A->in[k])
#define OUTP ((float*)(GAS float*)F.A->out)
#define WSG ((unsigned char*)(GAS unsigned char*)F.wsi)
#define FMOD ((float*)(WSG + WS_MOD))
#define FXC ((float*)(WSG + WS_XC))
#define FH ((bf16*)(WSG + WS_H))
#define FWB ((bf16*)(WSG + WS_W))
#define FYB (WSG + WS_Y)
#define FBIG (WSG + WS_BIG)
#define LAUNDER(F) do { asm volatile("" : "+s"(F.wsi), "+s"(F.A), "+v"(F.tid), "+s"(F.bid), "+s"(F.G)); F.lane = F.tid & 63; F.wave = __builtin_amdgcn_readfirstlane(F.tid >> 6); } while (0)
struct Frame {
    LAS unsigned char* lds; unsigned long long wsi;
    int tid, lane, wave, G, bid;
    const KArgs* A;
};
#define LDS_WAIT() asm volatile("s_waitcnt lgkmcnt(0)" ::: "memory")

__device__ __forceinline__ void ph_prologue(Frame& F) {
    LAS float* SL = (LAS float*)F.lds;
    LAS float* RED = (LAS float*)(F.lds + 40960);
    const float* c = INP(1); const float* cc = INP(3); const float* mod_w = INP(4); const float* mod_b = INP(5);
    for (int i = F.tid; i < 9 * 1024; i += 512) { const float v = (i < 8192) ? c[i] : cc[i - 8192]; SL[i] = v * sigmoidf_(v); }
    __syncthreads();
    for (int blk = F.bid; blk < 4 * 96; blk += F.G) {
        const int l = blk / 96, n0 = (blk % 96) * 64;
        const float* wp = mod_w + ((size_t)l * 1024 + (size_t)F.wave * 128) * 6144 + n0 + F.lane;
        float acc[9];
#pragma unroll
        for (int j = 0; j < 9; ++j) acc[j] = 0.f;
        for (int k = 0; k < 128; ++k) { const float w = wp[(size_t)k * 6144];
#pragma unroll
            for (int j = 0; j < 9; ++j) acc[j] += SL[j * 1024 + F.wave * 128 + k] * w; }
#pragma unroll
        for (int j = 0; j < 9; ++j) RED[(F.wave * 9 + j) * 64 + F.lane] = acc[j];
        __syncthreads();
        for (int i = F.tid; i < 9 * 64; i += 512) { const int j = i >> 6, ln = i & 63; float s = mod_b[l * 6144 + n0 + ln];
#pragma unroll
            for (int w = 0; w < 8; ++w) s += RED[(w * 9 + j) * 64 + ln];
            FMOD[((size_t)l * 9 + j) * 6144 + n0 + ln] = s; }
        __syncthreads();
    }
    const int gt = F.bid * 512 + F.tid;
    if (gt < 128 * 32) { const int pos = gt >> 5, dq = gt & 31; const float inv = powf(10000.0f, -(float)dq / 32.0f); float s, cs; sincosf((float)pos * inv, &s, &cs);
        float* T = (float*)(WSG + WS_ROPE_R); T[gt * 2] = cs; T[gt * 2 + 1] = s; }
    else if (gt < 128 * 32 + 128 * 16) { const int g2 = gt - 128 * 32, pos = g2 >> 4, dq = g2 & 15; const float inv = powf(10000.0f, -(float)dq / 16.0f); float s, cs; sincosf((float)pos * inv, &s, &cs);
        float* T = (float*)(WSG + WS_ROPE_D); T[g2 * 2] = cs; T[g2 * 2 + 1] = s; }
}

__device__ __forceinline__ void transpose_item(const float* W, int K, int N, bf16* WT, int drow0, int k0, int n0, LAS float* scr, int lane) {
#pragma unroll 8
    for (int i = 0; i < 32; ++i) { const int kk = 2 * i + (lane >> 5); scr[kk * 33 + (lane & 31)] = W[(size_t)(k0 + kk) * N + n0 + (lane & 31)]; }
    LDS_WAIT(); asm volatile("" ::: "memory");
    const int c = lane & 7;
#pragma unroll
    for (int j = 0; j < 4; ++j) { const int n = (lane >> 3) + 8 * j; const LAS float* s = scr + (8 * c) * 33 + n;
        v4u o; o.x = cvt_pk_bf16(s[0 * 33], s[1 * 33]); o.y = cvt_pk_bf16(s[2 * 33], s[3 * 33]); o.z = cvt_pk_bf16(s[4 * 33], s[5 * 33]); o.w = cvt_pk_bf16(s[6 * 33], s[7 * 33]);
        *(v4u*)(WT + (size_t)(drow0 + n) * K + k0 + 8 * c) = o; }
    LDS_WAIT(); asm volatile("" ::: "memory");
}
__device__ __forceinline__ void convert_job(Frame& F, const float* W, int K, int N, bf16* WT, int mode) {
    LAS float* scr = (LAS float*)(F.lds + F.wave * 16384);
    const int gw = F.bid * 8 + F.wave, NGW = F.G * 8, nblk = N / 32, nit = (K / 64) * nblk;
    for (int it = gw; it < nit; it += NGW) { const int kb = it / nblk, nb = it % nblk, n0 = nb * 32;
        const int drow0 = mode == 0 ? n0 : ((n0 >> 7) * 256 + (n0 & 127) + (mode == 2 ? 128 : 0));
        transpose_item(W, K, N, WT, drow0, kb * 64, n0, scr, F.lane); }
}
__device__ __forceinline__ void ph_convert(Frame& F, int l) {
    const int i = l >> 1; bf16* Wb = FWB;
    if ((l & 1) == 0) {
        convert_job(F, INP(7) + (size_t)i * D * EV_IN, D, EV_IN, Wb + W_IN / 2, 0);
        convert_job(F, INP(15) + (size_t)i * D * D, D, D, Wb + W_OUT / 2, 0);
        convert_job(F, INP(16) + (size_t)i * D * DFF, D, DFF, Wb + W_GU / 2, 1);
        convert_job(F, INP(17) + (size_t)i * D * DFF, D, DFF, Wb + W_GU / 2, 2);
        convert_job(F, INP(18) + (size_t)i * DFF * D, DFF, D, Wb + W_DN / 2, 0);
    } else {
        convert_job(F, INP(19) + (size_t)i * D * OD_IN, D, OD_IN, Wb + W_IN / 2, 0);
        convert_job(F, INP(32) + (size_t)i * D * D, D, D, Wb + W_OUT / 2, 0);
        convert_job(F, INP(28) + (size_t)i * 256 * 256, 256, 256, Wb + W_GLU / 2, 0);
        for (int e = 0; e < NE; ++e) {
            convert_job(F, INP(35) + ((size_t)i * NE + e) * D * DFF, D, DFF, Wb + W_MGU / 2 + (size_t)e * 7168 * 1024, 1);
            convert_job(F, INP(36) + ((size_t)i * NE + e) * D * DFF, D, DFF, Wb + W_MGU / 2 + (size_t)e * 7168 * 1024, 2);
            convert_job(F, INP(37) + ((size_t)i * NE + e) * DFF * D, DFF, D, Wb + W_MDN / 2 + (size_t)e * 1024 * 3584, 0);
        }
    }
}

struct NormArgs {
    int xin_input, has_y, two, write_x, final_, do_h, do_route;
    const float* gate; const float* gy;
    const float* gh; const float* shift; const float* scale;
    const float* rw; const float* rb;
};
__device__ __forceinline__ void ph_norm(Frame& F, const NormArgs& a) {
    LAS float* RWT = (LAS float*)F.lds;
    LAS int* cnt = (LAS int*)(F.lds + 32768);
    if (a.do_route) {
        for (int idx = F.tid; idx < 8192; idx += 512) RWT[(idx & 7) * 1024 + (idx >> 3)] = a.rw[idx];
        if (F.tid < 8) cnt[F.tid] = 0;
        __syncthreads();
    }
    const int r0 = (int)((long)M * F.bid / F.G), r1 = (int)((long)M * (F.bid + 1) / F.G);
    const bf16* Y0 = (const bf16*)FYB; const bf16* Y1 = (const bf16*)(FYB + Y_SLOT);
    const int c0 = 4 * F.lane;
    f32x4 pgy[4], pgh[4], pgt[4], psh[4], psc[4]; int cur_midx = -1;
#pragma unroll
    for (int j = 0; j < 4; ++j) { pgy[j] = a.has_y ? *(const f32x4*)(a.gy + c0 + 256 * j) : (f32x4){0.f, 0.f, 0.f, 0.f}; pgh[j] = a.do_h ? *(const f32x4*)(a.gh + c0 + 256 * j) : (f32x4){0.f, 0.f, 0.f, 0.f};
        pgt[j] = (f32x4){0.f, 0.f, 0.f, 0.f}; psh[j] = pgt[j]; psc[j] = pgt[j]; }
    f32x4 xn[4]; v2u yn[4], zn[4];
#pragma unroll
    for (int j = 0; j < 4; ++j) { xn[j] = (f32x4){0.f, 0.f, 0.f, 0.f}; yn[j] = (v2u){0u, 0u}; zn[j] = (v2u){0u, 0u}; }
#define NORM_LOAD(mm) do { const int b_ = (mm) / TB, t_ = (mm) - b_ * TB; const bool ic_ = t_ < CTXL; \
        const size_t off_ = ic_ ? ((size_t)(b_ * CTXL + t_) * D) : ((size_t)(b_ * SEQ + t_ - CTXL) * D); \
        const float* xi_ = ic_ ? ((a.xin_input ? INP(2) : FXC) + off_) : ((a.xin_input ? INP(0) : OUTP) + off_); \
        _Pragma("unroll") for (int j = 0; j < 4; ++j) { xn[j] = *(const f32x4*)(xi_ + c0 + 256 * j); \
            if (a.has_y) yn[j] = *(const v2u*)(Y0 + (size_t)(mm) * D + c0 + 256 * j); if (a.two) zn[j] = *(const v2u*)(Y1 + (size_t)(mm) * D + c0 + 256 * j); } } while (0)
    int m = r0 + F.wave;
    if (m < r1) NORM_LOAD(m);
    for (; m < r1; m += 8) {
        const int b = m / TB, t = m - b * TB; const bool isctx = t < CTXL; const int midx = isctx ? 8 : b;
        const size_t off = isctx ? ((size_t)(b * CTXL + t) * D) : ((size_t)(b * SEQ + t - CTXL) * D);
        float* xres = isctx ? (FXC + off) : (OUTP + off);
        f32x4 x[4]; v2u yv[4], zv[4];
#pragma unroll
        for (int j = 0; j < 4; ++j) { x[j] = xn[j]; yv[j] = yn[j]; zv[j] = zn[j]; }
        if (m + 8 < r1) NORM_LOAD(m + 8);
        if (midx != cur_midx) { cur_midx = midx;
#pragma unroll
            for (int j = 0; j < 4; ++j) { if (a.has_y) pgt[j] = *(const f32x4*)(a.gate + (size_t)midx * 6144 + c0 + 256 * j);
                if (a.do_h) { psh[j] = *(const f32x4*)(a.shift + (size_t)midx * 6144 + c0 + 256 * j); psc[j] = *(const f32x4*)(a.scale + (size_t)midx * 6144 + c0 + 256 * j); } } }
        if (a.has_y) {
            f32x4 y[4]; float ss = 0.f;
#pragma unroll
            for (int j = 0; j < 4; ++j) { y[j] = (f32x4){bflo(yv[j].x), bfhi(yv[j].x), bflo(yv[j].y), bfhi(yv[j].y)};
                if (a.two) y[j] += (f32x4){bflo(zv[j].x), bfhi(zv[j].x), bflo(zv[j].y), bfhi(zv[j].y)};
                ss += (y[j].x * y[j].x + y[j].y * y[j].y) + (y[j].z * y[j].z + y[j].w * y[j].w); }
            const float rs = 1.0f / sqrtf(wave_sum(ss) * (1.0f / D) + EPS);
#pragma unroll
            for (int j = 0; j < 4; ++j) x[j] += pgt[j] * (y[j] * rs * pgy[j]);
        }
        if (a.write_x && !(a.final_ && isctx)) {
#pragma unroll
            for (int j = 0; j < 4; ++j) *(f32x4*)(xres + c0 + 256 * j) = x[j];
        }
        if (a.do_h) {
            float ss = 0.f;
#pragma unroll
            for (int j = 0; j < 4; ++j) ss += (x[j].x * x[j].x + x[j].y * x[j].y) + (x[j].z * x[j].z + x[j].w * x[j].w);
            const float rs = 1.0f / sqrtf(wave_sum(ss) * (1.0f / D) + EPS);
            f32x4 h[4];
#pragma unroll
            for (int j = 0; j < 4; ++j) { h[j] = (x[j] * rs * pgh[j]) * (psc[j] + 1.0f) + psh[j];
                v2u w; w.x = cvt_pk_bf16(h[j].x, h[j].y); w.y = cvt_pk_bf16(h[j].z, h[j].w); *(v2u*)(FH + (size_t)m * D + c0 + 256 * j) = w; }
            if (a.do_route) {
                float lg[8];
#pragma unroll
                for (int e = 0; e < 8; ++e) { float s = 0.f;
#pragma unroll
                    for (int j = 0; j < 4; ++j) { const f32x4 w = *(const LAS f32x4*)(RWT + e * 1024 + c0 + 256 * j); s += (h[j].x * w.x + h[j].y * w.y) + (h[j].z * w.z + h[j].w * w.w); }
                    lg[e] = wave_sum(s) + a.rb[e]; }
                int e1 = 0; float v1 = lg[0];
#pragma unroll
                for (int e = 1; e < 8; ++e) if (lg[e] > v1) { v1 = lg[e]; e1 = e; }
                int e2 = -1; float v2 = -3.0e38f;
#pragma unroll
                for (int e = 0; e < 8; ++e) if (e != e1 && lg[e] > v2) { v2 = lg[e]; e2 = e; }
                const float p1 = 1.0f / (1.0f + expf(v2 - v1));
                if (F.lane == 0) { RouteRow rr; rr.e1 = e1; rr.e2 = e2; rr.p1 = p1; rr.p2 = 1.0f - p1; ((RouteRow*)(WSG + WS_ROUTE))[m] = rr;
                    atomicAdd((int*)&cnt[e1], 1); atomicAdd((int*)&cnt[e2], 1); }
            }
        }
    }
#undef NORM_LOAD
    if (a.do_route) { __syncthreads(); if (F.tid < 8) ((int*)(WSG + WS_WGCNT))[F.bid * 8 + F.tid] = cnt[F.tid]; }
}

__device__ __forceinline__ void ph_assign(Frame& F) {
    LAS int* part = (LAS int*)F.lds;
    LAS int* tot = (LAS int*)(F.lds + 32768);
    const int* WC = (const int*)(WSG + WS_WGCNT);
    int st[8], sb[8];
#pragma unroll
    for (int e = 0; e < 8; ++e) { st[e] = 0; sb[e] = 0; }
    for (int w = F.tid; w < F.G; w += 512) {
#pragma unroll
        for (int e = 0; e < 8; ++e) { const int c = WC[w * 8 + e]; st[e] += c; if (w < F.bid) sb[e] += c; } }
    if (F.tid < 32) tot[F.tid] = 0;
    __syncthreads();
#pragma unroll
    for (int e = 0; e < 8; ++e) { if (st[e]) atomicAdd((int*)&tot[e], st[e]); if (sb[e]) atomicAdd((int*)&tot[8 + e], sb[e]); }
    __syncthreads();
    if (F.tid == 0) { int o = 0; for (int e = 0; e < 8; ++e) { tot[16 + e] = o; o += (tot[e] + 255) & ~255; }
        if (F.bid == 0) { int* PE = (int*)(WSG + WS_PEXP); int p = 0; for (int e = 0; e < 8; ++e) { const int np = (tot[e] + 255) >> 8; for (int q = 0; q < np; ++q) PE[p++] = e; } PE[MAXP] = p; } }
    __syncthreads();
    RouteEnt* L = (RouteEnt*)(WSG + WS_LIST);
    if (F.bid == 0) {
        for (int e = 0; e < 8; ++e) { const int lo = tot[16 + e] + tot[e], hi = tot[16 + e] + ((tot[e] + 255) & ~255);
            for (int p = lo + F.tid; p < hi; p += 512) { RouteEnt z; z.tok = -1; z.slot = 0; z.w = 0.f; z.pad = 0; L[p] = z; } }
    }
    const RouteRow* RR = (const RouteRow*)(WSG + WS_ROUTE);
    const int r0 = (int)((long)M * F.bid / F.G), r1 = (int)((long)M * (F.bid + 1) / F.G);
    for (int m = r0 + F.tid; m < r1; m += 512) { const RouteRow rr = RR[m];
        { const int p = tot[16 + rr.e1] + tot[8 + rr.e1] + atomicAdd((int*)&tot[24 + rr.e1], 1); RouteEnt z; z.tok = m; z.slot = 0; z.w = rr.p1; z.pad = 0; L[p] = z; }
        { const int p = tot[16 + rr.e2] + tot[8 + rr.e2] + atomicAdd((int*)&tot[24 + rr.e2], 1); RouteEnt z; z.tok = m; z.slot = 1; z.w = rr.p2; z.pad = 0; L[p] = z; } }
}
__device__ __forceinline__ void ph_gather(Frame& F, int p0, int p1) {
    const RouteEnt* L = (const RouteEnt*)(WSG + WS_LIST); bf16* HG = (bf16*)(FBIG + BIG_HG);
    const int gw = F.bid * 8 + F.wave, NGW = F.G * 8, n = (p1 - p0) * 256;
    for (int r = gw; r < n; r += NGW) { const int tok = L[(size_t)p0 * 256 + r].tok;
        v4u a = (v4u){0u, 0u, 0u, 0u}, b = a;
        if (tok >= 0) { const v4u* s = (const v4u*)(FH + (size_t)tok * D); a = s[F.lane]; b = s[64 + F.lane]; }
        v4u* d = (v4u*)(HG + (size_t)r * D); d[F.lane] = a; d[64 + F.lane] = b; }
}
__device__ __forceinline__ void rope8(v4u& a, v4u& b, const float* cs, float sc) {
    unsigned* pa = (unsigned*)&a; unsigned* pb = (unsigned*)&b;
#pragma unroll
    for (int k = 0; k < 4; ++k) {
        float x1l = bflo(pa[k]), x1h = bfhi(pa[k]), x2l = bflo(pb[k]), x2h = bfhi(pb[k]);
        float c0 = 1.f, s0 = 0.f, c1 = 1.f, s1 = 0.f;
        if (cs) { c0 = cs[4 * k]; s0 = cs[4 * k + 1]; c1 = cs[4 * k + 2]; s1 = cs[4 * k + 3]; }
        const float o1l = (x1l * c0 - x2l * s0) * sc, o2l = (x1l * s0 + x2l * c0) * sc, o1h = (x1h * c1 - x2h * s1) * sc, o2h = (x1h * s1 + x2h * c1) * sc;
        pa[k] = cvt_pk_bf16(o1l, o1h); pb[k] = cvt_pk_bf16(o2l, o2h);
    }
}
__device__ __forceinline__ void ph_rope(Frame& F, int odd) {
    const int gw = F.bid * 8 + F.wave, NGW = F.G * 8;
    bf16* Z = (bf16*)FBIG;
    if (!odd) {
        const float* T = (const float*)(WSG + WS_ROPE_R);
        const int tensor = F.lane >> 5, head = (F.lane >> 3) & 3, d0 = (F.lane & 7) * 8;
        const float sc = tensor ? 0.08838834764831845f : 1.0f;
        for (int m = gw; m < M; m += NGW) { const int t = m % TB;
            bf16* p = Z + (size_t)m * EV_IN + 1024 + tensor * 512 + head * 128 + d0;
            v4u a = *(v4u*)p, b = *(v4u*)(p + 64);
            if (t >= CTXL) { const int tl = t - CTXL, pos = d0 < 32 ? (tl >> 6) : (tl & 63), dq = d0 & 31; rope8(a, b, T + (pos * 32 + dq) * 2, sc); }
            else { if (!tensor) continue; rope8(a, b, nullptr, sc); }
            *(v4u*)p = a; *(v4u*)(p + 64) = b; }
    } else {
        const float* T = (const float*)(WSG + WS_ROPE_D);
        for (int m = gw; m < M; m += NGW) { const int t = m % TB; if (t < CTXL) continue;
            const int tl = t - CTXL;
            for (int it = F.lane; it < 96; it += 64) { const int tensor = it / 48, r = it % 48, hm = r >> 2, d0 = (r & 3) * 8;
                bf16* p = Z + (size_t)m * OD_IN + 256 + tensor * 768 + hm * 64 + d0;
                v4u a = *(v4u*)p, b = *(v4u*)(p + 32);
                const int pos = d0 < 16 ? (tl >> 6) : (tl & 63), dq = d0 & 15; rope8(a, b, T + (pos * 16 + dq) * 2, 1.0f);
                *(v4u*)p = a; *(v4u*)(p + 32) = b; } }
    }
}
__device__ __forceinline__ void unpack8(const v4u& w, float* f) { f[0] = bflo(w.x); f[1] = bfhi(w.x); f[2] = bflo(w.y); f[3] = bfhi(w.y); f[4] = bflo(w.z); f[5] = bfhi(w.z); f[6] = bflo(w.w); f[7] = bfhi(w.w); }
__device__ __forceinline__ v4u pack8(const float* f) { v4u w; w.x = cvt_pk_bf16(f[0], f[1]); w.y = cvt_pk_bf16(f[2], f[3]); w.z = cvt_pk_bf16(f[4], f[5]); w.w = cvt_pk_bf16(f[6], f[7]); return w; }
__device__ __forceinline__ void ph_merge_even(Frame& F, int i) {
    const int gw = F.bid * 8 + F.wave, NGW = F.G * 8;
    const bf16* Z = (const bf16*)FBIG; const bf16* HF = (const bf16*)FYB; const bf16* HB = (const bf16*)(FYB + T_HALF);
    const bf16* RF = (const bf16*)(FYB + 2 * T_HALF); const bf16* RB = (const bf16*)(FYB + 3 * T_HALF);
    const float* gn = INP(14) + (size_t)i * 512; const int c0 = 8 * F.lane;
    float gnv[8];
#pragma unroll
    for (int k = 0; k < 8; ++k) gnv[k] = gn[c0 + k];
    for (int m = gw; m < M; m += NGW) {
        float a[8], b[8], g[8], o[8];
        unpack8(*(const v4u*)(HF + (size_t)m * 512 + c0), a); unpack8(*(const v4u*)(HB + (size_t)m * 512 + c0), b); unpack8(*(const v4u*)(Z + (size_t)m * EV_IN + 512 + c0), g);
#pragma unroll
        for (int k = 0; k < 8; ++k) o[k] = (a[k] + b[k]) * gelu_tanh(g[k]);
        *(v4u*)(FH + (size_t)m * D + c0) = pack8(o);
        unpack8(*(const v4u*)(RF + (size_t)m * 512 + c0), a); unpack8(*(const v4u*)(RB + (size_t)m * 512 + c0), b); unpack8(*(const v4u*)(Z + (size_t)m * EV_IN + 2560 + c0), g);
        float s = 0.f;
#pragma unroll
        for (int k = 0; k < 8; ++k) { a[k] += b[k]; s += a[k]; }
        s += __shfl_xor(s, 1); s += __shfl_xor(s, 2); s += __shfl_xor(s, 4); s += __shfl_xor(s, 8);
        const float mean = s * (1.0f / 128.0f); float q = 0.f;
#pragma unroll
        for (int k = 0; k < 8; ++k) { a[k] -= mean; q += a[k] * a[k]; }
        q += __shfl_xor(q, 1); q += __shfl_xor(q, 2); q += __shfl_xor(q, 4); q += __shfl_xor(q, 8);
        const float rs = 1.0f / sqrtf(q * (1.0f / 128.0f) + EPS);
#pragma unroll
        for (int k = 0; k < 8; ++k) o[k] = a[k] * rs * gnv[k] * (g[k] * sigmoidf_(g[k]));
        *(v4u*)(FH + (size_t)m * D + 512 + c0) = pack8(o);
    }
}
__device__ __forceinline__ void ph_zpass(Frame& F, int i) {
    const int gw = F.bid * 8 + F.wave, NGW = F.G * 8;
    const bf16* ZI = (const bf16*)FBIG; const bf16* YF = (const bf16*)FYB; const bf16* YB = (const bf16*)(FYB + T_QUART); bf16* ZO = (bf16*)(FYB + 2 * T_QUART);
    const float* dsk = INP(27) + (size_t)i * 256; const int c0 = 4 * F.lane;
    const f32x4 dv = *(const f32x4*)(dsk + c0);
    for (int m = gw; m < M; m += NGW) {
        const v2u a = *(const v2u*)(YF + (size_t)m * 256 + c0), b = *(const v2u*)(YB + (size_t)m * 256 + c0), u = *(const v2u*)(ZI + (size_t)m * OD_IN + c0);
        const float y0 = bflo(a.x) + bflo(b.x) + dv.x * bflo(u.x), y1 = bfhi(a.x) + bfhi(b.x) + dv.y * bfhi(u.x), y2 = bflo(a.y) + bflo(b.y) + dv.z * bflo(u.y), y3 = bfhi(a.y) + bfhi(b.y) + dv.w * bfhi(u.y);
        v2u w; w.x = cvt_pk_bf16(gelu_tanh(y0), gelu_tanh(y1)); w.y = cvt_pk_bf16(gelu_tanh(y2), gelu_tanh(y3));
        *(v2u*)(ZO + (size_t)m * 256 + c0) = w; }
}
__device__ __forceinline__ int chunk_tlo(int dir, int c) { return dir == 0 ? 128 * c : (c < 2 ? 128 * (1 - c) : 8576 - 128 * c); }

__device__ __forceinline__ void lru_item(Frame& F, int i, int b, int dir, int blk) {
    LAS unsigned char* lds = F.lds;
    LAS float* UR = (LAS float*)(lds);
    LAS float* AA = (LAS float*)(lds);
    LAS float* U = (LAS float*)(lds + 36864);
    LAS float* BB = U;
    LAS bf16* UB = (LAS bf16*)(lds + 69632);
    LAS float* SEG = (LAS float*)(lds + 88064);
    LAS float* PRM = (LAS float*)(lds + 92160);
    const int tid = F.tid, lane = F.lane, wave = F.wave, ch = tid & 63, seg = tid >> 6;
    const bf16* Z = (const bf16*)FBIG; bf16* OUT = (bf16*)(FYB + (size_t)dir * T_HALF);
    const float* conv_w = INP(8) + (size_t)i * 4 * 512; const float* conv_b = INP(9) + (size_t)i * 512;
    const float* gate_w = INP(10) + (((size_t)i * 2 + dir) * 2) * 8 * 64 * 64;
    const float* gate_b = INP(11) + (((size_t)i * 2 + dir) * 2) * 512;
    const float* lam = INP(12) + ((size_t)i * 2 + dir) * 512;
    __syncthreads();
    if (tid < 64) { const int cg = blk * 64 + tid;
        PRM[0 * 64 + tid] = conv_w[0 * 512 + cg]; PRM[1 * 64 + tid] = conv_w[1 * 512 + cg]; PRM[2 * 64 + tid] = conv_w[2 * 512 + cg]; PRM[3 * 64 + tid] = conv_w[3 * 512 + cg];
        PRM[4 * 64 + tid] = conv_b[cg]; const float lm = lam[cg]; PRM[5 * 64 + tid] = (-lm > 20.f) ? -lm : log1pf(expf(-lm));
        PRM[6 * 64 + tid] = gate_b[cg]; PRM[7 * 64 + tid] = gate_b[512 + cg]; }
    const int fr = lane & 15, fq = lane >> 4;
    bf16x8 wf[8][2];
#pragma unroll
    for (int nt = 0; nt < 8; ++nt)
#pragma unroll
        for (int ks = 0; ks < 2; ++ks) { const int col = 16 * nt + fr, gate = col >> 6, j = col & 63; const float* wp = gate_w + (((size_t)gate * 8 + blk) * 64 + (32 * ks + 8 * fq)) * 64 + j;
            v4u w; w.x = cvt_pk_bf16(wp[0], wp[64]); w.y = cvt_pk_bf16(wp[128], wp[192]); w.z = cvt_pk_bf16(wp[256], wp[320]); w.w = cvt_pk_bf16(wp[384], wp[448]);
            wf[nt][ks] = __builtin_bit_cast(bf16x8, w); }
    float carry = 0.f;
    __syncthreads();
    for (int c = 0; c < 66; ++c) {
        const int t_lo = chunk_tlo(dir, c), seq_lo = t_lo < CTXL ? 0 : CTXL, seq_hi = t_lo < CTXL ? CTXL : TB;
        const size_t rowbase = (size_t)b * TB;
        for (int it = tid; it < 131 * 8; it += 512) { const int r = it >> 3, cc = it & 7, t = t_lo - 2 + r; float f[8];
            if (t >= seq_lo && t < seq_hi) unpack8(*(const v4u*)(Z + (rowbase + t) * EV_IN + blk * 64 + cc * 8), f);
            else {
#pragma unroll
                for (int k = 0; k < 8; ++k) f[k] = 0.f; }
            *(LAS f32x4*)(UR + r * 64 + cc * 8) = (f32x4){f[0], f[1], f[2], f[3]}; *(LAS f32x4*)(UR + r * 64 + cc * 8 + 4) = (f32x4){f[4], f[5], f[6], f[7]}; }
        __syncthreads();
        { const float w0 = PRM[ch], w1 = PRM[64 + ch], w2 = PRM[128 + ch], w3 = PRM[192 + ch], cb = PRM[256 + ch];
#pragma unroll 4
          for (int k = 0; k < 16; ++k) { const int r = seg * 16 + k; const float u = cb + w0 * UR[r * 64 + ch] + w1 * UR[(r + 1) * 64 + ch] + w2 * UR[(r + 2) * 64 + ch] + w3 * UR[(r + 3) * 64 + ch];
              U[r * 64 + ch] = u; UB[r * 72 + ch] = (bf16)(cvt_pk_bf16(u, 0.f) & 0xffffu); } }
        __syncthreads();
        { f32x4 acc[8];
#pragma unroll
          for (int nt = 0; nt < 8; ++nt) acc[nt] = (f32x4){0.f, 0.f, 0.f, 0.f};
          const bf16x8 a0 = *(const LAS bf16x8*)(UB + (16 * wave + fr) * 72 + 8 * fq), a1 = *(const LAS bf16x8*)(UB + (16 * wave + fr) * 72 + 32 + 8 * fq);
#pragma unroll
          for (int nt = 0; nt < 8; ++nt) { acc[nt] = __builtin_amdgcn_mfma_f32_16x16x32_bf16(a0, wf[nt][0], acc[nt], 0, 0, 0); acc[nt] = __builtin_amdgcn_mfma_f32_16x16x32_bf16(a1, wf[nt][1], acc[nt], 0, 0, 0); }
#pragma unroll
          for (int nt = 0; nt < 4; ++nt) { const int cch = 16 * nt + fr; const float br = PRM[6 * 64 + cch], bi = PRM[7 * 64 + cch], sp = PRM[5 * 64 + cch];
#pragma unroll
              for (int rg = 0; rg < 4; ++rg) { const int r = 16 * wave + 4 * fq + rg; const float rgate = sigmoidf_(acc[nt][rg] + br), igate = sigmoidf_(acc[nt + 4][rg] + bi);
                  const float la = -8.0f * rgate * sp, av = expf(la), bv = sqrtf(-expm1f(2.0f * la)) * (igate * U[r * 64 + cch]);
                  AA[r * 64 + cch] = av; BB[r * 64 + cch] = bv; } } }
        __syncthreads();
        float hl[16], ca[16];
        { float h = 0.f, p = 1.f;
#pragma unroll
          for (int k = 0; k < 16; ++k) { const int ip = seg * 16 + k, r = dir == 0 ? ip : 127 - ip; const float av = AA[r * 64 + ch], bv = BB[r * 64 + ch]; h = av * h + bv; p *= av; hl[k] = h; ca[k] = p; }
          SEG[seg * 64 + ch] = p; SEG[512 + seg * 64 + ch] = h; }
        __syncthreads();
        float hin = carry, myin = 0.f;
#pragma unroll
        for (int s = 0; s < 8; ++s) { if (s == seg) myin = hin; hin = SEG[s * 64 + ch] * hin + SEG[512 + s * 64 + ch]; }
        carry = hin;
#pragma unroll
        for (int k = 0; k < 16; ++k) { const int ip = seg * 16 + k, r = dir == 0 ? ip : 127 - ip; const float h = hl[k] + ca[k] * myin;
            OUT[(rowbase + t_lo + r) * 512 + blk * 64 + ch] = (bf16)(cvt_pk_bf16(h, 0.f) & 0xffffu); }
        __syncthreads();
    }
}
__device__ __forceinline__ unsigned off_b(unsigned row, unsigned ch) { return 256u * row + 16u * (ch ^ (((row & 3) << 2) | ((row >> 2) & 3))); }
__device__ __forceinline__ unsigned row_read_addr(unsigned lane, unsigned rb, unsigned s) { return off_b(32 * rb + (lane & 31), 2 * s + (lane >> 5)); }
__device__ __forceinline__ unsigned tr_read_addr(unsigned lane, unsigned c, unsigned ks, unsigned t) {
    const unsigned h = lane >> 5, blk = (lane >> 4) & 1, q = (lane & 15) >> 2, p = lane & 3;
    return off_b(16 * ks + 8 * h + 4 * t + q, 4 * c + 2 * blk + (p >> 1)) + 8 * (p & 1);
}
typedef short v4i16_t __attribute__((ext_vector_type(4)));
__device__ __forceinline__ bf16x8 tr_frag(LAS unsigned char* tile, unsigned lane, unsigned c, unsigned ks) {
    const s16x4 lo = __builtin_bit_cast(s16x4, __builtin_amdgcn_ds_read_tr16_b64_v4i16((LAS v4i16_t*)(tile + tr_read_addr(lane, c, ks, 0))));
    const s16x4 hi = __builtin_bit_cast(s16x4, __builtin_amdgcn_ds_read_tr16_b64_v4i16((LAS v4i16_t*)(tile + tr_read_addr(lane, c, ks, 1))));
    return (bf16x8){lo[0], lo[1], lo[2], lo[3], hi[0], hi[1], hi[2], hi[3]};
}
__device__ __forceinline__ bf16x8 row_frag(LAS unsigned char* tile, unsigned lane, unsigned rb, unsigned s) { return *(const LAS bf16x8*)(tile + row_read_addr(lane, rb, s)); }
#define MFMA32(a, b, c) __builtin_amdgcn_mfma_f32_32x32x16_bf16((a), (b), (c), 0, 0, 0)

constexpr unsigned RT_KB = 0, RT_T2 = 32768, RT_QB = 65536, RT_VB = 98304;
__device__ __forceinline__ s16x4 ds_tr(LAS unsigned char* p) { return __builtin_bit_cast(s16x4, __builtin_amdgcn_ds_read_tr16_b64_v4i16((LAS v4i16_t*)p)); }
#define TRF(base0, base1, off) ({ const s16x4 lo_ = ds_tr(F.lds + (base0) + (off)), hi_ = ds_tr(F.lds + (base1) + (off)); (bf16x8){lo_[0], lo_[1], lo_[2], lo_[3], hi_[0], hi_[1], hi_[2], hi_[3]}; })
#define RWF(base, off) (*(const LAS bf16x8*)(F.lds + (base) + (off)))
__device__ __forceinline__ void ret_item(Frame& F, int li, int b, int head, int dir) {
    const int tid = F.tid, lane = F.lane, wave = F.wave, ib = wave & 3, eh = wave >> 2, r = lane & 31, h = lane >> 5;
    const bf16* Z = (const bf16*)FBIG; bf16* OUT = (bf16*)(FYB + (size_t)(2 + dir) * T_HALF);
    const float theta = INP(13)[((size_t)li * 2 + dir) * 4 + head];
    const float log_g = -((-theta > 20.f) ? -theta : log1pf(expf(-theta)));
    const float g1 = expf(log_g), g127 = expf(127.0f * log_g);
    const size_t rowbase = (size_t)b * TB;
    unsigned xsI[8], xsE[8];
    { const unsigned swz = ((r & 3) << 2) | ((r >> 2) & 3);
#pragma unroll
      for (int s = 0; s < 8; ++s) { const unsigned x = 256u * r + 16u * ((unsigned)(2 * s + h) ^ swz); xsI[s] = x + 8192u * ib + RT_QB; xsE[s] = x + 16384u * eh; } }
    const unsigned tK0 = RT_KB + tr_read_addr(lane, ib, 0, 0), tK1 = RT_KB + tr_read_addr(lane, ib, 0, 1);
    const unsigned tV00 = RT_VB + tr_read_addr(lane, 2 * eh, 0, 0), tV01 = RT_VB + tr_read_addr(lane, 2 * eh, 0, 1), tV10 = RT_VB + tr_read_addr(lane, 2 * eh + 1, 0, 0), tV11 = RT_VB + tr_read_addr(lane, 2 * eh + 1, 0, 1);
    __syncthreads();
    for (int it = tid; it < 2048; it += 512) *(LAS v4u*)(F.lds + RT_T2 + it * 16) = (v4u){0u, 0u, 0u, 0u};
    f32x16 SA[2]; SA[0] = f32x16{}; SA[1] = f32x16{};
    v4u pq[4], pk[4], pv[4];
#define RET_LOAD(c_) do { const int tl_ = chunk_tlo(dir, (c_)); _Pragma("unroll") for (int n_ = 0; n_ < 4; ++n_) { const int it_ = tid + 512 * n_, row_ = it_ >> 4, cn_ = it_ & 15; \
        const bf16* p_ = Z + (rowbase + tl_ + (dir == 0 ? row_ : 127 - row_)) * EV_IN + 1024 + head * 128 + cn_ * 8; pq[n_] = *(const v4u*)p_; pk[n_] = *(const v4u*)(p_ + 512); pv[n_] = *(const v4u*)(p_ + 1024); } } while (0)
    RET_LOAD(0);
#pragma nounroll
    for (int c = 0; c < 66; ++c) {
        const int t_lo = chunk_tlo(dir, c);
        __syncthreads();
#pragma unroll
        for (int n = 0; n < 4; ++n) { const int it = tid + 512 * n, row = it >> 4, cn = it & 15; const float sc = expf(-(float)row * log_g); const unsigned wo = off_b(row, cn);
            float f[8]; unpack8(pk[n], f);
#pragma unroll
            for (int k = 0; k < 8; ++k) f[k] *= sc;
            *(LAS v4u*)(F.lds + RT_QB + wo) = pq[n]; *(LAS v4u*)(F.lds + RT_KB + wo) = pack8(f); *(LAS v4u*)(F.lds + RT_VB + wo) = pv[n]; }
        if (c + 1 < 66) RET_LOAD(c + 1);
        __syncthreads();
        f32x16 OT[2], ST[2];
        OT[0] = f32x16{}; OT[1] = f32x16{}; ST[0] = f32x16{}; ST[1] = f32x16{};
#pragma unroll
        for (int s = 0; s < 8; ++s) { const bf16x8 qf = RWF(xsI[s], 0);
            OT[0] = MFMA32(RWF(xsE[s], RT_T2), qf, OT[0]); OT[1] = MFMA32(RWF(xsE[s], RT_T2 + 8192), qf, OT[1]);
            if (2 * eh <= ib) ST[0] = MFMA32(RWF(xsE[s], RT_KB), qf, ST[0]);
            if (2 * eh + 1 <= ib) ST[1] = MFMA32(RWF(xsE[s], RT_KB + 8192), qf, ST[1]); }
#pragma unroll
        for (int x = 0; x < 2; ++x)
#pragma unroll
            for (int q = 0; q < 16; ++q) SA[x][q] *= g1;
#pragma unroll
        for (int ks = 0; ks < 8; ++ks) { const bf16x8 kf = TRF(tK0, tK1, ks * 4096);
            SA[0] = MFMA32(kf, TRF(tV00, tV01, ks * 4096), SA[0]); SA[1] = MFMA32(kf, TRF(tV10, tV11, ks * 4096), SA[1]); }
#pragma unroll
        for (int x = 0; x < 2; ++x)
#pragma unroll
            for (int q = 0; q < 16; ++q) SA[x][q] *= g127;
        __syncthreads();
        const int irow = 32 * ib + r;
#pragma unroll
        for (int y = 0; y < 2; ++y) { const int jb = 2 * eh + y;
#pragma unroll
            for (int gq = 0; gq < 4; ++gq) { const int j0 = 32 * jb + 8 * gq + 4 * h; float p0 = ST[y][4 * gq], p1 = ST[y][4 * gq + 1], p2 = ST[y][4 * gq + 2], p3 = ST[y][4 * gq + 3];
                if (j0 > irow) p0 = 0.f; if (j0 + 1 > irow) p1 = 0.f; if (j0 + 2 > irow) p2 = 0.f; if (j0 + 3 > irow) p3 = 0.f;
                v2u w; w.x = cvt_pk_bf16(p0, p1); w.y = cvt_pk_bf16(p2, p3);
                *(LAS v2u*)(F.lds + RT_QB + off_b(irow, 4 * jb + gq) + 8 * h) = w; } }
#pragma unroll
        for (int x = 0; x < 2; ++x) { const int erow = 32 * (2 * eh + x) + r;
#pragma unroll
            for (int gq = 0; gq < 4; ++gq) { v2u w; w.x = cvt_pk_bf16(SA[x][4 * gq] * g1, SA[x][4 * gq + 1] * g1); w.y = cvt_pk_bf16(SA[x][4 * gq + 2] * g1, SA[x][4 * gq + 3] * g1);
                *(LAS v2u*)(F.lds + RT_T2 + off_b(erow, 4 * ib + gq) + 8 * h) = w; } }
        __syncthreads();
#pragma unroll
        for (int s = 0; s < 8; ++s) { const bf16x8 pf = RWF(xsI[s], 0);
            OT[0] = MFMA32(TRF(tV00, tV01, s * 4096), pf, OT[0]); OT[1] = MFMA32(TRF(tV10, tV11, s * 4096), pf, OT[1]); }
        { const float gi = expf((float)irow * log_g); const int t = t_lo + (dir == 0 ? irow : 127 - irow);
          bf16* op = OUT + (rowbase + t) * 512 + head * 128;
#pragma unroll
          for (int x = 0; x < 2; ++x)
#pragma unroll
              for (int gq = 0; gq < 4; ++gq) { v2u w; w.x = cvt_pk_bf16(OT[x][4 * gq] * gi, OT[x][4 * gq + 1] * gi); w.y = cvt_pk_bf16(OT[x][4 * gq + 2] * gi, OT[x][4 * gq + 3] * gi);
                  *(v2u*)(op + 32 * (2 * eh + x) + 8 * gq + 4 * h) = w; } }
    }
#undef RET_LOAD
}
#undef TRF
#undef RWF
#if DBG_SCAN
#define DBGCHK(stage, v) do { if (!(fabsf(v) < 1e30f)) atomicMax((unsigned*)(WSG + WS_CTL) + 2049, 100u - (unsigned)(stage)); } while (0)
#else
#define DBGCHK(stage, v) do {} while (0)
#endif
__device__ __forceinline__ void s5_item(Frame& F, int li, int b, int dir, int g) {
    LAS unsigned char* lds = F.lds;
    LAS float* U = (LAS float*)lds;
    LAS float* SEG = (LAS float*)(lds + 8192);
    LAS bf16* HS = (LAS bf16*)(lds + 12288);
    const int tid = F.tid, lane = F.lane, wave = F.wave, p = tid & 63, seg = tid >> 6, fr = lane & 15, fq = lane >> 4;
    const bf16* Z = (const bf16*)FBIG; bf16* OUT = (bf16*)(FYB + (size_t)dir * T_QUART);
    const size_t pb = ((size_t)li * 2 + dir) * 16 + g;
    const float lre = INP(20)[pb * 64 + p], lim = INP(21)[pb * 64 + p], dt = expf(INP(22)[pb]);
    const float x = lre * dt, y = lim * dt, ex = expf(x); float sy, cy; sincosf(y, &sy, &cy);
    const float ar = ex * cy, ai = ex * sy;
    const float sh = sinf(0.5f * y), am1r = expm1f(x) * cy - 2.0f * sh * sh, am1i = ai;
    const float den = 1.0f / (lre * lre + lim * lim), cr = (am1r * lre + am1i * lim) * den, ci = (am1i * lre - am1r * lim) * den;
    float bbr[16], bbi[16];
#pragma unroll
    for (int k = 0; k < 16; ++k) { const float br = INP(23)[(pb * 64 + p) * 16 + k], bi = INP(24)[(pb * 64 + p) * 16 + k]; bbr[k] = cr * br - ci * bi; bbi[k] = cr * bi + ci * br; }
    DBGCHK(1, ar); DBGCHK(1, ai); DBGCHK(2, cr); DBGCHK(2, ci); DBGCHK(3, bbr[0] + bbi[0] + bbr[15] + bbi[15]);
    float a16r = ar, a16i = ai;
#pragma unroll
    for (int k = 0; k < 4; ++k) { const float tr_ = a16r * a16r - a16i * a16i, ti_ = 2.0f * a16r * a16i; a16r = tr_; a16i = ti_; }
    bf16x8 cf[4];
#pragma unroll
    for (int ks = 0; ks < 4; ++ks) { float v[8];
#pragma unroll
        for (int j = 0; j < 8; ++j) { const int k = 32 * ks + 8 * fq + j; v[j] = k < 64 ? INP(25)[(pb * 16 + fr) * 64 + k] : -INP(26)[(pb * 16 + fr) * 64 + (k - 64)]; }
        cf[ks] = __builtin_bit_cast(bf16x8, pack8(v)); }
    float hr = 0.f, hi = 0.f;
    const size_t rowbase = (size_t)b * TB;
    v4u pu = (v4u){0u, 0u, 0u, 0u};
#define S5_LOAD(c_) do { if (tid < 256) { const int tl_ = chunk_tlo(dir, (c_)), row_ = tid >> 1; pu = *(const v4u*)(Z + (rowbase + tl_ + (dir == 0 ? row_ : 127 - row_)) * OD_IN + g * 16 + (tid & 1) * 8); } } while (0)
    S5_LOAD(0);
    for (int c = 0; c < 66; ++c) {
        const int t_lo = chunk_tlo(dir, c);
        __syncthreads();
        if (tid < 256) { float f[8]; unpack8(pu, f); *(LAS f32x4*)(U + (tid >> 1) * 16 + (tid & 1) * 8) = (f32x4){f[0], f[1], f[2], f[3]}; *(LAS f32x4*)(U + (tid >> 1) * 16 + (tid & 1) * 8 + 4) = (f32x4){f[4], f[5], f[6], f[7]}; }
        if (c + 1 < 66) S5_LOAD(c + 1);
        __syncthreads();
        float lr[16], lim_[16];
        { float sr = 0.f, si = 0.f;
#pragma unroll
          for (int k = 0; k < 16; ++k) { const LAS f32x4* up = (const LAS f32x4*)(U + (seg * 16 + k) * 16); const f32x4 u0 = up[0], u1 = up[1], u2 = up[2], u3 = up[3];
              float br = bbr[0] * u0.x + bbr[1] * u0.y + bbr[2] * u0.z + bbr[3] * u0.w + bbr[4] * u1.x + bbr[5] * u1.y + bbr[6] * u1.z + bbr[7] * u1.w
                       + bbr[8] * u2.x + bbr[9] * u2.y + bbr[10] * u2.z + bbr[11] * u2.w + bbr[12] * u3.x + bbr[13] * u3.y + bbr[14] * u3.z + bbr[15] * u3.w;
              float bi = bbi[0] * u0.x + bbi[1] * u0.y + bbi[2] * u0.z + bbi[3] * u0.w + bbi[4] * u1.x + bbi[5] * u1.y + bbi[6] * u1.z + bbi[7] * u1.w
                       + bbi[8] * u2.x + bbi[9] * u2.y + bbi[10] * u2.z + bbi[11] * u2.w + bbi[12] * u3.x + bbi[13] * u3.y + bbi[14] * u3.z + bbi[15] * u3.w;
              const float nr = ar * sr - ai * si + br, ni = ar * si + ai * sr + bi; sr = nr; si = ni; lr[k] = sr; lim_[k] = si; }
          DBGCHK(4, sr + si); SEG[(seg * 64 + p) * 2] = sr; SEG[(seg * 64 + p) * 2 + 1] = si; }
        __syncthreads();
        float inr = 0.f, ini = 0.f;
#pragma unroll
        for (int s = 0; s < 8; ++s) { if (s == seg) { inr = hr; ini = hi; } const float er = SEG[(s * 64 + p) * 2], ei = SEG[(s * 64 + p) * 2 + 1];
            const float nr = a16r * hr - a16i * hi + er, ni = a16r * hi + a16i * hr + ei; hr = nr; hi = ni; }
        DBGCHK(5, hr + hi + inr + ini);
        { float pr = ar, pi = ai;
#pragma unroll
          for (int k = 0; k < 16; ++k) { const float vr = lr[k] + pr * inr - pi * ini, vi = lim_[k] + pr * ini + pi * inr;
              HS[(seg * 16 + k) * 136 + p] = (bf16)(cvt_pk_bf16(vr, 0.f) & 0xffffu); HS[(seg * 16 + k) * 136 + 64 + p] = (bf16)(cvt_pk_bf16(vi, 0.f) & 0xffffu);
              const float npr = pr * ar - pi * ai, npi = pr * ai + pi * ar; pr = npr; pi = npi; } }
        __syncthreads();
        { pg8::f32x4 acc = (pg8::f32x4){0.f, 0.f, 0.f, 0.f};
#pragma unroll
          for (int ks = 0; ks < 4; ++ks) { const bf16x8 af = *(const LAS bf16x8*)(HS + (16 * wave + fr) * 136 + 32 * ks + 8 * fq); acc = __builtin_amdgcn_mfma_f32_16x16x32_bf16(cf[ks], af, acc, 0, 0, 0); }
          DBGCHK(6, acc[0] + acc[1] + acc[2] + acc[3]);
          const int ip = 16 * wave + fr, t = t_lo + (dir == 0 ? ip : 127 - ip);
          v2u w; w.x = cvt_pk_bf16(acc[0], acc[1]); w.y = cvt_pk_bf16(acc[2], acc[3]);
          *(v2u*)(OUT + (rowbase + t) * 256 + g * 16 + 4 * fq) = w; }
    }
#undef S5_LOAD
}
namespace att {
constexpr int KVBLK = 64, LD = OD_IN;
constexpr float SCALE = 0.125f, THR = 8.f;
constexpr size_t SHM_V = KVBLK * 128 * 2, SHM_K = KVBLK * 128 * 2;
#define KSWZ(row, colB) ((row) * 256 + ((colB) ^ (((row) & 7) << 4)))
#define SBAR() __builtin_amdgcn_sched_barrier(0)
__device__ __forceinline__ int crow(int r, int hi) { return (r & 3) + 8 * (r >> 2) + 4 * hi; }
__device__ __forceinline__ void partialSM(f32x16& p0, f32x16& p1, float& m_reg, float& mn, float& alpha) {
  constexpr float C = SCALE * 1.4426950408889634f;
  float pmax = p0[0];
#pragma unroll
  for (int r = 1; r < 16; ++r) pmax = fmaxf(pmax, p0[r]);
#pragma unroll
  for (int r = 0; r < 16; ++r) pmax = fmaxf(pmax, p1[r]);
  { auto rr = __builtin_amdgcn_permlane32_swap(__float_as_uint(pmax), __float_as_uint(pmax), false, false);
    pmax = fmaxf(__uint_as_float(rr[0]), __uint_as_float(rr[1])); }
  if (__builtin_expect(__all(pmax - m_reg <= THR / SCALE), 1)) { mn = m_reg; alpha = 1.f; }
  else { mn = fmaxf(m_reg, pmax); alpha = __builtin_amdgcn_exp2f((m_reg - mn) * C); m_reg = mn; }
  const float mnC = -mn * C;
#pragma unroll
  for (int r = 0; r < 16; ++r) p0[r] = fmaf(p0[r], C, mnC);
#pragma unroll
  for (int r = 0; r < 16; ++r) p1[r] = fmaf(p1[r], C, mnC);
#pragma unroll
  for (int r = 0; r < 16; ++r) p0[r] = __builtin_amdgcn_exp2f(p0[r]);
}
__device__ __forceinline__ void finishSM(f32x16& p0, f32x16& p1, float alpha, float& l_reg, bf16x8& pa0, bf16x8& pa1, bf16x8& pa2, bf16x8& pa3) {
#pragma unroll
  for (int r = 0; r < 16; ++r) p1[r] = __builtin_amdgcn_exp2f(p1[r]);
  float ps = 0;
#pragma unroll
  for (int r = 0; r < 16; ++r) ps += p0[r];
#pragma unroll
  for (int r = 0; r < 16; ++r) ps += p1[r];
  { auto rr = __builtin_amdgcn_permlane32_swap(__float_as_uint(ps), __float_as_uint(ps), false, false);
    ps = __uint_as_float(rr[0]) + __uint_as_float(rr[1]); }
  l_reg = l_reg * alpha + ps;
#define PK4(P, BASE, OUT) do { unsigned a0 = cvt_pk_bf16(P[BASE + 0], P[BASE + 1]), a1 = cvt_pk_bf16(P[BASE + 2], P[BASE + 3]);   \
    unsigned b0 = cvt_pk_bf16(P[BASE + 4], P[BASE + 5]), b1 = cvt_pk_bf16(P[BASE + 6], P[BASE + 7]);                              \
    auto r0 = __builtin_amdgcn_permlane32_swap(a0, b0, false, false); auto r1 = __builtin_amdgcn_permlane32_swap(a1, b1, false, false); \
    v4u w = {r0[0], r1[0], r0[1], r1[1]}; OUT = __builtin_bit_cast(bf16x8, w); } while (0)
  PK4(p0, 0, pa0); PK4(p0, 8, pa1); PK4(p1, 0, pa2); PK4(p1, 8, pa3);
#undef PK4
}
__device__ __forceinline__ void qkt(f32x16& p0, f32x16& p1, const char* Ks, const bf16x8* qr, int r32, int hi, int mapoff) {
  p0 = f32x16{}; p1 = f32x16{};
#pragma unroll
  for (int d0 = 0; d0 < 4; ++d0) { const int cb = mapoff + (d0 * 16 + hi * 8) * 2;
    const bf16x8 b0 = *reinterpret_cast<const bf16x8*>(Ks + KSWZ(r32, cb));
    const bf16x8 b1 = *reinterpret_cast<const bf16x8*>(Ks + KSWZ(32 + r32, cb));
    p0 = __builtin_amdgcn_mfma_f32_32x32x16_bf16(b0, qr[d0], p0, 0, 0, 0);
    p1 = __builtin_amdgcn_mfma_f32_32x32x16_bf16(b1, qr[d0], p1, 0, 0, 0); }
}
__device__ __forceinline__ int v_st(int k, int c) { const int kk = (k & ~0xC) | ((k & 4) << 1) | ((k & 8) >> 1); return ((kk >> 3) * 4 + (c >> 5)) * 512 + ((kk & 7) * 32 + (c & 31)) * 2; }
__device__ __forceinline__ int v_rd_base(int lane) { return ((lane & 3) << 3) | (((lane >> 2) & 3) << 6) | (((lane >> 4) & 1) << 5) | (((lane >> 5) & 1) << 8); }
constexpr int v_rd_off(int d0, int ks, int half) { return d0 * 512 + ks * 4096 + half * 2048; }
template <int OFF> __device__ __forceinline__ s16x4 tr_read(int vb) {
  s16x4 r; asm volatile("ds_read_b64_tr_b16 %0, %1 offset:%2" : "=&v"(r) : "v"(vb), "i"(OFF) : "memory"); return r;
}
template <int D0> __device__ __forceinline__ void pv_one(f32x16& od, int vb, bf16x8 pa0, bf16x8 pa1, bf16x8 pa2, bf16x8 pa3) {
  const s16x4 l0 = tr_read<v_rd_off(D0, 0, 0)>(vb), h0 = tr_read<v_rd_off(D0, 0, 1)>(vb), l1 = tr_read<v_rd_off(D0, 1, 0)>(vb), h1 = tr_read<v_rd_off(D0, 1, 1)>(vb);
  const s16x4 l2 = tr_read<v_rd_off(D0, 2, 0)>(vb), h2 = tr_read<v_rd_off(D0, 2, 1)>(vb), l3 = tr_read<v_rd_off(D0, 3, 0)>(vb), h3 = tr_read<v_rd_off(D0, 3, 1)>(vb);
  asm volatile("s_waitcnt lgkmcnt(0)" ::: "memory"); SBAR();
#define PK(L, H) (bf16x8){L[0], L[1], L[2], L[3], H[0], H[1], H[2], H[3]}
  od = __builtin_amdgcn_mfma_f32_32x32x16_bf16(pa0, PK(l0, h0), od, 0, 0, 0);
  od = __builtin_amdgcn_mfma_f32_32x32x16_bf16(pa1, PK(l1, h1), od, 0, 0, 0);
  od = __builtin_amdgcn_mfma_f32_32x32x16_bf16(pa2, PK(l2, h2), od, 0, 0, 0);
  od = __builtin_amdgcn_mfma_f32_32x32x16_bf16(pa3, PK(l3, h3), od, 0, 0, 0);
#undef PK
}
__device__ __forceinline__ void pv_d0(f32x16* o, int vb, bf16x8 pa0, bf16x8 pa1, bf16x8 pa2, bf16x8 pa3) {
  pv_one<0>(o[0], vb, pa0, pa1, pa2, pa3); pv_one<1>(o[1], vb, pa0, pa1, pa2, pa3); pv_one<2>(o[2], vb, pa0, pa1, pa2, pa3); pv_one<3>(o[3], vb, pa0, pa1, pa2, pa3);
}
__device__ __forceinline__ void unit(const bf16* __restrict__ Qb, const bf16* __restrict__ Kh, const bf16* __restrict__ Vh, bf16* __restrict__ Ob, int seq, char* lds,
                                     float lam, float gsc, const float* __restrict__ gn, const int tid) {
  const int wid = tid >> 6, lane = tid & 63, r32 = lane & 31, hi = lane >> 5, map = wid >> 2, wq = wid & 3;
  char* V_lds = lds; char* K_lds = lds + 2 * SHM_V;
  float* ws = (float*)(lds + 2 * SHM_V + 2 * SHM_K) + wid * 64; float* li_l = ws; float* al_l = ws + 32;
  float m_reg = -1e30f, l_reg = 0; f32x16 o[4] = {}; bf16x8 qr[4];
  const bf16* Qw = Qb + (long)(wq * 32 + r32) * LD + map * 64 + hi * 8;
#pragma unroll
  for (int d0 = 0; d0 < 4; ++d0) qr[d0] = *reinterpret_cast<const bf16x8*>(Qw + d0 * 16);
  const int sr = tid >> 4, sc = (tid & 15) * 8, vst0 = v_st(sr, sc), vst1 = v_st(32 + sr, sc);
  const int vb0 = (int)(uintptr_t)V_lds + v_rd_base(lane);
  const int mapoff = map * 128;
  struct { bf16x8 vs0, vs1, ks0, ks1; } sr_[2];
  const unsigned go0 = (unsigned)(sr * LD + sc) * 2u, go1 = (unsigned)((32 + sr) * LD + sc) * 2u;
#define SLOAD(i, k0) do { const char* vb_ = (const char*)Vh + (size_t)(k0) * (LD * 2); const char* kb_ = (const char*)Kh + (size_t)(k0) * (LD * 2); \
    sr_[i].vs0 = *reinterpret_cast<const bf16x8*>(vb_ + go0); sr_[i].vs1 = *reinterpret_cast<const bf16x8*>(vb_ + go1); \
    sr_[i].ks0 = *reinterpret_cast<const bf16x8*>(kb_ + go0); sr_[i].ks1 = *reinterpret_cast<const bf16x8*>(kb_ + go1); } while (0)
#define SWRITE(b, i) do { *(bf16x8*)(V_lds + (b) * SHM_V + vst0) = sr_[i].vs0;          \
    *(bf16x8*)(V_lds + (b) * SHM_V + vst1) = sr_[i].vs1; const int kc = sc * 2;               \
    *(bf16x8*)(K_lds + (b) * SHM_K + KSWZ(sr, kc)) = sr_[i].ks0;                       \
    *(bf16x8*)(K_lds + (b) * SHM_K + KSWZ(32 + sr, kc)) = sr_[i].ks1; } while (0)
#define SWAIT() asm volatile("s_waitcnt vmcnt(4)" ::: "memory")
#define RESC(a) do { if (__any((a) < 1.f)) { if (hi == 0) al_l[r32] = (a); asm volatile("s_waitcnt lgkmcnt(0)" ::: "memory"); \
    _Pragma("unroll") for (int d = 0; d < 4; ++d) _Pragma("unroll") for (int r = 0; r < 16; ++r) o[d][r] *= al_l[crow(r, hi)]; } } while (0)
  f32x16 pA0, pA1, pB0, pB1; float mnA, mnB, alA, alB; bf16x8 pa0, pa1, pa2, pa3; const int NT = seq / KVBLK;
  constexpr int SE = 0, SO = 1;
  SLOAD(SE, 0); asm volatile("s_waitcnt vmcnt(0)" ::: "memory"); SWRITE(0, SE); __syncthreads();
  qkt(pA0, pA1, K_lds, qr, r32, hi, mapoff); partialSM(pA0, pA1, m_reg, mnA, alA);
  SLOAD(SO, KVBLK); if (2 < NT) SLOAD(SE, 2 * KVBLK);
  SWAIT(); SWRITE(1, SO); __syncthreads();
  for (int j = 1; j + 1 < NT; j += 2) {
    SBAR(); qkt(pB0, pB1, K_lds + SHM_K, qr, r32, hi, mapoff);
    finishSM(pA0, pA1, alA, l_reg, pa0, pa1, pa2, pa3); SBAR();
    SLOAD(SO, (j + 2) * KVBLK); SBAR();
    pv_d0(o, vb0, pa0, pa1, pa2, pa3); partialSM(pB0, pB1, m_reg, mnB, alB);
    __syncthreads(); SWAIT(); SWRITE(0, SE);
    RESC(alB); __syncthreads();
    SBAR(); qkt(pA0, pA1, K_lds, qr, r32, hi, mapoff);
    finishSM(pB0, pB1, alB, l_reg, pa0, pa1, pa2, pa3); SBAR();
    if (j + 3 < NT) SLOAD(SE, (j + 3) * KVBLK); SBAR();
    pv_d0(o, vb0 + (int)SHM_V, pa0, pa1, pa2, pa3); partialSM(pA0, pA1, m_reg, mnA, alA);
    __syncthreads(); SWAIT(); SWRITE(1, SO);
    RESC(alA); __syncthreads();
  }
  SBAR(); qkt(pB0, pB1, K_lds + SHM_K, qr, r32, hi, mapoff);
  finishSM(pA0, pA1, alA, l_reg, pa0, pa1, pa2, pa3); SBAR();
  pv_d0(o, vb0, pa0, pa1, pa2, pa3); partialSM(pB0, pB1, m_reg, mnB, alB);
  __syncthreads(); RESC(alB);
  finishSM(pB0, pB1, alB, l_reg, pa0, pa1, pa2, pa3); SBAR();
  pv_d0(o, vb0 + (int)SHM_V, pa0, pa1, pa2, pa3);
  if (hi == 0) li_l[r32] = l_reg; asm volatile("s_waitcnt lgkmcnt(0)" ::: "memory");
  float rli[16];
#pragma unroll
  for (int r = 0; r < 16; ++r) rli[r] = __builtin_amdgcn_rcpf(li_l[crow(r, hi)]);
  __syncthreads();
  int zz = 0; asm volatile("" : "+v"(zz));
  float* EX = (float*)lds;
  const int eb = wq * 4096 + lane + zz;
  if (map == 1) {
#pragma unroll
    for (int d0 = 0; d0 < 4; ++d0)
#pragma unroll
      for (int r = 0; r < 16; ++r) EX[eb + (d0 * 16 + r) * 64] = -lam * o[d0][r] * rli[r];
  }
  __syncthreads();
  if (map == 0) {
    float ss[16];
#pragma unroll
    for (int r = 0; r < 16; ++r) ss[r] = 0.f;
#pragma unroll
    for (int d0 = 0; d0 < 4; ++d0)
#pragma unroll
      for (int r = 0; r < 16; ++r) { const float v = o[d0][r] * rli[r] + EX[eb + (d0 * 16 + r) * 64]; o[d0][r] = v; ss[r] += v * v; }
#pragma unroll
    for (int r = 0; r < 16; ++r) { float s = ss[r]; s += __shfl_xor(s, 1); s += __shfl_xor(s, 2); s += __shfl_xor(s, 4); s += __shfl_xor(s, 8); s += __shfl_xor(s, 16);
      ss[r] = gsc / sqrtf(s * (1.0f / 128.0f) + EPS); }
    bf16* Ow = Ob + (long)(wq * 32 + 4 * hi) * 1024 + r32 + zz;
#pragma unroll
    for (int d0 = 0; d0 < 4; ++d0) { const float gv = gn[d0 * 32 + r32];
#pragma unroll
      for (int r = 0; r < 16; ++r) Ow[((r & 3) + 8 * (r >> 2)) * 1024 + d0 * 32] = (bf16)(cvt_pk_bf16(o[d0][r] * ss[r] * gv, 0.f) & 0xffffu); }
  }
  __syncthreads();
#undef SLOAD
#undef SWRITE
#undef SWAIT
#undef RESC
}
#undef KSWZ
#undef SBAR
}
__device__ __forceinline__ void ph_mix_even(Frame& F, int i) {
    if (!(F.A->mode & 4)) for (int it = F.bid; it < 192; it += F.G) { LAUNDER(F);
#ifndef NO_RET
        if (it < 64) ret_item(F, i, it >> 3, (it >> 1) & 3, it & 1);
#endif
#ifndef NO_LRU
        if (it >= 64) { const int j = it - 64; lru_item(F, i, j >> 4, (j >> 3) & 1, j & 7); }
#endif
        __syncthreads();
    }
}
__device__ __forceinline__ void ph_mix_odd(Frame& F, int l, int ctx_out) {
    const int i = l >> 1;
#ifndef NO_S5
    if (!(F.A->mode & 1)) for (int it = F.bid; it < 256; it += F.G) { LAUNDER(F); s5_item(F, i, it >> 5, (it >> 4) & 1, it & 15); __syncthreads(); }
#endif
    const float* lp = INP(30) + (size_t)i * 256;
    const float s01 = wave_sum(lp[F.lane] * lp[64 + F.lane]), s23 = wave_sum(lp[128 + F.lane] * lp[192 + F.lane]);
    const float lam_init = 0.8f - 0.6f * expf(-0.3f * (float)l), lam = expf(s01) - expf(s23) + lam_init, gsc = 1.0f - lam_init;
    const bf16* Z = (const bf16*)FBIG; const float* gn = INP(31) + (size_t)i * 768;
    const int vcu = (F.G % 8 == 0) ? (F.bid % 8) * (F.G / 8) + F.bid / 8 : F.bid;
    const int nx = NB * 6 * 64, nc = ctx_out ? NB * 6 * 2 : 0;
    if (!(F.A->mode & 2)) for (int u = vcu; u < nx + nc; u += F.G) { LAUNDER(F);
        int bh, qb, row0, seq;
        if (u < nx) { bh = u >> 6; qb = u & 63; row0 = (bh / 6) * TB + CTXL + 128 * qb; seq = TB; }
        else { const int v = u - nx; bh = v >> 1; qb = v & 1; row0 = (bh / 6) * TB + 128 * qb; seq = CTXL; }
        const int b = bh / 6, h = bh % 6;
#ifndef NO_ATTN
        att::unit(Z + (size_t)row0 * OD_IN + 256 + h * 128, Z + (size_t)b * TB * OD_IN + 1024 + h * 128, Z + (size_t)b * TB * OD_IN + 1792 + h * 128,
                  FH + (size_t)row0 * D + 256 + h * 128, seq, (char*)F.lds, lam, gsc, gn + h * 128, F.tid);
#endif
    }
}

constexpr int PH_PER_LAYER = 18, PH_TOTAL = 2 + NLAYER * PH_PER_LAYER;
#define IN(k) (lo <= (k) && (k) < hi)
#define SEAM(k) do { if (IN((k) + 1)) xcd_barrier(bar); } while (0)
template <int l> __device__ __forceinline__ void run_layer(Frame& F, const XcdBarrier& bar, const int lo, const int hi) {
        constexpr int P = 1 + PH_PER_LAYER * l, i = l >> 1; constexpr bool odd = l & 1; constexpr int ctx_out = l < NLAYER - 1;
        const float* MODl = FMOD + (size_t)l * 9 * 6144; const float* ng = INP(6) + (size_t)l * 4 * 1024;
        if (IN(P + 0)) { LAUNDER(F);
            ph_convert(F, l);
#ifdef PROBE_CONVERT
            __syncthreads(); ph_convert(F, l);
#endif
            NormArgs a{}; a.xin_input = (l == 0); a.has_y = (l > 0); a.two = (l > 0) && ((l - 1) & 1); a.write_x = (l > 0); a.final_ = 0; a.do_h = 1; a.do_route = 0;
            if (l > 0) { a.gate = FMOD + (size_t)(l - 1) * 9 * 6144 + 5 * 1024; a.gy = INP(6) + (size_t)(l - 1) * 4 * 1024 + 3 * 1024; }
            a.gh = ng; a.shift = MODl; a.scale = MODl + 1024;
            __syncthreads(); ph_norm(F, a); SEAM(P + 0);
        }
        if (IN(P + 1)) { LAUNDER(F);
            const int N = odd ? OD_IN : EV_IN;
            pg8::Gemm g{FH, FWB + W_IN / 2, M, N, D}; pg8::StaticOrder S; S.init(M, N, F.G, F.bid);
            pg8::EpiPlain E{(bf16*)FBIG, N};
            pg8::gemm_phase<pg8::EpiPlain, pg8::StaticOrder, true, true>(F.lds, g, S, E, F.tid);
            SEAM(P + 1);
        }
        if (IN(P + 2)) { LAUNDER(F); ph_rope(F, odd); SEAM(P + 2); }
        if (IN(P + 3)) { LAUNDER(F); if (!odd) ph_mix_even(F, i); else ph_mix_odd(F, l, ctx_out); SEAM(P + 3); }
        if (IN(P + 4)) { LAUNDER(F); if (!odd) ph_merge_even(F, i); else ph_zpass(F, i); SEAM(P + 4); }
        if (odd && IN(P + 5)) { LAUNDER(F);
            int kglu = 256; asm volatile("" : "+s"(kglu));
            pg8::Gemm g{(const bf16*)(FYB + 2 * T_QUART), FWB + W_GLU / 2, M, 256, kglu}; pg8::StaticOrder S; S.init(M, 256, F.G, F.bid);
            pg8::EpiGLU E{FH, D, (const bf16*)(FYB + 2 * T_QUART), 256, INP(29) + (size_t)i * 256};
            pg8::gemm_phase<pg8::EpiGLU, pg8::StaticOrder, true, true>(F.lds, g, S, E, F.tid);
            SEAM(P + 5);
        }
        if (IN(P + 6)) { LAUNDER(F);
            pg8::Gemm g{FH, FWB + W_OUT / 2, M, D, D}; pg8::StaticOrder S; S.init(M, D, F.G, F.bid);
            pg8::EpiPlain E{(bf16*)FYB, D};
            pg8::gemm_phase<pg8::EpiPlain, pg8::StaticOrder, true, true>(F.lds, g, S, E, F.tid);
            SEAM(P + 6);
        }
        if (IN(P + 7)) { LAUNDER(F);
            NormArgs a{}; a.xin_input = (l == 0); a.has_y = 1; a.two = 0; a.write_x = 1; a.final_ = 0; a.do_h = 1; a.do_route = odd;
            a.gate = MODl + 2 * 1024; a.gy = ng + 1024; a.gh = ng + 2 * 1024; a.shift = MODl + 3 * 1024; a.scale = MODl + 4 * 1024;
            a.rw = INP(33) + (size_t)i * 8192; a.rb = INP(34) + (size_t)i * 8;
            ph_norm(F, a); SEAM(P + 7);
        }
        if (!odd) {
            if (IN(P + 9)) { LAUNDER(F);
                pg8::Gemm g{FH, FWB + W_GU / 2, M, 2 * DFF, D}; pg8::StaticOrder S; S.init(M, 2 * DFF, F.G, F.bid);
                pg8::EpiSwiGLU E{(bf16*)(FBIG + BIG_ACT), DFF};
                pg8::gemm_phase<pg8::EpiSwiGLU, pg8::StaticOrder, true, true>(F.lds, g, S, E, F.tid);
                SEAM(P + 9);
            }
            if (IN(P + 10)) { LAUNDER(F);
                pg8::Gemm g{(const bf16*)(FBIG + BIG_ACT), FWB + W_DN / 2, M, D, DFF}; pg8::StaticOrder S; S.init(M, D, F.G, F.bid);
                pg8::EpiPlain E{(bf16*)FYB, D};
                pg8::gemm_phase<pg8::EpiPlain, pg8::StaticOrder, true, true>(F.lds, g, S, E, F.tid);
                SEAM(P + 10);
            }
        } else {
            if (IN(P + 8)) { LAUNDER(F); ph_assign(F); SEAM(P + 8); }
#pragma nounroll
            for (int w = 0; w < 3; ++w) {
                const int* PE = (const int*)(WSG + WS_PEXP);
                if (IN(P + 9 + 3 * w)) { LAUNDER(F); const int np = PE[MAXP], p0 = min(np, PW * w), p1 = min(np, PW * (w + 1)); ph_gather(F, p0, p1); SEAM(P + 9 + 3 * w); }
                if (IN(P + 10 + 3 * w)) { LAUNDER(F); const int np = PE[MAXP], p0 = min(np, PW * w), p1 = min(np, PW * (w + 1));
                    pg8::Gemm g{(const bf16*)(FBIG + BIG_HG), FWB + W_MGU / 2, (p1 - p0) * 256, 2 * DFF, D};
                    pg8::ExpertOrder S; S.init((p1 - p0) * 256, 2 * DFF, F.G, F.bid); S.pexp = PE + p0; S.estride = (size_t)7168 * 1024 * 2;
                    pg8::EpiSwiGLU E{(bf16*)(FBIG + BIG_ACT), DFF};
                    pg8::gemm_phase<pg8::EpiSwiGLU, pg8::ExpertOrder, true, true>(F.lds, g, S, E, F.tid);
                    SEAM(P + 10 + 3 * w); }
                if (IN(P + 11 + 3 * w)) { LAUNDER(F); const int np = PE[MAXP], p0 = min(np, PW * w), p1 = min(np, PW * (w + 1));
                    pg8::Gemm g{(const bf16*)(FBIG + BIG_ACT), FWB + W_MDN / 2, (p1 - p0) * 256, D, DFF};
                    pg8::ExpertOrder S; S.init((p1 - p0) * 256, D, F.G, F.bid); S.pexp = PE + p0; S.estride = (size_t)1024 * 3584 * 2;
                    pg8::EpiScatter E{(const RouteEnt*)(WSG + WS_LIST) + (size_t)p0 * 256, (bf16*)FYB, (size_t)M * 1024, D};
                    pg8::gemm_phase<pg8::EpiScatter, pg8::ExpertOrder, true, true>(F.lds, g, S, E, F.tid);
                    SEAM(P + 11 + 3 * w); }
            }
        }
    }
#undef IN
#undef SEAM
__global__ void __launch_bounds__(512, 2) hybrid_fwd(Args args) {
    extern __shared__ __attribute__((aligned(16))) unsigned char lds_raw[];
    Frame F;
    F.lds = (LAS unsigned char*)lds_raw;
    F.tid = threadIdx.x; F.lane = F.tid & 63; F.wave = __builtin_amdgcn_readfirstlane(F.tid >> 6); F.G = gridDim.x; F.bid = blockIdx.x;
    F.A = (KArgs*)__builtin_amdgcn_kernarg_segment_ptr(); F.wsi = F.A->ws;
    volatile LAS unsigned* MISC = (volatile LAS unsigned*)(F.lds + MISC_OFF);
    for (int u = F.tid; u < (LDS_BYTES - LDSCTL_OFF) / 4; u += 512) ((LAS unsigned*)(F.lds + LDSCTL_OFF))[u] = 0u;
    __syncthreads();
    const int lo = args.ph_lo, hi = args.ph_hi;
    const bool multi = (hi - lo) > 1;
    unsigned* ctl = (unsigned*)(WSG + WS_CTL);
    XcdBarrier bar; bar.bar = ctl + CW_BAR; bar.x = 0; bar.st = nullptr;
    if (multi) bar = xcd_barrier_post(ctl + CW_BAR, MISC + 8);
#define IN(k) (lo <= (k) && (k) < hi)
#define SEAM(k) do { if (IN((k) + 1)) xcd_barrier(bar); } while (0)
    if (IN(0)) { LAUNDER(F); ph_prologue(F); SEAM(0); }
    run_layer<0>(F, bar, lo, hi); run_layer<1>(F, bar, lo, hi); run_layer<2>(F, bar, lo, hi); run_layer<3>(F, bar, lo, hi);
    if (IN(PH_TOTAL - 1)) { LAUNDER(F);
        NormArgs a{}; a.xin_input = 0; a.has_y = 1; a.two = 1; a.write_x = 1; a.final_ = 1; a.do_h = 0; a.do_route = 0;
        a.gate = FMOD + (size_t)3 * 9 * 6144 + 5 * 1024; a.gy = INP(6) + (size_t)3 * 4 * 1024 + 3 * 1024;
        ph_norm(F, a);
    }
#undef IN
#undef SEAM
}


#ifndef DBG_SCAN
#define DBG_SCAN 0
#endif
#if DBG_SCAN
constexpr int CW_DBG = 2048;
__global__ void __launch_bounds__(256) dbg_scan(unsigned char* ws, const float* out, int phase) {
    unsigned* flag = (unsigned*)(ws + WS_CTL) + CW_DBG; bool bad = false;
    const size_t gt = (size_t)blockIdx.x * 256 + threadIdx.x, gs = (size_t)gridDim.x * 256;
    { const uint4* p = (const uint4*)(ws + WS_W); const size_t n = (WS_END - WS_W) / 16;
      for (size_t i = gt; i < n; i += gs) { const uint4 v = p[i]; const unsigned w[4] = {v.x, v.y, v.z, v.w};
#pragma unroll
          for (int k = 0; k < 4; ++k) { if ((w[k] & 0x7F80u) == 0x7F80u || (w[k] & 0x7F800000u) == 0x7F800000u) bad = true; } } }
    { const uint4* p = (const uint4*)(ws + WS_XC); const size_t n = (size_t)NB * CTXL * D / 4;
      for (size_t i = gt; i < n; i += gs) { const uint4 v = p[i]; if ((v.x & 0x7F800000u) == 0x7F800000u || (v.y & 0x7F800000u) == 0x7F800000u || (v.z & 0x7F800000u) == 0x7F800000u || (v.w & 0x7F800000u) == 0x7F800000u) bad = true; } }
    { const uint4* p = (const uint4*)out; const size_t n = (size_t)NB * SEQ * D / 4;
      for (size_t i = gt; i < n; i += gs) { const uint4 v = p[i]; if ((v.x & 0x7F800000u) == 0x7F800000u || (v.y & 0x7F800000u) == 0x7F800000u || (v.z & 0x7F800000u) == 0x7F800000u || (v.w & 0x7F800000u) == 0x7F800000u) bad = true; } }
    { const unsigned* p = (const unsigned*)(ws + WS_MOD); const size_t n = 4 * 9 * 6144;
      for (size_t i = gt; i < n; i += gs) if ((p[i] & 0x7F800000u) == 0x7F800000u) bad = true; }
    if (bad) atomicMax(flag, 1000u - (unsigned)phase);
}
__global__ void __launch_bounds__(256) dbg_emit(unsigned char* ws, float* out) {
    const unsigned f = ((const unsigned*)(ws + WS_CTL))[CW_DBG], f2 = ((const unsigned*)(ws + WS_CTL))[CW_DBG + 1]; if (f == 0u && f2 == 0u) return;
    const int p = f2 ? 40 + (100 - (int)f2) : 1000 - (int)f;
    const size_t n = (size_t)NB * SEQ * D;
    for (size_t i = (size_t)blockIdx.x * 256 + threadIdx.x; i < n; i += (size_t)gridDim.x * 256) out[i] = (i == 0) ? ldexpf(1.0f, 14 + p) : 0.f;
}
#endif
static bool phase_exists(int ph) {
    if (ph == 0 || ph == PH_TOTAL - 1) return true;
    const int l = (ph - 1) / PH_PER_LAYER, k = (ph - 1) % PH_PER_LAYER; const bool odd = l & 1;
    if (odd) return true;
    return k <= 4 || k == 6 || k == 7 || k == 9 || k == 10;
}
#ifndef MK_ONE_LAUNCH
#define MK_ONE_LAUNCH 1
#endif
extern "C" void kernel_launch(void* const* d_in, const int* in_sizes, int n_in, void* d_out, int out_size, void* d_ws, size_t ws_size, hipStream_t stream) {
    static int grid = 0;
    if (grid == 0) {
        if (n_in != 38 || in_sizes[0] != NB * SEQ * D || out_size != NB * SEQ * D || ws_size < WS_END) { fprintf(stderr, "kernel_launch: unexpected shapes / workspace (%d inputs, ws %zu)\n", n_in, ws_size); grid = -1; return; }
        int dev = 0, cus = 0, per_cu = 0;
        if (hipGetDevice(&dev) != hipSuccess || hipDeviceGetAttribute(&cus, hipDeviceAttributeMultiprocessorCount, dev) != hipSuccess) { grid = -1; return; }
        if (hipFuncSetAttribute((const void*)hybrid_fwd, hipFuncAttributeMaxDynamicSharedMemorySize, LDS_BYTES) != hipSuccess) { fprintf(stderr, "kernel_launch: hipFuncSetAttribute failed\n"); grid = -1; return; }
        if (hipOccupancyMaxActiveBlocksPerMultiprocessor(&per_cu, (const void*)hybrid_fwd, 512, LDS_BYTES) != hipSuccess || per_cu < 1) fprintf(stderr, "kernel_launch: occupancy query reports %d workgroups per CU\n", per_cu);
        (void)hipGetLastError();
        grid = cus;
    }
    if (grid < 0) return;
    if (hipMemsetAsync((char*)d_ws + WS_CTL, 0, CTL_ZERO_BYTES, stream) != hipSuccess) return;
#if DBG_SCAN
    (void)hipMemsetAsync(d_ws, 0, WS_END, stream); (void)hipMemsetAsync(d_out, 0, (size_t)out_size * 4, stream);
#endif
    Args a{};
    for (int i = 0; i < 38; ++i) a.in[i] = (const float*)d_in[i];
    a.out = (float*)d_out; a.ws = (unsigned char*)d_ws;
    if (MK_ONE_LAUNCH) { a.ph_lo = 0; a.ph_hi = PH_TOTAL; hipLaunchKernelGGL(hybrid_fwd, dim3(grid), dim3(512), LDS_BYTES, stream, a); }
    else for (int ph = 0; ph < PH_TOTAL; ++ph) { if (!phase_exists(ph)) continue; a.ph_lo = ph; a.ph_hi = ph + 1;
        int reps = 1;
#ifdef PROBE_REPEAT
        if (ph > 0 && ph < PH_TOTAL - 1) { const int k = (ph - 1) % PH_PER_LAYER; if ((PROBE_REPEAT >> k) & 1) reps = 2; }
#endif
        for (int rp = 0; rp < reps; ++rp) {
#ifdef PROBE_MODE
            a.mode = rp ? PROBE_MODE : 0;
#endif
            hipLaunchKernelGGL(hybrid_fwd, dim3(grid), dim3(512), LDS_BYTES, stream, a); }
        a.mode = 0;
#if DBG_SCAN
        hipLaunchKernelGGL(dbg_scan, dim3(2048), dim3(256), 0, stream, (unsigned char*)d_ws, (const float*)d_out, ph);
#endif
    }
#if DBG_SCAN
    hipLaunchKernelGGL(dbg_emit, dim3(2048), dim3(256), 0, stream, (unsigned char*)d_ws, (float*)d_out);
#endif
    const hipError_t le = hipPeekAtLastError();
    if (le != hipSuccess) fprintf(stderr, "kernel_launch: launch failed: %s\n", hipGetErrorName(le));
}
```

```cpp
#include <hip/hip_runtime.h>
#include <cstdio>
#include <cstdint>
#include <cmath>
#define DBG_SCAN 0
namespace pg8 {
#define PG8_LAS __attribute__((address_space(3)))
typedef unsigned short bf16_t;
typedef short bf16x8 __attribute__((ext_vector_type(8)));
typedef float f32x4 __attribute__((ext_vector_type(4)));
typedef unsigned u32x4 __attribute__((ext_vector_type(4)));
typedef int v4i_t __attribute__((ext_vector_type(4)));
typedef int v8i_t __attribute__((ext_vector_type(8)));
constexpr int BM = 256, BK = 64, HALF = 128, HTB = HALF * BK * 2  , STAGE_BYTES = 8 * HTB, NXCD = 8, WGM = 8;

__host__ __device__ __forceinline__ int lds_byte(int r, int c) { const int st = (r >> 4) * 2 + (c >> 5), rr = r & 15, cc = c & 31, ob = rr * 64 + cc * 2; return st * 1024 + (ob ^ (((ob >> 9) & 1) << 5)); }
__host__ __device__ __forceinline__ void stage_rc(int b, int& R, int& C) { const int st = b / 1024, sb = b % 1024, swz = sb ^ (((sb >> 9) & 1) << 5); R = (st >> 1) * 16 + swz / 64; C = (st & 1) * 32 + (swz % 64) / 2; }
__host__ __device__ __forceinline__ int perm32(int rho) { const int n = rho >> 4, i = rho & 15; return 8 * (i >> 2) + 4 * n + (i & 3); }

struct Unit { int pm, pn; };
struct Gemm { const bf16_t* A; const bf16_t* Bt; int M, N, K; };

typedef float f32x2_cv __attribute__((ext_vector_type(2))); typedef __bf16 bf16x2_cv __attribute__((ext_vector_type(2)));
__device__ __forceinline__ unsigned cvt_pk_bf16(float lo, float hi) { const f32x2_cv v = {lo, hi}; const bf16x2_cv b = __builtin_convertvector(v, bf16x2_cv); return __builtin_bit_cast(unsigned, b); }
struct StaticOrder {
    int nM, nN, nwg, G, c;
    __host__ __device__ void init(int M, int N, int G_, int c_) { nM = M / BM; nN = N / BM; nwg = nM * nN; G = G_; c = c_; }
    __host__ __device__ bool next(int i, Unit& u) const {
        const long L = (long)i * G + c; if (L >= nwg) return false;
        int wgid = (int)L; { const int q = nwg / NXCD, r = nwg % NXCD, xcd = wgid % NXCD, off = wgid / NXCD; wgid = (xcd < r ? xcd * (q + 1) : r * (q + 1) + (xcd - r) * q) + off; }
        const int nig = WGM * nN, gid = wgid / nig, fm = gid * WGM, gsz = (nM - fm) < WGM ? (nM - fm) : WGM;
        u.pm = fm + ((wgid % nig) % gsz); u.pn = (wgid % nig) / gsz; return true;
    }
    __device__ __forceinline__ unsigned boff(const Gemm& g, const Unit& u) const { return (unsigned)u.pn * (unsigned)(BM * g.K * 2); }
    __device__ __forceinline__ void a_ready(const Unit&) const {}
    __device__ __forceinline__ void done(const Unit&) const {}
};
struct ExpertOrder : StaticOrder {
    const int* pexp; size_t estride;
    __device__ __forceinline__ unsigned boff(const Gemm& g, const Unit& u) const { const int e = __builtin_amdgcn_readfirstlane(pexp[u.pm]); return (unsigned)e * (unsigned)estride + (unsigned)u.pn * (unsigned)(BM * g.K * 2); }
};
__device__ __forceinline__ float fast_sigmoid(float x) { return __builtin_amdgcn_rcpf(1.0f + __builtin_amdgcn_exp2f(-1.4426950408889634f * x)); }
__device__ __forceinline__ float bflo(unsigned w) { return __uint_as_float(w << 16); }
__device__ __forceinline__ float bfhi(unsigned w) { return __uint_as_float(w & 0xffff0000u); }
struct EpiPlain {
    static constexpr bool PERM = true, AFTER_DRAIN = false;
    bf16_t* O; int ldc; float sc;
    __device__ __forceinline__ void operator()(const f32x4 (&acc)[2][2][4][2], const Unit& u, int wr, int wc, int fr, int fq) const {
        const int row0 = u.pm * BM + wr * 64 + fr, col0 = u.pn * BM + wc * 32 + 8 * fq;
#pragma unroll
        for (int ai = 0; ai < 2; ++ai)
#pragma unroll
            for (int m = 0; m < 4; ++m) { bf16_t* rowp = O + (size_t)(row0 + ai * HALF + m * 16) * ldc + col0;
#pragma unroll
                for (int bj = 0; bj < 2; ++bj) { const f32x4 v0 = acc[ai][bj][m][0], v1 = acc[ai][bj][m][1];
                    u32x4 w; w.x = cvt_pk_bf16(v0[0], v0[1]); w.y = cvt_pk_bf16(v0[2], v0[3]); w.z = cvt_pk_bf16(v1[0], v1[1]); w.w = cvt_pk_bf16(v1[2], v1[3]);
                    *(u32x4*)(rowp + bj * HALF) = w; } }
    }
};
template <int HD> struct EpiWin {
    static constexpr bool PERM = true, AFTER_DRAIN = false;
    bf16_t* O; int ldc; const float* T; int qlo, qhi, klo, khi; float qsc, ksc;
    __device__ __forceinline__ void operator()(const f32x4 (&acc)[2][2][4][2], const Unit& u, int wr, int wc, int fr, int fq) const {
        const int row0 = u.pm * BM + wr * 64 + fr;
        const bool isq = u.pn >= qlo && u.pn < qhi, isk = u.pn >= klo && u.pn < khi;
        if (!isq && !isk) {
            const int col0 = u.pn * BM + wc * 32 + 8 * fq;
#pragma unroll
            for (int ai = 0; ai < 2; ++ai)
#pragma unroll
                for (int m = 0; m < 4; ++m) { bf16_t* rowp = O + (size_t)(row0 + ai * HALF + m * 16) * ldc + col0;
#pragma unroll
                    for (int bj = 0; bj < 2; ++bj) { const f32x4 v0 = acc[ai][bj][m][0], v1 = acc[ai][bj][m][1];
                        u32x4 w; w.x = cvt_pk_bf16(v0[0], v0[1]); w.y = cvt_pk_bf16(v0[2], v0[3]); w.z = cvt_pk_bf16(v1[0], v1[1]); w.w = cvt_pk_bf16(v1[2], v1[3]);
                        *(u32x4*)(rowp + bj * HALF) = w; } }
            return;
        }
        const float sc = isq ? qsc : ksc;
        const int jj0 = wc * 32 + 8 * fq, g = jj0 / HD, d0 = jj0 % HD, Q = HD / 2;
        const int col1 = u.pn * BM + g * (2 * HD) + d0, dq = d0 % Q; const bool byrow = d0 < Q;
#pragma unroll
        for (int ai = 0; ai < 2; ++ai)
#pragma unroll
            for (int m = 0; m < 4; ++m) { const int r = row0 + ai * HALF + m * 16, t = r % 8448;
                float o1[8], o2[8];
                if (t >= 256) { const int tl = t - 256, pos = byrow ? (tl >> 6) : (tl & 63); const f32x4* cs = (const f32x4*)(T + (size_t)(pos * Q + dq) * 2);
                    const f32x4 c0 = cs[0], c1 = cs[1], c2 = cs[2], c3 = cs[3];
                    const float cc[8] = {c0[0], c0[2], c1[0], c1[2], c2[0], c2[2], c3[0], c3[2]}, ss[8] = {c0[1], c0[3], c1[1], c1[3], c2[1], c2[3], c3[1], c3[3]};
#pragma unroll
                    for (int e = 0; e < 8; ++e) { const float x1 = acc[ai][0][m][e >> 2][e & 3], x2 = acc[ai][1][m][e >> 2][e & 3]; o1[e] = (x1 * cc[e] - x2 * ss[e]) * sc; o2[e] = (x1 * ss[e] + x2 * cc[e]) * sc; }
                } else {
#pragma unroll
                    for (int e = 0; e < 8; ++e) { o1[e] = acc[ai][0][m][e >> 2][e & 3] * sc; o2[e] = acc[ai][1][m][e >> 2][e & 3] * sc; }
                }
                bf16_t* rowp = O + (size_t)r * ldc + col1;
                u32x4 w; w.x = cvt_pk_bf16(o1[0], o1[1]); w.y = cvt_pk_bf16(o1[2], o1[3]); w.z = cvt_pk_bf16(o1[4], o1[5]); w.w = cvt_pk_bf16(o1[6], o1[7]);
                *(u32x4*)rowp = w;
                w.x = cvt_pk_bf16(o2[0], o2[1]); w.y = cvt_pk_bf16(o2[2], o2[3]); w.z = cvt_pk_bf16(o2[4], o2[5]); w.w = cvt_pk_bf16(o2[6], o2[7]);
                *(u32x4*)(rowp + HD) = w; }
    }
};
struct EpiSwiGLU {
    static constexpr bool PERM = true, AFTER_DRAIN = false;
    bf16_t* O; int ldc;
    __device__ __forceinline__ void operator()(const f32x4 (&acc)[2][2][4][2], const Unit& u, int wr, int wc, int fr, int fq) const {
        const int row0 = u.pm * BM + wr * 64 + fr, col0 = u.pn * HALF + wc * 32 + 8 * fq;
#pragma unroll
        for (int ai = 0; ai < 2; ++ai)
#pragma unroll
            for (int m = 0; m < 4; ++m) { bf16_t* rowp = O + (size_t)(row0 + ai * HALF + m * 16) * ldc + col0;
                float o[8];
#pragma unroll
                for (int n = 0; n < 2; ++n)
#pragma unroll
                    for (int i = 0; i < 4; ++i) { const float g = acc[ai][0][m][n][i], up = acc[ai][1][m][n][i]; o[n * 4 + i] = g * fast_sigmoid(g) * up; }
                u32x4 w; w.x = cvt_pk_bf16(o[0], o[1]); w.y = cvt_pk_bf16(o[2], o[3]); w.z = cvt_pk_bf16(o[4], o[5]); w.w = cvt_pk_bf16(o[6], o[7]);
                *(u32x4*)rowp = w; }
    }
};
__device__ __forceinline__ unsigned pk4_fp8(float a, float b, float c, float d) { int r = __builtin_amdgcn_cvt_pk_fp8_f32(a, b, 0, false); r = __builtin_amdgcn_cvt_pk_fp8_f32(c, d, r, true); return (unsigned)r; }
struct EpiSwiGLU8 {
    static constexpr bool PERM = true, AFTER_DRAIN = false;
    unsigned char* O; int ldc; float sc;
    __device__ __forceinline__ void operator()(const f32x4 (&acc)[2][2][4][2], const Unit& u, int wr, int wc, int fr, int fq) const {
        const int row0 = u.pm * BM + wr * 64 + fr, col0 = u.pn * HALF + wc * 32 + 8 * fq;
#pragma unroll
        for (int ai = 0; ai < 2; ++ai)
#pragma unroll
            for (int m = 0; m < 4; ++m) { unsigned char* rowp = O + (size_t)(row0 + ai * HALF + m * 16) * ldc + col0;
                float o[8];
#pragma unroll
                for (int n = 0; n < 2; ++n)
#pragma unroll
                    for (int i = 0; i < 4; ++i) { const float g = acc[ai][0][m][n][i] * sc, up = acc[ai][1][m][n][i] * sc; o[n * 4 + i] = g * fast_sigmoid(g) * up; }
                typedef unsigned u32x2 __attribute__((ext_vector_type(2)));
                u32x2 w; w.x = pk4_fp8(o[0], o[1], o[2], o[3]); w.y = pk4_fp8(o[4], o[5], o[6], o[7]);
                *(u32x2*)rowp = w; }
    }
};
struct EpiGLU {
    static constexpr bool PERM = true, AFTER_DRAIN = false;
    bf16_t* O; int ldc; const bf16_t* Z; int ldz; const float* bias;
    __device__ __forceinline__ void operator()(const f32x4 (&acc)[2][2][4][2], const Unit& u, int wr, int wc, int fr, int fq) const {
        const int row0 = u.pm * BM + wr * 64 + fr, col0 = u.pn * BM + wc * 32 + 8 * fq;
#pragma unroll
        for (int bj = 0; bj < 2; ++bj) { const f32x4 b0 = *(const f32x4*)(bias + col0 + bj * HALF), b1 = *(const f32x4*)(bias + col0 + bj * HALF + 4);
#pragma unroll
            for (int ai = 0; ai < 2; ++ai)
#pragma unroll
                for (int m = 0; m < 4; ++m) { const size_t r = (size_t)(row0 + ai * HALF + m * 16);
                    const u32x4 zz = *(const u32x4*)(Z + r * ldz + col0 + bj * HALF);
                    const f32x4 v0 = acc[ai][bj][m][0] + b0, v1 = acc[ai][bj][m][1] + b1;
                    u32x4 w; w.x = cvt_pk_bf16(bflo(zz.x) * fast_sigmoid(v0[0]), bfhi(zz.x) * fast_sigmoid(v0[1])); w.y = cvt_pk_bf16(bflo(zz.y) * fast_sigmoid(v0[2]), bfhi(zz.y) * fast_sigmoid(v0[3]));
                    w.z = cvt_pk_bf16(bflo(zz.z) * fast_sigmoid(v1[0]), bfhi(zz.z) * fast_sigmoid(v1[1])); w.w = cvt_pk_bf16(bflo(zz.w) * fast_sigmoid(v1[2]), bfhi(zz.w) * fast_sigmoid(v1[3]));
                    *(u32x4*)(O + r * ldc + col0 + bj * HALF) = w; } }
    }
};
struct RouteEnt { int tok; int slot; float w; int pad; };
struct EpiScatter {
    static constexpr bool PERM = true, AFTER_DRAIN = false;
    const RouteEnt* L; bf16_t* Y; size_t slot_stride; int ldc; float sc;
    __device__ __forceinline__ void operator()(const f32x4 (&acc)[2][2][4][2], const Unit& u, int wr, int wc, int fr, int fq) const {
        const int row0 = u.pm * BM + wr * 64 + fr, col0 = u.pn * BM + wc * 32 + 8 * fq;
#pragma unroll
        for (int ai = 0; ai < 2; ++ai)
#pragma unroll
            for (int m = 0; m < 4; ++m) { const RouteEnt e = L[row0 + ai * HALF + m * 16];
                if (e.tok >= 0) { bf16_t* rowp = Y + (size_t)e.slot * slot_stride + (size_t)e.tok * ldc + col0;
#pragma unroll
                    for (int bj = 0; bj < 2; ++bj) { const float ww = e.w * sc; const f32x4 v0 = acc[ai][bj][m][0] * ww, v1 = acc[ai][bj][m][1] * ww;
                        u32x4 w; w.x = cvt_pk_bf16(v0[0], v0[1]); w.y = cvt_pk_bf16(v0[2], v0[3]); w.z = cvt_pk_bf16(v1[0], v1[1]); w.w = cvt_pk_bf16(v1[2], v1[3]);
                        *(u32x4*)(rowp + bj * HALF) = w; } } }
    }
};
template <class Epi, class Sched, bool ALIGN_EPI = false, bool SP2 = false, bool F8 = false>
__device__ __forceinline__ void gemm_phase(PG8_LAS unsigned char* lds, const Gemm g, const Sched& S, const Epi& E, const int tid) {
    const int wid = __builtin_amdgcn_readfirstlane(tid >> 6), lane = tid & 63, wr = wid >> 2, wc = wid & 3, fr = lane & 15, fq = lane >> 4;
    const int K = g.K, nt = K / BK;
    unsigned voffA[2], voffB[2];
#pragma unroll
    for (int i = 0; i < 2; ++i) { int R, C; stage_rc(tid * 16 + i * 8192, R, C); const int Rb = Epi::PERM ? ((R & ~31) + perm32(R & 31)) : R;
        voffA[i] = (unsigned)(R * K + C) * 2u; voffB[i] = (unsigned)(Rb * K + C) * 2u; }
    const unsigned kstep = (unsigned)(BK * 2);
    const unsigned hstep = (unsigned)HALF * K * 2;
    const unsigned tstep = 2 * hstep;
    const __amdgpu_buffer_rsrc_t rsA = __builtin_amdgcn_make_buffer_rsrc((void*)g.A, 0, 0x7fffffff, 0x00020000), rsB = __builtin_amdgcn_make_buffer_rsrc((void*)g.Bt, 0, 0x7fffffff, 0x00020000);
    const unsigned ldsw = (unsigned)wid * 1024u;
    const int aoff = lds_byte(wr * 64 + fr, fq * 8), boff = lds_byte(wc * 32 + fr, fq * 8);
#define PG8_SA(b, h) (((b) * 2 + (h)) * HTB)
#define PG8_SB(b, h) ((4 + (b) * 2 + (h)) * HTB)
#define PG8_STAGE(rs, bufoff, goff, voff) do { _Pragma("unroll") for (int _i = 0; _i < 2; ++_i) \
        __builtin_amdgcn_raw_ptr_buffer_load_lds(rs, (PG8_LAS unsigned*)(lds + (bufoff) + ldsw + _i * 8192), 16, (int)(voff)[_i], (int)(goff), 0, 0); } while (0)
#define PG8_LDA(dst, b, h) do { if constexpr (F8) { _Pragma("unroll") for (int m = 0; m < 4; ++m) dst##8[m] = __builtin_shufflevector(*(const PG8_LAS v4i_t*)(lds + PG8_SA(b, h) + aoff + m * 2048), *(const PG8_LAS v4i_t*)(lds + PG8_SA(b, h) + aoff + m * 2048 + 1024), 0, 1, 2, 3, 4, 5, 6, 7); } \
    else { _Pragma("unroll") for (int m = 0; m < 4; ++m) _Pragma("unroll") for (int k = 0; k < 2; ++k) dst[m][k] = *(const PG8_LAS bf16x8*)(lds + PG8_SA(b, h) + aoff + m * 2048 + k * 1024); } } while (0)
#define PG8_LDB(dst, b, h) do { if constexpr (F8) { _Pragma("unroll") for (int n = 0; n < 2; ++n) dst##8[n] = __builtin_shufflevector(*(const PG8_LAS v4i_t*)(lds + PG8_SB(b, h) + boff + n * 2048), *(const PG8_LAS v4i_t*)(lds + PG8_SB(b, h) + boff + n * 2048 + 1024), 0, 1, 2, 3, 4, 5, 6, 7); } \
    else { _Pragma("unroll") for (int n = 0; n < 2; ++n) _Pragma("unroll") for (int k = 0; k < 2; ++k) dst[n][k] = *(const PG8_LAS bf16x8*)(lds + PG8_SB(b, h) + boff + n * 2048 + k * 1024); } } while (0)
#define PG8_MMA(ai, bj, At, Bt) do { __builtin_amdgcn_s_setprio(1); _Pragma("unroll") for (int m = 0; m < 4; ++m) _Pragma("unroll") for (int n = 0; n < 2; ++n) { \
        if constexpr (F8) acc[ai][bj][m][n] = __builtin_amdgcn_mfma_scale_f32_16x16x128_f8f6f4(Bt##8[n], At##8[m], acc[ai][bj][m][n], 0, 0, 0, 0x7f7f7f7f, 0, 0x7f7f7f7f); \
        else { _Pragma("unroll") for (int k = 0; k < 2; ++k) acc[ai][bj][m][n] = __builtin_amdgcn_mfma_f32_16x16x32_bf16(Bt[n][k], At[m][k], acc[ai][bj][m][n], 0, 0, 0); } } \
        __builtin_amdgcn_s_setprio(0); } while (0)
#define PG8_WAIT_V(n) asm volatile("s_waitcnt vmcnt(" #n ")" ::: "memory")
#define PG8_WAIT_L(n) asm volatile("s_waitcnt lgkmcnt(" #n ")" ::: "memory")
#define PG8_BAR __builtin_amdgcn_s_barrier()
#define PG8_SCHED __builtin_amdgcn_sched_barrier(0)
    Unit cur, nxt; int ui = 0;
    if (!S.next(0, cur)) return;
    f32x4 acc[2][2][4][2];
#pragma unroll
    for (int a = 0; a < 2; ++a)
#pragma unroll
        for (int b = 0; b < 2; ++b)
#pragma unroll
            for (int m = 0; m < 4; ++m)
#pragma unroll
                for (int n = 0; n < 2; ++n) acc[a][b][m][n] = (f32x4){0.f, 0.f, 0.f, 0.f};
    bf16x8 At[4][2], B0[2][2], B1[2][2]; v8i_t At8[4], B08[2], B18[2];
    unsigned cA = (unsigned)cur.pm * tstep, cB = S.boff(g, cur);
    S.a_ready(cur);
    if constexpr (SP2) {
        PG8_STAGE(rsB, PG8_SB(0, 0), cB, voffB); PG8_STAGE(rsB, PG8_SB(0, 1), cB + hstep, voffB); PG8_STAGE(rsA, PG8_SA(0, 0), cA, voffA); PG8_STAGE(rsA, PG8_SA(0, 1), cA + hstep, voffA);
        if (wr == 1) PG8_BAR;
        PG8_WAIT_V(2); PG8_BAR;
        PG8_STAGE(rsB, PG8_SB(1, 0), cB + kstep, voffB); PG8_STAGE(rsA, PG8_SA(1, 0), cA + kstep, voffA); PG8_STAGE(rsB, PG8_SB(1, 1), cB + hstep + kstep, voffB);
        PG8_WAIT_V(6); PG8_BAR;
    } else {
        PG8_STAGE(rsB, PG8_SB(0, 0), cB, voffB); PG8_STAGE(rsA, PG8_SA(0, 0), cA, voffA); PG8_STAGE(rsB, PG8_SB(0, 1), cB + hstep, voffB); PG8_STAGE(rsA, PG8_SA(0, 1), cA + hstep, voffA);
        if (wr == 1) PG8_BAR;
        PG8_WAIT_V(4); PG8_BAR;
        PG8_STAGE(rsB, PG8_SB(1, 0), cB + kstep, voffB); PG8_STAGE(rsA, PG8_SA(1, 0), cA + kstep, voffA); PG8_STAGE(rsB, PG8_SB(1, 1), cB + hstep + kstep, voffB);
        PG8_WAIT_V(6); PG8_BAR;
    }
    for (;;) {
        const bool has_next = S.next(ui + 1, nxt);
        const unsigned nA = has_next ? (unsigned)nxt.pm * tstep : cA, nB = has_next ? S.boff(g, nxt) : cB;
        for (int t = 0; t < nt; t += 2) {
            const bool last = (t == nt - 2);
            const unsigned a1 = cA + (unsigned)(t + 1) * kstep;
            const unsigned a2 = last ? nA : cA + (unsigned)(t + 2) * kstep, b2 = last ? nB : cB + (unsigned)(t + 2) * kstep;
            const unsigned a3 = a2 + kstep, b3 = b2 + kstep;
            if (last && has_next) S.a_ready(nxt);
            if constexpr (SP2) {
            PG8_LDB(B0, 0, 0); PG8_LDB(B1, 0, 1); PG8_SCHED; PG8_LDA(At, 0, 0); PG8_STAGE(rsA, PG8_SA(1, 1), a1 + hstep, voffA);
            PG8_WAIT_V(8); PG8_WAIT_L(0); PG8_BAR; PG8_MMA(0, 0, At, B0); PG8_MMA(0, 1, At, B1); PG8_BAR; PG8_SCHED;
            PG8_LDA(At, 0, 1); PG8_STAGE(rsB, PG8_SB(0, 0), b2, voffB); PG8_STAGE(rsB, PG8_SB(0, 1), b2 + hstep, voffB); PG8_STAGE(rsA, PG8_SA(0, 0), a2, voffA);
            PG8_WAIT_V(8); PG8_WAIT_L(0); PG8_BAR; PG8_MMA(1, 0, At, B0); PG8_MMA(1, 1, At, B1); PG8_BAR; PG8_SCHED;
            PG8_LDB(B0, 1, 0); PG8_LDB(B1, 1, 1); PG8_SCHED; PG8_LDA(At, 1, 0); PG8_STAGE(rsA, PG8_SA(0, 1), a2 + hstep, voffA);
            PG8_WAIT_V(8); PG8_WAIT_L(0); PG8_BAR; PG8_MMA(0, 0, At, B0); PG8_MMA(0, 1, At, B1); PG8_BAR; PG8_SCHED;
            PG8_LDA(At, 1, 1); PG8_STAGE(rsB, PG8_SB(1, 0), b3, voffB); PG8_STAGE(rsB, PG8_SB(1, 1), b3 + hstep, voffB); PG8_STAGE(rsA, PG8_SA(1, 0), a3, voffA);
            PG8_WAIT_V(8); PG8_WAIT_L(0); PG8_BAR; PG8_MMA(1, 0, At, B0); PG8_MMA(1, 1, At, B1); PG8_BAR; PG8_SCHED;
            } else {
            PG8_LDB(B0, 0, 0); PG8_SCHED; PG8_LDA(At, 0, 0); PG8_STAGE(rsA, PG8_SA(1, 1), a1 + hstep, voffA);
            PG8_WAIT_L(8); PG8_BAR; PG8_WAIT_L(0); PG8_MMA(0, 0, At, B0); PG8_BAR; PG8_SCHED;
            PG8_LDB(B1, 0, 1); PG8_STAGE(rsB, PG8_SB(0, 0), b2, voffB);
            PG8_BAR; PG8_WAIT_L(0); PG8_MMA(0, 1, At, B1); PG8_BAR;
            PG8_LDA(At, 0, 1); PG8_STAGE(rsA, PG8_SA(0, 0), a2, voffA);
            PG8_BAR; PG8_WAIT_L(0); PG8_MMA(1, 0, At, B0); PG8_BAR; PG8_SCHED;
            PG8_STAGE(rsB, PG8_SB(0, 1), b2 + hstep, voffB);
            PG8_WAIT_V(6); PG8_BAR; PG8_MMA(1, 1, At, B1); PG8_BAR;
            PG8_LDB(B0, 1, 0); PG8_SCHED; PG8_LDA(At, 1, 0); PG8_STAGE(rsA, PG8_SA(0, 1), a2 + hstep, voffA);
            PG8_WAIT_L(8); PG8_BAR; PG8_WAIT_L(0); PG8_MMA(0, 0, At, B0); PG8_BAR; PG8_SCHED;
            PG8_LDB(B1, 1, 1); PG8_STAGE(rsB, PG8_SB(1, 0), b3, voffB);
            PG8_BAR; PG8_WAIT_L(0); PG8_MMA(0, 1, At, B1); PG8_BAR;
            PG8_LDA(At, 1, 1); PG8_STAGE(rsA, PG8_SA(1, 0), a3, voffA);
            PG8_BAR; PG8_WAIT_L(0); PG8_MMA(1, 0, At, B0); PG8_BAR; PG8_SCHED;
            PG8_STAGE(rsB, PG8_SB(1, 1), b3 + hstep, voffB);
            PG8_WAIT_V(6); PG8_BAR; PG8_MMA(1, 1, At, B1); PG8_BAR;
            }
        }
        if constexpr (ALIGN_EPI) { if (wr == 0) PG8_BAR; }
        if constexpr (!Epi::AFTER_DRAIN) { E(acc, cur, wr, wc, fr, fq); S.done(cur); }
        if (!has_next) break;
#pragma unroll
        for (int a = 0; a < 2; ++a)
#pragma unroll
            for (int b = 0; b < 2; ++b)
#pragma unroll
                for (int m = 0; m < 4; ++m)
#pragma unroll
                    for (int n = 0; n < 2; ++n) acc[a][b][m][n] = (f32x4){0.f, 0.f, 0.f, 0.f};
        cur = nxt; cA = nA; cB = nB; ++ui;
        if constexpr (ALIGN_EPI) { if (wr == 1) PG8_BAR; }
    }
    PG8_WAIT_V(0);
    if constexpr (!ALIGN_EPI) { if (wr == 0) PG8_BAR; }
    PG8_BAR;
    if constexpr (Epi::AFTER_DRAIN) { E.fused(acc, cur, wr, wc, fr, fq, lds, wid, lane); S.done(cur); }
#undef PG8_SA
#undef PG8_SB
#undef PG8_STAGE
#undef PG8_LDA
#undef PG8_LDB
#undef PG8_MMA
#undef PG8_WAIT_V
#undef PG8_WAIT_L
#undef PG8_BAR
#undef PG8_SCHED
}
}

#define GAS __attribute__((address_space(1)))
#define LAS __attribute__((address_space(3)))
#define XB_TMO      128
#define XB_XCNT(j)  (256  + 64 * (j))
#define XB_XSUB(j)  (1280 + 64 * (j))
#define XB_XGEN(j)  (2304 + 64 * (j))
#define XB_TOP      3328
#define XB_TOPGEN   3392
#define XCD_BAR_WORDS 3456
#define XB_SPIN_CAP (1u << 18)

__device__ __forceinline__ unsigned xb_ld(unsigned* p)              { return __hip_atomic_load(p, __ATOMIC_RELAXED, __HIP_MEMORY_SCOPE_AGENT); }
__device__ __forceinline__ unsigned xb_add(unsigned* p, unsigned v) { return __hip_atomic_fetch_add(p, v, __ATOMIC_RELAXED, __HIP_MEMORY_SCOPE_AGENT); }
__device__ __forceinline__ unsigned xb_xcc_id() { return (unsigned)__builtin_amdgcn_s_getreg((3 << 11) | 20) & 0xFu; }
#define XB_SPIN(cond, bar) do { unsigned _sp = 0; while (cond) { __builtin_amdgcn_s_sleep(1); \
    if ((++_sp & 255u) == 0u) { if (xb_ld(&(bar)[XB_TMO])) break; if (_sp > XB_SPIN_CAP) { atomicAdd(&(bar)[XB_TMO], 1u); break; } } } } while (0)

struct XcdBarrier {
    unsigned* bar; unsigned x;
    volatile LAS unsigned* st;
};

__device__ __forceinline__ XcdBarrier xcd_barrier_post(unsigned* bar, volatile LAS unsigned* st) {
    XcdBarrier b; b.bar = bar; b.x = xb_xcc_id(); b.st = st;
    if (threadIdx.x == 0) (void)xb_add(&bar[XB_XCNT(b.x)], 1u);
    return b;
}
__device__ __forceinline__ void xcd_barrier_complete(unsigned* bar, unsigned x, unsigned& nloc, unsigned& nx) {
    const unsigned G = gridDim.x * gridDim.y * gridDim.z;
    unsigned sum, cnt, mine, sp = 0u;
    for (;;) {
        sum = 0u; cnt = 0u; mine = 0u;
#pragma unroll
        for (unsigned j = 0; j < 16; ++j) { const unsigned c = xb_ld(&bar[XB_XCNT(j)]); sum += c; cnt += (c > 0u) ? 1u : 0u; mine = (j == x) ? c : mine; }
        if (sum == G) break;
        __builtin_amdgcn_s_sleep(1);
        if ((++sp & 255u) == 0u) { if (xb_ld(&bar[XB_TMO])) break; if (sp > XB_SPIN_CAP) { atomicAdd(&bar[XB_TMO], 1u); break; } }
    }
    nloc = mine > 0u ? mine : 1u; nx = cnt > 0u ? cnt : 1u;
}

__device__ __forceinline__ void xcd_barrier(const XcdBarrier& b, const bool leader_thread  ) {
    asm volatile("s_waitcnt vmcnt(0)" ::: "memory");
    __syncthreads();
    if (leader_thread) {
        unsigned* bar = b.bar;
        __builtin_amdgcn_s_waitcnt(0);
        unsigned nloc = b.st[0], nx = b.st[1];
        if (nloc == 0u) { xcd_barrier_complete(bar, b.x, nloc, nx); b.st[0] = nloc; b.st[1] = nx; }
        const unsigned old = xb_add(&bar[XB_XSUB(b.x)], 1u);
        const unsigned gen = old / nloc;
        if (old + 1u == (gen + 1u) * nloc) {
            __builtin_amdgcn_fence(__ATOMIC_RELEASE, "agent");
            asm volatile("s_waitcnt vmcnt(0)" ::: "memory");
            const unsigned og = xb_add(&bar[XB_TOP], 1u);
            const unsigned tg = og / nx;
            if (og + 1u == (tg + 1u) * nx) xb_add(&bar[XB_TOPGEN], 1u);
            else XB_SPIN(xb_ld(&bar[XB_TOPGEN]) == tg, bar);
            __builtin_amdgcn_fence(__ATOMIC_ACQUIRE, "agent");
            xb_add(&bar[XB_XGEN(b.x)], 1u);
            asm volatile("s_waitcnt vmcnt(0)" ::: "memory");
        } else {
            XB_SPIN(xb_ld(&bar[XB_XGEN(b.x)]) == gen, bar);
            __builtin_amdgcn_fence(__ATOMIC_ACQUIRE, "agent");
            asm volatile("s_waitcnt vmcnt(0)" ::: "memory");
        }
    }
    __syncthreads();
}
constexpr int D = 1024, NB = 8, SEQ = 8192, CTXL = 256, TB = SEQ + CTXL, M = NB * TB;
constexpr int EV_IN = 3072, OD_IN = 2560, DFF = 3584, NE = 8, NLAYER = 4;
constexpr int NPANEL = M / 256;
constexpr int PW = 268, MAXP = 2 * PW;
constexpr float EPS = 1e-6f;
constexpr size_t MiB = 1u << 20;
constexpr size_t WS_CTL = 0, CTL_ZERO_BYTES = 1 * MiB;
constexpr size_t WS_MOD = 1 * MiB;
constexpr size_t WS_ROPE_R = 2 * MiB, WS_ROPE_D = 2 * MiB + 65536;
constexpr size_t WS_ROUTE = 3 * MiB;
constexpr size_t WS_WGCNT = 5 * MiB;
constexpr size_t WS_PEXP = 5 * MiB + 65536;
constexpr size_t WS_LIST = 6 * MiB;
constexpr size_t WS_XC = 10 * MiB;
constexpr size_t WS_W = 20 * MiB;
constexpr size_t WS_H = 198 * MiB;
constexpr size_t WS_Y = 330 * MiB;
constexpr size_t WS_BIG = 594 * MiB;
constexpr size_t WS_END = 1056 * MiB;
constexpr size_t W_IN = 0, W_OUT = 6 * MiB, W_GU = 8 * MiB, W_DN = 16 * MiB;
constexpr size_t W_GLU = 8 * MiB, W_MGU = 9 * MiB, W_MDN = 65 * MiB;
constexpr size_t Y_SLOT = (size_t)M * 1024 * 2;
constexpr size_t T_HALF = (size_t)M * 512 * 2;
constexpr size_t T_QUART = (size_t)M * 256 * 2;
constexpr size_t BIG_ACT = 0, BIG_HG = 236 * MiB;
constexpr int CW_TMO = 0, CW_BAR = 4096;
constexpr int RING_BYTES = 131072, LDSCTL_OFF = RING_BYTES + 8192, MISC_OFF = LDSCTL_OFF + 320, LDS_BYTES = 147456;
typedef unsigned short bf16;
typedef unsigned v4u __attribute__((ext_vector_type(4)));
typedef unsigned v2u __attribute__((ext_vector_type(2)));
typedef float f32x4 __attribute__((ext_vector_type(4)));
typedef float f32x16 __attribute__((ext_vector_type(16)));
typedef short bf16x8 __attribute__((ext_vector_type(8)));
typedef short s16x4 __attribute__((ext_vector_type(4)));
#define RLX_AGENT __ATOMIC_RELAXED, __HIP_MEMORY_SCOPE_AGENT
using pg8::cvt_pk_bf16; using pg8::bflo; using pg8::bfhi; using pg8::RouteEnt;
struct RouteRow { int e1, e2; float p1, p2; };
__device__ __forceinline__ float bf2f(bf16 v) { return __uint_as_float((unsigned)v << 16); }
__device__ __forceinline__ float wave_sum(float v) {
#pragma unroll
    for (int o = 1; o < 64; o <<= 1) v += __shfl_xor(v, o);
    return v;
}
__device__ __forceinline__ float gelu_tanh(float x) {
    const float u = 0.7978845608028654f * (x + 0.044715f * x * x * x);
    return x * __builtin_amdgcn_rcpf(1.0f + __builtin_amdgcn_exp2f(-2.0f * 1.4426950408889634f * u));
}
__device__ __forceinline__ float sigmoidf_(float x) { return __builtin_amdgcn_rcpf(1.0f + __builtin_amdgcn_exp2f(-1.4426950408889634f * x)); }
struct Args { const float* in[38]; float* out; unsigned char* ws; int ph_lo, ph_hi, mode, pad; };
struct ArgsI { unsigned long long in[38]; unsigned long long out, ws; int ph_lo, ph_hi, mode, pad; };
typedef __attribute__((address_space(4))) const ArgsI KArgs;
#define INP(k) ((const float*)(GAS const float*)F.A->in[k])
#define OUTP ((float*)(GAS float*)F.A->out)
#define WSG ((unsigned char*)(GAS unsigned char*)F.wsi)
#define FMOD ((float*)(WSG + WS_MOD))
#define FXC ((float*)(WSG + WS_XC))
#define FH ((bf16*)(WSG + WS_H))
#define FWB ((bf16*)(WSG + WS_W))
#define FYB (WSG + WS_Y)
#define FBIG (WSG + WS_BIG)
#define LAUNDER(F) do { asm volatile("" : "+s"(F.wsi), "+s"(F.A), "+s"(F.wave), "+s"(F.bid), "+s"(F.G)); { unsigned z_ = 0u; asm volatile("" : "+v"(z_)); F.lane = (int)__builtin_amdgcn_mbcnt_hi(~0u, __builtin_amdgcn_mbcnt_lo(~0u, z_)); } F.tid = F.wave * 64 + F.lane; } while (0)
struct Frame {
    LAS unsigned char* lds; unsigned long long wsi;
    int tid, lane, wave, G, bid;
    const KArgs* A;
};
#define LDS_WAIT() asm volatile("s_waitcnt lgkmcnt(0)" ::: "memory")

__device__ __forceinline__ void ph_prologue(Frame& F) {
    LAS float* SL = (LAS float*)F.lds;
    LAS float* RED = (LAS float*)(F.lds + 40960);
    const float* c = INP(1); const float* cc = INP(3); const float* mod_w = INP(4); const float* mod_b = INP(5);
    for (int i = F.tid; i < 9 * 1024; i += 512) { const float v = (i < 8192) ? c[i] : cc[i - 8192]; SL[i] = v * sigmoidf_(v); }
    __syncthreads();
    for (int blk = F.bid; blk < 4 * 96; blk += F.G) {
        const int l = blk / 96, n0 = (blk % 96) * 64;
        const float* wp = mod_w + ((size_t)l * 1024 + (size_t)F.wave * 128) * 6144 + n0 + F.lane;
        float acc[9];
#pragma unroll
        for (int j = 0; j < 9; ++j) acc[j] = 0.f;
        for (int k = 0; k < 128; ++k) { const float w = wp[(size_t)k * 6144];
#pragma unroll
            for (int j = 0; j < 9; ++j) acc[j] += SL[j * 1024 + F.wave * 128 + k] * w; }
#pragma unroll
        for (int j = 0; j < 9; ++j) RED[(F.wave * 9 + j) * 64 + F.lane] = acc[j];
        __syncthreads();
        for (int i = F.tid; i < 9 * 64; i += 512) { const int j = i >> 6, ln = i & 63; float s = mod_b[l * 6144 + n0 + ln];
#pragma unroll
            for (int w = 0; w < 8; ++w) s += RED[(w * 9 + j) * 64 + ln];
            FMOD[((size_t)l * 9 + j) * 6144 + n0 + ln] = s; }
        __syncthreads();
    }
    const int gt = F.bid * 512 + F.tid;
    if (gt < 128 * 32) { const int pos = gt >> 5, dq = gt & 31; const float inv = powf(10000.0f, -(float)dq / 32.0f); float s, cs; sincosf((float)pos * inv, &s, &cs);
        float* T = (float*)(WSG + WS_ROPE_R); T[gt * 2] = cs; T[gt * 2 + 1] = s; }
    else if (gt < 128 * 32 + 128 * 16) { const int g2 = gt - 128 * 32, pos = g2 >> 4, dq = g2 & 15; const float inv = powf(10000.0f, -(float)dq / 16.0f); float s, cs; sincosf((float)pos * inv, &s, &cs);
        float* T = (float*)(WSG + WS_ROPE_D); T[g2 * 2] = cs; T[g2 * 2 + 1] = s; }
}

__device__ __forceinline__ void transpose_item(const float* W, int K, int N, bf16* WT, int drow0, int k0, int n0, LAS float* scr, int lane) {
#pragma unroll 8
    for (int i = 0; i < 32; ++i) { const int kk = 2 * i + (lane >> 5); scr[kk * 33 + (lane & 31)] = W[(size_t)(k0 + kk) * N + n0 + (lane & 31)]; }
    LDS_WAIT(); asm volatile("" ::: "memory");
    const int c = lane & 7;
#pragma unroll
    for (int j = 0; j < 4; ++j) { const int n = (lane >> 3) + 8 * j; const LAS float* s = scr + (8 * c) * 33 + n;
        v4u o; o.x = cvt_pk_bf16(s[0 * 33], s[1 * 33]); o.y = cvt_pk_bf16(s[2 * 33], s[3 * 33]); o.z = cvt_pk_bf16(s[4 * 33], s[5 * 33]); o.w = cvt_pk_bf16(s[6 * 33], s[7 * 33]);
        *(v4u*)(WT + (size_t)(drow0 + n) * K + k0 + 8 * c) = o; }
    LDS_WAIT(); asm volatile("" ::: "memory");
}
__device__ __forceinline__ void convert_job(Frame& F, const float* W, int K, int N, bf16* WT, int mode) {
    LAS float* scr = (LAS float*)(F.lds + F.wave * 16384);
    const int gw = F.bid * 8 + F.wave, NGW = F.G * 8, nblk = N / 32, nit = (K / 64) * nblk;
    for (int it = gw; it < nit; it += NGW) { const int kb = it / nblk, nb = it % nblk, n0 = nb * 32;
        int drow0 = n0;
        if (mode == 1 || mode == 2) drow0 = (n0 >> 7) * 256 + (n0 & 127) + (mode == 2 ? 128 : 0);
        else if (mode == 3) { const int tile = n0 >> 8, w = n0 & 255; if (tile >= 4 && tile < 8) drow0 = tile * 256 + ((w >> 6) & 1) * 128 + (w >> 7) * 64 + (w & 63); }
        else if (mode == 4) { const int tile = n0 >> 8, w = n0 & 255; if (tile >= 1 && tile < 7) drow0 = tile * 256 + ((w >> 5) & 1) * 128 + (w >> 6) * 32 + (w & 31); }
        transpose_item(W, K, N, WT, drow0, kb * 64, n0, scr, F.lane); }
}
__device__ __forceinline__ void transpose_item_f8(const float* W, int K, int N, unsigned char* WT, int drow0, int k0, int n0, LAS float* scr, int lane, float wscale) {
#pragma unroll 8
    for (int i = 0; i < 32; ++i) { const int kk = 2 * i + (lane >> 5); scr[kk * 33 + (lane & 31)] = W[(size_t)(k0 + kk) * N + n0 + (lane & 31)] * wscale; }
    LDS_WAIT(); asm volatile("" ::: "memory");
#pragma unroll
    for (int j = 0; j < 2; ++j) { const int idx = lane + 64 * j, n = idx >> 2, c = idx & 3; const LAS float* s = scr + (16 * c) * 33 + n;
        v4u o; o.x = pg8::pk4_fp8(s[0 * 33], s[1 * 33], s[2 * 33], s[3 * 33]); o.y = pg8::pk4_fp8(s[4 * 33], s[5 * 33], s[6 * 33], s[7 * 33]);
        o.z = pg8::pk4_fp8(s[8 * 33], s[9 * 33], s[10 * 33], s[11 * 33]); o.w = pg8::pk4_fp8(s[12 * 33], s[13 * 33], s[14 * 33], s[15 * 33]);
        *(v4u*)(WT + (size_t)(drow0 + n) * K + k0 + 16 * c) = o; }
    LDS_WAIT(); asm volatile("" ::: "memory");
}
constexpr float W8_SCALE = 32.0f, W8_INV = 1.0f / 32.0f;
__device__ __forceinline__ void convert_job_f8(Frame& F, const float* W, int K, int N, unsigned char* WT, int mode) {
    LAS float* scr = (LAS float*)(F.lds + F.wave * 16384);
    const int gw = F.bid * 8 + F.wave, NGW = F.G * 8, nblk = N / 32, nit = (K / 64) * nblk;
    for (int it = gw; it < nit; it += NGW) { const int kb = it / nblk, nb = it % nblk, n0 = nb * 32;
        int drow0 = n0;
        if (mode == 1 || mode == 2) drow0 = (n0 >> 7) * 256 + (n0 & 127) + (mode == 2 ? 128 : 0);
        transpose_item_f8(W, K, N, WT, drow0, kb * 64, n0, scr, F.lane, W8_SCALE); }
}
__device__ __forceinline__ void ph_convert(Frame& F, int l) {
    const int i = l >> 1; bf16* Wb = FWB;
    if ((l & 1) == 0) {
        convert_job(F, INP(7) + (size_t)i * D * EV_IN, D, EV_IN, Wb + W_IN / 2, 3);
        convert_job(F, INP(15) + (size_t)i * D * D, D, D, Wb + W_OUT / 2, 0);
        convert_job_f8(F, INP(16) + (size_t)i * D * DFF, D, DFF, (unsigned char*)Wb + W_GU, 1);
        convert_job_f8(F, INP(17) + (size_t)i * D * DFF, D, DFF, (unsigned char*)Wb + W_GU, 2);
        convert_job_f8(F, INP(18) + (size_t)i * DFF * D, DFF, D, (unsigned char*)Wb + W_DN, 0);
    } else {
        convert_job(F, INP(19) + (size_t)i * D * OD_IN, D, OD_IN, Wb + W_IN / 2, 4);
        convert_job(F, INP(32) + (size_t)i * D * D, D, D, Wb + W_OUT / 2, 0);
        convert_job(F, INP(28) + (size_t)i * 256 * 256, 256, 256, Wb + W_GLU / 2, 0);
        for (int e = 0; e < NE; ++e) {
            convert_job_f8(F, INP(35) + ((size_t)i * NE + e) * D * DFF, D, DFF, (unsigned char*)Wb + W_MGU + (size_t)e * 7168 * 1024, 1);
            convert_job_f8(F, INP(36) + ((size_t)i * NE + e) * D * DFF, D, DFF, (unsigned char*)Wb + W_MGU + (size_t)e * 7168 * 1024, 2);
            convert_job_f8(F, INP(37) + ((size_t)i * NE + e) * DFF * D, DFF, D, (unsigned char*)Wb + W_MDN + (size_t)e * 1024 * 3584, 0);
        }
    }
}

struct NormArgs {
    int xin_input, has_y, two, write_x, final_, do_h, do_route, h8;
    const float* gate; const float* gy;
    const float* gh; const float* shift; const float* scale;
    const float* rw; const float* rb;
};
__device__ __forceinline__ void ph_norm(Frame& F, const NormArgs& a) {
    LAS float* RWT = (LAS float*)F.lds;
    LAS int* cnt = (LAS int*)(F.lds + 32768);
    if (a.do_route) {
        for (int idx = F.tid; idx < 8192; idx += 512) RWT[(idx & 7) * 1024 + (idx >> 3)] = a.rw[idx];
        if (F.tid < 8) cnt[F.tid] = 0;
        __syncthreads();
    }
    const int r0 = (int)((long)M * F.bid / F.G), r1 = (int)((long)M * (F.bid + 1) / F.G);
    const bf16* Y0 = (const bf16*)FYB; const bf16* Y1 = (const bf16*)(FYB + Y_SLOT);
    const int c0 = 4 * F.lane;
    f32x4 pgy[4], pgh[4], pgt[4], psh[4], psc[4]; int cur_midx = -1;
#pragma unroll
    for (int j = 0; j < 4; ++j) { pgy[j] = a.has_y ? *(const f32x4*)(a.gy + c0 + 256 * j) : (f32x4){0.f, 0.f, 0.f, 0.f}; pgh[j] = a.do_h ? *(const f32x4*)(a.gh + c0 + 256 * j) : (f32x4){0.f, 0.f, 0.f, 0.f};
        pgt[j] = (f32x4){0.f, 0.f, 0.f, 0.f}; psh[j] = pgt[j]; psc[j] = pgt[j]; }
    f32x4 xn[4]; v2u yn[4], zn[4];
#pragma unroll
    for (int j = 0; j < 4; ++j) { xn[j] = (f32x4){0.f, 0.f, 0.f, 0.f}; yn[j] = (v2u){0u, 0u}; zn[j] = (v2u){0u, 0u}; }
#define NORM_LOAD(mm) do { const int b_ = (mm) / TB, t_ = (mm) - b_ * TB; const bool ic_ = t_ < CTXL; \
        const size_t off_ = ic_ ? ((size_t)(b_ * CTXL + t_) * D) : ((size_t)(b_ * SEQ + t_ - CTXL) * D); \
        const float* xi_ = ic_ ? ((a.xin_input ? INP(2) : FXC) + off_) : ((a.xin_input ? INP(0) : OUTP) + off_); \
        _Pragma("unroll") for (int j = 0; j < 4; ++j) { xn[j] = *(const f32x4*)(xi_ + c0 + 256 * j); \
            if (a.has_y) yn[j] = *(const v2u*)(Y0 + (size_t)(mm) * D + c0 + 256 * j); if (a.two) zn[j] = *(const v2u*)(Y1 + (size_t)(mm) * D + c0 + 256 * j); } } while (0)
    int m = r0 + F.wave;
    if (m < r1) NORM_LOAD(m);
    for (; m < r1; m += 8) {
        const int b = m / TB, t = m - b * TB; const bool isctx = t < CTXL; const int midx = isctx ? 8 : b;
        const size_t off = isctx ? ((size_t)(b * CTXL + t) * D) : ((size_t)(b * SEQ + t - CTXL) * D);
        float* xres = isctx ? (FXC + off) : (OUTP + off);
        f32x4 x[4]; v2u yv[4], zv[4];
#pragma unroll
        for (int j = 0; j < 4; ++j) { x[j] = xn[j]; yv[j] = yn[j]; zv[j] = zn[j]; }
        if (m + 8 < r1) NORM_LOAD(m + 8);
        if (midx != cur_midx) { cur_midx = midx;
#pragma unroll
            for (int j = 0; j < 4; ++j) { if (a.has_y) pgt[j] = *(const f32x4*)(a.gate + (size_t)midx * 6144 + c0 + 256 * j);
                if (a.do_h) { psh[j] = *(const f32x4*)(a.shift + (size_t)midx * 6144 + c0 + 256 * j); psc[j] = *(const f32x4*)(a.scale + (size_t)midx * 6144 + c0 + 256 * j); } } }
        if (a.has_y) {
            f32x4 y[4]; float ss = 0.f;
#pragma unroll
            for (int j = 0; j < 4; ++j) { y[j] = (f32x4){bflo(yv[j].x), bfhi(yv[j].x), bflo(yv[j].y), bfhi(yv[j].y)};
                if (a.two) y[j] += (f32x4){bflo(zv[j].x), bfhi(zv[j].x), bflo(zv[j].y), bfhi(zv[j].y)};
                ss += (y[j].x * y[j].x + y[j].y * y[j].y) + (y[j].z * y[j].z + y[j].w * y[j].w); }
            const float rs = 1.0f / sqrtf(wave_sum(ss) * (1.0f / D) + EPS);
#pragma unroll
            for (int j = 0; j < 4; ++j) x[j] += pgt[j] * (y[j] * rs * pgy[j]);
        }
        if (a.write_x && !(a.final_ && isctx)) {
#pragma unroll
            for (int j = 0; j < 4; ++j) *(f32x4*)(xres + c0 + 256 * j) = x[j];
        }
        if (a.do_h) {
            float ss = 0.f;
#pragma unroll
            for (int j = 0; j < 4; ++j) ss += (x[j].x * x[j].x + x[j].y * x[j].y) + (x[j].z * x[j].z + x[j].w * x[j].w);
            const float rs = 1.0f / sqrtf(wave_sum(ss) * (1.0f / D) + EPS);
            f32x4 h[4];
#pragma unroll
            for (int j = 0; j < 4; ++j) { h[j] = (x[j] * rs * pgh[j]) * (psc[j] + 1.0f) + psh[j];
                if (a.h8) *(unsigned*)((unsigned char*)FH + (size_t)m * D + c0 + 256 * j) = pg8::pk4_fp8(h[j].x, h[j].y, h[j].z, h[j].w);
                else { v2u w; w.x = cvt_pk_bf16(h[j].x, h[j].y); w.y = cvt_pk_bf16(h[j].z, h[j].w); *(v2u*)(FH + (size_t)m * D + c0 + 256 * j) = w; } }
            if (a.do_route) {
                float lg[8];
#pragma unroll
                for (int e = 0; e < 8; ++e) { float s = 0.f;
#pragma unroll
                    for (int j = 0; j < 4; ++j) { const f32x4 w = *(const LAS f32x4*)(RWT + e * 1024 + c0 + 256 * j); s += (h[j].x * w.x + h[j].y * w.y) + (h[j].z * w.z + h[j].w * w.w); }
                    lg[e] = wave_sum(s) + a.rb[e]; }
                int e1 = 0; float v1 = lg[0];
#pragma unroll
                for (int e = 1; e < 8; ++e) if (lg[e] > v1) { v1 = lg[e]; e1 = e; }
                int e2 = -1; float v2 = -3.0e38f;
#pragma unroll
                for (int e = 0; e < 8; ++e) if (e != e1 && lg[e] > v2) { v2 = lg[e]; e2 = e; }
                const float p1 = 1.0f / (1.0f + expf(v2 - v1));
                if (F.lane == 0) { RouteRow rr; rr.e1 = e1; rr.e2 = e2; rr.p1 = p1; rr.p2 = 1.0f - p1; ((RouteRow*)(WSG + WS_ROUTE))[m] = rr;
                    atomicAdd((int*)&cnt[e1], 1); atomicAdd((int*)&cnt[e2], 1); }
            }
        }
    }
#undef NORM_LOAD
    if (a.do_route) { __syncthreads(); if (F.tid < 8) ((int*)(WSG + WS_WGCNT))[F.bid * 8 + F.tid] = cnt[F.tid]; }
}

__device__ __forceinline__ void ph_assign(Frame& F) {
    LAS int* part = (LAS int*)F.lds;
    LAS int* tot = (LAS int*)(F.lds + 32768);
    const int* WC = (const int*)(WSG + WS_WGCNT);
    int st[8], sb[8];
#pragma unroll
    for (int e = 0; e < 8; ++e) { st[e] = 0; sb[e] = 0; }
    for (int w = F.tid; w < F.G; w += 512) {
#pragma unroll
        for (int e = 0; e < 8; ++e) { const int c = WC[w * 8 + e]; st[e] += c; if (w < F.bid) sb[e] += c; } }
    if (F.tid < 32) tot[F.tid] = 0;
    __syncthreads();
#pragma unroll
    for (int e = 0; e < 8; ++e) { if (st[e]) atomicAdd((int*)&tot[e], st[e]); if (sb[e]) atomicAdd((int*)&tot[8 + e], sb[e]); }
    __syncthreads();
    if (F.tid == 0) { int o = 0; for (int e = 0; e < 8; ++e) { tot[16 + e] = o; o += (tot[e] + 255) & ~255; }
        if (F.bid == 0) { int* PE = (int*)(WSG + WS_PEXP); int p = 0; for (int e = 0; e < 8; ++e) { const int np = (tot[e] + 255) >> 8; for (int q = 0; q < np; ++q) PE[p++] = e; } PE[MAXP] = p; } }
    __syncthreads();
    RouteEnt* L = (RouteEnt*)(WSG + WS_LIST);
    if (F.bid == 0) {
        for (int e = 0; e < 8; ++e) { const int lo = tot[16 + e] + tot[e], hi = tot[16 + e] + ((tot[e] + 255) & ~255);
            for (int p = lo + F.tid; p < hi; p += 512) { RouteEnt z; z.tok = -1; z.slot = 0; z.w = 0.f; z.pad = 0; L[p] = z; } }
    }
    const RouteRow* RR = (const RouteRow*)(WSG + WS_ROUTE);
    const int r0 = (int)((long)M * F.bid / F.G), r1 = (int)((long)M * (F.bid + 1) / F.G);
    for (int m = r0 + F.tid; m < r1; m += 512) { const RouteRow rr = RR[m];
        { const int p = tot[16 + rr.e1] + tot[8 + rr.e1] + atomicAdd((int*)&tot[24 + rr.e1], 1); RouteEnt z; z.tok = m; z.slot = 0; z.w = rr.p1; z.pad = 0; L[p] = z; }
        { const int p = tot[16 + rr.e2] + tot[8 + rr.e2] + atomicAdd((int*)&tot[24 + rr.e2], 1); RouteEnt z; z.tok = m; z.slot = 1; z.w = rr.p2; z.pad = 0; L[p] = z; } }
}
__device__ __forceinline__ void ph_gather(Frame& F, int p0, int p1) {
    const RouteEnt* L = (const RouteEnt*)(WSG + WS_LIST); unsigned char* HG = FBIG + BIG_HG; const unsigned char* H8 = (const unsigned char*)FH;
    const int gw = F.bid * 8 + F.wave, NGW = F.G * 8, n = (p1 - p0) * 256;
    for (int r = gw; r < n; r += NGW) { const int tok = L[(size_t)p0 * 256 + r].tok;
        v4u a = (v4u){0u, 0u, 0u, 0u};
        if (tok >= 0) a = ((const v4u*)(H8 + (size_t)tok * D))[F.lane];
        ((v4u*)(HG + (size_t)r * D))[F.lane] = a; }
}
__device__ __forceinline__ void rope8(v4u& a, v4u& b, const float* cs, float sc) {
    unsigned* pa = (unsigned*)&a; unsigned* pb = (unsigned*)&b;
#pragma unroll
    for (int k = 0; k < 4; ++k) {
        float x1l = bflo(pa[k]), x1h = bfhi(pa[k]), x2l = bflo(pb[k]), x2h = bfhi(pb[k]);
        float c0 = 1.f, s0 = 0.f, c1 = 1.f, s1 = 0.f;
        if (cs) { c0 = cs[4 * k]; s0 = cs[4 * k + 1]; c1 = cs[4 * k + 2]; s1 = cs[4 * k + 3]; }
        const float o1l = (x1l * c0 - x2l * s0) * sc, o2l = (x1l * s0 + x2l * c0) * sc, o1h = (x1h * c1 - x2h * s1) * sc, o2h = (x1h * s1 + x2h * c1) * sc;
        pa[k] = cvt_pk_bf16(o1l, o1h); pb[k] = cvt_pk_bf16(o2l, o2h);
    }
}
__device__ __forceinline__ void ph_rope(Frame& F, int odd) {
    const int gw = F.bid * 8 + F.wave, NGW = F.G * 8;
    bf16* Z = (bf16*)FBIG;
    if (!odd) {
        const float* T = (const float*)(WSG + WS_ROPE_R);
        const int tensor = F.lane >> 5, head = (F.lane >> 3) & 3, d0 = (F.lane & 7) * 8;
        const float sc = tensor ? 0.08838834764831845f : 1.0f;
        for (int m = gw; m < M; m += NGW) { const int t = m % TB;
            bf16* p = Z + (size_t)m * EV_IN + 1024 + tensor * 512 + head * 128 + d0;
            v4u a = *(v4u*)p, b = *(v4u*)(p + 64);
            if (t >= CTXL) { const int tl = t - CTXL, pos = d0 < 32 ? (tl >> 6) : (tl & 63), dq = d0 & 31; rope8(a, b, T + (pos * 32 + dq) * 2, sc); }
            else { if (!tensor) continue; rope8(a, b, nullptr, sc); }
            *(v4u*)p = a; *(v4u*)(p + 64) = b; }
    } else {
        const float* T = (const float*)(WSG + WS_ROPE_D);
        for (int m = gw; m < M; m += NGW) { const int t = m % TB; if (t < CTXL) continue;
            const int tl = t - CTXL;
            for (int it = F.lane; it < 96; it += 64) { const int tensor = it / 48, r = it % 48, hm = r >> 2, d0 = (r & 3) * 8;
                bf16* p = Z + (size_t)m * OD_IN + 256 + tensor * 768 + hm * 64 + d0;
                v4u a = *(v4u*)p, b = *(v4u*)(p + 32);
                const int pos = d0 < 16 ? (tl >> 6) : (tl & 63), dq = d0 & 15; rope8(a, b, T + (pos * 16 + dq) * 2, 1.0f);
                *(v4u*)p = a; *(v4u*)(p + 32) = b; } }
    }
}
__device__ __forceinline__ void unpack8(const v4u& w, float* f) { f[0] = bflo(w.x); f[1] = bfhi(w.x); f[2] = bflo(w.y); f[3] = bfhi(w.y); f[4] = bflo(w.z); f[5] = bfhi(w.z); f[6] = bflo(w.w); f[7] = bfhi(w.w); }
__device__ __forceinline__ v4u pack8(const float* f) { v4u w; w.x = cvt_pk_bf16(f[0], f[1]); w.y = cvt_pk_bf16(f[2], f[3]); w.z = cvt_pk_bf16(f[4], f[5]); w.w = cvt_pk_bf16(f[6], f[7]); return w; }
__device__ __forceinline__ void ph_merge_even(Frame& F, int i) {
    const int gw = F.bid * 8 + F.wave, NGW = F.G * 8;
    const bf16* Z = (const bf16*)FBIG; const bf16* HF = (const bf16*)FYB; const bf16* HB = (const bf16*)(FYB + T_HALF);
    const bf16* RF = (const bf16*)(FYB + 2 * T_HALF); const bf16* RB = (const bf16*)(FYB + 3 * T_HALF);
    const float* gn = INP(14) + (size_t)i * 512; const int c0 = 8 * F.lane;
    float gnv[8];
#pragma unroll
    for (int k = 0; k < 8; ++k) gnv[k] = gn[c0 + k];
    for (int m = gw; m < M; m += NGW) {
        float a[8], b[8], g[8], o[8];
        unpack8(*(const v4u*)(HF + (size_t)m * 512 + c0), a); unpack8(*(const v4u*)(HB + (size_t)m * 512 + c0), b); unpack8(*(const v4u*)(Z + (size_t)m * EV_IN + 512 + c0), g);
#pragma unroll
        for (int k = 0; k < 8; ++k) o[k] = (a[k] + b[k]) * gelu_tanh(g[k]);
        *(v4u*)(FH + (size_t)m * D + c0) = pack8(o);
        unpack8(*(const v4u*)(RF + (size_t)m * 512 + c0), a); unpack8(*(const v4u*)(RB + (size_t)m * 512 + c0), b); unpack8(*(const v4u*)(Z + (size_t)m * EV_IN + 2560 + c0), g);
        float s = 0.f;
#pragma unroll
        for (int k = 0; k < 8; ++k) { a[k] += b[k]; s += a[k]; }
        s += __shfl_xor(s, 1); s += __shfl_xor(s, 2); s += __shfl_xor(s, 4); s += __shfl_xor(s, 8);
        const float mean = s * (1.0f / 128.0f); float q = 0.f;
#pragma unroll
        for (int k = 0; k < 8; ++k) { a[k] -= mean; q += a[k] * a[k]; }
        q += __shfl_xor(q, 1); q += __shfl_xor(q, 2); q += __shfl_xor(q, 4); q += __shfl_xor(q, 8);
        const float rs = 1.0f / sqrtf(q * (1.0f / 128.0f) + EPS);
#pragma unroll
        for (int k = 0; k < 8; ++k) o[k] = a[k] * rs * gnv[k] * (g[k] * sigmoidf_(g[k]));
        *(v4u*)(FH + (size_t)m * D + 512 + c0) = pack8(o);
    }
}
__device__ __forceinline__ void ph_zpass(Frame& F, int i) {
    const int gw = F.bid * 8 + F.wave, NGW = F.G * 8;
    const bf16* ZI = (const bf16*)FBIG; const bf16* YF = (const bf16*)FYB; const bf16* YB = (const bf16*)(FYB + T_QUART); bf16* ZO = (bf16*)(FYB + 2 * T_QUART);
    const float* dsk = INP(27) + (size_t)i * 256; const int c0 = 4 * F.lane;
    const f32x4 dv = *(const f32x4*)(dsk + c0);
    for (int m = gw; m < M; m += NGW) {
        const v2u a = *(const v2u*)(YF + (size_t)m * 256 + c0), b = *(const v2u*)(YB + (size_t)m * 256 + c0), u = *(const v2u*)(ZI + (size_t)m * OD_IN + c0);
        const float y0 = bflo(a.x) + bflo(b.x) + dv.x * bflo(u.x), y1 = bfhi(a.x) + bfhi(b.x) + dv.y * bfhi(u.x), y2 = bflo(a.y) + bflo(b.y) + dv.z * bflo(u.y), y3 = bfhi(a.y) + bfhi(b.y) + dv.w * bfhi(u.y);
        v2u w; w.x = cvt_pk_bf16(gelu_tanh(y0), gelu_tanh(y1)); w.y = cvt_pk_bf16(gelu_tanh(y2), gelu_tanh(y3));
        *(v2u*)(ZO + (size_t)m * 256 + c0) = w; }
}
__device__ __forceinline__ int chunk_tlo(int dir, int c) { return dir == 0 ? 128 * c : (c < 2 ? 128 * (1 - c) : 8576 - 128 * c); }

__device__ __forceinline__ void lru_item(Frame& F, int i, int b, int dir, int blk) {
    LAS unsigned char* lds = F.lds;
    LAS float* UR = (LAS float*)(lds);
    LAS float* AA = (LAS float*)(lds);
    LAS float* U = (LAS float*)(lds + 36864);
    LAS float* BB = U;
    LAS bf16* UB = (LAS bf16*)(lds + 69632);
    LAS float* SEG = (LAS float*)(lds + 88064);
    LAS float* PRM = (LAS float*)(lds + 92160);
    const int tid = F.tid, lane = F.lane, wave = F.wave, ch = tid & 63, seg = tid >> 6;
    const bf16* Z = (const bf16*)FBIG; bf16* OUT = (bf16*)(FYB + (size_t)dir * T_HALF);
    const float* conv_w = INP(8) + (size_t)i * 4 * 512; const float* conv_b = INP(9) + (size_t)i * 512;
    const float* gate_w = INP(10) + (((size_t)i * 2 + dir) * 2) * 8 * 64 * 64;
    const float* gate_b = INP(11) + (((size_t)i * 2 + dir) * 2) * 512;
    const float* lam = INP(12) + ((size_t)i * 2 + dir) * 512;
    __syncthreads();
    if (tid < 64) { const int cg = blk * 64 + tid;
        PRM[0 * 64 + tid] = conv_w[0 * 512 + cg]; PRM[1 * 64 + tid] = conv_w[1 * 512 + cg]; PRM[2 * 64 + tid] = conv_w[2 * 512 + cg]; PRM[3 * 64 + tid] = conv_w[3 * 512 + cg];
        PRM[4 * 64 + tid] = conv_b[cg]; const float lm = lam[cg]; PRM[5 * 64 + tid] = (-lm > 20.f) ? -lm : log1pf(expf(-lm));
        PRM[6 * 64 + tid] = gate_b[cg]; PRM[7 * 64 + tid] = gate_b[512 + cg]; }
    const int fr = lane & 15, fq = lane >> 4;
    bf16x8 wf[8][2];
#pragma unroll
    for (int nt = 0; nt < 8; ++nt)
#pragma unroll
        for (int ks = 0; ks < 2; ++ks) { const int col = 16 * nt + fr, gate = col >> 6, j = col & 63; const float* wp = gate_w + (((size_t)gate * 8 + blk) * 64 + (32 * ks + 8 * fq)) * 64 + j;
            v4u w; w.x = cvt_pk_bf16(wp[0], wp[64]); w.y = cvt_pk_bf16(wp[128], wp[192]); w.z = cvt_pk_bf16(wp[256], wp[320]); w.w = cvt_pk_bf16(wp[384], wp[448]);
            wf[nt][ks] = __builtin_bit_cast(bf16x8, w); }
    float carry = 0.f;
    __syncthreads();
    for (int c = 0; c < 66; ++c) {
        const int t_lo = chunk_tlo(dir, c), seq_lo = t_lo < CTXL ? 0 : CTXL, seq_hi = t_lo < CTXL ? CTXL : TB;
        const size_t rowbase = (size_t)b * TB;
        for (int it = tid; it < 131 * 8; it += 512) { const int r = it >> 3, cc = it & 7, t = t_lo - 2 + r; float f[8];
            if (t >= seq_lo && t < seq_hi) unpack8(*(const v4u*)(Z + (rowbase + t) * EV_IN + blk * 64 + cc * 8), f);
            else {
#pragma unroll
                for (int k = 0; k < 8; ++k) f[k] = 0.f; }
            *(LAS f32x4*)(UR + r * 64 + cc * 8) = (f32x4){f[0], f[1], f[2], f[3]}; *(LAS f32x4*)(UR + r * 64 + cc * 8 + 4) = (f32x4){f[4], f[5], f[6], f[7]}; }
        __syncthreads();
        { const float w0 = PRM[ch], w1 = PRM[64 + ch], w2 = PRM[128 + ch], w3 = PRM[192 + ch], cb = PRM[256 + ch];
#pragma unroll 4
          for (int k = 0; k < 16; ++k) { const int r = seg * 16 + k; const float u = cb + w0 * UR[r * 64 + ch] + w1 * UR[(r + 1) * 64 + ch] + w2 * UR[(r + 2) * 64 + ch] + w3 * UR[(r + 3) * 64 + ch];
              U[r * 64 + ch] = u; UB[r * 72 + ch] = (bf16)(cvt_pk_bf16(u, 0.f) & 0xffffu); } }
        __syncthreads();
        { f32x4 acc[8];
#pragma unroll
          for (int nt = 0; nt < 8; ++nt) acc[nt] = (f32x4){0.f, 0.f, 0.f, 0.f};
          const bf16x8 a0 = *(const LAS bf16x8*)(UB + (16 * wave + fr) * 72 + 8 * fq), a1 = *(const LAS bf16x8*)(UB + (16 * wave + fr) * 72 + 32 + 8 * fq);
#pragma unroll
          for (int nt = 0; nt < 8; ++nt) { acc[nt] = __builtin_amdgcn_mfma_f32_16x16x32_bf16(a0, wf[nt][0], acc[nt], 0, 0, 0); acc[nt] = __builtin_amdgcn_mfma_f32_16x16x32_bf16(a1, wf[nt][1], acc[nt], 0, 0, 0); }
#pragma unroll
          for (int nt = 0; nt < 4; ++nt) { const int cch = 16 * nt + fr; const float br = PRM[6 * 64 + cch], bi = PRM[7 * 64 + cch], sp = PRM[5 * 64 + cch];
#pragma unroll
              for (int rg = 0; rg < 4; ++rg) { const int r = 16 * wave + 4 * fq + rg; const float rgate = sigmoidf_(acc[nt][rg] + br), igate = sigmoidf_(acc[nt + 4][rg] + bi);
                  const float la = -8.0f * rgate * sp, av = expf(la), bv = sqrtf(-expm1f(2.0f * la)) * (igate * U[r * 64 + cch]);
                  AA[r * 64 + cch] = av; BB[r * 64 + cch] = bv; } } }
        __syncthreads();
        float hl[16], ca[16];
        { float h = 0.f, p = 1.f;
#pragma unroll
          for (int k = 0; k < 16; ++k) { const int ip = seg * 16 + k, r = dir == 0 ? ip : 127 - ip; const float av = AA[r * 64 + ch], bv = BB[r * 64 + ch]; h = av * h + bv; p *= av; hl[k] = h; ca[k] = p; }
          SEG[seg * 64 + ch] = p; SEG[512 + seg * 64 + ch] = h; }
        __syncthreads();
        float hin = carry, myin = 0.f;
#pragma unroll
        for (int s = 0; s < 8; ++s) { if (s == seg) myin = hin; hin = SEG[s * 64 + ch] * hin + SEG[512 + s * 64 + ch]; }
        carry = hin;
#pragma unroll
        for (int k = 0; k < 16; ++k) { const int ip = seg * 16 + k, r = dir == 0 ? ip : 127 - ip; const float h = hl[k] + ca[k] * myin;
            OUT[(rowbase + t_lo + r) * 512 + blk * 64 + ch] = (bf16)(cvt_pk_bf16(h, 0.f) & 0xffffu); }
        __syncthreads();
    }
}
__device__ __forceinline__ unsigned off_b(unsigned row, unsigned ch) { return 256u * row + 16u * (ch ^ (((row & 3) << 2) | ((row >> 2) & 3))); }
__device__ __forceinline__ unsigned row_read_addr(unsigned lane, unsigned rb, unsigned s) { return off_b(32 * rb + (lane & 31), 2 * s + (lane >> 5)); }
__device__ __forceinline__ unsigned tr_read_addr(unsigned lane, unsigned c, unsigned ks, unsigned t) {
    const unsigned h = lane >> 5, blk = (lane >> 4) & 1, q = (lane & 15) >> 2, p = lane & 3;
    return off_b(16 * ks + 8 * h + 4 * t + q, 4 * c + 2 * blk + (p >> 1)) + 8 * (p & 1);
}
typedef short v4i16_t __attribute__((ext_vector_type(4)));
__device__ __forceinline__ bf16x8 tr_frag(LAS unsigned char* tile, unsigned lane, unsigned c, unsigned ks) {
    const s16x4 lo = __builtin_bit_cast(s16x4, __builtin_amdgcn_ds_read_tr16_b64_v4i16((LAS v4i16_t*)(tile + tr_read_addr(lane, c, ks, 0))));
    const s16x4 hi = __builtin_bit_cast(s16x4, __builtin_amdgcn_ds_read_tr16_b64_v4i16((LAS v4i16_t*)(tile + tr_read_addr(lane, c, ks, 1))));
    return (bf16x8){lo[0], lo[1], lo[2], lo[3], hi[0], hi[1], hi[2], hi[3]};
}
__device__ __forceinline__ bf16x8 row_frag(LAS unsigned char* tile, unsigned lane, unsigned rb, unsigned s) { return *(const LAS bf16x8*)(tile + row_read_addr(lane, rb, s)); }
#define MFMA32(a, b, c) __builtin_amdgcn_mfma_f32_32x32x16_bf16((a), (b), (c), 0, 0, 0)

constexpr unsigned RT_KB = 0, RT_T2 = 32768, RT_QB = 65536, RT_VB = 98304;
__device__ __forceinline__ s16x4 ds_tr(LAS unsigned char* p) { return __builtin_bit_cast(s16x4, __builtin_amdgcn_ds_read_tr16_b64_v4i16((LAS v4i16_t*)p)); }
#define TRF(base0, base1, off) ({ const s16x4 lo_ = ds_tr(F.lds + (base0) + (off)), hi_ = ds_tr(F.lds + (base1) + (off)); (bf16x8){lo_[0], lo_[1], lo_[2], lo_[3], hi_[0], hi_[1], hi_[2], hi_[3]}; })
#define RWF(base, off) (*(const LAS bf16x8*)(F.lds + (base) + (off)))
__device__ __forceinline__ void ret_item(Frame& F, int li, int b, int head, int dir) {
    const int tid = F.tid, lane = F.lane, wave = F.wave, ib = wave & 3, eh = wave >> 2, r = lane & 31, h = lane >> 5;
    const bf16* Z = (const bf16*)FBIG; bf16* OUT = (bf16*)(FYB + (size_t)(2 + dir) * T_HALF);
    const float theta = INP(13)[((size_t)li * 2 + dir) * 4 + head];
    const float log_g = -((-theta > 20.f) ? -theta : log1pf(expf(-theta)));
    const float g1 = expf(log_g), g127 = expf(127.0f * log_g);
    const size_t rowbase = (size_t)b * TB;
    unsigned xsI[8], xsE[8];
    { const unsigned swz = ((r & 3) << 2) | ((r >> 2) & 3);
#pragma unroll
      for (int s = 0; s < 8; ++s) { const unsigned x = 256u * r + 16u * ((unsigned)(2 * s + h) ^ swz); xsI[s] = x + 8192u * ib + RT_QB; xsE[s] = x + 16384u * eh; } }
    const unsigned tK0 = RT_KB + tr_read_addr(lane, ib, 0, 0), tK1 = RT_KB + tr_read_addr(lane, ib, 0, 1);
    const unsigned tV00 = RT_VB + tr_read_addr(lane, 2 * eh, 0, 0), tV01 = RT_VB + tr_read_addr(lane, 2 * eh, 0, 1), tV10 = RT_VB + tr_read_addr(lane, 2 * eh + 1, 0, 0), tV11 = RT_VB + tr_read_addr(lane, 2 * eh + 1, 0, 1);
    __syncthreads();
    for (int it = tid; it < 2048; it += 512) *(LAS v4u*)(F.lds + RT_T2 + it * 16) = (v4u){0u, 0u, 0u, 0u};
    f32x16 SA[2]; SA[0] = f32x16{}; SA[1] = f32x16{};
    v4u pq[4], pk[4], pv[4];
#define RET_LOAD(c_) do { const int tl_ = chunk_tlo(dir, (c_)); _Pragma("unroll") for (int n_ = 0; n_ < 4; ++n_) { const int it_ = tid + 512 * n_, row_ = it_ >> 4, cn_ = it_ & 15; \
        const bf16* p_ = Z + (rowbase + tl_ + (dir == 0 ? row_ : 127 - row_)) * EV_IN + 1024 + head * 128 + cn_ * 8; pq[n_] = *(const v4u*)p_; pk[n_] = *(const v4u*)(p_ + 512); pv[n_] = *(const v4u*)(p_ + 1024); } } while (0)
    RET_LOAD(0);
#pragma nounroll
    for (int c = 0; c < 66; ++c) {
        const int t_lo = chunk_tlo(dir, c);
        __syncthreads();
#pragma unroll
        for (int n = 0; n < 4; ++n) { const int it = tid + 512 * n, row = it >> 4, cn = it & 15; const float sc = expf(-(float)row * log_g); const unsigned wo = off_b(row, cn);
            float f[8]; unpack8(pk[n], f);
#pragma unroll
            for (int k = 0; k < 8; ++k) f[k] *= sc;
            *(LAS v4u*)(F.lds + RT_QB + wo) = pq[n]; *(LAS v4u*)(F.lds + RT_KB + wo) = pack8(f); *(LAS v4u*)(F.lds + RT_VB + wo) = pv[n]; }
        if (c + 1 < 66) RET_LOAD(c + 1);
        __syncthreads();
        f32x16 OT[2], ST[2];
        OT[0] = f32x16{}; OT[1] = f32x16{}; ST[0] = f32x16{}; ST[1] = f32x16{};
#pragma unroll
        for (int s = 0; s < 8; ++s) { const bf16x8 qf = RWF(xsI[s], 0);
            OT[0] = MFMA32(RWF(xsE[s], RT_T2), qf, OT[0]); OT[1] = MFMA32(RWF(xsE[s], RT_T2 + 8192), qf, OT[1]);
            if (2 * eh <= ib) ST[0] = MFMA32(RWF(xsE[s], RT_KB), qf, ST[0]);
            if (2 * eh + 1 <= ib) ST[1] = MFMA32(RWF(xsE[s], RT_KB + 8192), qf, ST[1]); }
#pragma unroll
        for (int x = 0; x < 2; ++x)
#pragma unroll
            for (int q = 0; q < 16; ++q) SA[x][q] *= g1;
#pragma unroll
        for (int ks = 0; ks < 8; ++ks) { const bf16x8 kf = TRF(tK0, tK1, ks * 4096);
            SA[0] = MFMA32(kf, TRF(tV00, tV01, ks * 4096), SA[0]); SA[1] = MFMA32(kf, TRF(tV10, tV11, ks * 4096), SA[1]); }
#pragma unroll
        for (int x = 0; x < 2; ++x)
#pragma unroll
            for (int q = 0; q < 16; ++q) SA[x][q] *= g127;
        __syncthreads();
        const int irow = 32 * ib + r;
#pragma unroll
        for (int y = 0; y < 2; ++y) { const int jb = 2 * eh + y;
#pragma unroll
            for (int gq = 0; gq < 4; ++gq) { const int j0 = 32 * jb + 8 * gq + 4 * h; float p0 = ST[y][4 * gq], p1 = ST[y][4 * gq + 1], p2 = ST[y][4 * gq + 2], p3 = ST[y][4 * gq + 3];
                if (j0 > irow) p0 = 0.f; if (j0 + 1 > irow) p1 = 0.f; if (j0 + 2 > irow) p2 = 0.f; if (j0 + 3 > irow) p3 = 0.f;
                v2u w; w.x = cvt_pk_bf16(p0, p1); w.y = cvt_pk_bf16(p2, p3);
                *(LAS v2u*)(F.lds + RT_QB + off_b(irow, 4 * jb + gq) + 8 * h) = w; } }
#pragma unroll
        for (int x = 0; x < 2; ++x) { const int erow = 32 * (2 * eh + x) + r;
#pragma unroll
            for (int gq = 0; gq < 4; ++gq) { v2u w; w.x = cvt_pk_bf16(SA[x][4 * gq] * g1, SA[x][4 * gq + 1] * g1); w.y = cvt_pk_bf16(SA[x][4 * gq + 2] * g1, SA[x][4 * gq + 3] * g1);
                *(LAS v2u*)(F.lds + RT_T2 + off_b(erow, 4 * ib + gq) + 8 * h) = w; } }
        __syncthreads();
#pragma unroll
        for (int s = 0; s < 8; ++s) { const bf16x8 pf = RWF(xsI[s], 0);
            OT[0] = MFMA32(TRF(tV00, tV01, s * 4096), pf, OT[0]); OT[1] = MFMA32(TRF(tV10, tV11, s * 4096), pf, OT[1]); }
        { const float gi = expf((float)irow * log_g); const int t = t_lo + (dir == 0 ? irow : 127 - irow);
          bf16* op = OUT + (rowbase + t) * 512 + head * 128;
#pragma unroll
          for (int x = 0; x < 2; ++x)
#pragma unroll
              for (int gq = 0; gq < 4; ++gq) { v2u w; w.x = cvt_pk_bf16(OT[x][4 * gq] * gi, OT[x][4 * gq + 1] * gi); w.y = cvt_pk_bf16(OT[x][4 * gq + 2] * gi, OT[x][4 * gq + 3] * gi);
                  *(v2u*)(op + 32 * (2 * eh + x) + 8 * gq + 4 * h) = w; } }
    }
#undef RET_LOAD
}
#undef TRF
#undef RWF
#if DBG_SCAN
#define DBGCHK(stage, v) do { if (!(fabsf(v) < 1e30f)) atomicMax((unsigned*)(WSG + WS_CTL) + 2049, 100u - (unsigned)(stage)); } while (0)
#else
#define DBGCHK(stage, v) do {} while (0)
#endif
__device__ __forceinline__ void s5_item(Frame& F, int li, int b, int dir, int g) {
    LAS unsigned char* lds = F.lds;
    LAS float* U = (LAS float*)lds;
    LAS float* SEG = (LAS float*)(lds + 8192);
    LAS bf16* HS = (LAS bf16*)(lds + 12288);
    const int tid = F.tid, lane = F.lane, wave = F.wave, p = tid & 63, seg = tid >> 6, fr = lane & 15, fq = lane >> 4;
    const bf16* Z = (const bf16*)FBIG; bf16* OUT = (bf16*)(FYB + (size_t)dir * T_QUART);
    const size_t pb = ((size_t)li * 2 + dir) * 16 + g;
    const float lre = INP(20)[pb * 64 + p], lim = INP(21)[pb * 64 + p], dt = expf(INP(22)[pb]);
    const float x = lre * dt, y = lim * dt, ex = expf(x); float sy, cy; sincosf(y, &sy, &cy);
    const float ar = ex * cy, ai = ex * sy;
    const float sh = sinf(0.5f * y), am1r = expm1f(x) * cy - 2.0f * sh * sh, am1i = ai;
    const float den = 1.0f / (lre * lre + lim * lim), cr = (am1r * lre + am1i * lim) * den, ci = (am1i * lre - am1r * lim) * den;
    float bbr[16], bbi[16];
#pragma unroll
    for (int k = 0; k < 16; ++k) { const float br = INP(23)[(pb * 64 + p) * 16 + k], bi = INP(24)[(pb * 64 + p) * 16 + k]; bbr[k] = cr * br - ci * bi; bbi[k] = cr * bi + ci * br; }
    DBGCHK(1, ar); DBGCHK(1, ai); DBGCHK(2, cr); DBGCHK(2, ci); DBGCHK(3, bbr[0] + bbi[0] + bbr[15] + bbi[15]);
    float a16r = ar, a16i = ai;
#pragma unroll
    for (int k = 0; k < 4; ++k) { const float tr_ = a16r * a16r - a16i * a16i, ti_ = 2.0f * a16r * a16i; a16r = tr_; a16i = ti_; }
    bf16x8 cf[4];
#pragma unroll
    for (int ks = 0; ks < 4; ++ks) { float v[8];
#pragma unroll
        for (int j = 0; j < 8; ++j) { const int k = 32 * ks + 8 * fq + j; v[j] = k < 64 ? INP(25)[(pb * 16 + fr) * 64 + k] : -INP(26)[(pb * 16 + fr) * 64 + (k - 64)]; }
        cf[ks] = __builtin_bit_cast(bf16x8, pack8(v)); }
    float hr = 0.f, hi = 0.f;
    const size_t rowbase = (size_t)b * TB;
    v4u pu = (v4u){0u, 0u, 0u, 0u};
#define S5_LOAD(c_) do { if (tid < 256) { const int tl_ = chunk_tlo(dir, (c_)), row_ = tid >> 1; pu = *(const v4u*)(Z + (rowbase + tl_ + (dir == 0 ? row_ : 127 - row_)) * OD_IN + g * 16 + (tid & 1) * 8); } } while (0)
    S5_LOAD(0);
    for (int c = 0; c < 66; ++c) {
        const int t_lo = chunk_tlo(dir, c);
        __syncthreads();
        if (tid < 256) { float f[8]; unpack8(pu, f); *(LAS f32x4*)(U + (tid >> 1) * 16 + (tid & 1) * 8) = (f32x4){f[0], f[1], f[2], f[3]}; *(LAS f32x4*)(U + (tid >> 1) * 16 + (tid & 1) * 8 + 4) = (f32x4){f[4], f[5], f[6], f[7]}; }
        if (c + 1 < 66) S5_LOAD(c + 1);
        __syncthreads();
        float lr[16], lim_[16];
        { float sr = 0.f, si = 0.f;
#pragma unroll
          for (int k = 0; k < 16; ++k) { const LAS f32x4* up = (const LAS f32x4*)(U + (seg * 16 + k) * 16); const f32x4 u0 = up[0], u1 = up[1], u2 = up[2], u3 = up[3];
              float br = bbr[0] * u0.x + bbr[1] * u0.y + bbr[2] * u0.z + bbr[3] * u0.w + bbr[4] * u1.x + bbr[5] * u1.y + bbr[6] * u1.z + bbr[7] * u1.w
                       + bbr[8] * u2.x + bbr[9] * u2.y + bbr[10] * u2.z + bbr[11] * u2.w + bbr[12] * u3.x + bbr[13] * u3.y + bbr[14] * u3.z + bbr[15] * u3.w;
              float bi = bbi[0] * u0.x + bbi[1] * u0.y + bbi[2] * u0.z + bbi[3] * u0.w + bbi[4] * u1.x + bbi[5] * u1.y + bbi[6] * u1.z + bbi[7] * u1.w
                       + bbi[8] * u2.x + bbi[9] * u2.y + bbi[10] * u2.z + bbi[11] * u2.w + bbi[12] * u3.x + bbi[13] * u3.y + bbi[14] * u3.z + bbi[15] * u3.w;
              const float nr = ar * sr - ai * si + br, ni = ar * si + ai * sr + bi; sr = nr; si = ni; lr[k] = sr; lim_[k] = si; }
          DBGCHK(4, sr + si); SEG[(seg * 64 + p) * 2] = sr; SEG[(seg * 64 + p) * 2 + 1] = si; }
        __syncthreads();
        float inr = 0.f, ini = 0.f;
#pragma unroll
        for (int s = 0; s < 8; ++s) { if (s == seg) { inr = hr; ini = hi; } const float er = SEG[(s * 64 + p) * 2], ei = SEG[(s * 64 + p) * 2 + 1];
            const float nr = a16r * hr - a16i * hi + er, ni = a16r * hi + a16i * hr + ei; hr = nr; hi = ni; }
        DBGCHK(5, hr + hi + inr + ini);
        { float pr = ar, pi = ai;
#pragma unroll
          for (int k = 0; k < 16; ++k) { const float vr = lr[k] + pr * inr - pi * ini, vi = lim_[k] + pr * ini + pi * inr;
              HS[(seg * 16 + k) * 136 + p] = (bf16)(cvt_pk_bf16(vr, 0.f) & 0xffffu); HS[(seg * 16 + k) * 136 + 64 + p] = (bf16)(cvt_pk_bf16(vi, 0.f) & 0xffffu);
              const float npr = pr * ar - pi * ai, npi = pr * ai + pi * ar; pr = npr; pi = npi; } }
        __syncthreads();
        { pg8::f32x4 acc = (pg8::f32x4){0.f, 0.f, 0.f, 0.f};
#pragma unroll
          for (int ks = 0; ks < 4; ++ks) { const bf16x8 af = *(const LAS bf16x8*)(HS + (16 * wave + fr) * 136 + 32 * ks + 8 * fq); acc = __builtin_amdgcn_mfma_f32_16x16x32_bf16(cf[ks], af, acc, 0, 0, 0); }
          DBGCHK(6, acc[0] + acc[1] + acc[2] + acc[3]);
          const int ip = 16 * wave + fr, t = t_lo + (dir == 0 ? ip : 127 - ip);
          v2u w; w.x = cvt_pk_bf16(acc[0], acc[1]); w.y = cvt_pk_bf16(acc[2], acc[3]);
          *(v2u*)(OUT + (rowbase + t) * 256 + g * 16 + 4 * fq) = w; }
    }
#undef S5_LOAD
}
namespace att {
constexpr int KVBLK = 64, LD = OD_IN;
constexpr float THR = 8.f;
constexpr size_t SHM_V = KVBLK * 128 * 2, SHM_K = KVBLK * 128 * 2;
#define KSWZ(row, colB) ((row) * 256 + ((colB) ^ (((row) & 7) << 4)))
#define SBAR() __builtin_amdgcn_sched_barrier(0)
__device__ __forceinline__ int crow(int r, int hi) { return (r & 3) + 8 * (r >> 2) + 4 * hi; }
constexpr float THRL = THR * 1.4426950408889634f;
#define MX3(a, b, c) __builtin_fmaxf(__builtin_fmaxf((a), (b)), (c))
template <bool FIRST> __device__ __forceinline__ void partialSM(f32x16& p0, f32x16& p1, float& mhat, f32x16& negm, float& alpha) {
  float a = MX3(p0[0], p0[1], p1[0]), b = MX3(p0[2], p0[3], p1[1]); a = MX3(a, p1[2], p1[3]);
#pragma unroll
  for (int r = 4; r < 16; r += 4) { a = MX3(a, p0[r], p0[r + 1]); b = MX3(b, p0[r + 2], p0[r + 3]); a = MX3(a, p1[r], p1[r + 1]); b = MX3(b, p1[r + 2], p1[r + 3]); }
  float rm = __builtin_fmaxf(a, b);
  { auto rr = __builtin_amdgcn_permlane32_swap(__float_as_uint(rm), __float_as_uint(rm), false, false);
    rm = __builtin_fmaxf(__uint_as_float(rr[0]), __uint_as_float(rr[1])); }
  alpha = 1.f;
  if (FIRST || !__builtin_expect(__all(rm <= THRL), 1)) {
    const float dl = FIRST ? rm : __builtin_fmaxf(rm, 0.f);
    mhat += dl;
#pragma unroll
    for (int r = 0; r < 16; ++r) { p0[r] -= dl; p1[r] -= dl; }
#pragma unroll
    for (int r = 0; r < 16; ++r) negm[r] = -mhat;
    alpha = FIRST ? 1.f : __builtin_amdgcn_exp2f(-dl);
  }
#pragma unroll
  for (int r = 0; r < 16; ++r) p0[r] = __builtin_amdgcn_exp2f(p0[r]);
}
__device__ __forceinline__ void finishSM(f32x16& p0, f32x16& p1, float alpha, float& l_reg, bf16x8& pa0, bf16x8& pa1, bf16x8& pa2, bf16x8& pa3) {
#pragma unroll
  for (int r = 0; r < 16; ++r) p1[r] = __builtin_amdgcn_exp2f(p1[r]);
  float ps = 0;
#pragma unroll
  for (int r = 0; r < 16; ++r) ps += p0[r];
#pragma unroll
  for (int r = 0; r < 16; ++r) ps += p1[r];
  { auto rr = __builtin_amdgcn_permlane32_swap(__float_as_uint(ps), __float_as_uint(ps), false, false);
    ps = __uint_as_float(rr[0]) + __uint_as_float(rr[1]); }
  l_reg = l_reg * alpha + ps;
#define PK4(P, BASE, OUT) do { unsigned a0 = cvt_pk_bf16(P[BASE + 0], P[BASE + 1]), a1 = cvt_pk_bf16(P[BASE + 2], P[BASE + 3]);   \
    unsigned b0 = cvt_pk_bf16(P[BASE + 4], P[BASE + 5]), b1 = cvt_pk_bf16(P[BASE + 6], P[BASE + 7]);                              \
    auto r0 = __builtin_amdgcn_permlane32_swap(a0, b0, false, false); auto r1 = __builtin_amdgcn_permlane32_swap(a1, b1, false, false); \
    v4u w = {r0[0], r1[0], r0[1], r1[1]}; OUT = __builtin_bit_cast(bf16x8, w); } while (0)
  PK4(p0, 0, pa0); PK4(p0, 8, pa1); PK4(p1, 0, pa2); PK4(p1, 8, pa3);
#undef PK4
}
__device__ __forceinline__ void qkt(f32x16& p0, f32x16& p1, const char* Ks, const bf16x8* qr, int r32, int hi, int mapoff, const f32x16& negm) {
#pragma unroll
  for (int d0 = 0; d0 < 4; ++d0) { const int cb = mapoff + (d0 * 16 + hi * 8) * 2;
    const bf16x8 b0 = *reinterpret_cast<const bf16x8*>(Ks + KSWZ(r32, cb));
    const bf16x8 b1 = *reinterpret_cast<const bf16x8*>(Ks + KSWZ(32 + r32, cb));
    if (d0 == 0) { p0 = __builtin_amdgcn_mfma_f32_32x32x16_bf16(b0, qr[0], negm, 0, 0, 0); p1 = __builtin_amdgcn_mfma_f32_32x32x16_bf16(b1, qr[0], negm, 0, 0, 0); }
    else { p0 = __builtin_amdgcn_mfma_f32_32x32x16_bf16(b0, qr[d0], p0, 0, 0, 0); p1 = __builtin_amdgcn_mfma_f32_32x32x16_bf16(b1, qr[d0], p1, 0, 0, 0); } }
}
__device__ __forceinline__ int v_st(int k, int c) { const int kk = (k & ~0xC) | ((k & 4) << 1) | ((k & 8) >> 1); return ((kk >> 3) * 4 + (c >> 5)) * 512 + ((kk & 7) * 32 + (c & 31)) * 2; }
__device__ __forceinline__ int v_rd_base(int lane) { return ((lane & 3) << 3) | (((lane >> 2) & 3) << 6) | (((lane >> 4) & 1) << 5) | (((lane >> 5) & 1) << 8); }
constexpr int v_rd_off(int d0, int ks, int half) { return d0 * 512 + ks * 4096 + half * 2048; }
template <int OFF> __device__ __forceinline__ s16x4 tr_read(int vb) {
  s16x4 r; asm volatile("ds_read_b64_tr_b16 %0, %1 offset:%2" : "=&v"(r) : "v"(vb), "i"(OFF) : "memory"); return r;
}
template <int D0> __device__ __forceinline__ void pv_one(f32x16& od, int vb, bf16x8 pa0, bf16x8 pa1, bf16x8 pa2, bf16x8 pa3) {
  const s16x4 l0 = tr_read<v_rd_off(D0, 0, 0)>(vb), h0 = tr_read<v_rd_off(D0, 0, 1)>(vb), l1 = tr_read<v_rd_off(D0, 1, 0)>(vb), h1 = tr_read<v_rd_off(D0, 1, 1)>(vb);
  const s16x4 l2 = tr_read<v_rd_off(D0, 2, 0)>(vb), h2 = tr_read<v_rd_off(D0, 2, 1)>(vb), l3 = tr_read<v_rd_off(D0, 3, 0)>(vb), h3 = tr_read<v_rd_off(D0, 3, 1)>(vb);
  asm volatile("s_waitcnt lgkmcnt(0)" ::: "memory"); SBAR();
#define PK(L, H) (bf16x8){L[0], L[1], L[2], L[3], H[0], H[1], H[2], H[3]}
  od = __builtin_amdgcn_mfma_f32_32x32x16_bf16(pa0, PK(l0, h0), od, 0, 0, 0);
  od = __builtin_amdgcn_mfma_f32_32x32x16_bf16(pa1, PK(l1, h1), od, 0, 0, 0);
  od = __builtin_amdgcn_mfma_f32_32x32x16_bf16(pa2, PK(l2, h2), od, 0, 0, 0);
  od = __builtin_amdgcn_mfma_f32_32x32x16_bf16(pa3, PK(l3, h3), od, 0, 0, 0);
#undef PK
}
__device__ __forceinline__ void pv_d0(f32x16* o, int vb, bf16x8 pa0, bf16x8 pa1, bf16x8 pa2, bf16x8 pa3) {
  pv_one<0>(o[0], vb, pa0, pa1, pa2, pa3); pv_one<1>(o[1], vb, pa0, pa1, pa2, pa3); pv_one<2>(o[2], vb, pa0, pa1, pa2, pa3); pv_one<3>(o[3], vb, pa0, pa1, pa2, pa3);
}
__device__ __forceinline__ void unit(const bf16* __restrict__ Qb, const bf16* __restrict__ Kh, const bf16* __restrict__ Vh, bf16* __restrict__ Ob, int seq, char* lds,
                                     float lam, float gsc, const float* __restrict__ gn, const int tid) {
  const int wid = tid >> 6, lane = tid & 63, r32 = lane & 31, hi = lane >> 5, map = wid >> 2, wq = wid & 3;
  char* V_lds = lds; char* K_lds = lds + 2 * SHM_V;
  float* ws = (float*)(lds + 2 * SHM_V + 2 * SHM_K) + wid * 64; float* li_l = ws; float* al_l = ws + 32;
  float mhat = 0.f, l_reg = 0; f32x16 o[4] = {}; bf16x8 qr[4]; f32x16 negm = {};
  const bf16* Qw = Qb + (long)(wq * 32 + r32) * LD + map * 64 + hi * 8;
#pragma unroll
  for (int d0 = 0; d0 < 4; ++d0) qr[d0] = *reinterpret_cast<const bf16x8*>(Qw + d0 * 16);
  const int sr = tid >> 4, sc = (tid & 15) * 8, vst0 = v_st(sr, sc), vst1 = v_st(32 + sr, sc);
  const int vb0 = (int)(uintptr_t)V_lds + v_rd_base(lane);
  const int mapoff = map * 128;
  struct { bf16x8 vs0, vs1, ks0, ks1; } sr_[1];
  const unsigned go0 = (unsigned)(sr * LD + sc) * 2u, go1 = (unsigned)((32 + sr) * LD + sc) * 2u;
#define SLOAD(i, k0) do { const char* vb_ = (const char*)Vh + (size_t)(k0) * (LD * 2); const char* kb_ = (const char*)Kh + (size_t)(k0) * (LD * 2); \
    sr_[i].vs0 = *reinterpret_cast<const bf16x8*>(vb_ + go0); sr_[i].vs1 = *reinterpret_cast<const bf16x8*>(vb_ + go1); \
    sr_[i].ks0 = *reinterpret_cast<const bf16x8*>(kb_ + go0); sr_[i].ks1 = *reinterpret_cast<const bf16x8*>(kb_ + go1); } while (0)
#define SWRITE(b, i) do { *(bf16x8*)(V_lds + (b) * SHM_V + vst0) = sr_[i].vs0;          \
    *(bf16x8*)(V_lds + (b) * SHM_V + vst1) = sr_[i].vs1; const int kc = sc * 2;               \
    *(bf16x8*)(K_lds + (b) * SHM_K + KSWZ(sr, kc)) = sr_[i].ks0;                       \
    *(bf16x8*)(K_lds + (b) * SHM_K + KSWZ(32 + sr, kc)) = sr_[i].ks1; } while (0)
#define SWAIT() asm volatile("s_waitcnt vmcnt(0)" ::: "memory")
#define RESC(a) do { if (__any((a) < 1.f)) { if (hi == 0) al_l[r32] = (a); asm volatile("s_waitcnt lgkmcnt(0)" ::: "memory"); \
    _Pragma("unroll") for (int d = 0; d < 4; ++d) _Pragma("unroll") for (int r = 0; r < 16; ++r) o[d][r] *= al_l[crow(r, hi)]; } } while (0)
  f32x16 pA0, pA1, pB0, pB1; float alA, alB; bf16x8 pa0, pa1, pa2, pa3; const int NT = seq / KVBLK;
  constexpr int SE = 0, SO = 0;
  SLOAD(SE, 0); asm volatile("s_waitcnt vmcnt(0)" ::: "memory"); SWRITE(0, SE); __syncthreads();
  qkt(pA0, pA1, K_lds, qr, r32, hi, mapoff, negm); partialSM<true>(pA0, pA1, mhat, negm, alA);
  SLOAD(SO, KVBLK);
  SWAIT(); SWRITE(1, SO); __syncthreads();
  for (int j = 1; j + 1 < NT; j += 2) {
    SBAR(); qkt(pB0, pB1, K_lds + SHM_K, qr, r32, hi, mapoff, negm);
    finishSM(pA0, pA1, alA, l_reg, pa0, pa1, pa2, pa3); SBAR();
    SLOAD(SO, (j + 1) * KVBLK); SBAR();
    pv_d0(o, vb0, pa0, pa1, pa2, pa3); partialSM<false>(pB0, pB1, mhat, negm, alB);
    __syncthreads(); SWAIT(); SWRITE(0, SE);
    RESC(alB); __syncthreads();
    SBAR(); qkt(pA0, pA1, K_lds, qr, r32, hi, mapoff, negm);
    finishSM(pB0, pB1, alB, l_reg, pa0, pa1, pa2, pa3); SBAR();
    SLOAD(SE, (j + 2) * KVBLK); SBAR();
    pv_d0(o, vb0 + (int)SHM_V, pa0, pa1, pa2, pa3); partialSM<false>(pA0, pA1, mhat, negm, alA);
    __syncthreads(); SWAIT(); SWRITE(1, SO);
    RESC(alA); __syncthreads();
  }
  SBAR(); qkt(pB0, pB1, K_lds + SHM_K, qr, r32, hi, mapoff, negm);
  finishSM(pA0, pA1, alA, l_reg, pa0, pa1, pa2, pa3); SBAR();
  pv_d0(o, vb0, pa0, pa1, pa2, pa3); partialSM<false>(pB0, pB1, mhat, negm, alB);
  __syncthreads(); RESC(alB);
  finishSM(pB0, pB1, alB, l_reg, pa0, pa1, pa2, pa3); SBAR();
  pv_d0(o, vb0 + (int)SHM_V, pa0, pa1, pa2, pa3);
  if (hi == 0) li_l[r32] = l_reg; asm volatile("s_waitcnt lgkmcnt(0)" ::: "memory");
  float rli[16];
#pragma unroll
  for (int r = 0; r < 16; ++r) rli[r] = __builtin_amdgcn_rcpf(li_l[crow(r, hi)]);
  __syncthreads();
  int zz = 0; asm volatile("" : "+v"(zz));
  float* EX = (float*)lds;
  const int eb = wq * 4096 + lane + zz;
  if (map == 1) {
#pragma unroll
    for (int d0 = 0; d0 < 4; ++d0)
#pragma unroll
      for (int r = 0; r < 16; ++r) EX[eb + (d0 * 16 + r) * 64] = -lam * o[d0][r] * rli[r];
  }
  __syncthreads();
  if (map == 0) {
    float ss[16];
#pragma unroll
    for (int r = 0; r < 16; ++r) ss[r] = 0.f;
#pragma unroll
    for (int d0 = 0; d0 < 4; ++d0)
#pragma unroll
      for (int r = 0; r < 16; ++r) { const float v = o[d0][r] * rli[r] + EX[eb + (d0 * 16 + r) * 64]; o[d0][r] = v; ss[r] += v * v; }
#pragma unroll
    for (int r = 0; r < 16; ++r) { float s = ss[r]; s += __shfl_xor(s, 1); s += __shfl_xor(s, 2); s += __shfl_xor(s, 4); s += __shfl_xor(s, 8); s += __shfl_xor(s, 16);
      ss[r] = gsc / sqrtf(s * (1.0f / 128.0f) + EPS); }
    bf16* Ow = Ob + (long)(wq * 32 + 4 * hi) * 1024 + r32 + zz;
#pragma unroll
    for (int d0 = 0; d0 < 4; ++d0) { const float gv = gn[d0 * 32 + r32];
#pragma unroll
      for (int r = 0; r < 16; ++r) Ow[((r & 3) + 8 * (r >> 2)) * 1024 + d0 * 32] = (bf16)(cvt_pk_bf16(o[d0][r] * ss[r] * gv, 0.f) & 0xffffu); }
  }
  __syncthreads();
#undef SLOAD
#undef SWRITE
#undef SWAIT
#undef RESC
}
#undef MX3
#undef KSWZ
#undef SBAR
}
__device__ __forceinline__ void ph_mix_even(Frame& F, int i) {
    if (!(F.A->mode & 4)) for (int it = F.bid; it < 192; it += F.G) { LAUNDER(F);
#ifndef NO_RET
        if (it < 64) ret_item(F, i, it >> 3, (it >> 1) & 3, it & 1);
#endif
#ifndef NO_LRU
        if (it >= 64) { const int j = it - 64; lru_item(F, i, j >> 4, (j >> 3) & 1, j & 7); }
#endif
        __syncthreads();
    }
}
__device__ __forceinline__ void ph_mix_odd(Frame& F, int l, int ctx_out) {
    const int i = l >> 1;
#ifndef NO_S5
    if (!(F.A->mode & 1)) for (int it = F.bid; it < 256; it += F.G) { LAUNDER(F); s5_item(F, i, it >> 5, (it >> 4) & 1, it & 15); __syncthreads(); }
#endif
    const float* lp = INP(30) + (size_t)i * 256;
    const float s01 = wave_sum(lp[F.lane] * lp[64 + F.lane]), s23 = wave_sum(lp[128 + F.lane] * lp[192 + F.lane]);
    const float lam_init = 0.8f - 0.6f * expf(-0.3f * (float)l), lam = expf(s01) - expf(s23) + lam_init, gsc = 1.0f - lam_init;
    const bf16* Z = (const bf16*)FBIG; const float* gn = INP(31) + (size_t)i * 768;
    const int vcu = (F.G % 8 == 0) ? (F.bid % 8) * (F.G / 8) + F.bid / 8 : F.bid;
    const int nx = NB * 6 * 64, nc = ctx_out ? NB * 6 * 2 : 0;
    if (!(F.A->mode & 2)) for (int u = vcu; u < nx + nc; u += F.G) { LAUNDER(F);
        int bh, qb, row0, seq;
        if (u < nx) { bh = u >> 6; qb = u & 63; row0 = (bh / 6) * TB + CTXL + 128 * qb; seq = TB; }
        else { const int v = u - nx; bh = v >> 1; qb = v & 1; row0 = (bh / 6) * TB + 128 * qb; seq = CTXL; }
        const int b = bh / 6, h = bh % 6;
#ifndef NO_ATTN
        att::unit(Z + (size_t)row0 * OD_IN + 256 + h * 128, Z + (size_t)b * TB * OD_IN + 1024 + h * 128, Z + (size_t)b * TB * OD_IN + 1792 + h * 128,
                  FH + (size_t)row0 * D + 256 + h * 128, seq, (char*)F.lds, lam, gsc, gn + h * 128, F.tid);
#endif
    }
}

constexpr int PH_PER_LAYER = 18, PH_TOTAL = 2 + NLAYER * PH_PER_LAYER;
#define IN(k) (lo <= (k) && (k) < hi)
#define SEAM(k) do { if (IN((k) + 1)) xcd_barrier(bar, F.tid == 0); } while (0)
template <int l> __device__ __forceinline__ void run_layer(Frame& F, const XcdBarrier& bar, const int lo, const int hi) {
        constexpr int P = 1 + PH_PER_LAYER * l, i = l >> 1; constexpr bool odd = l & 1; constexpr int ctx_out = l < NLAYER - 1;
        const float* MODl = FMOD + (size_t)l * 9 * 6144; const float* ng = INP(6) + (size_t)l * 4 * 1024;
        if (IN(P + 0)) { LAUNDER(F);
            ph_convert(F, l);
#ifdef PROBE_CONVERT
            __syncthreads(); ph_convert(F, l);
#endif
            NormArgs a{}; a.xin_input = (l == 0); a.has_y = (l > 0); a.two = (l > 0) && ((l - 1) & 1); a.write_x = (l > 0); a.final_ = 0; a.do_h = 1; a.do_route = 0;
            if (l > 0) { a.gate = FMOD + (size_t)(l - 1) * 9 * 6144 + 5 * 1024; a.gy = INP(6) + (size_t)(l - 1) * 4 * 1024 + 3 * 1024; }
            a.gh = ng; a.shift = MODl; a.scale = MODl + 1024;
            __syncthreads(); ph_norm(F, a); SEAM(P + 0);
        }
        if (IN(P + 1)) { LAUNDER(F);
            constexpr int N = odd ? OD_IN : EV_IN, HD = odd ? 32 : 64;
            pg8::Gemm g{FH, FWB + W_IN / 2, M, N, D}; pg8::StaticOrder S; S.init(M, N, F.G, F.bid);
            pg8::EpiWin<HD> E{(bf16*)FBIG, N, (const float*)(WSG + (odd ? WS_ROPE_D : WS_ROPE_R)), odd ? 1 : 4, odd ? 4 : 6, odd ? 4 : 6, odd ? 7 : 8, odd ? 0.125f * 1.4426950408889634f : 1.0f, odd ? 1.0f : 0.08838834764831845f};
            pg8::gemm_phase<pg8::EpiWin<HD>, pg8::StaticOrder, true, true>(F.lds, g, S, E, F.tid);
            SEAM(P + 2);
        }
        if (IN(P + 3)) { LAUNDER(F); if (!odd) ph_mix_even(F, i); else ph_mix_odd(F, l, ctx_out); SEAM(P + 3); }
        if (IN(P + 4)) { LAUNDER(F); if (!odd) ph_merge_even(F, i); else ph_zpass(F, i); SEAM(P + 4); }
        if (odd && IN(P + 5)) { LAUNDER(F);
            int kglu = 256; asm volatile("" : "+s"(kglu));
            pg8::Gemm g{(const bf16*)(FYB + 2 * T_QUART), FWB + W_GLU / 2, M, 256, kglu}; pg8::StaticOrder S; S.init(M, 256, F.G, F.bid);
            pg8::EpiGLU E{FH, D, (const bf16*)(FYB + 2 * T_QUART), 256, INP(29) + (size_t)i * 256};
            pg8::gemm_phase<pg8::EpiGLU, pg8::StaticOrder, true, true>(F.lds, g, S, E, F.tid);
            SEAM(P + 5);
        }
        if (IN(P + 6)) { LAUNDER(F);
            pg8::Gemm g{FH, FWB + W_OUT / 2, M, D, D}; pg8::StaticOrder S; S.init(M, D, F.G, F.bid);
            pg8::EpiPlain E{(bf16*)FYB, D, 1.0f};
            pg8::gemm_phase<pg8::EpiPlain, pg8::StaticOrder, true, true>(F.lds, g, S, E, F.tid);
            SEAM(P + 6);
        }
        if (IN(P + 7)) { LAUNDER(F);
            NormArgs a{}; a.xin_input = (l == 0); a.has_y = 1; a.two = 0; a.write_x = 1; a.final_ = 0; a.do_h = 1; a.do_route = odd; a.h8 = 1;
            a.gate = MODl + 2 * 1024; a.gy = ng + 1024; a.gh = ng + 2 * 1024; a.shift = MODl + 3 * 1024; a.scale = MODl + 4 * 1024;
            a.rw = INP(33) + (size_t)i * 8192; a.rb = INP(34) + (size_t)i * 8;
            ph_norm(F, a); SEAM(P + 7);
        }
        if (!odd) {
            if (IN(P + 9)) { LAUNDER(F);
                int k8 = D / 2; asm volatile("" : "+s"(k8));
                pg8::Gemm g{FH, (const bf16*)((const unsigned char*)FWB + W_GU), M, 2 * DFF, k8}; pg8::StaticOrder S; S.init(M, 2 * DFF, F.G, F.bid);
                pg8::EpiSwiGLU8 E{FBIG + BIG_ACT, DFF, W8_INV};
                pg8::gemm_phase<pg8::EpiSwiGLU8, pg8::StaticOrder, true, true, true>(F.lds, g, S, E, F.tid);
                SEAM(P + 9);
            }
            if (IN(P + 10)) { LAUNDER(F);
                int k8 = DFF / 2; asm volatile("" : "+s"(k8));
                pg8::Gemm g{(const bf16*)(FBIG + BIG_ACT), (const bf16*)((const unsigned char*)FWB + W_DN), M, D, k8}; pg8::StaticOrder S; S.init(M, D, F.G, F.bid);
                pg8::EpiPlain E{(bf16*)FYB, D, W8_INV};
                pg8::gemm_phase<pg8::EpiPlain, pg8::StaticOrder, true, true, true>(F.lds, g, S, E, F.tid);
                SEAM(P + 10);
            }
        } else {
            if (IN(P + 8)) { LAUNDER(F); ph_assign(F); SEAM(P + 8); }
#pragma nounroll
            for (int w = 0; w < 2; ++w) {
                const int* PE = (const int*)(WSG + WS_PEXP);
                if (IN(P + 9 + 3 * w)) { LAUNDER(F); const int np = PE[MAXP], p0 = min(np, PW * w), p1 = min(np, PW * (w + 1)); ph_gather(F, p0, p1); SEAM(P + 9 + 3 * w); }
                if (IN(P + 10 + 3 * w)) { LAUNDER(F); const int np = PE[MAXP], p0 = min(np, PW * w), p1 = min(np, PW * (w + 1));
                    int k8 = D / 2; asm volatile("" : "+s"(k8));
                    pg8::Gemm g{(const bf16*)(FBIG + BIG_HG), (const bf16*)((const unsigned char*)FWB + W_MGU), (p1 - p0) * 256, 2 * DFF, k8};
                    pg8::ExpertOrder S; S.init((p1 - p0) * 256, 2 * DFF, F.G, F.bid); S.pexp = PE + p0; S.estride = (size_t)7168 * 1024;
                    pg8::EpiSwiGLU8 E{FBIG + BIG_ACT, DFF, W8_INV};
                    pg8::gemm_phase<pg8::EpiSwiGLU8, pg8::ExpertOrder, true, true, true>(F.lds, g, S, E, F.tid);
                    SEAM(P + 10 + 3 * w); }
                if (IN(P + 11 + 3 * w)) { LAUNDER(F); const int np = PE[MAXP], p0 = min(np, PW * w), p1 = min(np, PW * (w + 1));
                    int k8 = DFF / 2; asm volatile("" : "+s"(k8));
                    pg8::Gemm g{(const bf16*)(FBIG + BIG_ACT), (const bf16*)((const unsigned char*)FWB + W_MDN), (p1 - p0) * 256, D, k8};
                    pg8::ExpertOrder S; S.init((p1 - p0) * 256, D, F.G, F.bid); S.pexp = PE + p0; S.estride = (size_t)1024 * 3584;
                    pg8::EpiScatter E{(const RouteEnt*)(WSG + WS_LIST) + (size_t)p0 * 256, (bf16*)FYB, (size_t)M * 1024, D, W8_INV};
                    pg8::gemm_phase<pg8::EpiScatter, pg8::ExpertOrder, true, true, true>(F.lds, g, S, E, F.tid);
                    if (w == 0) { SEAM(P + 11); } else { if (IN(P + PH_PER_LAYER)) xcd_barrier(bar, F.tid == 0); } }
            }
        }
    }
#undef IN
#undef SEAM
__global__ void __launch_bounds__(512, 2) hybrid_fwd(Args args) {
    extern __shared__ __attribute__((aligned(16))) unsigned char lds_raw[];
    Frame F;
    F.lds = (LAS unsigned char*)lds_raw;
    F.tid = threadIdx.x; F.lane = F.tid & 63; F.wave = __builtin_amdgcn_readfirstlane(F.tid >> 6); F.G = gridDim.x; F.bid = blockIdx.x;
    F.A = (KArgs*)__builtin_amdgcn_kernarg_segment_ptr(); F.wsi = F.A->ws;
    volatile LAS unsigned* MISC = (volatile LAS unsigned*)(F.lds + MISC_OFF);
    for (int u = F.tid; u < (LDS_BYTES - LDSCTL_OFF) / 4; u += 512) ((LAS unsigned*)(F.lds + LDSCTL_OFF))[u] = 0u;
    __syncthreads();
    const int lo = args.ph_lo, hi = args.ph_hi;
    const bool multi = (hi - lo) > 1;
    unsigned* ctl = (unsigned*)(WSG + WS_CTL);
    XcdBarrier bar; bar.bar = ctl + CW_BAR; bar.x = 0; bar.st = nullptr;
    if (multi) bar = xcd_barrier_post(ctl + CW_BAR, MISC + 8);
#define IN(k) (lo <= (k) && (k) < hi)
#define SEAM(k) do { if (IN((k) + 1)) xcd_barrier(bar, F.tid == 0); } while (0)
    if (IN(0)) { LAUNDER(F); ph_prologue(F); SEAM(0); }
    run_layer<0>(F, bar, lo, hi); run_layer<1>(F, bar, lo, hi); run_layer<2>(F, bar, lo, hi); run_layer<3>(F, bar, lo, hi);
    if (IN(PH_TOTAL - 1)) { LAUNDER(F);
        NormArgs a{}; a.xin_input = 0; a.has_y = 1; a.two = 1; a.write_x = 1; a.final_ = 1; a.do_h = 0; a.do_route = 0;
        a.gate = FMOD + (size_t)3 * 9 * 6144 + 5 * 1024; a.gy = INP(6) + (size_t)3 * 4 * 1024 + 3 * 1024;
        ph_norm(F, a);
    }
#undef IN
#undef SEAM
}


#ifndef DBG_SCAN
#define DBG_SCAN 0
#endif
#if DBG_SCAN
constexpr int CW_DBG = 2048;
__global__ void __launch_bounds__(256) dbg_scan(unsigned char* ws, const float* out, int phase) {
    unsigned* flag = (unsigned*)(ws + WS_CTL) + CW_DBG; bool bad = false;
    const size_t gt = (size_t)blockIdx.x * 256 + threadIdx.x, gs = (size_t)gridDim.x * 256;
    { const uint4* p = (const uint4*)(ws + WS_W); const size_t n = (WS_END - WS_W) / 16;
      for (size_t i = gt; i < n; i += gs) { const uint4 v = p[i]; const unsigned w[4] = {v.x, v.y, v.z, v.w};
#pragma unroll
          for (int k = 0; k < 4; ++k) { if ((w[k] & 0x7F80u) == 0x7F80u || (w[k] & 0x7F800000u) == 0x7F800000u) bad = true; } } }
    { const uint4* p = (const uint4*)(ws + WS_XC); const size_t n = (size_t)NB * CTXL * D / 4;
      for (size_t i = gt; i < n; i += gs) { const uint4 v = p[i]; if ((v.x & 0x7F800000u) == 0x7F800000u || (v.y & 0x7F800000u) == 0x7F800000u || (v.z & 0x7F800000u) == 0x7F800000u || (v.w & 0x7F800000u) == 0x7F800000u) bad = true; } }
    { const uint4* p = (const uint4*)out; const size_t n = (size_t)NB * SEQ * D / 4;
      for (size_t i = gt; i < n; i += gs) { const uint4 v = p[i]; if ((v.x & 0x7F800000u) == 0x7F800000u || (v.y & 0x7F800000u) == 0x7F800000u || (v.z & 0x7F800000u) == 0x7F800000u || (v.w & 0x7F800000u) == 0x7F800000u) bad = true; } }
    { const unsigned* p = (const unsigned*)(ws + WS_MOD); const size_t n = 4 * 9 * 6144;
      for (size_t i = gt; i < n; i += gs) if ((p[i] & 0x7F800000u) == 0x7F800000u) bad = true; }
    if (bad) atomicMax(flag, 1000u - (unsigned)phase);
}
__global__ void __launch_bounds__(256) dbg_emit(unsigned char* ws, float* out) {
    const unsigned f = ((const unsigned*)(ws + WS_CTL))[CW_DBG], f2 = ((const unsigned*)(ws + WS_CTL))[CW_DBG + 1]; if (f == 0u && f2 == 0u) return;
    const int p = f2 ? 40 + (100 - (int)f2) : 1000 - (int)f;
    const size_t n = (size_t)NB * SEQ * D;
    for (size_t i = (size_t)blockIdx.x * 256 + threadIdx.x; i < n; i += (size_t)gridDim.x * 256) out[i] = (i == 0) ? ldexpf(1.0f, 14 + p) : 0.f;
}
#endif
static bool phase_exists(int ph) {
    if (ph == 0 || ph == PH_TOTAL - 1) return true;
    const int l = (ph - 1) / PH_PER_LAYER, k = (ph - 1) % PH_PER_LAYER; const bool odd = l & 1;
    if (k == 2) return false;
    if (odd) return k <= 14;
    return k <= 1 || k == 3 || k == 4 || k == 6 || k == 7 || k == 9 || k == 10;
}
#ifndef MK_ONE_LAUNCH
#define MK_ONE_LAUNCH 1
#endif
extern "C" void kernel_launch(void* const* d_in, const int* in_sizes, int n_in, void* d_out, int out_size, void* d_ws, size_t ws_size, hipStream_t stream) {
    static int grid = 0;
    if (grid == 0) {
        if (n_in != 38 || in_sizes[0] != NB * SEQ * D || out_size != NB * SEQ * D || ws_size < WS_END) { fprintf(stderr, "kernel_launch: unexpected shapes / workspace (%d inputs, ws %zu)\n", n_in, ws_size); grid = -1; return; }
        int dev = 0, cus = 0, per_cu = 0;
        if (hipGetDevice(&dev) != hipSuccess || hipDeviceGetAttribute(&cus, hipDeviceAttributeMultiprocessorCount, dev) != hipSuccess) { grid = -1; return; }
        if (hipFuncSetAttribute((const void*)hybrid_fwd, hipFuncAttributeMaxDynamicSharedMemorySize, LDS_BYTES) != hipSuccess) { fprintf(stderr, "kernel_launch: hipFuncSetAttribute failed\n"); grid = -1; return; }
        if (hipOccupancyMaxActiveBlocksPerMultiprocessor(&per_cu, (const void*)hybrid_fwd, 512, LDS_BYTES) != hipSuccess || per_cu < 1) fprintf(stderr, "kernel_launch: occupancy query reports %d workgroups per CU\n", per_cu);
        (void)hipGetLastError();
        grid = cus;
    }
    if (grid < 0) return;
    if (hipMemsetAsync((char*)d_ws + WS_CTL, 0, CTL_ZERO_BYTES, stream) != hipSuccess) return;
#if DBG_SCAN
    (void)hipMemsetAsync(d_ws, 0, WS_END, stream); (void)hipMemsetAsync(d_out, 0, (size_t)out_size * 4, stream);
#endif
    Args a{};
    for (int i = 0; i < 38; ++i) a.in[i] = (const float*)d_in[i];
    a.out = (float*)d_out; a.ws = (unsigned char*)d_ws;
    if (MK_ONE_LAUNCH) { a.ph_lo = 0; a.ph_hi = PH_TOTAL; hipLaunchKernelGGL(hybrid_fwd, dim3(grid), dim3(512), LDS_BYTES, stream, a); }
    else for (int ph = 0; ph < PH_TOTAL; ++ph) { if (!phase_exists(ph)) continue; a.ph_lo = ph; a.ph_hi = ph + 1;
        int reps = 1;
#ifdef PROBE_REPEAT
        if (ph > 0 && ph < PH_TOTAL - 1) { const int k = (ph - 1) % PH_PER_LAYER; if ((PROBE_REPEAT >> k) & 1) reps = 2; }
#endif
        for (int rp = 0; rp < reps; ++rp) {
#ifdef PROBE_MODE
            a.mode = rp ? PROBE_MODE : 0;
#endif
            hipLaunchKernelGGL(hybrid_fwd, dim3(grid), dim3(512), LDS_BYTES, stream, a); }
        a.mode = 0;
#if DBG_SCAN
        hipLaunchKernelGGL(dbg_scan, dim3(2048), dim3(256), 0, stream, (unsigned char*)d_ws, (const float*)d_out, ph);
#endif
    }
#if DBG_SCAN
    hipLaunchKernelGGL(dbg_emit, dim3(2048), dim3(256), 0, stream, (unsigned char*)d_ws, (float*)d_out);
#endif
    const hipError_t le = hipPeekAtLastError();
    if (le != hipSuccess) fprintf(stderr, "kernel_launch: launch failed: %s\n", hipGetErrorName(le));
}
```

```cpp
#include <hip/hip_runtime.h>
#include <cstdio>
#include <cstdint>
#include <cmath>
#define DBG_SCAN 0
namespace pg8 {
#define PG8_LAS __attribute__((address_space(3)))
typedef unsigned short bf16_t;
typedef short bf16x8 __attribute__((ext_vector_type(8)));
typedef float f32x4 __attribute__((ext_vector_type(4)));
typedef unsigned u32x4 __attribute__((ext_vector_type(4)));
typedef int v4i_t __attribute__((ext_vector_type(4)));
typedef int v8i_t __attribute__((ext_vector_type(8)));
constexpr int BM = 256, BK = 64, HALF = 128, HTB = HALF * BK * 2  , STAGE_BYTES = 8 * HTB, NXCD = 8, WGM = 8;

__host__ __device__ __forceinline__ int lds_byte(int r, int c) { const int st = (r >> 4) * 2 + (c >> 5), rr = r & 15, cc = c & 31, ob = rr * 64 + cc * 2; return st * 1024 + (ob ^ (((ob >> 9) & 1) << 5)); }
__host__ __device__ __forceinline__ void stage_rc(int b, int& R, int& C) { const int st = b / 1024, sb = b % 1024, swz = sb ^ (((sb >> 9) & 1) << 5); R = (st >> 1) * 16 + swz / 64; C = (st & 1) * 32 + (swz % 64) / 2; }
__host__ __device__ __forceinline__ int perm32(int rho) { const int n = rho >> 4, i = rho & 15; return 8 * (i >> 2) + 4 * n + (i & 3); }

struct Unit { int pm, pn, e; };
struct Gemm { const bf16_t* A; const bf16_t* Bt; int M, N, K; };

typedef float f32x2_cv __attribute__((ext_vector_type(2))); typedef __bf16 bf16x2_cv __attribute__((ext_vector_type(2)));
__device__ __forceinline__ unsigned cvt_pk_bf16(float lo, float hi) { const f32x2_cv v = {lo, hi}; const bf16x2_cv b = __builtin_convertvector(v, bf16x2_cv); return __builtin_bit_cast(unsigned, b); }
struct StaticOrder {
    int nM, nN, nwg, G, c;
    __host__ __device__ void init(int M, int N, int G_, int c_) { nM = M / BM; nN = N / BM; nwg = nM * nN; G = G_; c = c_; }
    __host__ __device__ bool next(int i, Unit& u) const {
        const long L = (long)i * G + c; if (L >= nwg) return false;
        int wgid = (int)L; { const int q = nwg / NXCD, r = nwg % NXCD, xcd = wgid % NXCD, off = wgid / NXCD; wgid = (xcd < r ? xcd * (q + 1) : r * (q + 1) + (xcd - r) * q) + off; }
        const int nig = WGM * nN, gid = wgid / nig, fm = gid * WGM, gsz = (nM - fm) < WGM ? (nM - fm) : WGM;
        u.pm = fm + ((wgid % nig) % gsz); u.pn = (wgid % nig) / gsz; return true;
    }
    __device__ __forceinline__ unsigned boff(const Gemm& g, const Unit& u) const { return (unsigned)u.pn * (unsigned)(BM * g.K * 2); }
    __device__ __forceinline__ void a_ready(const Unit&) const {}
    __device__ __forceinline__ void done(const Unit&) const {}
};
struct ExpertOrder : StaticOrder {
    const int* pexp; size_t estride; PG8_LAS int* tab;
    __device__ __forceinline__ void fill(int tid) const { Unit u; if (StaticOrder::next(tid, u)) tab[tid] = pexp[u.pm]; }
    __device__ __forceinline__ bool next(int i, Unit& u) const { const bool ok = StaticOrder::next(i, u); u.e = ok ? tab[i] : 0; return ok; }
    __device__ __forceinline__ unsigned boff(const Gemm& g, const Unit& u) const { return (unsigned)__builtin_amdgcn_readfirstlane(u.e) * (unsigned)estride + (unsigned)u.pn * (unsigned)(BM * g.K * 2); }
};
__device__ __forceinline__ float fast_sigmoid(float x) { return __builtin_amdgcn_rcpf(1.0f + __builtin_amdgcn_exp2f(-1.4426950408889634f * x)); }
__device__ __forceinline__ float bflo(unsigned w) { return __uint_as_float(w << 16); }
__device__ __forceinline__ float bfhi(unsigned w) { return __uint_as_float(w & 0xffff0000u); }
struct EpiPlain {
    static constexpr bool PERM = true, AFTER_DRAIN = false;
    bf16_t* O; int ldc; float sc;
    __device__ __forceinline__ void operator()(const f32x4 (&acc)[2][2][4][2], const Unit& u, int wr, int wc, int fr, int fq) const {
        const int row0 = u.pm * BM + wr * 64 + fr, col0 = u.pn * BM + wc * 32 + 8 * fq;
#pragma unroll
        for (int ai = 0; ai < 2; ++ai)
#pragma unroll
            for (int m = 0; m < 4; ++m) { bf16_t* rowp = O + (size_t)(row0 + ai * HALF + m * 16) * ldc + col0;
#pragma unroll
                for (int bj = 0; bj < 2; ++bj) { const f32x4 v0 = acc[ai][bj][m][0], v1 = acc[ai][bj][m][1];
                    u32x4 w; w.x = cvt_pk_bf16(v0[0], v0[1]); w.y = cvt_pk_bf16(v0[2], v0[3]); w.z = cvt_pk_bf16(v1[0], v1[1]); w.w = cvt_pk_bf16(v1[2], v1[3]);
                    *(u32x4*)(rowp + bj * HALF) = w; } }
    }
};
__device__ __forceinline__ unsigned pk4_fp8u(float a, float b, float c, float d) { int r; asm volatile("" : "=v"(r)); r = __builtin_amdgcn_cvt_pk_fp8_f32(a, b, r, false); r = __builtin_amdgcn_cvt_pk_fp8_f32(c, d, r, true); return (unsigned)r; }
__device__ __forceinline__ unsigned pk4_fp8(float a, float b, float c, float d) { int r = __builtin_amdgcn_cvt_pk_fp8_f32(a, b, 0, false); r = __builtin_amdgcn_cvt_pk_fp8_f32(c, d, r, true); return (unsigned)r; }
template <int HD> struct EpiWin {
    static constexpr bool PERM = true, AFTER_DRAIN = false;
    bf16_t* O; int ldc; const float* T; int qlo, qhi, klo, khi; float qsc, ksc;
    unsigned char* Q8; unsigned char* K8; int qcol0, kcol0;
    __device__ __forceinline__ void operator()(const f32x4 (&acc)[2][2][4][2], const Unit& u, int wr, int wc, int fr, int fq) const {
        const int row0 = u.pm * BM + wr * 64 + fr;
        const bool isq = u.pn >= qlo && u.pn < qhi, isk = u.pn >= klo && u.pn < khi;
        if (!isq && !isk) {
            const int col0 = u.pn * BM + wc * 32 + 8 * fq;
#pragma unroll
            for (int ai = 0; ai < 2; ++ai)
#pragma unroll
                for (int m = 0; m < 4; ++m) { bf16_t* rowp = O + (size_t)(row0 + ai * HALF + m * 16) * ldc + col0;
#pragma unroll
                    for (int bj = 0; bj < 2; ++bj) { const f32x4 v0 = acc[ai][bj][m][0], v1 = acc[ai][bj][m][1];
                        u32x4 w; w.x = cvt_pk_bf16(v0[0], v0[1]); w.y = cvt_pk_bf16(v0[2], v0[3]); w.z = cvt_pk_bf16(v1[0], v1[1]); w.w = cvt_pk_bf16(v1[2], v1[3]);
                        *(u32x4*)(rowp + bj * HALF) = w; } }
            return;
        }
        const float sc = isq ? qsc : ksc;
        const int jj0 = wc * 32 + 8 * fq, g = jj0 / HD, d0 = jj0 % HD, Q = HD / 2;
        const int col1 = u.pn * BM + g * (2 * HD) + d0, dq = d0 % Q; const bool byrow = d0 < Q;
#pragma unroll
        for (int ai = 0; ai < 2; ++ai)
#pragma unroll
            for (int m = 0; m < 4; ++m) { const int r = row0 + ai * HALF + m * 16, t = r % 8448;
                float o1[8], o2[8];
                if (t >= 256) { const int tl = t - 256, pos = byrow ? (tl >> 6) : (tl & 63); const f32x4* cs = (const f32x4*)(T + (size_t)(pos * Q + dq) * 2);
                    const f32x4 c0 = cs[0], c1 = cs[1], c2 = cs[2], c3 = cs[3];
                    const float cc[8] = {c0[0], c0[2], c1[0], c1[2], c2[0], c2[2], c3[0], c3[2]}, ss[8] = {c0[1], c0[3], c1[1], c1[3], c2[1], c2[3], c3[1], c3[3]};
#pragma unroll
                    for (int e = 0; e < 8; ++e) { const float x1 = acc[ai][0][m][e >> 2][e & 3], x2 = acc[ai][1][m][e >> 2][e & 3]; o1[e] = (x1 * cc[e] - x2 * ss[e]) * sc; o2[e] = (x1 * ss[e] + x2 * cc[e]) * sc; }
                } else {
#pragma unroll
                    for (int e = 0; e < 8; ++e) { o1[e] = acc[ai][0][m][e >> 2][e & 3] * sc; o2[e] = acc[ai][1][m][e >> 2][e & 3] * sc; }
                }
                if (Q8) { unsigned char* p8 = (isq ? Q8 + (size_t)r * 768 + (col1 - qcol0) : K8 + (size_t)r * 768 + (col1 - kcol0));
                    typedef unsigned u32x2 __attribute__((ext_vector_type(2)));
                    u32x2 w8; w8.x = pk4_fp8(o1[0], o1[1], o1[2], o1[3]); w8.y = pk4_fp8(o1[4], o1[5], o1[6], o1[7]); *(u32x2*)p8 = w8;
                    w8.x = pk4_fp8(o2[0], o2[1], o2[2], o2[3]); w8.y = pk4_fp8(o2[4], o2[5], o2[6], o2[7]); *(u32x2*)(p8 + HD) = w8; continue; }
                bf16_t* rowp = O + (size_t)r * ldc + col1;
                u32x4 w; w.x = cvt_pk_bf16(o1[0], o1[1]); w.y = cvt_pk_bf16(o1[2], o1[3]); w.z = cvt_pk_bf16(o1[4], o1[5]); w.w = cvt_pk_bf16(o1[6], o1[7]);
                *(u32x4*)rowp = w;
                w.x = cvt_pk_bf16(o2[0], o2[1]); w.y = cvt_pk_bf16(o2[2], o2[3]); w.z = cvt_pk_bf16(o2[4], o2[5]); w.w = cvt_pk_bf16(o2[6], o2[7]);
                *(u32x4*)(rowp + HD) = w; }
    }
};
struct EpiSwiGLU {
    static constexpr bool PERM = true, AFTER_DRAIN = false;
    bf16_t* O; int ldc;
    __device__ __forceinline__ void operator()(const f32x4 (&acc)[2][2][4][2], const Unit& u, int wr, int wc, int fr, int fq) const {
        const int row0 = u.pm * BM + wr * 64 + fr, col0 = u.pn * HALF + wc * 32 + 8 * fq;
#pragma unroll
        for (int ai = 0; ai < 2; ++ai)
#pragma unroll
            for (int m = 0; m < 4; ++m) { bf16_t* rowp = O + (size_t)(row0 + ai * HALF + m * 16) * ldc + col0;
                float o[8];
#pragma unroll
                for (int n = 0; n < 2; ++n)
#pragma unroll
                    for (int i = 0; i < 4; ++i) { const float g = acc[ai][0][m][n][i], up = acc[ai][1][m][n][i]; o[n * 4 + i] = g * fast_sigmoid(g) * up; }
                u32x4 w; w.x = cvt_pk_bf16(o[0], o[1]); w.y = cvt_pk_bf16(o[2], o[3]); w.z = cvt_pk_bf16(o[4], o[5]); w.w = cvt_pk_bf16(o[6], o[7]);
                *(u32x4*)rowp = w; }
    }
};
struct EpiSwiGLU8 {
    static constexpr bool PERM = true, AFTER_DRAIN = false;
    unsigned char* O; int ldc; float sc;
    __device__ __forceinline__ void operator()(const f32x4 (&acc)[2][2][4][2], const Unit& u, int wr, int wc, int fr, int fq) const {
        const int row0 = u.pm * BM + wr * 64 + fr, col0 = u.pn * HALF + wc * 32 + 8 * fq;
        const float kx = -1.4426950408889634f * sc, cc = 1.0f / (sc * sc);
#pragma unroll
        for (int ai = 0; ai < 2; ++ai)
#pragma unroll
            for (int m = 0; m < 4; ++m) { unsigned char* rowp = O + (size_t)(row0 + ai * HALF + m * 16) * ldc + col0;
                float o[8];
#pragma unroll
                for (int n = 0; n < 2; ++n)
#pragma unroll
                    for (int i = 0; i < 4; i += 2) { typedef float f32x2e __attribute__((ext_vector_type(2)));
                        const f32x2e ag = {acc[ai][0][m][n][i], acc[ai][0][m][n][i + 1]}, au = {acc[ai][1][m][n][i], acc[ai][1][m][n][i + 1]};
                        const f32x2e x = ag * kx; const f32x2e e = {__builtin_amdgcn_exp2f(x.x), __builtin_amdgcn_exp2f(x.y)};
                        const f32x2e d = e * cc + cc; const f32x2e r = {__builtin_amdgcn_rcpf(d.x), __builtin_amdgcn_rcpf(d.y)};
                        const f32x2e o2 = (ag * au) * r; o[n * 4 + i] = o2.x; o[n * 4 + i + 1] = o2.y; }
                typedef unsigned u32x2 __attribute__((ext_vector_type(2)));
                u32x2 w; w.x = pk4_fp8u(o[0], o[1], o[2], o[3]); w.y = pk4_fp8u(o[4], o[5], o[6], o[7]);
                *(u32x2*)rowp = w; }
    }
};
struct EpiGLU {
    static constexpr bool PERM = true, AFTER_DRAIN = false;
    bf16_t* O; int ldc; const bf16_t* Z; int ldz; const float* bias;
    __device__ __forceinline__ void operator()(const f32x4 (&acc)[2][2][4][2], const Unit& u, int wr, int wc, int fr, int fq) const {
        const int row0 = u.pm * BM + wr * 64 + fr, col0 = u.pn * BM + wc * 32 + 8 * fq;
#pragma unroll
        for (int bj = 0; bj < 2; ++bj) { const f32x4 b0 = *(const f32x4*)(bias + col0 + bj * HALF), b1 = *(const f32x4*)(bias + col0 + bj * HALF + 4);
#pragma unroll
            for (int ai = 0; ai < 2; ++ai)
#pragma unroll
                for (int m = 0; m < 4; ++m) { const size_t r = (size_t)(row0 + ai * HALF + m * 16);
                    const u32x4 zz = *(const u32x4*)(Z + r * ldz + col0 + bj * HALF);
                    const f32x4 v0 = acc[ai][bj][m][0] + b0, v1 = acc[ai][bj][m][1] + b1;
                    u32x4 w; w.x = cvt_pk_bf16(bflo(zz.x) * fast_sigmoid(v0[0]), bfhi(zz.x) * fast_sigmoid(v0[1])); w.y = cvt_pk_bf16(bflo(zz.y) * fast_sigmoid(v0[2]), bfhi(zz.y) * fast_sigmoid(v0[3]));
                    w.z = cvt_pk_bf16(bflo(zz.z) * fast_sigmoid(v1[0]), bfhi(zz.z) * fast_sigmoid(v1[1])); w.w = cvt_pk_bf16(bflo(zz.w) * fast_sigmoid(v1[2]), bfhi(zz.w) * fast_sigmoid(v1[3]));
                    *(u32x4*)(O + r * ldc + col0 + bj * HALF) = w; } }
    }
};
struct RouteEnt { int tok; int slot; float w; int pad; };
struct EpiScatter {
    static constexpr bool PERM = true, AFTER_DRAIN = false;
    const RouteEnt* L; bf16_t* Y; size_t slot_stride; int ldc; float sc;
    __device__ __forceinline__ void operator()(const f32x4 (&acc)[2][2][4][2], const Unit& u, int wr, int wc, int fr, int fq) const {
        const int row0 = u.pm * BM + wr * 64 + fr, col0 = u.pn * BM + wc * 32 + 8 * fq;
#pragma unroll
        for (int ai = 0; ai < 2; ++ai)
#pragma unroll
            for (int m = 0; m < 4; ++m) { const RouteEnt e = L[row0 + ai * HALF + m * 16];
                if (e.tok >= 0) { bf16_t* rowp = Y + (size_t)e.slot * slot_stride + (size_t)e.tok * ldc + col0;
#pragma unroll
                    for (int bj = 0; bj < 2; ++bj) { const float ww = e.w * sc; const f32x4 v0 = acc[ai][bj][m][0] * ww, v1 = acc[ai][bj][m][1] * ww;
                        u32x4 w; w.x = cvt_pk_bf16(v0[0], v0[1]); w.y = cvt_pk_bf16(v0[2], v0[3]); w.z = cvt_pk_bf16(v1[0], v1[1]); w.w = cvt_pk_bf16(v1[2], v1[3]);
                        *(u32x4*)(rowp + bj * HALF) = w; } } }
    }
};
template <class Epi, class Sched, bool ALIGN_EPI = false, bool SP2 = false, bool F8 = false>
__device__ __forceinline__ void gemm_phase(PG8_LAS unsigned char* lds, const Gemm g, const Sched& S, const Epi& E, const int tid) {
    const int wid = __builtin_amdgcn_readfirstlane(tid >> 6), lane = tid & 63, wr = wid >> 2, wc = wid & 3, fr = lane & 15, fq = lane >> 4;
    const int K = g.K, nt = K / BK;
    unsigned voffA[2], voffB[2];
#pragma unroll
    for (int i = 0; i < 2; ++i) { int R, C; stage_rc(tid * 16 + i * 8192, R, C); const int Rb = Epi::PERM ? ((R & ~31) + perm32(R & 31)) : R;
        voffA[i] = (unsigned)(R * K + C) * 2u; voffB[i] = (unsigned)(Rb * K + C) * 2u; }
    const unsigned kstep = (unsigned)(BK * 2);
    const unsigned hstep = (unsigned)HALF * K * 2;
    const unsigned tstep = 2 * hstep;
    const __amdgpu_buffer_rsrc_t rsA = __builtin_amdgcn_make_buffer_rsrc((void*)g.A, 0, 0x7fffffff, 0x00020000), rsB = __builtin_amdgcn_make_buffer_rsrc((void*)g.Bt, 0, 0x7fffffff, 0x00020000);
    const unsigned ldsw = (unsigned)wid * 1024u;
    const int aoff = lds_byte(wr * 64 + fr, fq * 8), boff = lds_byte(wc * 32 + fr, fq * 8);
#define PG8_SA(b, h) (((b) * 2 + (h)) * HTB)
#define PG8_SB(b, h) ((4 + (b) * 2 + (h)) * HTB)
#define PG8_STAGE(rs, bufoff, goff, voff) do { _Pragma("unroll") for (int _i = 0; _i < 2; ++_i) \
        __builtin_amdgcn_raw_ptr_buffer_load_lds(rs, (PG8_LAS unsigned*)(lds + (bufoff) + ldsw + _i * 8192), 16, (int)(voff)[_i], (int)(goff), 0, 0); } while (0)
#define PG8_LDA(dst, b, h) do { if constexpr (F8) { _Pragma("unroll") for (int m = 0; m < 4; ++m) dst##8[m] = __builtin_shufflevector(*(const PG8_LAS v4i_t*)(lds + PG8_SA(b, h) + aoff + m * 2048), *(const PG8_LAS v4i_t*)(lds + PG8_SA(b, h) + aoff + m * 2048 + 1024), 0, 1, 2, 3, 4, 5, 6, 7); } \
    else { _Pragma("unroll") for (int m = 0; m < 4; ++m) _Pragma("unroll") for (int k = 0; k < 2; ++k) dst[m][k] = *(const PG8_LAS bf16x8*)(lds + PG8_SA(b, h) + aoff + m * 2048 + k * 1024); } } while (0)
#define PG8_LDB(dst, b, h) do { if constexpr (F8) { _Pragma("unroll") for (int n = 0; n < 2; ++n) dst##8[n] = __builtin_shufflevector(*(const PG8_LAS v4i_t*)(lds + PG8_SB(b, h) + boff + n * 2048), *(const PG8_LAS v4i_t*)(lds + PG8_SB(b, h) + boff + n * 2048 + 1024), 0, 1, 2, 3, 4, 5, 6, 7); } \
    else { _Pragma("unroll") for (int n = 0; n < 2; ++n) _Pragma("unroll") for (int k = 0; k < 2; ++k) dst[n][k] = *(const PG8_LAS bf16x8*)(lds + PG8_SB(b, h) + boff + n * 2048 + k * 1024); } } while (0)
#define PG8_MMA(ai, bj, At, Bt) do { __builtin_amdgcn_s_setprio(1); _Pragma("unroll") for (int m = 0; m < 4; ++m) _Pragma("unroll") for (int n = 0; n < 2; ++n) { \
        if constexpr (F8) acc[ai][bj][m][n] = __builtin_amdgcn_mfma_scale_f32_16x16x128_f8f6f4(Bt##8[n], At##8[m], acc[ai][bj][m][n], 0, 0, 0, 0x7f7f7f7f, 0, 0x7f7f7f7f); \
        else { _Pragma("unroll") for (int k = 0; k < 2; ++k) acc[ai][bj][m][n] = __builtin_amdgcn_mfma_f32_16x16x32_bf16(Bt[n][k], At[m][k], acc[ai][bj][m][n], 0, 0, 0); } } \
        __builtin_amdgcn_s_setprio(0); } while (0)
#define PG8_WAIT_V(n) asm volatile("s_waitcnt vmcnt(" #n ")" ::: "memory")
#define PG8_WAIT_L(n) asm volatile("s_waitcnt lgkmcnt(" #n ")" ::: "memory")
#define PG8_BAR __builtin_amdgcn_s_barrier()
#define PG8_SCHED __builtin_amdgcn_sched_barrier(0)
    Unit cur, nxt; int ui = 0;
    if (!S.next(0, cur)) return;
    f32x4 acc[2][2][4][2];
#pragma unroll
    for (int a = 0; a < 2; ++a)
#pragma unroll
        for (int b = 0; b < 2; ++b)
#pragma unroll
            for (int m = 0; m < 4; ++m)
#pragma unroll
                for (int n = 0; n < 2; ++n) acc[a][b][m][n] = (f32x4){0.f, 0.f, 0.f, 0.f};
    bf16x8 At[4][2], B0[2][2], B1[2][2]; v8i_t At8[4], B08[2], B18[2];
    unsigned cA = (unsigned)cur.pm * tstep, cB = S.boff(g, cur);
    S.a_ready(cur);
    if constexpr (SP2) {
        PG8_STAGE(rsB, PG8_SB(0, 0), cB, voffB); PG8_STAGE(rsB, PG8_SB(0, 1), cB + hstep, voffB); PG8_STAGE(rsA, PG8_SA(0, 0), cA, voffA); PG8_STAGE(rsA, PG8_SA(0, 1), cA + hstep, voffA);
        if (wr == 1) PG8_BAR;
        PG8_WAIT_V(2); PG8_BAR;
        PG8_STAGE(rsB, PG8_SB(1, 0), cB + kstep, voffB); PG8_STAGE(rsA, PG8_SA(1, 0), cA + kstep, voffA); PG8_STAGE(rsB, PG8_SB(1, 1), cB + hstep + kstep, voffB);
        PG8_WAIT_V(6); PG8_BAR;
    } else {
        PG8_STAGE(rsB, PG8_SB(0, 0), cB, voffB); PG8_STAGE(rsA, PG8_SA(0, 0), cA, voffA); PG8_STAGE(rsB, PG8_SB(0, 1), cB + hstep, voffB); PG8_STAGE(rsA, PG8_SA(0, 1), cA + hstep, voffA);
        if (wr == 1) PG8_BAR;
        PG8_WAIT_V(4); PG8_BAR;
        PG8_STAGE(rsB, PG8_SB(1, 0), cB + kstep, voffB); PG8_STAGE(rsA, PG8_SA(1, 0), cA + kstep, voffA); PG8_STAGE(rsB, PG8_SB(1, 1), cB + hstep + kstep, voffB);
        PG8_WAIT_V(6); PG8_BAR;
    }
    for (;;) {
        const bool has_next = S.next(ui + 1, nxt);
        const unsigned nA = has_next ? (unsigned)nxt.pm * tstep : cA, nB = has_next ? S.boff(g, nxt) : cB;
        for (int t = 0; t < nt; t += 2) {
            const bool last = (t == nt - 2);
            const unsigned a1 = cA + (unsigned)(t + 1) * kstep;
            const unsigned a2 = last ? nA : cA + (unsigned)(t + 2) * kstep, b2 = last ? nB : cB + (unsigned)(t + 2) * kstep;
            const unsigned a3 = a2 + kstep, b3 = b2 + kstep;
            if (last && has_next) S.a_ready(nxt);
            if constexpr (SP2) {
            PG8_LDB(B0, 0, 0); PG8_LDB(B1, 0, 1); PG8_SCHED; PG8_LDA(At, 0, 0); PG8_STAGE(rsA, PG8_SA(1, 1), a1 + hstep, voffA);
            PG8_WAIT_V(8); PG8_WAIT_L(0); PG8_BAR; PG8_MMA(0, 0, At, B0); PG8_MMA(0, 1, At, B1); PG8_BAR; PG8_SCHED;
            PG8_LDA(At, 0, 1); PG8_STAGE(rsB, PG8_SB(0, 0), b2, voffB); PG8_STAGE(rsB, PG8_SB(0, 1), b2 + hstep, voffB); PG8_STAGE(rsA, PG8_SA(0, 0), a2, voffA);
            PG8_WAIT_V(8); PG8_WAIT_L(0); PG8_BAR; PG8_MMA(1, 0, At, B0); PG8_MMA(1, 1, At, B1); PG8_BAR; PG8_SCHED;
            PG8_LDB(B0, 1, 0); PG8_LDB(B1, 1, 1); PG8_SCHED; PG8_LDA(At, 1, 0); PG8_STAGE(rsA, PG8_SA(0, 1), a2 + hstep, voffA);
            PG8_WAIT_V(8); PG8_WAIT_L(0); PG8_BAR; PG8_MMA(0, 0, At, B0); PG8_MMA(0, 1, At, B1); PG8_BAR; PG8_SCHED;
            PG8_LDA(At, 1, 1); PG8_STAGE(rsB, PG8_SB(1, 0), b3, voffB); PG8_STAGE(rsB, PG8_SB(1, 1), b3 + hstep, voffB); PG8_STAGE(rsA, PG8_SA(1, 0), a3, voffA);
            PG8_WAIT_V(8); PG8_WAIT_L(0); PG8_BAR; PG8_MMA(1, 0, At, B0); PG8_MMA(1, 1, At, B1); PG8_BAR; PG8_SCHED;
            } else {
            PG8_LDB(B0, 0, 0); PG8_SCHED; PG8_LDA(At, 0, 0); PG8_STAGE(rsA, PG8_SA(1, 1), a1 + hstep, voffA);
            PG8_WAIT_L(8); PG8_BAR; PG8_WAIT_L(0); PG8_MMA(0, 0, At, B0); PG8_BAR; PG8_SCHED;
            PG8_LDB(B1, 0, 1); PG8_STAGE(rsB, PG8_SB(0, 0), b2, voffB);
            PG8_BAR; PG8_WAIT_L(0); PG8_MMA(0, 1, At, B1); PG8_BAR;
            PG8_LDA(At, 0, 1); PG8_STAGE(rsA, PG8_SA(0, 0), a2, voffA);
            PG8_BAR; PG8_WAIT_L(0); PG8_MMA(1, 0, At, B0); PG8_BAR; PG8_SCHED;
            PG8_STAGE(rsB, PG8_SB(0, 1), b2 + hstep, voffB);
            PG8_WAIT_V(6); PG8_BAR; PG8_MMA(1, 1, At, B1); PG8_BAR;
            PG8_LDB(B0, 1, 0); PG8_SCHED; PG8_LDA(At, 1, 0); PG8_STAGE(rsA, PG8_SA(0, 1), a2 + hstep, voffA);
            PG8_WAIT_L(8); PG8_BAR; PG8_WAIT_L(0); PG8_MMA(0, 0, At, B0); PG8_BAR; PG8_SCHED;
            PG8_LDB(B1, 1, 1); PG8_STAGE(rsB, PG8_SB(1, 0), b3, voffB);
            PG8_BAR; PG8_WAIT_L(0); PG8_MMA(0, 1, At, B1); PG8_BAR;
            PG8_LDA(At, 1, 1); PG8_STAGE(rsA, PG8_SA(1, 0), a3, voffA);
            PG8_BAR; PG8_WAIT_L(0); PG8_MMA(1, 0, At, B0); PG8_BAR; PG8_SCHED;
            PG8_STAGE(rsB, PG8_SB(1, 1), b3 + hstep, voffB);
            PG8_WAIT_V(6); PG8_BAR; PG8_MMA(1, 1, At, B1); PG8_BAR;
            }
        }
        if constexpr (ALIGN_EPI) { if (wr == 0) PG8_BAR; }
        if constexpr (!Epi::AFTER_DRAIN) { E(acc, cur, wr, wc, fr, fq); S.done(cur); }
        if (!has_next) break;
#pragma unroll
        for (int a = 0; a < 2; ++a)
#pragma unroll
            for (int b = 0; b < 2; ++b)
#pragma unroll
                for (int m = 0; m < 4; ++m)
#pragma unroll
                    for (int n = 0; n < 2; ++n) acc[a][b][m][n] = (f32x4){0.f, 0.f, 0.f, 0.f};
        cur = nxt; cA = nA; cB = nB; ++ui;
        if constexpr (ALIGN_EPI) { if (wr == 1) PG8_BAR; }
    }
    PG8_WAIT_V(0);
    if constexpr (!ALIGN_EPI) { if (wr == 0) PG8_BAR; }
    PG8_BAR;
    if constexpr (Epi::AFTER_DRAIN) { E.fused(acc, cur, wr, wc, fr, fq, lds, wid, lane); S.done(cur); }
#undef PG8_SA
#undef PG8_SB
#undef PG8_STAGE
#undef PG8_LDA
#undef PG8_LDB
#undef PG8_MMA
#undef PG8_WAIT_V
#undef PG8_WAIT_L
#undef PG8_BAR
#undef PG8_SCHED
}
}

#define GAS __attribute__((address_space(1)))
#define LAS __attribute__((address_space(3)))
#define XB_TMO      128
#define XB_XCNT(j)  (256  + 64 * (j))
#define XB_XSUB(j)  (1280 + 64 * (j))
#define XB_XGEN(j)  (2304 + 64 * (j))
#define XB_TOP      3328
#define XB_TOPGEN   3392
#define XCD_BAR_WORDS 3456
#define XB_SPIN_CAP (1u << 18)

__device__ __forceinline__ unsigned xb_ld(unsigned* p)              { return __hip_atomic_load(p, __ATOMIC_RELAXED, __HIP_MEMORY_SCOPE_AGENT); }
__device__ __forceinline__ unsigned xb_add(unsigned* p, unsigned v) { return __hip_atomic_fetch_add(p, v, __ATOMIC_RELAXED, __HIP_MEMORY_SCOPE_AGENT); }
__device__ __forceinline__ unsigned xb_xcc_id() { return (unsigned)__builtin_amdgcn_s_getreg((3 << 11) | 20) & 0xFu; }
#define XB_SPIN(cond, bar) do { unsigned _sp = 0; while (cond) { __builtin_amdgcn_s_sleep(1); \
    if ((++_sp & 255u) == 0u) { if (xb_ld(&(bar)[XB_TMO])) break; if (_sp > XB_SPIN_CAP) { atomicAdd(&(bar)[XB_TMO], 1u); break; } } } } while (0)

struct XcdBarrier {
    unsigned* bar; unsigned x;
    volatile LAS unsigned* st;
};

__device__ __forceinline__ XcdBarrier xcd_barrier_post(unsigned* bar, volatile LAS unsigned* st) {
    XcdBarrier b; b.bar = bar; b.x = xb_xcc_id(); b.st = st;
    if (threadIdx.x == 0) (void)xb_add(&bar[XB_XCNT(b.x)], 1u);
    return b;
}
__device__ __forceinline__ void xcd_barrier_complete(unsigned* bar, unsigned x, unsigned& nloc, unsigned& nx) {
    const unsigned G = gridDim.x * gridDim.y * gridDim.z;
    unsigned sum, cnt, mine, sp = 0u;
    for (;;) {
        sum = 0u; cnt = 0u; mine = 0u;
#pragma unroll
        for (unsigned j = 0; j < 16; ++j) { const unsigned c = xb_ld(&bar[XB_XCNT(j)]); sum += c; cnt += (c > 0u) ? 1u : 0u; mine = (j == x) ? c : mine; }
        if (sum == G) break;
        __builtin_amdgcn_s_sleep(1);
        if ((++sp & 255u) == 0u) { if (xb_ld(&bar[XB_TMO])) break; if (sp > XB_SPIN_CAP) { atomicAdd(&bar[XB_TMO], 1u); break; } }
    }
    nloc = mine > 0u ? mine : 1u; nx = cnt > 0u ? cnt : 1u;
}

__device__ __forceinline__ void xcd_barrier(const XcdBarrier& b, const bool leader_thread  ) {
    asm volatile("s_waitcnt vmcnt(0)" ::: "memory");
    __syncthreads();
    if (leader_thread) {
        unsigned* bar = b.bar;
        __builtin_amdgcn_s_waitcnt(0);
        unsigned nloc = b.st[0], nx = b.st[1];
        if (nloc == 0u) { xcd_barrier_complete(bar, b.x, nloc, nx); b.st[0] = nloc; b.st[1] = nx; }
        const unsigned old = xb_add(&bar[XB_XSUB(b.x)], 1u);
        const unsigned gen = old / nloc;
        if (old + 1u == (gen + 1u) * nloc) {
            __builtin_amdgcn_fence(__ATOMIC_RELEASE, "agent");
            asm volatile("s_waitcnt vmcnt(0)" ::: "memory");
            const unsigned og = xb_add(&bar[XB_TOP], 1u);
            const unsigned tg = og / nx;
            if (og + 1u == (tg + 1u) * nx) xb_add(&bar[XB_TOPGEN], 1u);
            else XB_SPIN(xb_ld(&bar[XB_TOPGEN]) == tg, bar);
            __builtin_amdgcn_fence(__ATOMIC_ACQUIRE, "agent");
            xb_add(&bar[XB_XGEN(b.x)], 1u);
            asm volatile("s_waitcnt vmcnt(0)" ::: "memory");
        } else {
            XB_SPIN(xb_ld(&bar[XB_XGEN(b.x)]) == gen, bar);
            __builtin_amdgcn_fence(__ATOMIC_ACQUIRE, "agent");
            asm volatile("s_waitcnt vmcnt(0)" ::: "memory");
        }
    }
    __syncthreads();
}
constexpr int D = 1024, NB = 8, SEQ = 8192, CTXL = 256, TB = SEQ + CTXL, M = NB * TB;
constexpr int EV_IN = 3072, OD_IN = 2560, DFF = 3584, NE = 8, NLAYER = 4;
constexpr int NPANEL = M / 256;
constexpr int PW = 280, MAXP = 536;
constexpr float EPS = 1e-6f;
constexpr size_t MiB = 1u << 20;
constexpr size_t WS_CTL = 0, CTL_ZERO_BYTES = 1 * MiB;
constexpr size_t WS_MOD = 1 * MiB;
constexpr size_t WS_ROPE_R = 2 * MiB, WS_ROPE_D = 2 * MiB + 65536;
constexpr size_t WS_ROUTE = 3 * MiB;
constexpr size_t WS_WGCNT = 5 * MiB;
constexpr size_t WS_PEXP = 5 * MiB + 65536;
constexpr size_t WS_LIST = 6 * MiB;
constexpr size_t WS_W = 20 * MiB;
constexpr size_t WS_X = 116 * MiB;
constexpr size_t WS_H = 248 * MiB;
constexpr size_t WS_Y = 380 * MiB;
constexpr size_t WS_BIG = 644 * MiB;
constexpr size_t WS_W2 = 1044 * MiB;
constexpr size_t WS_END = 1128 * MiB;
constexpr size_t W_IN = 0, W_OUT = 6 * MiB, W_GU = 8 * MiB, W_DN = 16 * MiB;
constexpr size_t W_GLU = 8 * MiB;
constexpr size_t W2_MGU = 0, W2_MDN = 56 * MiB;
constexpr size_t Y_SLOT = (size_t)M * 1024 * 2;
constexpr size_t T_HALF = (size_t)M * 512 * 2;
constexpr size_t T_QUART = (size_t)M * 256 * 2;
constexpr size_t BIG_ACT = 0, BIG_HG = 246 * MiB;
constexpr int CW_TMO = 0, CW_BAR = 4096;
constexpr int RING_BYTES = 131072, LDSCTL_OFF = RING_BYTES + 8192, MISC_OFF = LDSCTL_OFF + 320, LDS_BYTES = 147456;
typedef unsigned short bf16;
typedef unsigned v4u __attribute__((ext_vector_type(4)));
typedef unsigned v2u __attribute__((ext_vector_type(2)));
typedef float f32x4 __attribute__((ext_vector_type(4)));
typedef float f32x16 __attribute__((ext_vector_type(16)));
typedef short bf16x8 __attribute__((ext_vector_type(8)));
typedef short s16x4 __attribute__((ext_vector_type(4)));
#define RLX_AGENT __ATOMIC_RELAXED, __HIP_MEMORY_SCOPE_AGENT
using pg8::cvt_pk_bf16; using pg8::bflo; using pg8::bfhi; using pg8::RouteEnt;
struct RouteRow { int e1, e2; float p1, p2; };
__device__ __forceinline__ float bf2f(bf16 v) { return __uint_as_float((unsigned)v << 16); }
__device__ __forceinline__ float wave_sum(float v) {
#define DPP_ADD(ctrl, rmask) v += __builtin_bit_cast(float, __builtin_amdgcn_update_dpp(0, __builtin_bit_cast(int, v), (ctrl), (rmask), 0xF, false))
    DPP_ADD(0xB1, 0xF); DPP_ADD(0x4E, 0xF); DPP_ADD(0x141, 0xF); DPP_ADD(0x140, 0xF); DPP_ADD(0x142, 0xA); DPP_ADD(0x143, 0xC);
#undef DPP_ADD
    return __builtin_bit_cast(float, __builtin_amdgcn_readlane(__builtin_bit_cast(int, v), 63));
}
__device__ __forceinline__ float gelu_tanh(float x) {
    const float u = 0.7978845608028654f * (x + 0.044715f * x * x * x);
    return x * __builtin_amdgcn_rcpf(1.0f + __builtin_amdgcn_exp2f(-2.0f * 1.4426950408889634f * u));
}
__device__ __forceinline__ float sigmoidf_(float x) { return __builtin_amdgcn_rcpf(1.0f + __builtin_amdgcn_exp2f(-1.4426950408889634f * x)); }
struct Args { const float* in[38]; float* out; unsigned char* ws; int ph_lo, ph_hi, mode, pad; };
struct ArgsI { unsigned long long in[38]; unsigned long long out, ws; int ph_lo, ph_hi, mode, pad; };
typedef __attribute__((address_space(4))) const ArgsI KArgs;
#define INP(k) ((const float*)(GAS const float*)F.A->in[k])
#define OUTP ((float*)(GAS float*)F.A->out)
#define WSG ((unsigned char*)(GAS unsigned char*)F.wsi)
#define FMOD ((float*)(WSG + WS_MOD))
#define FX ((bf16*)(WSG + WS_X))
#define FH ((bf16*)(WSG + WS_H))
#define FWB ((bf16*)(WSG + WS_W))
#define FYB (WSG + WS_Y)
#define FBIG (WSG + WS_BIG)
#define LAUNDER(F) do { asm volatile("" : "+s"(F.wsi), "+s"(F.A), "+s"(F.wave), "+s"(F.bid), "+s"(F.G)); { unsigned z_ = 0u; asm volatile("" : "+v"(z_)); F.lane = (int)__builtin_amdgcn_mbcnt_hi(~0u, __builtin_amdgcn_mbcnt_lo(~0u, z_)); } F.tid = F.wave * 64 + F.lane; } while (0)
__device__ __forceinline__ bool lead0_lane() { unsigned z_ = 0u; asm volatile("" : "+v"(z_)); return __builtin_amdgcn_mbcnt_hi(~0u, __builtin_amdgcn_mbcnt_lo(~0u, z_)) == 0u; }
#define LEAD0(F) ((F).wave == 0 && lead0_lane())
struct Frame {
    LAS unsigned char* lds; unsigned long long wsi;
    int tid, lane, wave, G, bid;
    const KArgs* A;
};
#define LDS_WAIT() asm volatile("s_waitcnt lgkmcnt(0)" ::: "memory")

__device__ __forceinline__ void ph_prologue(Frame& F) {
    LAS float* SL = (LAS float*)F.lds;
    LAS float* RED = (LAS float*)(F.lds + 40960);
    const float* c = INP(1); const float* cc = INP(3); const float* mod_w = INP(4); const float* mod_b = INP(5);
    for (int i = F.tid; i < 9 * 1024; i += 512) { const float v = (i < 8192) ? c[i] : cc[i - 8192]; SL[i] = v * sigmoidf_(v); }
    __syncthreads();
    for (int blk = F.bid; blk < 4 * 96; blk += F.G) {
        const int l = blk / 96, n0 = (blk % 96) * 64;
        const float* wp = mod_w + ((size_t)l * 1024 + (size_t)F.wave * 128) * 6144 + n0 + F.lane;
        float acc[9];
#pragma unroll
        for (int j = 0; j < 9; ++j) acc[j] = 0.f;
        for (int k = 0; k < 128; ++k) { const float w = wp[(size_t)k * 6144];
#pragma unroll
            for (int j = 0; j < 9; ++j) acc[j] += SL[j * 1024 + F.wave * 128 + k] * w; }
#pragma unroll
        for (int j = 0; j < 9; ++j) RED[(F.wave * 9 + j) * 64 + F.lane] = acc[j];
        __syncthreads();
        for (int i = F.tid; i < 9 * 64; i += 512) { const int j = i >> 6, ln = i & 63; float s = mod_b[l * 6144 + n0 + ln];
#pragma unroll
            for (int w = 0; w < 8; ++w) s += RED[(w * 9 + j) * 64 + ln];
            FMOD[((size_t)l * 9 + j) * 6144 + n0 + ln] = s; }
        __syncthreads();
    }
    const int gt = F.bid * 512 + F.tid;
    if (gt < 128 * 32) { const int pos = gt >> 5, dq = gt & 31; const float inv = powf(10000.0f, -(float)dq / 32.0f); float s, cs; sincosf((float)pos * inv, &s, &cs);
        float* T = (float*)(WSG + WS_ROPE_R); T[gt * 2] = cs; T[gt * 2 + 1] = s; }
    else if (gt < 128 * 32 + 128 * 16) { const int g2 = gt - 128 * 32, pos = g2 >> 4, dq = g2 & 15; const float inv = powf(10000.0f, -(float)dq / 16.0f); float s, cs; sincosf((float)pos * inv, &s, &cs);
        float* T = (float*)(WSG + WS_ROPE_D); T[g2 * 2] = cs; T[g2 * 2 + 1] = s; }
}

__device__ __forceinline__ void transpose_item(const float* W, int K, int N, bf16* WT, int drow0, int k0, int n0, LAS float* scr, int lane) {
#pragma unroll
    for (int i = 0; i < 8; ++i) { const int kk = 8 * i + (lane >> 3), nn = (lane & 7) * 4; const f32x4 v = *(const f32x4*)(W + (size_t)(k0 + kk) * N + n0 + nn);
        scr[kk * 33 + nn] = v.x; scr[kk * 33 + nn + 1] = v.y; scr[kk * 33 + nn + 2] = v.z; scr[kk * 33 + nn + 3] = v.w; }
    LDS_WAIT(); asm volatile("" ::: "memory");
    const int c = lane & 7;
#pragma unroll
    for (int j = 0; j < 4; ++j) { const int n = (lane >> 3) + 8 * j; const LAS float* s = scr + (8 * c) * 33 + n;
        v4u o; o.x = cvt_pk_bf16(s[0 * 33], s[1 * 33]); o.y = cvt_pk_bf16(s[2 * 33], s[3 * 33]); o.z = cvt_pk_bf16(s[4 * 33], s[5 * 33]); o.w = cvt_pk_bf16(s[6 * 33], s[7 * 33]);
        *(v4u*)(WT + (size_t)(drow0 + n) * K + k0 + 8 * c) = o; }
    LDS_WAIT(); asm volatile("" ::: "memory");
}
__device__ __forceinline__ void convert_job(Frame& F, const float* W, int K, int N, bf16* WT, int mode) {
    LAS float* scr = (LAS float*)(F.lds + F.wave * 16384);
    const int gw = F.bid * 8 + F.wave, NGW = F.G * 8, nblk = N / 32, nit = (K / 64) * nblk;
    for (int it = gw; it < nit; it += NGW) { const int kb = it / nblk, nb = it % nblk, n0 = nb * 32;
        int drow0 = n0;
        if (mode == 1 || mode == 2) drow0 = (n0 >> 7) * 256 + (n0 & 127) + (mode == 2 ? 128 : 0);
        else if (mode == 3) { const int tile = n0 >> 8, w = n0 & 255; if (tile >= 4 && tile < 8) drow0 = tile * 256 + ((w >> 6) & 1) * 128 + (w >> 7) * 64 + (w & 63); }
        else if (mode == 4) { const int tile = n0 >> 8, w = n0 & 255; if (tile >= 1 && tile < 7) drow0 = tile * 256 + ((w >> 5) & 1) * 128 + (w >> 6) * 32 + (w & 31); }
        transpose_item(W, K, N, WT, drow0, kb * 64, n0, scr, F.lane); }
}
__device__ __forceinline__ void transpose_item_f8(const float* W, int K, int N, unsigned char* WT, int drow0, int k0, int n0, LAS float* scr, int lane, float wscale) {
#pragma unroll
    for (int i = 0; i < 8; ++i) { const int kk = 8 * i + (lane >> 3), nn = (lane & 7) * 4; const f32x4 v = *(const f32x4*)(W + (size_t)(k0 + kk) * N + n0 + nn);
        scr[kk * 33 + nn] = v.x * wscale; scr[kk * 33 + nn + 1] = v.y * wscale; scr[kk * 33 + nn + 2] = v.z * wscale; scr[kk * 33 + nn + 3] = v.w * wscale; }
    LDS_WAIT(); asm volatile("" ::: "memory");
#pragma unroll
    for (int j = 0; j < 2; ++j) { const int idx = lane + 64 * j, n = idx >> 2, c = idx & 3; const LAS float* s = scr + (16 * c) * 33 + n;
        v4u o; o.x = pg8::pk4_fp8(s[0 * 33], s[1 * 33], s[2 * 33], s[3 * 33]); o.y = pg8::pk4_fp8(s[4 * 33], s[5 * 33], s[6 * 33], s[7 * 33]);
        o.z = pg8::pk4_fp8(s[8 * 33], s[9 * 33], s[10 * 33], s[11 * 33]); o.w = pg8::pk4_fp8(s[12 * 33], s[13 * 33], s[14 * 33], s[15 * 33]);
        *(v4u*)(WT + (size_t)(drow0 + n) * K + k0 + 16 * c) = o; }
    LDS_WAIT(); asm volatile("" ::: "memory");
}
constexpr float W8_SCALE = 32.0f, W8_INV = 1.0f / 32.0f;
__device__ __forceinline__ void convert_job_f8(Frame& F, const float* W, int K, int N, unsigned char* WT, int mode, int wg0 = 0, int nwg = 0) {
    LAS float* scr = (LAS float*)(F.lds + F.wave * 16384);
    const int gw = (F.bid - wg0) * 8 + F.wave, NGW = (nwg ? nwg : F.G) * 8, nblk = N / 32, nit = (K / 64) * nblk;
    for (int it = gw; it < nit; it += NGW) { const int kb = it / nblk, nb = it % nblk, n0 = nb * 32;
        int drow0 = n0;
        if (mode == 1 || mode == 2) drow0 = (n0 >> 7) * 256 + (n0 & 127) + (mode == 2 ? 128 : 0);
        transpose_item_f8(W, K, N, WT, drow0, kb * 64, n0, scr, F.lane, W8_SCALE); }
}
__device__ __forceinline__ void ph_convert_moe(Frame& F, int i, int wg0, int nwg, int e0 = 0, int e1 = NE) {
    unsigned char* W2 = WSG + WS_W2;
    for (int e = e0; e < e1; ++e) {
        convert_job_f8(F, INP(35) + ((size_t)i * NE + e) * D * DFF, D, DFF, W2 + W2_MGU + (size_t)e * 7168 * 1024, 1, wg0, nwg);
        convert_job_f8(F, INP(36) + ((size_t)i * NE + e) * D * DFF, D, DFF, W2 + W2_MGU + (size_t)e * 7168 * 1024, 2, wg0, nwg);
        convert_job_f8(F, INP(37) + ((size_t)i * NE + e) * DFF * D, DFF, D, W2 + W2_MDN + (size_t)e * 1024 * 3584, 0, wg0, nwg);
    }
}
__device__ __forceinline__ void ph_convert(Frame& F, int l) {
    const int i = l >> 1; bf16* Wb = FWB;
    if ((l & 1) == 0) {
        convert_job(F, INP(7) + (size_t)i * D * EV_IN, D, EV_IN, Wb + W_IN / 2, 3);
        convert_job(F, INP(15) + (size_t)i * D * D, D, D, Wb + W_OUT / 2, 0);
        convert_job_f8(F, INP(16) + (size_t)i * D * DFF, D, DFF, (unsigned char*)Wb + W_GU, 1);
        convert_job_f8(F, INP(17) + (size_t)i * D * DFF, D, DFF, (unsigned char*)Wb + W_GU, 2);
        convert_job_f8(F, INP(18) + (size_t)i * DFF * D, DFF, D, (unsigned char*)Wb + W_DN, 0);
    } else {
        convert_job(F, INP(19) + (size_t)i * D * OD_IN, D, OD_IN, Wb + W_IN / 2, 4);
        convert_job(F, INP(32) + (size_t)i * D * D, D, D, Wb + W_OUT / 2, 0);
        convert_job(F, INP(28) + (size_t)i * 256 * 256, 256, 256, Wb + W_GLU / 2, 0);
    }
}

struct NormArgs {
    int xin_input, has_y, two, write_x, final_, do_h, do_route, h8;
    const float* gate; const float* gy;
    const float* gh; const float* shift; const float* scale;
    const float* rw; const float* rb;
};
__device__ __forceinline__ void ph_norm(Frame& F, const NormArgs& a) {
    LAS float* RWT = (LAS float*)F.lds;
    LAS int* cnt = (LAS int*)(F.lds + 32768);
    if (a.do_route) {
        for (int idx = F.tid; idx < 8192; idx += 512) RWT[(idx & 7) * 1024 + (idx >> 3)] = a.rw[idx];
        if (F.tid < 8) cnt[F.tid] = 0;
        __syncthreads();
    }
    const int r0 = (int)((long)M * F.bid / F.G), r1 = (int)((long)M * (F.bid + 1) / F.G);
    const bf16* Y0 = (const bf16*)FYB; const bf16* Y1 = (const bf16*)(FYB + Y_SLOT);
    const int c0 = 4 * F.lane;
    f32x4 pgy[4], pgh[4], pgt[4], psh[4], psc[4]; int cur_midx = -1;
#pragma unroll
    for (int j = 0; j < 4; ++j) { pgy[j] = a.has_y ? *(const f32x4*)(a.gy + c0 + 256 * j) : (f32x4){0.f, 0.f, 0.f, 0.f}; pgh[j] = a.do_h ? *(const f32x4*)(a.gh + c0 + 256 * j) : (f32x4){0.f, 0.f, 0.f, 0.f};
        pgt[j] = (f32x4){0.f, 0.f, 0.f, 0.f}; psh[j] = pgt[j]; psc[j] = pgt[j]; }
    f32x4 xn[4]; v2u xb[4], yn[4], zn[4];
#pragma unroll
    for (int j = 0; j < 4; ++j) { xn[j] = (f32x4){0.f, 0.f, 0.f, 0.f}; xb[j] = (v2u){0u, 0u}; yn[j] = (v2u){0u, 0u}; zn[j] = (v2u){0u, 0u}; }
#define NORM_LOAD(mm) do { const int b_ = (mm) / TB, t_ = (mm) - b_ * TB; const bool ic_ = t_ < CTXL; \
        if (a.xin_input) { const float* xi_ = ic_ ? (INP(2) + (size_t)(b_ * CTXL + t_) * D) : (INP(0) + (size_t)(b_ * SEQ + t_ - CTXL) * D); \
            _Pragma("unroll") for (int j = 0; j < 4; ++j) xn[j] = *(const f32x4*)(xi_ + c0 + 256 * j); } \
        else { _Pragma("unroll") for (int j = 0; j < 4; ++j) xb[j] = *(const v2u*)(FX + (size_t)(mm) * D + c0 + 256 * j); } \
        _Pragma("unroll") for (int j = 0; j < 4; ++j) { \
            if (a.has_y) yn[j] = *(const v2u*)(Y0 + (size_t)(mm) * D + c0 + 256 * j); if (a.two) zn[j] = *(const v2u*)(Y1 + (size_t)(mm) * D + c0 + 256 * j); } } while (0)
    int m = r0 + F.wave;
    if (m < r1) NORM_LOAD(m);
    for (; m < r1; m += 8) {
        const int b = m / TB, t = m - b * TB; const bool isctx = t < CTXL; const int midx = isctx ? 8 : b;
        f32x4 x[4]; v2u yv[4], zv[4];
#pragma unroll
        for (int j = 0; j < 4; ++j) { x[j] = a.xin_input ? xn[j] : (f32x4){bflo(xb[j].x), bfhi(xb[j].x), bflo(xb[j].y), bfhi(xb[j].y)}; yv[j] = yn[j]; zv[j] = zn[j]; }
        if (m + 8 < r1) NORM_LOAD(m + 8);
        if (midx != cur_midx) { cur_midx = midx;
#pragma unroll
            for (int j = 0; j < 4; ++j) { if (a.has_y) pgt[j] = *(const f32x4*)(a.gate + (size_t)midx * 6144 + c0 + 256 * j);
                if (a.do_h) { psh[j] = *(const f32x4*)(a.shift + (size_t)midx * 6144 + c0 + 256 * j); psc[j] = *(const f32x4*)(a.scale + (size_t)midx * 6144 + c0 + 256 * j); } } }
        if (a.has_y) {
            f32x4 y[4]; float ss = 0.f;
#pragma unroll
            for (int j = 0; j < 4; ++j) { y[j] = (f32x4){bflo(yv[j].x), bfhi(yv[j].x), bflo(yv[j].y), bfhi(yv[j].y)};
                if (a.two) y[j] += (f32x4){bflo(zv[j].x), bfhi(zv[j].x), bflo(zv[j].y), bfhi(zv[j].y)};
                ss += (y[j].x * y[j].x + y[j].y * y[j].y) + (y[j].z * y[j].z + y[j].w * y[j].w); }
            const float rs = 1.0f / sqrtf(wave_sum(ss) * (1.0f / D) + EPS);
#pragma unroll
            for (int j = 0; j < 4; ++j) x[j] += pgt[j] * (y[j] * rs * pgy[j]);
        }
        if (a.final_) { if (!isctx) { float* o_ = OUTP + (size_t)(b * SEQ + t - CTXL) * D;
#pragma unroll
            for (int j = 0; j < 4; ++j) *(f32x4*)(o_ + c0 + 256 * j) = x[j]; } }
        else if (a.write_x) {
#pragma unroll
            for (int j = 0; j < 4; ++j) { v2u w_; w_.x = cvt_pk_bf16(x[j].x, x[j].y); w_.y = cvt_pk_bf16(x[j].z, x[j].w); *(v2u*)(FX + (size_t)m * D + c0 + 256 * j) = w_; }
        }
        if (a.do_h) {
            float ss = 0.f;
#pragma unroll
            for (int j = 0; j < 4; ++j) ss += (x[j].x * x[j].x + x[j].y * x[j].y) + (x[j].z * x[j].z + x[j].w * x[j].w);
            const float rs = 1.0f / sqrtf(wave_sum(ss) * (1.0f / D) + EPS);
            f32x4 h[4];
#pragma unroll
            for (int j = 0; j < 4; ++j) { h[j] = (x[j] * rs * pgh[j]) * (psc[j] + 1.0f) + psh[j];
                if (a.h8) *(unsigned*)((unsigned char*)FH + (size_t)m * D + c0 + 256 * j) = pg8::pk4_fp8(h[j].x, h[j].y, h[j].z, h[j].w);
                else { v2u w; w.x = cvt_pk_bf16(h[j].x, h[j].y); w.y = cvt_pk_bf16(h[j].z, h[j].w); *(v2u*)(FH + (size_t)m * D + c0 + 256 * j) = w; } }
            if (a.do_route) {
                float lg[8];
#pragma unroll
                for (int e = 0; e < 8; ++e) { float s = 0.f;
#pragma unroll
                    for (int j = 0; j < 4; ++j) { const f32x4 w = *(const LAS f32x4*)(RWT + e * 1024 + c0 + 256 * j); s += (h[j].x * w.x + h[j].y * w.y) + (h[j].z * w.z + h[j].w * w.w); }
                    lg[e] = wave_sum(s) + a.rb[e]; }
                int e1 = 0; float v1 = lg[0];
#pragma unroll
                for (int e = 1; e < 8; ++e) if (lg[e] > v1) { v1 = lg[e]; e1 = e; }
                int e2 = -1; float v2 = -3.0e38f;
#pragma unroll
                for (int e = 0; e < 8; ++e) if (e != e1 && lg[e] > v2) { v2 = lg[e]; e2 = e; }
                const float p1 = 1.0f / (1.0f + expf(v2 - v1));
                if (F.lane == 0) { RouteRow rr; rr.e1 = e1; rr.e2 = e2; rr.p1 = p1; rr.p2 = 1.0f - p1; ((RouteRow*)(WSG + WS_ROUTE))[m] = rr;
                    atomicAdd((int*)&cnt[e1], 1); atomicAdd((int*)&cnt[e2], 1); }
            }
        }
    }
#undef NORM_LOAD
    if (a.do_route) { __syncthreads(); if (F.tid < 8) ((int*)(WSG + WS_WGCNT))[F.bid * 8 + F.tid] = cnt[F.tid]; }
}

__device__ __forceinline__ void ph_assign(Frame& F) {
    LAS int* part = (LAS int*)F.lds;
    LAS int* tot = (LAS int*)(F.lds + 32768);
    const int* WC = (const int*)(WSG + WS_WGCNT);
    int st[8], sb[8];
#pragma unroll
    for (int e = 0; e < 8; ++e) { st[e] = 0; sb[e] = 0; }
    for (int w = F.tid; w < F.G; w += 512) {
#pragma unroll
        for (int e = 0; e < 8; ++e) { const int c = WC[w * 8 + e]; st[e] += c; if (w < F.bid) sb[e] += c; } }
    if (F.tid < 32) tot[F.tid] = 0;
    __syncthreads();
#pragma unroll
    for (int e = 0; e < 8; ++e) { if (st[e]) atomicAdd((int*)&tot[e], st[e]); if (sb[e]) atomicAdd((int*)&tot[8 + e], sb[e]); }
    __syncthreads();
    if (F.tid == 0) { int o = 0; for (int e = 0; e < 8; ++e) { tot[16 + e] = o; o += (tot[e] + 255) & ~255; }
        if (F.bid == 0) { int* PE = (int*)(WSG + WS_PEXP); int p = 0; for (int e = 0; e < 8; ++e) { const int np = (tot[e] + 255) >> 8; for (int q = 0; q < np; ++q) PE[p++] = e; } PE[MAXP] = p; } }
    __syncthreads();
    RouteEnt* L = (RouteEnt*)(WSG + WS_LIST);
    if (F.bid == 0) {
        for (int e = 0; e < 8; ++e) { const int lo = tot[16 + e] + tot[e], hi = tot[16 + e] + ((tot[e] + 255) & ~255);
            for (int p = lo + F.tid; p < hi; p += 512) { RouteEnt z; z.tok = -1; z.slot = 0; z.w = 0.f; z.pad = 0; L[p] = z; } }
    }
    const RouteRow* RR = (const RouteRow*)(WSG + WS_ROUTE);
    const int r0 = (int)((long)M * F.bid / F.G), r1 = (int)((long)M * (F.bid + 1) / F.G);
    for (int m = r0 + F.tid; m < r1; m += 512) { const RouteRow rr = RR[m];
        { const int p = tot[16 + rr.e1] + tot[8 + rr.e1] + atomicAdd((int*)&tot[24 + rr.e1], 1); RouteEnt z; z.tok = m; z.slot = 0; z.w = rr.p1; z.pad = 0; L[p] = z; }
        { const int p = tot[16 + rr.e2] + tot[8 + rr.e2] + atomicAdd((int*)&tot[24 + rr.e2], 1); RouteEnt z; z.tok = m; z.slot = 1; z.w = rr.p2; z.pad = 0; L[p] = z; } }
}
__device__ __forceinline__ void ph_gather(Frame& F, int p0, int p1) {
    const RouteEnt* L = (const RouteEnt*)(WSG + WS_LIST); unsigned char* HG = FBIG + BIG_HG; const unsigned char* H8 = (const unsigned char*)FH;
    const int gw = F.bid * 8 + F.wave, NGW = F.G * 8, n = (p1 - p0) * 256;
    const int nit = gw < n ? (n - gw + NGW - 1) / NGW : 0;
    int mytok = -1; { const int rr = gw + F.lane * NGW; if (rr < n) mytok = L[(size_t)p0 * 256 + rr].tok; }
    for (int it = 0; it < nit; it += 4) { v4u a[4]; int tk[4];
#pragma unroll
        for (int u = 0; u < 4; ++u) { tk[u] = (it + u < nit) ? __builtin_amdgcn_readlane(mytok, it + u) : -2; a[u] = (v4u){0u, 0u, 0u, 0u}; }
#pragma unroll
        for (int u = 0; u < 4; ++u) if (tk[u] >= 0) a[u] = ((const v4u*)(H8 + (size_t)tk[u] * D))[F.lane];
#pragma unroll
        for (int u = 0; u < 4; ++u) if (tk[u] != -2) ((v4u*)(HG + (size_t)(gw + (it + u) * NGW) * D))[F.lane] = a[u]; }
}
__device__ __forceinline__ void rope8(v4u& a, v4u& b, const float* cs, float sc) {
    unsigned* pa = (unsigned*)&a; unsigned* pb = (unsigned*)&b;
#pragma unroll
    for (int k = 0; k < 4; ++k) {
        float x1l = bflo(pa[k]), x1h = bfhi(pa[k]), x2l = bflo(pb[k]), x2h = bfhi(pb[k]);
        float c0 = 1.f, s0 = 0.f, c1 = 1.f, s1 = 0.f;
        if (cs) { c0 = cs[4 * k]; s0 = cs[4 * k + 1]; c1 = cs[4 * k + 2]; s1 = cs[4 * k + 3]; }
        const float o1l = (x1l * c0 - x2l * s0) * sc, o2l = (x1l * s0 + x2l * c0) * sc, o1h = (x1h * c1 - x2h * s1) * sc, o2h = (x1h * s1 + x2h * c1) * sc;
        pa[k] = cvt_pk_bf16(o1l, o1h); pb[k] = cvt_pk_bf16(o2l, o2h);
    }
}
__device__ __forceinline__ void ph_rope(Frame& F, int odd) {
    const int gw = F.bid * 8 + F.wave, NGW = F.G * 8;
    bf16* Z = (bf16*)FBIG;
    if (!odd) {
        const float* T = (const float*)(WSG + WS_ROPE_R);
        const int tensor = F.lane >> 5, head = (F.lane >> 3) & 3, d0 = (F.lane & 7) * 8;
        const float sc = tensor ? 0.08838834764831845f : 1.0f;
        for (int m = gw; m < M; m += NGW) { const int t = m % TB;
            bf16* p = Z + (size_t)m * EV_IN + 1024 + tensor * 512 + head * 128 + d0;
            v4u a = *(v4u*)p, b = *(v4u*)(p + 64);
            if (t >= CTXL) { const int tl = t - CTXL, pos = d0 < 32 ? (tl >> 6) : (tl & 63), dq = d0 & 31; rope8(a, b, T + (pos * 32 + dq) * 2, sc); }
            else { if (!tensor) continue; rope8(a, b, nullptr, sc); }
            *(v4u*)p = a; *(v4u*)(p + 64) = b; }
    } else {
        const float* T = (const float*)(WSG + WS_ROPE_D);
        for (int m = gw; m < M; m += NGW) { const int t = m % TB; if (t < CTXL) continue;
            const int tl = t - CTXL;
            for (int it = F.lane; it < 96; it += 64) { const int tensor = it / 48, r = it % 48, hm = r >> 2, d0 = (r & 3) * 8;
                bf16* p = Z + (size_t)m * OD_IN + 256 + tensor * 768 + hm * 64 + d0;
                v4u a = *(v4u*)p, b = *(v4u*)(p + 32);
                const int pos = d0 < 16 ? (tl >> 6) : (tl & 63), dq = d0 & 15; rope8(a, b, T + (pos * 16 + dq) * 2, 1.0f);
                *(v4u*)p = a; *(v4u*)(p + 32) = b; } }
    }
}
__device__ __forceinline__ void unpack8(const v4u& w, float* f) { f[0] = bflo(w.x); f[1] = bfhi(w.x); f[2] = bflo(w.y); f[3] = bfhi(w.y); f[4] = bflo(w.z); f[5] = bfhi(w.z); f[6] = bflo(w.w); f[7] = bfhi(w.w); }
__device__ __forceinline__ v4u pack8(const float* f) { v4u w; w.x = cvt_pk_bf16(f[0], f[1]); w.y = cvt_pk_bf16(f[2], f[3]); w.z = cvt_pk_bf16(f[4], f[5]); w.w = cvt_pk_bf16(f[6], f[7]); return w; }
__device__ __forceinline__ void ph_merge_even(Frame& F, int i) {
    const int gw = F.bid * 8 + F.wave, NGW = F.G * 8;
    const bf16* Z = (const bf16*)FBIG; const bf16* HF = (const bf16*)FYB; const bf16* HB = (const bf16*)(FYB + T_HALF);
    const bf16* RF = (const bf16*)(FYB + 2 * T_HALF); const bf16* RB = (const bf16*)(FYB + 3 * T_HALF);
    const float* gn = INP(14) + (size_t)i * 512; const int c0 = 8 * F.lane;
    float gnv[8];
#pragma unroll
    for (int k = 0; k < 8; ++k) gnv[k] = gn[c0 + k];
    v4u n0, n1, n2, n3, n4, n5;
#define MRG_LOAD(m_) do { n0 = *(const v4u*)(HF + (size_t)(m_) * 512 + c0); n1 = *(const v4u*)(HB + (size_t)(m_) * 512 + c0); n2 = *(const v4u*)(Z + (size_t)(m_) * EV_IN + 512 + c0); \
        n3 = *(const v4u*)(RF + (size_t)(m_) * 512 + c0); n4 = *(const v4u*)(RB + (size_t)(m_) * 512 + c0); n5 = *(const v4u*)(Z + (size_t)(m_) * EV_IN + 2560 + c0); } while (0)
    if (gw < M) MRG_LOAD(gw);
    for (int m = gw; m < M; m += NGW) {
        float a[8], b[8], g[8], o[8];
        const v4u c0_ = n0, c1_ = n1, c2_ = n2, c3_ = n3, c4_ = n4, c5_ = n5;
        if (m + NGW < M) MRG_LOAD(m + NGW);
        unpack8(c0_, a); unpack8(c1_, b); unpack8(c2_, g);
#pragma unroll
        for (int k = 0; k < 8; ++k) o[k] = (a[k] + b[k]) * gelu_tanh(g[k]);
        *(v4u*)(FH + (size_t)m * D + c0) = pack8(o);
        unpack8(c3_, a); unpack8(c4_, b); unpack8(c5_, g);
        float s = 0.f;
#pragma unroll
        for (int k = 0; k < 8; ++k) { a[k] += b[k]; s += a[k]; }
        s += __shfl_xor(s, 1); s += __shfl_xor(s, 2); s += __shfl_xor(s, 4); s += __shfl_xor(s, 8);
        const float mean = s * (1.0f / 128.0f); float q = 0.f;
#pragma unroll
        for (int k = 0; k < 8; ++k) { a[k] -= mean; q += a[k] * a[k]; }
        q += __shfl_xor(q, 1); q += __shfl_xor(q, 2); q += __shfl_xor(q, 4); q += __shfl_xor(q, 8);
        const float rs = 1.0f / sqrtf(q * (1.0f / 128.0f) + EPS);
#pragma unroll
        for (int k = 0; k < 8; ++k) o[k] = a[k] * rs * gnv[k] * (g[k] * sigmoidf_(g[k]));
        *(v4u*)(FH + (size_t)m * D + 512 + c0) = pack8(o);
    }
}
#undef MRG_LOAD
__device__ __forceinline__ void ph_zpass(Frame& F, int i) {
    const int gw = F.bid * 8 + F.wave, NGW = F.G * 8;
    const bf16* ZI = (const bf16*)FBIG; const bf16* YF = (const bf16*)FYB; const bf16* YB = (const bf16*)(FYB + T_QUART); bf16* ZO = (bf16*)(FYB + 2 * T_QUART);
    const float* dsk = INP(27) + (size_t)i * 256; const int c0 = 4 * F.lane;
    const f32x4 dv = *(const f32x4*)(dsk + c0);
    v2u na0, nb0, nu0, na1, nb1, nu1;
#define ZP_LOAD(m_, A_, B_, U_) do { if ((m_) < M) { A_ = *(const v2u*)(YF + (size_t)(m_) * 256 + c0); B_ = *(const v2u*)(YB + (size_t)(m_) * 256 + c0); U_ = *(const v2u*)(ZI + (size_t)(m_) * OD_IN + c0); } } while (0)
    ZP_LOAD(gw, na0, nb0, nu0); ZP_LOAD(gw + NGW, na1, nb1, nu1);
    for (int m = gw; m < M; m += NGW) {
        const v2u a = na0, b = nb0, u = nu0; na0 = na1; nb0 = nb1; nu0 = nu1; ZP_LOAD(m + 2 * NGW, na1, nb1, nu1);
        const float y0 = bflo(a.x) + bflo(b.x) + dv.x * bflo(u.x), y1 = bfhi(a.x) + bfhi(b.x) + dv.y * bfhi(u.x), y2 = bflo(a.y) + bflo(b.y) + dv.z * bflo(u.y), y3 = bfhi(a.y) + bfhi(b.y) + dv.w * bfhi(u.y);
        v2u w; w.x = cvt_pk_bf16(gelu_tanh(y0), gelu_tanh(y1)); w.y = cvt_pk_bf16(gelu_tanh(y2), gelu_tanh(y3));
        *(v2u*)(ZO + (size_t)m * 256 + c0) = w; }
}

constexpr size_t VT_OFF = 128 * MiB, K8_OFF = 180 * MiB;
constexpr size_t Q8_OFF = 332 * MiB;
#undef ZP_LOAD
__device__ __forceinline__ void ph_vt(Frame& F) {
    LAS bf16* T = (LAS bf16*)(F.lds + F.wave * 17408);
    const bf16* Z = (const bf16*)FBIG; unsigned char* VT = FYB + VT_OFF;
    const int gw = F.bid * 8 + F.wave, NGW = F.G * 8, lane = F.lane;
    for (int it = gw; it < NB * 6 * 132; it += NGW) { const int bh = it / 132, t = it % 132, b = bh / 6, h = bh % 6;
        const bf16* src = Z + ((size_t)b * TB + 64 * t) * OD_IN + 1792 + h * 128;
#pragma unroll
        for (int i = 0; i < 16; ++i) { const int row = i * 4 + (lane >> 4), ch = lane & 15; *(LAS v4u*)(T + row * 136 + ch * 8) = *(const v4u*)(src + (size_t)row * OD_IN + ch * 8); }
        LDS_WAIT(); asm volatile("" ::: "memory");
        unsigned char* dst = VT + (size_t)it * 8192;
#pragma unroll
        for (int rr = 0; rr < 2; ++rr) { const int d = lane + 64 * rr;
#pragma unroll
            for (int q = 0; q < 4; ++q) { unsigned w[4];
#pragma unroll
                for (int k = 0; k < 4; ++k) { float v[4];
#pragma unroll
                    for (int e = 0; e < 4; ++e) { const int beta = q * 16 + k * 4 + e, i2 = beta & 31, hh = beta >> 5, key = ((i2 & 15) & 3) + 8 * ((i2 & 15) >> 2) + 4 * hh + 32 * (i2 >> 4); v[e] = bf2f(T[key * 136 + d]); }
                    w[k] = pg8::pk4_fp8(v[0], v[1], v[2], v[3]); }
                *(v4u*)(dst + d * 64 + q * 16) = (v4u){w[0], w[1], w[2], w[3]}; } }
        LDS_WAIT(); asm volatile("" ::: "memory");
    }
}
__device__ __forceinline__ int chunk_tlo(int dir, int c) { return dir == 0 ? 128 * c : (c < 2 ? 128 * (1 - c) : 8576 - 128 * c); }

__device__ __forceinline__ void lru_item(Frame& F, int i, int b, int dir, int blk) {
    LAS unsigned char* lds = F.lds;
    LAS float* UR = (LAS float*)(lds);
    LAS float* AA = (LAS float*)(lds + 98304);
    LAS float* U = (LAS float*)(lds + 36864);
    LAS float* BB = U;
    LAS bf16* UB = (LAS bf16*)(lds + 69632);
    LAS float* SEG = (LAS float*)(lds + 88064);
    LAS float* PRM = (LAS float*)(lds + 92160);
    const int tid = F.tid, lane = F.lane, wave = F.wave, ch = tid & 63, seg = tid >> 6;
    const bf16* Z = (const bf16*)FBIG; bf16* OUT = (bf16*)(FYB + (size_t)dir * T_HALF);
    const float* conv_w = INP(8) + (size_t)i * 4 * 512; const float* conv_b = INP(9) + (size_t)i * 512;
    const float* gate_w = INP(10) + (((size_t)i * 2 + dir) * 2) * 8 * 64 * 64;
    const float* gate_b = INP(11) + (((size_t)i * 2 + dir) * 2) * 512;
    const float* lam = INP(12) + ((size_t)i * 2 + dir) * 512;
    __syncthreads();
    if (tid < 64) { const int cg = blk * 64 + tid;
        PRM[0 * 64 + tid] = conv_w[0 * 512 + cg]; PRM[1 * 64 + tid] = conv_w[1 * 512 + cg]; PRM[2 * 64 + tid] = conv_w[2 * 512 + cg]; PRM[3 * 64 + tid] = conv_w[3 * 512 + cg];
        PRM[4 * 64 + tid] = conv_b[cg]; const float lm = lam[cg]; PRM[5 * 64 + tid] = (-lm > 20.f) ? -lm : log1pf(expf(-lm));
        PRM[6 * 64 + tid] = gate_b[cg]; PRM[7 * 64 + tid] = gate_b[512 + cg]; }
    const int fr = lane & 15, fq = lane >> 4;
    bf16x8 wf[8][2];
#pragma unroll
    for (int nt = 0; nt < 8; ++nt)
#pragma unroll
        for (int ks = 0; ks < 2; ++ks) { const int col = 16 * nt + fr, gate = col >> 6, j = col & 63; const float* wp = gate_w + (((size_t)gate * 8 + blk) * 64 + (32 * ks + 8 * fq)) * 64 + j;
            v4u w; w.x = cvt_pk_bf16(wp[0], wp[64]); w.y = cvt_pk_bf16(wp[128], wp[192]); w.z = cvt_pk_bf16(wp[256], wp[320]); w.w = cvt_pk_bf16(wp[384], wp[448]);
            wf[nt][ks] = __builtin_bit_cast(bf16x8, w); }
    float carry = 0.f;
    const size_t rowbase = (size_t)b * TB;
    v4u pre[3];
#define LRU_LOAD(c_) do { const int tl_ = chunk_tlo(dir, (c_)), lo_ = tl_ < CTXL ? 0 : CTXL, hi_ = tl_ < CTXL ? CTXL : TB; \
        _Pragma("unroll") for (int n_ = 0; n_ < 3; ++n_) { const int it_ = tid + 512 * n_, r_ = it_ >> 3, cc_ = it_ & 7, t_ = tl_ - 2 + r_; \
            pre[n_] = (it_ < 131 * 8 && t_ >= lo_ && t_ < hi_) ? *(const v4u*)(Z + (rowbase + t_) * EV_IN + blk * 64 + cc_ * 8) : (v4u){0u, 0u, 0u, 0u}; } } while (0)
    LRU_LOAD(0);
    __syncthreads();
    for (int c = 0; c < 66; ++c) {
        const int t_lo = chunk_tlo(dir, c);
#pragma unroll
        for (int n = 0; n < 3; ++n) { const int it = tid + 512 * n; if (it < 131 * 8) { const int r = it >> 3, cc = it & 7; float f[8]; unpack8(pre[n], f);
            *(LAS f32x4*)(UR + r * 64 + cc * 8) = (f32x4){f[0], f[1], f[2], f[3]}; *(LAS f32x4*)(UR + r * 64 + cc * 8 + 4) = (f32x4){f[4], f[5], f[6], f[7]}; } }
        if (c + 1 < 66) LRU_LOAD(c + 1);
        __syncthreads();
        { const float w0 = PRM[ch], w1 = PRM[64 + ch], w2 = PRM[128 + ch], w3 = PRM[192 + ch], cb = PRM[256 + ch];
#pragma unroll 4
          for (int k = 0; k < 16; ++k) { const int r = seg * 16 + k; const float u = cb + w0 * UR[r * 64 + ch] + w1 * UR[(r + 1) * 64 + ch] + w2 * UR[(r + 2) * 64 + ch] + w3 * UR[(r + 3) * 64 + ch];
              U[r * 64 + ch] = u; UB[r * 72 + ch] = (bf16)(cvt_pk_bf16(u, 0.f) & 0xffffu); } }
        asm volatile("s_waitcnt lgkmcnt(0)" ::: "memory");
        { f32x4 acc[8];
#pragma unroll
          for (int nt = 0; nt < 8; ++nt) acc[nt] = (f32x4){0.f, 0.f, 0.f, 0.f};
          const bf16x8 a0 = *(const LAS bf16x8*)(UB + (16 * wave + fr) * 72 + 8 * fq), a1 = *(const LAS bf16x8*)(UB + (16 * wave + fr) * 72 + 32 + 8 * fq);
#pragma unroll
          for (int nt = 0; nt < 8; ++nt) { acc[nt] = __builtin_amdgcn_mfma_f32_16x16x32_bf16(a0, wf[nt][0], acc[nt], 0, 0, 0); acc[nt] = __builtin_amdgcn_mfma_f32_16x16x32_bf16(a1, wf[nt][1], acc[nt], 0, 0, 0); }
#pragma unroll
          for (int nt = 0; nt < 4; ++nt) { const int cch = 16 * nt + fr; const float br = PRM[6 * 64 + cch], bi = PRM[7 * 64 + cch], sp = PRM[5 * 64 + cch];
#pragma unroll
              for (int rg = 0; rg < 4; ++rg) { const int r = 16 * wave + 4 * fq + rg; const float rgate = sigmoidf_(acc[nt][rg] + br), igate = sigmoidf_(acc[nt + 4][rg] + bi);
                  const float la = -8.0f * rgate * sp, av = __builtin_amdgcn_exp2f(1.4426950408889634f * la), x2 = 2.0f * la;
                  const float om = (x2 > -0.25f) ? (-x2 * (1.0f + x2 * (0.5f + x2 * (0.16666667f + x2 * (0.041666668f + x2 * 0.0083333338f))))) : (1.0f - av * av);
                  const float bv = __builtin_amdgcn_sqrtf(om) * (igate * U[r * 64 + cch]);
                  AA[r * 64 + cch] = av; BB[r * 64 + cch] = bv; } } }
        __syncthreads();
        float hl[16], ca[16];
        { float h = 0.f, p = 1.f;
#pragma unroll
          for (int k = 0; k < 16; ++k) { const int ip = seg * 16 + k, r = dir == 0 ? ip : 127 - ip; const float av = AA[r * 64 + ch], bv = BB[r * 64 + ch]; h = av * h + bv; p *= av; hl[k] = h; ca[k] = p; }
          SEG[seg * 64 + ch] = p; SEG[512 + seg * 64 + ch] = h; }
        __syncthreads();
        float hin = carry, myin = 0.f;
#pragma unroll
        for (int s = 0; s < 8; ++s) { if (s == seg) myin = hin; hin = SEG[s * 64 + ch] * hin + SEG[512 + s * 64 + ch]; }
        carry = hin;
#pragma unroll
        for (int k = 0; k < 16; ++k) { const int ip = seg * 16 + k, r = dir == 0 ? ip : 127 - ip; const float h = hl[k] + ca[k] * myin;
            OUT[(rowbase + t_lo + r) * 512 + blk * 64 + ch] = (bf16)(cvt_pk_bf16(h, 0.f) & 0xffffu); }
    }
#undef LRU_LOAD
}
__device__ __forceinline__ unsigned off_b(unsigned row, unsigned ch) { return 256u * row + 16u * (ch ^ (((row & 3) << 2) | ((row >> 2) & 3))); }
__device__ __forceinline__ unsigned row_read_addr(unsigned lane, unsigned rb, unsigned s) { return off_b(32 * rb + (lane & 31), 2 * s + (lane >> 5)); }
__device__ __forceinline__ unsigned tr_read_addr(unsigned lane, unsigned c, unsigned ks, unsigned t) {
    const unsigned h = lane >> 5, blk = (lane >> 4) & 1, q = (lane & 15) >> 2, p = lane & 3;
    return off_b(16 * ks + 8 * h + 4 * t + q, 4 * c + 2 * blk + (p >> 1)) + 8 * (p & 1);
}
typedef short v4i16_t __attribute__((ext_vector_type(4)));
__device__ __forceinline__ bf16x8 tr_frag(LAS unsigned char* tile, unsigned lane, unsigned c, unsigned ks) {
    const s16x4 lo = __builtin_bit_cast(s16x4, __builtin_amdgcn_ds_read_tr16_b64_v4i16((LAS v4i16_t*)(tile + tr_read_addr(lane, c, ks, 0))));
    const s16x4 hi = __builtin_bit_cast(s16x4, __builtin_amdgcn_ds_read_tr16_b64_v4i16((LAS v4i16_t*)(tile + tr_read_addr(lane, c, ks, 1))));
    return (bf16x8){lo[0], lo[1], lo[2], lo[3], hi[0], hi[1], hi[2], hi[3]};
}
__device__ __forceinline__ bf16x8 row_frag(LAS unsigned char* tile, unsigned lane, unsigned rb, unsigned s) { return *(const LAS bf16x8*)(tile + row_read_addr(lane, rb, s)); }
#define MFMA32(a, b, c) __builtin_amdgcn_mfma_f32_32x32x16_bf16((a), (b), (c), 0, 0, 0)

constexpr unsigned RT_KB = 0, RT_T2 = 32768, RT_QB = 65536, RT_VB = 98304;
__device__ __forceinline__ s16x4 ds_tr(LAS unsigned char* p) { return __builtin_bit_cast(s16x4, __builtin_amdgcn_ds_read_tr16_b64_v4i16((LAS v4i16_t*)p)); }
#define TRF(base0, base1, off) ({ const s16x4 lo_ = ds_tr(F.lds + (base0) + (off)), hi_ = ds_tr(F.lds + (base1) + (off)); (bf16x8){lo_[0], lo_[1], lo_[2], lo_[3], hi_[0], hi_[1], hi_[2], hi_[3]}; })
#define RWF(base, off) (*(const LAS bf16x8*)(F.lds + (base) + (off)))
__device__ __forceinline__ void ret_item(Frame& F, int li, int b, int head, int dir, int z) {
    const int tid = F.tid, lane = F.lane, wave = F.wave, ib = wave & 3, xw = wave >> 2, eb = 2 * z + xw, r = lane & 31, h = lane >> 5;
    const bf16* Z = (const bf16*)FBIG; bf16* OUT = (bf16*)(FYB + (size_t)(2 + dir) * T_HALF);
    const float theta = INP(13)[((size_t)li * 2 + dir) * 4 + head];
    const float log_g = -((-theta > 20.f) ? -theta : log1pf(expf(-theta)));
    const float g1 = expf(log_g), g127 = expf(127.0f * log_g);
    const size_t rowbase = (size_t)b * TB;
    unsigned xsI[8], xsT[8], xsJ[8];
    { const unsigned swz = ((r & 3) << 2) | ((r >> 2) & 3);
#pragma unroll
      for (int s = 0; s < 8; ++s) { const unsigned x = 256u * r + 16u * ((unsigned)(2 * s + h) ^ swz); xsI[s] = x + 8192u * ib + RT_QB; xsT[s] = x + 8192u * eb; xsJ[s] = x + 16384u * xw; } }
    const unsigned tK0 = RT_KB + tr_read_addr(lane, ib, 0, 0), tK1 = RT_KB + tr_read_addr(lane, ib, 0, 1);
    const unsigned tV0 = RT_VB + tr_read_addr(lane, eb, 0, 0), tV1 = RT_VB + tr_read_addr(lane, eb, 0, 1);
    __syncthreads();
    for (int it = tid; it < 2048; it += 512) *(LAS v4u*)(F.lds + RT_T2 + it * 16) = (v4u){0u, 0u, 0u, 0u};
    f32x16 SA = f32x16{};
    v4u pq[4], pk[4], pv[2];
#define RET_LOAD(c_) do { const int tl_ = chunk_tlo(dir, (c_)); _Pragma("unroll") for (int n_ = 0; n_ < 4; ++n_) { const int it_ = tid + 512 * n_, row_ = it_ >> 4, cn_ = it_ & 15; \
        const bf16* p_ = Z + (rowbase + tl_ + (dir == 0 ? row_ : 127 - row_)) * EV_IN + 1024 + head * 128 + cn_ * 8; pq[n_] = *(const v4u*)p_; pk[n_] = *(const v4u*)(p_ + 512); } \
        _Pragma("unroll") for (int n_ = 0; n_ < 2; ++n_) { const int it_ = tid + 512 * n_, row_ = it_ >> 3, cn_ = 8 * z + (it_ & 7); \
        pv[n_] = *(const v4u*)(Z + (rowbase + tl_ + (dir == 0 ? row_ : 127 - row_)) * EV_IN + 2048 + head * 128 + cn_ * 8); } } while (0)
    RET_LOAD(0);
#pragma nounroll
    for (int c = 0; c < 66; ++c) {
        const int t_lo = chunk_tlo(dir, c);
        __syncthreads();
#pragma unroll
        for (int n = 0; n < 4; ++n) { const int it = tid + 512 * n, row = it >> 4, cn = it & 15; const float sc = __builtin_amdgcn_exp2f(-(float)row * (log_g * 1.4426950408889634f)); const unsigned wo = off_b(row, cn);
            float f[8]; unpack8(pk[n], f);
#pragma unroll
            for (int k = 0; k < 8; ++k) f[k] *= sc;
            *(LAS v4u*)(F.lds + RT_QB + wo) = pq[n]; *(LAS v4u*)(F.lds + RT_KB + wo) = pack8(f); }
#pragma unroll
        for (int n = 0; n < 2; ++n) { const int it = tid + 512 * n, row = it >> 3, cn = 8 * z + (it & 7); *(LAS v4u*)(F.lds + RT_VB + off_b(row, cn)) = pv[n]; }
        if (c + 1 < 66) RET_LOAD(c + 1);
        __syncthreads();
        f32x16 OT = f32x16{}, ST[2]; ST[0] = f32x16{}; ST[1] = f32x16{};
#pragma unroll
        for (int s = 0; s < 8; ++s) { const bf16x8 qf = RWF(xsI[s], 0);
            OT = MFMA32(RWF(xsT[s], RT_T2), qf, OT);
            if (2 * xw <= ib) ST[0] = MFMA32(RWF(xsJ[s], RT_KB), qf, ST[0]);
            if (2 * xw + 1 <= ib) ST[1] = MFMA32(RWF(xsJ[s], RT_KB + 8192), qf, ST[1]); }
#pragma unroll
        for (int q = 0; q < 16; ++q) SA[q] *= g1;
#pragma unroll
        for (int ks = 0; ks < 8; ++ks) SA = MFMA32(TRF(tK0, tK1, ks * 4096), TRF(tV0, tV1, ks * 4096), SA);
#pragma unroll
        for (int q = 0; q < 16; ++q) SA[q] *= g127;
        __syncthreads();
        const int irow = 32 * ib + r;
#pragma unroll
        for (int y = 0; y < 2; ++y) { const int jb = 2 * xw + y;
#pragma unroll
            for (int gq = 0; gq < 4; ++gq) { const int j0 = 32 * jb + 8 * gq + 4 * h; float p0 = ST[y][4 * gq], p1 = ST[y][4 * gq + 1], p2 = ST[y][4 * gq + 2], p3 = ST[y][4 * gq + 3];
                if (j0 > irow) p0 = 0.f; if (j0 + 1 > irow) p1 = 0.f; if (j0 + 2 > irow) p2 = 0.f; if (j0 + 3 > irow) p3 = 0.f;
                v2u w; w.x = cvt_pk_bf16(p0, p1); w.y = cvt_pk_bf16(p2, p3);
                *(LAS v2u*)(F.lds + RT_QB + off_b(irow, 4 * jb + gq) + 8 * h) = w; } }
        { const int erow = 32 * eb + r;
#pragma unroll
            for (int gq = 0; gq < 4; ++gq) { v2u w; w.x = cvt_pk_bf16(SA[4 * gq] * g1, SA[4 * gq + 1] * g1); w.y = cvt_pk_bf16(SA[4 * gq + 2] * g1, SA[4 * gq + 3] * g1);
                *(LAS v2u*)(F.lds + RT_T2 + off_b(erow, 4 * ib + gq) + 8 * h) = w; } }
        __syncthreads();
#pragma unroll
        for (int s = 0; s < 8; ++s) OT = MFMA32(TRF(tV0, tV1, s * 4096), RWF(xsI[s], 0), OT);
        { const float gi = __builtin_amdgcn_exp2f((float)irow * (log_g * 1.4426950408889634f)); const int t = t_lo + (dir == 0 ? irow : 127 - irow);
          bf16* op = OUT + (rowbase + t) * 512 + head * 128;
#pragma unroll
          for (int gq = 0; gq < 4; ++gq) { v2u w; w.x = cvt_pk_bf16(OT[4 * gq] * gi, OT[4 * gq + 1] * gi); w.y = cvt_pk_bf16(OT[4 * gq + 2] * gi, OT[4 * gq + 3] * gi);
              *(v2u*)(op + 32 * eb + 8 * gq + 4 * h) = w; } }
    }
#undef RET_LOAD
}
#undef TRF
#undef RWF
#if DBG_SCAN
#define DBGCHK(stage, v) do { if (!(fabsf(v) < 1e30f)) atomicMax((unsigned*)(WSG + WS_CTL) + 2049, 100u - (unsigned)(stage)); } while (0)
#else
#define DBGCHK(stage, v) do {} while (0)
#endif
typedef float f32x2 __attribute__((ext_vector_type(2)));
__device__ __forceinline__ f32x2 cmul_add(f32x2 a, f32x2 h, f32x2 c) {
    f32x2 t = (f32x2){a.x, a.x} * h + c; return (f32x2){-a.y, a.y} * (f32x2){h.y, h.x} + t; }
__device__ __forceinline__ void s5_item(Frame& F, int li, int b, int dir, int g) {
    LAS unsigned char* lds = F.lds;
    LAS f32x2* SEG = (LAS f32x2*)(lds + 8192);
    LAS unsigned* HS = (LAS unsigned*)(lds + 12288);
    const int tid = F.tid, lane = F.lane, wave = F.wave, fr = lane & 15, fq = lane >> 4;
    const int j = lane & 31, h = lane >> 5, tb = wave >> 1, sb = wave & 1, p = 32 * sb + j;
    LAS f32x2* QE = (LAS f32x2*)(lds + 49152) + wave * 256;
    const bf16* Z = (const bf16*)FBIG; bf16* OUT = (bf16*)(FYB + (size_t)dir * T_QUART);
    const size_t pb = ((size_t)li * 2 + dir) * 16 + g;
    const float lre = INP(20)[pb * 64 + p], lim = INP(21)[pb * 64 + p], dt = expf(INP(22)[pb]);
    const float x = lre * dt, y = lim * dt, ex = expf(x); float sy, cy; sincosf(y, &sy, &cy);
    const f32x2 a = (f32x2){ex * cy, ex * sy};
    const float sh = sinf(0.5f * y), am1r = expm1f(x) * cy - 2.0f * sh * sh, am1i = a.y;
    const float den = 1.0f / (lre * lre + lim * lim), cr = (am1r * lre + am1i * lim) * den, ci = (am1i * lre - am1r * lim) * den;
    bf16x8 bfre, bfim, bfre2, bfim2;
    { float vr[8], vi[8];
#pragma unroll
      for (int k = 0; k < 8; ++k) { const float br = INP(23)[(pb * 64 + p) * 16 + 8 * h + k], bi = INP(24)[(pb * 64 + p) * 16 + 8 * h + k]; vr[k] = cr * br - ci * bi; vi[k] = cr * bi + ci * br; }
      const v4u pr = pack8(vr), pi = pack8(vi); bfre = __builtin_bit_cast(bf16x8, pr); bfim = __builtin_bit_cast(bf16x8, pi);
      float hr[8], hi_[8]; unpack8(pr, hr); unpack8(pi, hi_);
#pragma unroll
      for (int k = 0; k < 8; ++k) { vr[k] -= hr[k]; vi[k] -= hi_[k]; }
      bfre2 = __builtin_bit_cast(bf16x8, pack8(vr)); bfim2 = __builtin_bit_cast(bf16x8, pack8(vi)); }
    const f32x2 zero2 = (f32x2){0.f, 0.f};
    const f32x2 a2 = cmul_add(a, a, zero2), a3 = cmul_add(a2, a, zero2), a4 = cmul_add(a2, a2, zero2);
    f32x2 a32 = a4;
#pragma unroll
    for (int k = 0; k < 3; ++k) a32 = cmul_add(a32, a32, zero2);
    bf16x8 cf[4];
#pragma unroll
    for (int ks = 0; ks < 4; ++ks) { float v[8];
#pragma unroll
        for (int jj = 0; jj < 8; ++jj) { const int k = 32 * ks + 8 * fq + jj, pp = k >> 1; v[jj] = (k & 1) ? -INP(26)[(pb * 16 + fr) * 64 + pp] : INP(25)[(pb * 16 + fr) * 64 + pp]; }
        cf[ks] = __builtin_bit_cast(bf16x8, pack8(v)); }
    f32x2 hc = zero2;
    const size_t rowbase = (size_t)b * TB;
    v4u pu = (v4u){0u, 0u, 0u, 0u};
#define S5_LOAD(c_) do { const int tl_ = chunk_tlo(dir, (c_)), ip_ = 32 * tb + j; pu = *(const v4u*)(Z + (rowbase + tl_ + (dir == 0 ? ip_ : 127 - ip_)) * OD_IN + g * 16 + 8 * h); } while (0)
    S5_LOAD(0);
    __syncthreads();
    for (int c = 0; c < 66; ++c) {
        const int t_lo = chunk_tlo(dir, c);
        const bf16x8 au = __builtin_bit_cast(bf16x8, pu);
        if (c + 1 < 66) S5_LOAD(c + 1);
        f32x16 Bre = __builtin_amdgcn_mfma_f32_32x32x16_bf16(au, bfre2, f32x16{}, 0, 0, 0), Bim = __builtin_amdgcn_mfma_f32_32x32x16_bf16(au, bfim2, f32x16{}, 0, 0, 0);
        Bre = __builtin_amdgcn_mfma_f32_32x32x16_bf16(au, bfre, Bre, 0, 0, 0); Bim = __builtin_amdgcn_mfma_f32_32x32x16_bf16(au, bfim, Bim, 0, 0, 0);
        f32x2 eq[8];
#pragma unroll
        for (int q = 0; q < 4; ++q) { f32x2 sr = zero2;
#pragma unroll
            for (int e = 0; e < 4; ++e) { sr = cmul_add(a, sr, (f32x2){Bre[4 * q + e], Bim[4 * q + e]}); Bre[4 * q + e] = sr.x; Bim[4 * q + e] = sr.y; }
            QE[(2 * q + h) * 32 + j] = sr; }
        asm volatile("s_waitcnt lgkmcnt(0)" ::: "memory");
#pragma unroll
        for (int Q = 0; Q < 8; ++Q) eq[Q] = QE[Q * 32 + j];
        { f32x2 sq = zero2;
#pragma unroll
          for (int Q = 0; Q < 8; ++Q) sq = cmul_add(a4, sq, eq[Q]);
          if (h == 0) SEG[tb * 64 + p] = sq; }
        __syncthreads();
        f32x2 hin = zero2;
#pragma unroll
        for (int b2 = 0; b2 < 4; ++b2) { if (b2 == tb) hin = hc; hc = cmul_add(a32, hc, SEG[b2 * 64 + p]); }
        { f32x2 tq = hin;
#pragma unroll
          for (int Q = 0; Q < 8; ++Q) {
              if ((Q & 1) == h) { const int q = Q >> 1;
#pragma unroll
                  for (int e = 0; e < 4; ++e) { const f32x2 pw = e == 0 ? a : (e == 1 ? a2 : (e == 2 ? a3 : a4)); const f32x2 v = cmul_add(pw, tq, (f32x2){Bre[4 * q + e], Bim[4 * q + e]});
                      HS[(32 * tb + 8 * q + 4 * h + e) * 68 + p] = cvt_pk_bf16(v.x, v.y); } }
              tq = cmul_add(a4, tq, eq[Q]); } }
        __syncthreads();
        { pg8::f32x4 acc = (pg8::f32x4){0.f, 0.f, 0.f, 0.f};
#pragma unroll
          for (int ks = 0; ks < 4; ++ks) { const bf16x8 af = *(const LAS bf16x8*)(HS + (16 * wave + fr) * 68 + 16 * ks + 4 * fq); acc = __builtin_amdgcn_mfma_f32_16x16x32_bf16(cf[ks], af, acc, 0, 0, 0); }
          const int ip = 16 * wave + fr, t = t_lo + (dir == 0 ? ip : 127 - ip);
          v2u w; w.x = cvt_pk_bf16(acc[0], acc[1]); w.y = cvt_pk_bf16(acc[2], acc[3]);
          *(v2u*)(OUT + (rowbase + t) * 256 + g * 16 + 4 * fq) = w; }
    }
#undef S5_LOAD
}
namespace att {
constexpr int KVBLK = 64, LD = OD_IN;
#define SBAR() __builtin_amdgcn_sched_barrier(0)
__device__ __forceinline__ int crow(int r, int hi) { return (r & 3) + 8 * (r >> 2) + 4 * hi; }
constexpr float THRL = 5.0f, POFF = 3.0f;
constexpr float KP0 = 8.0f * (POFF + 7.0f) - 0.094f, LIM8 = KP0 + 8.0f * THRL;
#define MX3(a, b, c) __builtin_fmaxf(__builtin_fmaxf((a), (b)), (c))
typedef int v8i_a __attribute__((ext_vector_type(8)));
typedef int v4i_a __attribute__((ext_vector_type(4)));
typedef float f32x4_a __attribute__((ext_vector_type(4)));
typedef __attribute__((address_space(3))) v4i_a lds_v4i;
#define LDSV(a_) (*(const lds_v4i*)(a_))
#define CAT8(x_, y_) __builtin_shufflevector((x_), (y_), 0, 1, 2, 3, 4, 5, 6, 7)
#define QKMF(x_, y_, c_) __builtin_amdgcn_mfma_scale_f32_32x32x64_f8f6f4(CAT8(x_, y_), qf, (c_), 0, 0, 0, 0x7f7f7f7f, 0, 0x80808080)
#define PVMF(pf_, acc_, x_, y_) __builtin_amdgcn_mfma_scale_f32_32x32x64_f8f6f4(pf_, CAT8(x_, y_), (acc_), 0, 0, 0, 0x7f7f7f7f, 0, 0x7f7f7f7f)
#define EXPB1(P_, r_, w_) w_ = (int)__builtin_amdgcn_cvt_pk_u8_f32(P_[r_], (r_) & 3, (unsigned)w_)
#define EXPW(P_, q_, W_, wi_) do { int w_; asm volatile("" : "=v"(w_)); EXPB1(P_, 4 * (q_), w_); EXPB1(P_, 4 * (q_) + 1, w_); EXPB1(P_, 4 * (q_) + 2, w_); EXPB1(P_, 4 * (q_) + 3, w_); asm volatile("" : "+v"(w_)); W_[wi_] = w_; } while (0)
#define EXPS(P_, h_, W_, w0_) do { EXPW(P_, 2 * (h_), W_, (w0_) + 2 * (h_)); EXPW(P_, 2 * (h_) + 1, W_, (w0_) + 2 * (h_) + 1); } while (0)
template <int MAP> __device__ __forceinline__ void unit(const unsigned char* q8, size_t row0, int qcol, const unsigned char* k8, size_t krow0, const unsigned char* vtb, unsigned vtoff, bf16* __restrict__ Ob, int seq, char* lds,
                                     float lam, float gsc, const float* __restrict__ gn, const int tid) {
  const int wid = __builtin_amdgcn_readfirstlane(tid >> 6), lane = tid & 63, r32 = lane & 31, hi = lane >> 5, wq = wid & 3; constexpr int map = MAP;
  constexpr int SLOT = 16384, VOFF = 8192;
  float* ws = (float*)(lds + 8 * SLOT) + wid * 64; float* al_l = ws + 32;
  f32x16 o[4] = {}; f32x4_a lacc = {};
  v8i_a qf;
  { const v4i_a* qp = (const v4i_a*)(q8 + (row0 + wq * 32 + r32) * 768 + qcol + map * 64 + hi * 32); const v4i_a x0 = qp[0], x1 = qp[1]; qf = CAT8(x0, x1); }
  asm volatile("s_waitcnt vmcnt(0)" ::: "memory");
  const int on_ = ((lane & 15) == ((lane >> 4) & 1)) ? 0x38383838 : 0;
  v8i_a ones = {on_, on_, on_, on_, on_, on_, on_, on_}; asm volatile("" : "+v"(ones));
  const int krow = wid * 8 + (lane >> 3); const unsigned voK = (unsigned)(krow * 768 + (((lane & 7) ^ ((krow >> 1) & 7)) * 16));
  const int vrow = wid * 16 + (lane >> 2); const unsigned voV = (unsigned)(vrow * 64 + (((lane & 3) ^ ((vrow >> 2) & 3)) * 16));
  const __amdgpu_buffer_rsrc_t rsK = __builtin_amdgcn_make_buffer_rsrc((void*)k8, 0, 0x7fffffff, 0x00020000), rsV = __builtin_amdgcn_make_buffer_rsrc((void*)vtb, 0, 0x7fffffff, 0x00020000);
  const unsigned koff = (unsigned)(krow0 * 768 + qcol);
  typedef __attribute__((address_space(3))) unsigned lds_u32;
  const int NT = seq / KVBLK;
#define DMA_TILE(t) do { const int tt_ = (t) < NT ? (t) : NT - 1; const int sl_ = ((t) & 7) * SLOT + wid * 1024; \
    __builtin_amdgcn_raw_ptr_buffer_load_lds(rsK, (lds_u32*)(lds + sl_), 16, (int)voK, (int)(koff + (unsigned)tt_ * (unsigned)(KVBLK * 768)), 0, 0); \
    __builtin_amdgcn_raw_ptr_buffer_load_lds(rsV, (lds_u32*)(lds + sl_ + VOFF), 16, (int)voV, (int)(vtoff + (unsigned)tt_ * 8192u), 0, 0); } while (0)
#define WAITB() asm volatile("s_waitcnt vmcnt(2)\n\ts_barrier" ::: "memory")
#define RESC(X0, X1) do { if (__builtin_expect(__any(dl8 > 0.f), 0)) { if (hi == 0) al_l[r32] = __builtin_amdgcn_exp2f(-0.125f * dl8); asm volatile("s_waitcnt lgkmcnt(0)" ::: "memory"); \
    _Pragma("unroll") for (int r = 0; r < 4; ++r) lacc[r] *= al_l[4 * (lane >> 4) + r + 16 * (lane & 1)]; \
    _Pragma("unroll") for (int r = 0; r < 16; ++r) { const float f_ = al_l[crow(r, hi)]; _Pragma("unroll") for (int d = 0; d < 4; ++d) o[d][r] *= f_; } \
    _Pragma("unroll") for (int r = 0; r < 16; ++r) { X0[r] -= dl8; X1[r] -= dl8; CKP[r] -= dl8; } } } while (0)
  const int kb0 = (int)(uintptr_t)lds + r32 * 128 + (((4 * map + 2 * hi) ^ ((r32 >> 1) & 7)) * 16);
  const int vb0 = (int)(uintptr_t)lds + VOFF + r32 * 64 + (((2 * hi) ^ ((r32 >> 2) & 3)) * 16);
  const int kb0x = kb0 ^ 16, vb0x = vb0 ^ 16;
  f32x16 pA0, pA1, pB0, pB1, CKP; v8i_a pf; float dl8 = 0.f;
#define ROWMAX_A(X0) mxa_ = MX3(X0[0], X0[1], X0[2]); mxb_ = MX3(X0[3], X0[4], X0[5]); mxa_ = MX3(mxa_, X0[6], X0[7]); mxb_ = MX3(mxb_, X0[8], X0[9]); mxa_ = MX3(mxa_, X0[10], X0[11]); mxb_ = MX3(mxb_, X0[12], X0[13]); mxa_ = MX3(mxa_, X0[14], X0[15]);
#define ROWMAX_B(X1) mxb_ = MX3(mxb_, X1[0], X1[1]); mxa_ = MX3(mxa_, X1[2], X1[3]); mxb_ = MX3(mxb_, X1[4], X1[5]); mxa_ = MX3(mxa_, X1[6], X1[7]); mxb_ = MX3(mxb_, X1[8], X1[9]); mxa_ = MX3(mxa_, X1[10], X1[11]); mxb_ = MX3(mxb_, X1[12], X1[13]); \
    mxa_ = MX3(mxa_, X1[14], X1[15]); rm_ = __builtin_fmaxf(mxa_, mxb_); \
    { auto rr_ = __builtin_amdgcn_permlane32_swap(__float_as_uint(rm_), __float_as_uint(rm_), false, false); rm_ = __builtin_fmaxf(__uint_as_float(rr_[0]), __uint_as_float(rr_[1])); }
#define PIN(x_) asm volatile("" : "+v"(x_))
  v4i_a va0_, va1_, vc0_, vc1_, vd0_, vd1_, ve0_, ve1_;
#define VREADS(t_) do { const int so_ = ((t_) & 7) * SLOT; const int vb_ = vb0 + so_, vx_ = vb0x + so_; va0_ = LDSV(vb_); va1_ = LDSV(vx_); vc0_ = LDSV(vb_ + 2048); vc1_ = LDSV(vx_ + 2048); \
    vd0_ = LDSV(vb_ + 4096); vd1_ = LDSV(vx_ + 4096); ve0_ = LDSV(vb_ + 6144); ve1_ = LDSV(vx_ + 6144); } while (0)
#define INTERVAL(X0, X1, Y0, Y1, j_) do { float mxa_ = 0.f, mxb_ = 0.f, rm_ = 0.f; \
    WAITB(); \
    const int kb_ = kb0 + ((j_) & 7) * SLOT, kx_ = kb0x + ((j_) & 7) * SLOT; \
    v4i_a ka0_ = LDSV(kb_), ka1_ = LDSV(kx_), kc0_ = LDSV(kb_ + 4096), kc1_ = LDSV(kx_ + 4096); \
    DMA_TILE((j_) + 2); \
    SBAR(); EXPS(Y0, 0, pf, 0); EXPS(Y0, 1, pf, 0); SBAR(); \
    PIN(ka0_); X0 = QKMF(ka0_, ka1_, CKP); PIN(X0); SBAR(); \
    EXPS(Y1, 0, pf, 4); EXPS(Y1, 1, pf, 4); SBAR(); \
    PIN(kc0_); X1 = QKMF(kc0_, kc1_, CKP); PIN(X1); SBAR(); \
    PIN(va0_); o[0] = PVMF(pf, o[0], va0_, va1_); PIN(o[0]); SBAR(); \
    ROWMAX_A(X0) \
    SBAR(); PIN(vc0_); o[1] = PVMF(pf, o[1], vc0_, vc1_); PIN(o[1]); SBAR(); \
    ROWMAX_B(X1) \
    dl8 = rm_ > LIM8 ? rm_ - KP0 : 0.f; \
    SBAR(); PIN(vd0_); o[2] = PVMF(pf, o[2], vd0_, vd1_); PIN(o[2]); SBAR(); \
    PIN(ve0_); o[3] = PVMF(pf, o[3], ve0_, ve1_); PIN(o[3]); SBAR(); \
    PIN(pf); lacc = __builtin_amdgcn_mfma_scale_f32_16x16x128_f8f6f4(pf, ones, lacc, 0, 0, 0, 0x7f7f7f7f, 0, 0x7f7f7f7f); PIN(lacc); SBAR(); \
    VREADS(j_); SBAR(); \
    RESC(X0, X1); } while (0)
  DMA_TILE(0); DMA_TILE(1);
  WAITB();
  DMA_TILE(2);
  { const v4i_a ka0_ = LDSV(kb0), ka1_ = LDSV(kb0 ^ 16), kc0_ = LDSV(kb0 + 4096), kc1_ = LDSV((kb0 + 4096) ^ 16);
    pA0 = QKMF(ka0_, ka1_, f32x16{}); pA1 = QKMF(kc0_, kc1_, f32x16{}); float mxa_, mxb_, rm_;
    ROWMAX_A(pA0) ROWMAX_B(pA1)
    const float kp0_ = KP0 - rm_;
#pragma unroll
    for (int r = 0; r < 16; ++r) { CKP[r] = kp0_; pA0[r] += kp0_; pA1[r] += kp0_; }
    PIN(CKP); VREADS(0); }
  for (int j = 1; j + 1 < NT; j += 2) {
    INTERVAL(pB0, pB1, pA0, pA1, j);
    INTERVAL(pA0, pA1, pB0, pB1, j + 1); }
  INTERVAL(pB0, pB1, pA0, pA1, NT - 1);
  { EXPS(pB0, 0, pf, 0); EXPS(pB0, 1, pf, 0); EXPS(pB1, 0, pf, 4); EXPS(pB1, 1, pf, 4);
    o[0] = PVMF(pf, o[0], va0_, va1_); o[1] = PVMF(pf, o[1], vc0_, vc1_); o[2] = PVMF(pf, o[2], vd0_, vd1_); o[3] = PVMF(pf, o[3], ve0_, ve1_);
    lacc = __builtin_amdgcn_mfma_scale_f32_16x16x128_f8f6f4(pf, ones, lacc, 0, 0, 0, 0x7f7f7f7f, 0, 0x7f7f7f7f); }
  asm volatile("s_waitcnt vmcnt(0)" ::: "memory");
#undef INTERVAL
#undef VREADS
#undef PIN
#undef ROWMAX_A
#undef ROWMAX_B
#undef DMA_TILE
#undef WAITB
  float rli[16];
  if ((lane & 15) < 2) {
#pragma unroll
    for (int r = 0; r < 4; ++r) ws[16 * (lane & 15) + 4 * (lane >> 4) + r] = lacc[r]; }
  asm volatile("s_waitcnt lgkmcnt(0)" ::: "memory");
#pragma unroll
  for (int r = 0; r < 16; ++r) rli[r] = __builtin_amdgcn_rcpf(ws[crow(r, hi)]);
  __syncthreads();
  int zz = 0; asm volatile("" : "+v"(zz));
  float* EX = (float*)lds;
  const int eb = wq * 4096 + lane + zz;
  if constexpr (MAP == 1) {
#pragma unroll
    for (int d0 = 0; d0 < 4; ++d0)
#pragma unroll
      for (int r = 0; r < 16; ++r) EX[eb + (d0 * 16 + r) * 64] = -lam * o[d0][r] * rli[r];
  }
  __syncthreads();
  if constexpr (MAP == 0) {
    float ss[16];
#pragma unroll
    for (int r = 0; r < 16; ++r) ss[r] = 0.f;
#pragma unroll
    for (int d0 = 0; d0 < 4; ++d0)
#pragma unroll
      for (int r = 0; r < 16; ++r) { const float v = o[d0][r] * rli[r] + EX[eb + (d0 * 16 + r) * 64]; o[d0][r] = v; ss[r] += v * v; }
#pragma unroll
    for (int r = 0; r < 16; ++r) { float s = ss[r]; s += __shfl_xor(s, 1); s += __shfl_xor(s, 2); s += __shfl_xor(s, 4); s += __shfl_xor(s, 8); s += __shfl_xor(s, 16);
      ss[r] = gsc / sqrtf(s * (1.0f / 128.0f) + EPS); }
    bf16* Ow = Ob + (long)(wq * 32 + 4 * hi) * 1024 + r32 + zz;
#pragma unroll
    for (int d0 = 0; d0 < 4; ++d0) { const float gv = gn[d0 * 32 + r32];
#pragma unroll
      for (int r = 0; r < 16; ++r) Ow[((r & 3) + 8 * (r >> 2)) * 1024 + d0 * 32] = (bf16)(cvt_pk_bf16(o[d0][r] * ss[r] * gv, 0.f) & 0xffffu); }
  }
  __syncthreads();
#undef RESC
#undef LDSV
#undef CAT8
#undef QKMF
#undef PVMF
#undef EXPS
#undef EXPW
#undef EXPB1
}
#undef MX3
#undef SBAR
}
#ifdef PROBE_SUB
#define SUB_T0 const unsigned long long sub_t0_ = __builtin_amdgcn_s_memrealtime()
#define SUB_SPIN(id) do { if (PROBE_SUB == (id)) { const unsigned long long t1_ = __builtin_amdgcn_s_memrealtime(), d_ = 9ull * (t1_ - sub_t0_); while (__builtin_amdgcn_s_memrealtime() - t1_ < d_) __builtin_amdgcn_s_sleep(8); } } while (0)
#else
#define SUB_T0 do {} while (0)
#define SUB_SPIN(id) do {} while (0)
#endif
__device__ __forceinline__ void ph_mix_even(Frame& F, int i) {
    SUB_T0;
    if (!(F.A->mode & 4)) for (int it = F.bid; it < 256; it += F.G) { LAUNDER(F);
#ifndef NO_RET
        if (it < 128) ret_item(F, i, it >> 4, (it >> 2) & 3, (it >> 1) & 1, it & 1);
#endif
#ifndef NO_LRU
        if (it >= 128) { const int j = it - 128; lru_item(F, i, j >> 4, (j >> 3) & 1, j & 7); }
#endif
        __syncthreads();
    }
    SUB_SPIN(3);
#ifdef PROBE_SUB
    if (F.bid < 128) { SUB_SPIN(5); } else { SUB_SPIN(6); }
#endif
}
__device__ __forceinline__ void ph_mix_odd(Frame& F, int l, int ctx_out) {
    const int i = l >> 1;
    { SUB_T0;
#ifndef NO_S5
    if (!(F.A->mode & 1)) for (int it = F.bid; it < 256; it += F.G) { LAUNDER(F); s5_item(F, i, it >> 5, (it >> 4) & 1, it & 15); __syncthreads(); }
#endif
    SUB_SPIN(1); }
    SUB_T0;
    const float* lp = INP(30) + (size_t)i * 256;
    const float s01 = wave_sum(lp[F.lane] * lp[64 + F.lane]), s23 = wave_sum(lp[128 + F.lane] * lp[192 + F.lane]);
    const float lam_init = 0.8f - 0.6f * expf(-0.3f * (float)l), lam = expf(s01) - expf(s23) + lam_init, gsc = 1.0f - lam_init;
    const bf16* Z = (const bf16*)FBIG; const float* gn = INP(31) + (size_t)i * 768;
    const int vcu = (F.G % 8 == 0) ? (F.bid % 8) * (F.G / 8) + F.bid / 8 : F.bid;
    const int nx = NB * 6 * 64, nc = ctx_out ? NB * 6 * 2 : 0;
    if (!(F.A->mode & 2)) for (int u = vcu; u < nx + nc; u += F.G) { LAUNDER(F);
        int bh, qb, row0, seq;
        if (u < nx) { bh = u >> 6; qb = u & 63; row0 = (bh / 6) * TB + CTXL + 128 * qb; seq = TB; }
        else { const int v = u - nx; bh = v >> 1; qb = v & 1; row0 = (bh / 6) * TB + 128 * qb; seq = CTXL; }
        const int b = bh / 6, h = bh % 6;
#ifndef NO_ATTN
        if (F.wave < 4) att::unit<0>(FBIG + Q8_OFF, (size_t)row0, h * 128, FYB + K8_OFF, (size_t)b * TB, FYB + VT_OFF, (unsigned)((size_t)bh * 132 * 8192),
                  FH + (size_t)row0 * D + 256 + h * 128, seq, (char*)F.lds, lam, gsc, gn + h * 128, F.tid);
        else att::unit<1>(FBIG + Q8_OFF, (size_t)row0, h * 128, FYB + K8_OFF, (size_t)b * TB, FYB + VT_OFF, (unsigned)((size_t)bh * 132 * 8192),
                  FH + (size_t)row0 * D + 256 + h * 128, seq, (char*)F.lds, lam, gsc, gn + h * 128, F.tid);
#endif
    }
    SUB_SPIN(2);
}

constexpr int PH_PER_LAYER = 18, PH_TOTAL = 2 + NLAYER * PH_PER_LAYER;
#define IN(k) (lo <= (k) && (k) < hi)
#ifndef PROBE_PARITY
#define PROBE_PARITY (-1)
#endif
#ifdef PROBE_SPIN_KINDS
#define PH0 const unsigned long long ph_t0_ = __builtin_amdgcn_s_memrealtime()
#define SEAM(k) do { if (IN((k) + 1)) xcd_barrier(bar, LEAD0(F)); { const int kk_ = ((k) - 1) % PH_PER_LAYER; if (((k) > 0) && ((PROBE_SPIN_KINDS >> kk_) & 1) && (PROBE_PARITY < 0 || ((((k) - 1) / PH_PER_LAYER) & 1) == PROBE_PARITY)) { const unsigned long long t1_ = __builtin_amdgcn_s_memrealtime(), d_ = 9ull * (t1_ - ph_t0_); \
        while (__builtin_amdgcn_s_memrealtime() - t1_ < d_) __builtin_amdgcn_s_sleep(8); } } } while (0)
#else
#define PH0 do {} while (0)
#define SEAM(k) do { if (IN((k) + 1)) xcd_barrier(bar, LEAD0(F)); } while (0)
#endif
template <int l> __device__ __forceinline__ void run_layer(Frame& F, const XcdBarrier& bar, const int lo, const int hi) {
        constexpr int P = 1 + PH_PER_LAYER * l, i = l >> 1; constexpr bool odd = l & 1; constexpr int ctx_out = l < NLAYER - 1;
        const float* MODl = FMOD + (size_t)l * 9 * 6144; const float* ng = INP(6) + (size_t)l * 4 * 1024;
        if (IN(P + 0)) { LAUNDER(F); PH0;
            ph_convert(F, l);
#ifdef PROBE_CONVERT
            __syncthreads(); ph_convert(F, l);
#endif
            NormArgs a{}; a.xin_input = (l == 0); a.has_y = (l > 0); a.two = (l > 0) && ((l - 1) & 1); a.write_x = (l > 0); a.final_ = 0; a.do_h = 1; a.do_route = 0;
            if (l > 0) { a.gate = FMOD + (size_t)(l - 1) * 9 * 6144 + 5 * 1024; a.gy = INP(6) + (size_t)(l - 1) * 4 * 1024 + 3 * 1024; }
            a.gh = ng; a.shift = MODl; a.scale = MODl + 1024;
            __syncthreads(); ph_norm(F, a); SEAM(P + 0);
        }
        if (IN(P + 1)) { LAUNDER(F); PH0;
            constexpr int N = odd ? OD_IN : EV_IN, HD = odd ? 32 : 64;
            pg8::Gemm g{FH, FWB + W_IN / 2, M, N, D}; pg8::StaticOrder S; S.init(M, N, F.G, F.bid);
            pg8::EpiWin<HD> E{(bf16*)FBIG, N, (const float*)(WSG + (odd ? WS_ROPE_D : WS_ROPE_R)), odd ? 1 : 4, odd ? 4 : 6, odd ? 4 : 6, odd ? 7 : 8, odd ? 4.0f * 0.125f * 1.4426950408889634f : 1.0f, odd ? 1.0f : 0.08838834764831845f,
                                 odd ? FBIG + Q8_OFF : (unsigned char*)nullptr, odd ? FYB + K8_OFF : (unsigned char*)nullptr, 256, 1024};
            pg8::gemm_phase<pg8::EpiWin<HD>, pg8::StaticOrder, true, true>(F.lds, g, S, E, F.tid);
            if (odd) { SEAM(P + 1); } else { SEAM(P + 2); }
        }
        if (odd && IN(P + 2)) { LAUNDER(F); PH0; ph_vt(F); SEAM(P + 2); }
        if (IN(P + 3)) { LAUNDER(F); PH0;
            if (!odd) { ph_mix_even(F, i); }
            else ph_mix_odd(F, l, ctx_out);
            SEAM(P + 3); }
        if (IN(P + 4)) { LAUNDER(F); PH0; if (!odd) ph_merge_even(F, i); else ph_zpass(F, i); SEAM(P + 4); }
        if (odd && IN(P + 5)) { LAUNDER(F); PH0;
            int kglu = 256; asm volatile("" : "+s"(kglu));
            pg8::Gemm g{(const bf16*)(FYB + 2 * T_QUART), FWB + W_GLU / 2, M, 256, kglu}; pg8::StaticOrder S; S.init(M, 256, F.G, F.bid);
            pg8::EpiGLU E{FH, D, (const bf16*)(FYB + 2 * T_QUART), 256, INP(29) + (size_t)i * 256};
            pg8::gemm_phase<pg8::EpiGLU, pg8::StaticOrder, true, true>(F.lds, g, S, E, F.tid);
            SEAM(P + 5);
        }
        if (IN(P + 6)) { LAUNDER(F); PH0;
            pg8::Gemm g{FH, FWB + W_OUT / 2, M, D, D}; pg8::StaticOrder S; S.init(M, D, F.G, F.bid);
            pg8::EpiPlain E{(bf16*)FYB, D, 1.0f};
            pg8::gemm_phase<pg8::EpiPlain, pg8::StaticOrder, true, true>(F.lds, g, S, E, F.tid);
            if (!odd) { const int tw = ((M / 256) * (D / 256)) % F.G; if (tw == 0 || F.bid >= tw) { __syncthreads(); ph_convert_moe(F, i, tw, F.G - tw, 0, 3); } }
            SEAM(P + 6);
        }
        if (IN(P + 7)) { LAUNDER(F); PH0;
            NormArgs a{}; a.xin_input = (l == 0); a.has_y = 1; a.two = 0; a.write_x = 1; a.final_ = 0; a.do_h = 1; a.do_route = odd; a.h8 = 1;
            a.gate = MODl + 2 * 1024; a.gy = ng + 1024; a.gh = ng + 2 * 1024; a.shift = MODl + 3 * 1024; a.scale = MODl + 4 * 1024;
            a.rw = INP(33) + (size_t)i * 8192; a.rb = INP(34) + (size_t)i * 8;
            ph_norm(F, a); SEAM(P + 7);
        }
        if (!odd) {
            if (IN(P + 9)) { LAUNDER(F); PH0;
                int k8 = D / 2; asm volatile("" : "+s"(k8));
                pg8::Gemm g{FH, (const bf16*)((const unsigned char*)FWB + W_GU), M, 2 * DFF, k8}; pg8::StaticOrder S; S.init(M, 2 * DFF, F.G, F.bid);
                pg8::EpiSwiGLU8 E{FBIG + BIG_ACT, DFF, W8_INV};
                pg8::gemm_phase<pg8::EpiSwiGLU8, pg8::StaticOrder, true, true, true>(F.lds, g, S, E, F.tid);
                SEAM(P + 9);
            }
            if (IN(P + 10)) { LAUNDER(F); PH0;
                int k8 = DFF / 2; asm volatile("" : "+s"(k8));
                pg8::Gemm g{(const bf16*)(FBIG + BIG_ACT), (const bf16*)((const unsigned char*)FWB + W_DN), M, D, k8}; pg8::StaticOrder S; S.init(M, D, F.G, F.bid);
                pg8::EpiPlain E{(bf16*)FYB, D, W8_INV};
                pg8::gemm_phase<pg8::EpiPlain, pg8::StaticOrder, true, true, true>(F.lds, g, S, E, F.tid);
                { const int tw = ((M / 256) * (D / 256)) % F.G; if (tw == 0 || F.bid >= tw) { __syncthreads(); ph_convert_moe(F, i, tw, F.G - tw, 3, NE); } }
                SEAM(P + 10);
            }
        } else {
            if (IN(P + 8)) { LAUNDER(F); PH0; ph_assign(F); SEAM(P + 8); }
#pragma nounroll
            for (int w = 0; w < 2; ++w) {
                const int* PE = (const int*)(WSG + WS_PEXP);
                if (IN(P + 9 + 3 * w)) { LAUNDER(F); PH0; const int np = PE[MAXP], p0 = min(np, 256 * w), p1 = (w == 0) ? min(np, 256) : np; ph_gather(F, p0, p1); SEAM(P + 9 + 3 * w); }
                if (IN(P + 10 + 3 * w)) { LAUNDER(F); PH0; const int np = PE[MAXP], p0 = min(np, 256 * w), p1 = (w == 0) ? min(np, 256) : np;
                    int k8 = D / 2; asm volatile("" : "+s"(k8));
                    pg8::Gemm g{(const bf16*)(FBIG + BIG_HG), (const bf16*)(WSG + WS_W2 + W2_MGU), (p1 - p0) * 256, 2 * DFF, k8};
                    pg8::ExpertOrder S; S.init((p1 - p0) * 256, 2 * DFF, F.G, F.bid); S.pexp = PE + p0; S.estride = (size_t)7168 * 1024; S.tab = (LAS int*)(F.lds + RING_BYTES); __syncthreads(); S.fill(F.tid); __syncthreads();
                    pg8::EpiSwiGLU8 E{FBIG + BIG_ACT, DFF, W8_INV};
                    pg8::gemm_phase<pg8::EpiSwiGLU8, pg8::ExpertOrder, true, true, true>(F.lds, g, S, E, F.tid);
                    SEAM(P + 10 + 3 * w); }
                if (IN(P + 11 + 3 * w)) { LAUNDER(F); PH0; const int np = PE[MAXP], p0 = min(np, 256 * w), p1 = (w == 0) ? min(np, 256) : np;
                    int k8 = DFF / 2; asm volatile("" : "+s"(k8));
                    pg8::Gemm g{(const bf16*)(FBIG + BIG_ACT), (const bf16*)(WSG + WS_W2 + W2_MDN), (p1 - p0) * 256, D, k8};
                    pg8::ExpertOrder S; S.init((p1 - p0) * 256, D, F.G, F.bid); S.pexp = PE + p0; S.estride = (size_t)1024 * 3584; S.tab = (LAS int*)(F.lds + RING_BYTES); __syncthreads(); S.fill(F.tid); __syncthreads();
                    pg8::EpiScatter E{(const RouteEnt*)(WSG + WS_LIST) + (size_t)p0 * 256, (bf16*)FYB, (size_t)M * 1024, D, W8_INV};
                    pg8::gemm_phase<pg8::EpiScatter, pg8::ExpertOrder, true, true, true>(F.lds, g, S, E, F.tid);
                    if (w == 0) { SEAM(P + 11); } else { if (IN(P + PH_PER_LAYER)) xcd_barrier(bar, LEAD0(F)); } }
            }
        }
    }
#undef IN
#undef SEAM
__global__ void __launch_bounds__(512, 2) hybrid_fwd(Args args) {
    extern __shared__ __attribute__((aligned(16))) unsigned char lds_raw[];
    Frame F;
    F.lds = (LAS unsigned char*)lds_raw;
    F.tid = threadIdx.x; F.lane = F.tid & 63; F.wave = __builtin_amdgcn_readfirstlane(F.tid >> 6); F.G = gridDim.x; F.bid = blockIdx.x;
    F.A = (KArgs*)__builtin_amdgcn_kernarg_segment_ptr(); F.wsi = F.A->ws;
    volatile LAS unsigned* MISC = (volatile LAS unsigned*)(F.lds + MISC_OFF);
    for (int u = F.tid; u < (LDS_BYTES - LDSCTL_OFF) / 4; u += 512) ((LAS unsigned*)(F.lds + LDSCTL_OFF))[u] = 0u;
    __syncthreads();
    const int lo = args.ph_lo, hi = args.ph_hi;
    const bool multi = (hi - lo) > 1;
    unsigned* ctl = (unsigned*)(WSG + WS_CTL);
    XcdBarrier bar; bar.bar = ctl + CW_BAR; bar.x = 0; bar.st = nullptr;
    if (multi) bar = xcd_barrier_post(ctl + CW_BAR, MISC + 8);
#define IN(k) (lo <= (k) && (k) < hi)
#ifdef PROBE_SPIN_KINDS
#define PH0 const unsigned long long ph_t0_ = __builtin_amdgcn_s_memrealtime()
#define SEAM(k) do { if (IN((k) + 1)) xcd_barrier(bar, LEAD0(F)); { const int kk_ = ((k) - 1) % PH_PER_LAYER; if (((k) > 0) && ((PROBE_SPIN_KINDS >> kk_) & 1) && (PROBE_PARITY < 0 || ((((k) - 1) / PH_PER_LAYER) & 1) == PROBE_PARITY)) { const unsigned long long t1_ = __builtin_amdgcn_s_memrealtime(), d_ = 9ull * (t1_ - ph_t0_); \
        while (__builtin_amdgcn_s_memrealtime() - t1_ < d_) __builtin_amdgcn_s_sleep(8); } } } while (0)
#else
#define PH0 do {} while (0)
#define SEAM(k) do { if (IN((k) + 1)) xcd_barrier(bar, LEAD0(F)); } while (0)
#endif
#if defined(UBENCH) && UBENCH == 6
    { typedef int ub_v8i __attribute__((ext_vector_type(8)));
      ub_v8i ua = {(int)F.tid, 1, 2, 3, 4, 5, 6, 7}, ub = {7, 6, 5, 4, 3, 2, 1, (int)F.tid}; f32x16 c0 = {}, c1 = {}, c2 = {}, c3 = {};
      for (int i = 0; i < UB_N; ++i) { asm volatile("" : "+v"(ua), "+v"(ub));
        c0 = __builtin_amdgcn_mfma_scale_f32_32x32x64_f8f6f4(ua, ub, c0, 0, 0, 0, 0x7f7f7f7f, 0, 0x7f7f7f7f); c1 = __builtin_amdgcn_mfma_scale_f32_32x32x64_f8f6f4(ua, ub, c1, 0, 0, 0, 0x7f7f7f7f, 0, 0x7f7f7f7f);
        c2 = __builtin_amdgcn_mfma_scale_f32_32x32x64_f8f6f4(ua, ub, c2, 0, 0, 0, 0x7f7f7f7f, 0, 0x7f7f7f7f); c3 = __builtin_amdgcn_mfma_scale_f32_32x32x64_f8f6f4(ua, ub, c3, 0, 0, 0, 0x7f7f7f7f, 0, 0x7f7f7f7f); }
      asm volatile("" :: "v"(c0), "v"(c1), "v"(c2), "v"(c3)); }
#elif defined(UBENCH) && UBENCH == 7
    { typedef int ub_v8i __attribute__((ext_vector_type(8)));
      ub_v8i ua = {(int)F.tid, 1, 2, 3, 4, 5, 6, 7}, ub = {7, 6, 5, 4, 3, 2, 1, (int)F.tid}; f32x16 c0 = {}, c1 = {}, c2 = {}, c3 = {};
      float a0 = (float)F.tid, a1 = a0 + 1.f, a2 = a0 + 2.f, a3 = a0 + 3.f, a4 = a0 + 4.f, a5 = a0 + 5.f, a6 = a0 + 6.f;
#define UBF(r) "v_fma_f32 " r ", " r ", " r ", " r "\n\t"
#define UBF14 UBF("%0") UBF("%1") UBF("%2") UBF("%3") UBF("%4") UBF("%5") UBF("%6") UBF("%0") UBF("%1") UBF("%2") UBF("%3") UBF("%4") UBF("%5") UBF("%6")
#define UBV() asm volatile(UBF14 : "+v"(a0), "+v"(a1), "+v"(a2), "+v"(a3), "+v"(a4), "+v"(a5), "+v"(a6))
      for (int i = 0; i < UB_N; ++i) { asm volatile("" : "+v"(ua), "+v"(ub));
        c0 = __builtin_amdgcn_mfma_scale_f32_32x32x64_f8f6f4(ua, ub, c0, 0, 0, 0, 0x7f7f7f7f, 0, 0x7f7f7f7f); asm volatile("" : "+v"(c0)); UBV();
        c1 = __builtin_amdgcn_mfma_scale_f32_32x32x64_f8f6f4(ua, ub, c1, 0, 0, 0, 0x7f7f7f7f, 0, 0x7f7f7f7f); asm volatile("" : "+v"(c1)); UBV();
        c2 = __builtin_amdgcn_mfma_scale_f32_32x32x64_f8f6f4(ua, ub, c2, 0, 0, 0, 0x7f7f7f7f, 0, 0x7f7f7f7f); asm volatile("" : "+v"(c2)); UBV();
        c3 = __builtin_amdgcn_mfma_scale_f32_32x32x64_f8f6f4(ua, ub, c3, 0, 0, 0, 0x7f7f7f7f, 0, 0x7f7f7f7f); asm volatile("" : "+v"(c3)); UBV(); }
      asm volatile("" :: "v"(c0), "v"(c1), "v"(c2), "v"(c3), "v"(a0), "v"(a1), "v"(a2), "v"(a3), "v"(a4), "v"(a5), "v"(a6)); }
#elif defined(UBENCH)
    { float a0 = (float)F.tid, a1 = a0 + 1.f, a2 = a0 + 2.f, a3 = a0 + 3.f, a4 = a0 + 4.f, a5 = a0 + 5.f, a6 = a0 + 6.f, a7 = a0 + 7.f;
#if UBENCH == 1
#define UB1(r) "v_fma_f32 " r ", " r ", " r ", " r "\n\t"
#elif UBENCH == 2
#define UB1(r) "v_cvt_u32_f32 " r ", " r "\n\t"
#elif UBENCH == 3
#define UB1(r) "v_cvt_pk_fp8_f32 " r ", " r ", " r "\n\t"
#elif UBENCH == 4
#define UB1(r) "v_exp_f32 " r ", " r "\n\t"
#elif UBENCH == 10
#define UB1(r) "v_cvt_pk_u8_f32 " r ", " r ", 1, " r "\n\t"
#elif UBENCH == 9
#define UB1(r) "v_fma_f32 %0, %0, %0, %0\n\t"
#elif UBENCH == 5
#define UB1(r) "v_max3_f32 " r ", " r ", " r ", " r "\n\t"
#endif
#define UB8 UB1("%0") UB1("%1") UB1("%2") UB1("%3") UB1("%4") UB1("%5") UB1("%6") UB1("%7")
      for (int i = 0; i < UB_N; ++i) asm volatile(UB8 UB8 UB8 UB8 : "+v"(a0), "+v"(a1), "+v"(a2), "+v"(a3), "+v"(a4), "+v"(a5), "+v"(a6), "+v"(a7));
      asm volatile("" :: "v"(a0), "v"(a1), "v"(a2), "v"(a3), "v"(a4), "v"(a5), "v"(a6), "v"(a7)); }
#endif
    if (IN(0)) { LAUNDER(F); PH0; ph_prologue(F); SEAM(0); }
    run_layer<0>(F, bar, lo, hi); run_layer<1>(F, bar, lo, hi); run_layer<2>(F, bar, lo, hi); run_layer<3>(F, bar, lo, hi);
    if (IN(PH_TOTAL - 1)) { LAUNDER(F); PH0;
        NormArgs a{}; a.xin_input = 0; a.has_y = 1; a.two = 1; a.write_x = 1; a.final_ = 1; a.do_h = 0; a.do_route = 0;
        a.gate = FMOD + (size_t)3 * 9 * 6144 + 5 * 1024; a.gy = INP(6) + (size_t)3 * 4 * 1024 + 3 * 1024;
        ph_norm(F, a);
    }
#undef IN
#undef SEAM
}


#ifndef DBG_SCAN
#define DBG_SCAN 0
#endif
#if DBG_SCAN
constexpr int CW_DBG = 2048;
__global__ void __launch_bounds__(256) dbg_scan(unsigned char* ws, const float* out, int phase) {
    unsigned* flag = (unsigned*)(ws + WS_CTL) + CW_DBG; bool bad = false;
    const size_t gt = (size_t)blockIdx.x * 256 + threadIdx.x, gs = (size_t)gridDim.x * 256;
    { const uint4* p = (const uint4*)(ws + WS_W); const size_t n = (WS_END - WS_W) / 16;
      for (size_t i = gt; i < n; i += gs) { const uint4 v = p[i]; const unsigned w[4] = {v.x, v.y, v.z, v.w};
#pragma unroll
          for (int k = 0; k < 4; ++k) { if ((w[k] & 0x7F80u) == 0x7F80u || (w[k] & 0x7F800000u) == 0x7F800000u) bad = true; } } }
    { const uint4* p = (const uint4*)(ws + WS_MOD); const size_t n = 4 * 9 * 6144 / 4;
      for (size_t i = gt; i < n; i += gs) { const uint4 v = p[i]; if ((v.x & 0x7F800000u) == 0x7F800000u || (v.y & 0x7F800000u) == 0x7F800000u || (v.z & 0x7F800000u) == 0x7F800000u || (v.w & 0x7F800000u) == 0x7F800000u) bad = true; } }
    { const uint4* p = (const uint4*)out; const size_t n = (size_t)NB * SEQ * D / 4;
      for (size_t i = gt; i < n; i += gs) { const uint4 v = p[i]; if ((v.x & 0x7F800000u) == 0x7F800000u || (v.y & 0x7F800000u) == 0x7F800000u || (v.z & 0x7F800000u) == 0x7F800000u || (v.w & 0x7F800000u) == 0x7F800000u) bad = true; } }
    { const unsigned* p = (const unsigned*)(ws + WS_MOD); const size_t n = 4 * 9 * 6144;
      for (size_t i = gt; i < n; i += gs) if ((p[i] & 0x7F800000u) == 0x7F800000u) bad = true; }
    if (bad) atomicMax(flag, 1000u - (unsigned)phase);
}
__global__ void __launch_bounds__(256) dbg_emit(unsigned char* ws, float* out) {
    const unsigned f = ((const unsigned*)(ws + WS_CTL))[CW_DBG], f2 = ((const unsigned*)(ws + WS_CTL))[CW_DBG + 1]; if (f == 0u && f2 == 0u) return;
    const int p = f2 ? 40 + (100 - (int)f2) : 1000 - (int)f;
    const size_t n = (size_t)NB * SEQ * D;
    for (size_t i = (size_t)blockIdx.x * 256 + threadIdx.x; i < n; i += (size_t)gridDim.x * 256) out[i] = (i == 0) ? ldexpf(1.0f, 14 + p) : 0.f;
}
#endif
static bool phase_exists(int ph) {
    if (ph == 0 || ph == PH_TOTAL - 1) return true;
    const int l = (ph - 1) / PH_PER_LAYER, k = (ph - 1) % PH_PER_LAYER; const bool odd = l & 1;
    if (k == 2) return odd;
    if (odd) return k <= 14;
    return k <= 1 || k == 3 || k == 4 || k == 6 || k == 7 || k == 9 || k == 10;
}
#ifndef MK_ONE_LAUNCH
#define MK_ONE_LAUNCH 1
#endif
extern "C" void kernel_launch(void* const* d_in, const int* in_sizes, int n_in, void* d_out, int out_size, void* d_ws, size_t ws_size, hipStream_t stream) {
    static int grid = 0;
    if (grid == 0) {
        if (n_in != 38 || in_sizes[0] != NB * SEQ * D || out_size != NB * SEQ * D || ws_size < WS_END) { fprintf(stderr, "kernel_launch: unexpected shapes / workspace (%d inputs, ws %zu)\n", n_in, ws_size); grid = -1; return; }
        int dev = 0, cus = 0, per_cu = 0;
        if (hipGetDevice(&dev) != hipSuccess || hipDeviceGetAttribute(&cus, hipDeviceAttributeMultiprocessorCount, dev) != hipSuccess) { grid = -1; return; }
        if (hipFuncSetAttribute((const void*)hybrid_fwd, hipFuncAttributeMaxDynamicSharedMemorySize, LDS_BYTES) != hipSuccess) { fprintf(stderr, "kernel_launch: hipFuncSetAttribute failed\n"); grid = -1; return; }
        if (hipOccupancyMaxActiveBlocksPerMultiprocessor(&per_cu, (const void*)hybrid_fwd, 512, LDS_BYTES) != hipSuccess || per_cu < 1) fprintf(stderr, "kernel_launch: occupancy query reports %d workgroups per CU\n", per_cu);
        (void)hipGetLastError();
        grid = cus;
    }
    if (grid < 0) return;
    if (hipMemsetAsync((char*)d_ws + WS_CTL, 0, CTL_ZERO_BYTES, stream) != hipSuccess) return;
#if DBG_SCAN
    (void)hipMemsetAsync(d_ws, 0, WS_END, stream); (void)hipMemsetAsync(d_out, 0, (size_t)out_size * 4, stream);
#endif
    Args a{};
    for (int i = 0; i < 38; ++i) a.in[i] = (const float*)d_in[i];
    a.out = (float*)d_out; a.ws = (unsigned char*)d_ws;
    if (MK_ONE_LAUNCH) { a.ph_lo = 0; a.ph_hi = PH_TOTAL; hipLaunchKernelGGL(hybrid_fwd, dim3(grid), dim3(512), LDS_BYTES, stream, a); }
    else for (int ph = 0; ph < PH_TOTAL; ++ph) { if (!phase_exists(ph)) continue; a.ph_lo = ph; a.ph_hi = ph + 1;
        int reps = 1;
#ifdef PROBE_REPEAT
        if (ph > 0 && ph < PH_TOTAL - 1) { const int k = (ph - 1) % PH_PER_LAYER; if ((PROBE_REPEAT >> k) & 1) reps = 2; }
#endif
        for (int rp = 0; rp < reps; ++rp) {
#ifdef PROBE_MODE
            a.mode = rp ? PROBE_MODE : 0;
#endif
            hipLaunchKernelGGL(hybrid_fwd, dim3(grid), dim3(512), LDS_BYTES, stream, a); }
        a.mode = 0;
#if DBG_SCAN
        hipLaunchKernelGGL(dbg_scan, dim3(2048), dim3(256), 0, stream, (unsigned char*)d_ws, (const float*)d_out, ph);
#endif
    }
#if DBG_SCAN
    hipLaunchKernelGGL(dbg_emit, dim3(2048), dim3(256), 0, stream, (unsigned char*)d_ws, (float*)d_out);
#endif
    const hipError_t le = hipPeekAtLastError();
    if (le != hipSuccess) fprintf(stderr, "kernel_launch: launch failed: %s\n", hipGetErrorName(le));
}
```

```cpp
#include <hip/hip_runtime.h>
#include <cstdio>
#include <cstdint>
#include <cmath>
#define DBG_SCAN 0
namespace pg8 {
#define PG8_LAS __attribute__((address_space(3)))
typedef unsigned short bf16_t;
typedef short bf16x8 __attribute__((ext_vector_type(8)));
typedef float f32x4 __attribute__((ext_vector_type(4)));
typedef unsigned u32x4 __attribute__((ext_vector_type(4)));
typedef int v4i_t __attribute__((ext_vector_type(4)));
typedef int v8i_t __attribute__((ext_vector_type(8)));
constexpr int BM = 256, BK = 64, HALF = 128, HTB = HALF * BK * 2  , STAGE_BYTES = 8 * HTB, NXCD = 8, WGM = 8;

__host__ __device__ __forceinline__ int lds_byte(int r, int c) { const int st = (r >> 4) * 2 + (c >> 5), rr = r & 15, cc = c & 31, ob = rr * 64 + cc * 2; return st * 1024 + (ob ^ (((ob >> 9) & 1) << 5)); }
__host__ __device__ __forceinline__ void stage_rc(int b, int& R, int& C) { const int st = b / 1024, sb = b % 1024, swz = sb ^ (((sb >> 9) & 1) << 5); R = (st >> 1) * 16 + swz / 64; C = (st & 1) * 32 + (swz % 64) / 2; }
__host__ __device__ __forceinline__ int perm32(int rho) { const int n = rho >> 4, i = rho & 15; return 8 * (i >> 2) + 4 * n + (i & 3); }

struct Unit { int pm, pn, e; };
struct Gemm { const bf16_t* A; const bf16_t* Bt; int M, N, K; };

typedef float f32x2_cv __attribute__((ext_vector_type(2))); typedef __bf16 bf16x2_cv __attribute__((ext_vector_type(2)));
__device__ __forceinline__ unsigned cvt_pk_bf16(float lo, float hi) { const f32x2_cv v = {lo, hi}; const bf16x2_cv b = __builtin_convertvector(v, bf16x2_cv); return __builtin_bit_cast(unsigned, b); }
struct StaticOrder {
    int nM, nN, nwg, G, c;
    __host__ __device__ void init(int M, int N, int G_, int c_) { nM = M / BM; nN = N / BM; nwg = nM * nN; G = G_; c = c_; }
    __host__ __device__ bool next(int i, Unit& u) const {
        const long L = (long)i * G + c; if (L >= nwg) return false;
        int wgid = (int)L; { const int q = nwg / NXCD, r = nwg % NXCD, xcd = wgid % NXCD, off = wgid / NXCD; wgid = (xcd < r ? xcd * (q + 1) : r * (q + 1) + (xcd - r) * q) + off; }
        const int nig = WGM * nN, gid = wgid / nig, fm = gid * WGM, gsz = (nM - fm) < WGM ? (nM - fm) : WGM;
        u.pm = fm + ((wgid % nig) % gsz); u.pn = (wgid % nig) / gsz; return true;
    }
    __device__ __forceinline__ unsigned boff(const Gemm& g, const Unit& u) const { return (unsigned)u.pn * (unsigned)(BM * g.K * 2); }
    __device__ __forceinline__ void a_ready(const Unit&) const {}
    __device__ __forceinline__ void done(const Unit&) const {}
};
struct ExpertOrder : StaticOrder {
    const int* pexp; size_t estride; PG8_LAS int* tab;
    __device__ __forceinline__ void fill(int tid) const { Unit u; if (StaticOrder::next(tid, u)) tab[tid] = pexp[u.pm]; }
    __device__ __forceinline__ bool next(int i, Unit& u) const { const bool ok = StaticOrder::next(i, u); u.e = ok ? tab[i] : 0; return ok; }
    __device__ __forceinline__ unsigned boff(const Gemm& g, const Unit& u) const { return (unsigned)__builtin_amdgcn_readfirstlane(u.e) * (unsigned)estride + (unsigned)u.pn * (unsigned)(BM * g.K * 2); }
};
__device__ __forceinline__ float fast_sigmoid(float x) { return __builtin_amdgcn_rcpf(1.0f + __builtin_amdgcn_exp2f(-1.4426950408889634f * x)); }
__device__ __forceinline__ float bflo(unsigned w) { return __uint_as_float(w << 16); }
__device__ __forceinline__ float bfhi(unsigned w) { return __uint_as_float(w & 0xffff0000u); }
struct EpiPlain {
    static constexpr bool PERM = true, AFTER_DRAIN = false;
    bf16_t* O; int ldc; float sc;
    __device__ __forceinline__ void operator()(const f32x4 (&acc)[2][2][4][2], const Unit& u, int wr, int wc, int fr, int fq) const {
        const int row0 = u.pm * BM + wr * 64 + fr, col0 = u.pn * BM + wc * 32 + 8 * fq;
#pragma unroll
        for (int ai = 0; ai < 2; ++ai)
#pragma unroll
            for (int m = 0; m < 4; ++m) { bf16_t* rowp = O + (size_t)(row0 + ai * HALF + m * 16) * ldc + col0;
#pragma unroll
                for (int bj = 0; bj < 2; ++bj) { const f32x4 v0 = acc[ai][bj][m][0], v1 = acc[ai][bj][m][1];
                    u32x4 w; w.x = cvt_pk_bf16(v0[0], v0[1]); w.y = cvt_pk_bf16(v0[2], v0[3]); w.z = cvt_pk_bf16(v1[0], v1[1]); w.w = cvt_pk_bf16(v1[2], v1[3]);
                    *(u32x4*)(rowp + bj * HALF) = w; } }
    }
};
__device__ __forceinline__ unsigned pk4_fp8u(float a, float b, float c, float d) { int r; asm volatile("" : "=v"(r)); r = __builtin_amdgcn_cvt_pk_fp8_f32(a, b, r, false); r = __builtin_amdgcn_cvt_pk_fp8_f32(c, d, r, true); return (unsigned)r; }
__device__ __forceinline__ unsigned pk4_fp8(float a, float b, float c, float d) { int r = __builtin_amdgcn_cvt_pk_fp8_f32(a, b, 0, false); r = __builtin_amdgcn_cvt_pk_fp8_f32(c, d, r, true); return (unsigned)r; }
template <int HD> struct EpiWin {
    static constexpr bool PERM = true, AFTER_DRAIN = false;
    bf16_t* O; int ldc; const float* T; int qlo, qhi, klo, khi; float qsc, ksc;
    unsigned char* Q8; unsigned char* K8; int qcol0, kcol0;
    __device__ __forceinline__ void operator()(const f32x4 (&acc)[2][2][4][2], const Unit& u, int wr, int wc, int fr, int fq) const {
        const int row0 = u.pm * BM + wr * 64 + fr;
        const bool isq = u.pn >= qlo && u.pn < qhi, isk = u.pn >= klo && u.pn < khi;
        if (!isq && !isk) {
            const int col0 = u.pn * BM + wc * 32 + 8 * fq;
#pragma unroll
            for (int ai = 0; ai < 2; ++ai)
#pragma unroll
                for (int m = 0; m < 4; ++m) { bf16_t* rowp = O + (size_t)(row0 + ai * HALF + m * 16) * ldc + col0;
#pragma unroll
                    for (int bj = 0; bj < 2; ++bj) { const f32x4 v0 = acc[ai][bj][m][0], v1 = acc[ai][bj][m][1];
                        u32x4 w; w.x = cvt_pk_bf16(v0[0], v0[1]); w.y = cvt_pk_bf16(v0[2], v0[3]); w.z = cvt_pk_bf16(v1[0], v1[1]); w.w = cvt_pk_bf16(v1[2], v1[3]);
                        *(u32x4*)(rowp + bj * HALF) = w; } }
            return;
        }
        const float sc = isq ? qsc : ksc;
        const int jj0 = wc * 32 + 8 * fq, g = jj0 / HD, d0 = jj0 % HD, Q = HD / 2;
        const int col1 = u.pn * BM + g * (2 * HD) + d0, dq = d0 % Q; const bool byrow = d0 < Q;
#pragma unroll
        for (int ai = 0; ai < 2; ++ai)
#pragma unroll
            for (int m = 0; m < 4; ++m) { const int r = row0 + ai * HALF + m * 16, t = r % 8448;
                float o1[8], o2[8];
                if (t >= 256) { const int tl = t - 256, pos = byrow ? (tl >> 6) : (tl & 63); const f32x4* cs = (const f32x4*)(T + (size_t)(pos * Q + dq) * 2);
                    const f32x4 c0 = cs[0], c1 = cs[1], c2 = cs[2], c3 = cs[3];
                    const float cc[8] = {c0[0], c0[2], c1[0], c1[2], c2[0], c2[2], c3[0], c3[2]}, ss[8] = {c0[1], c0[3], c1[1], c1[3], c2[1], c2[3], c3[1], c3[3]};
#pragma unroll
                    for (int e = 0; e < 8; ++e) { const float x1 = acc[ai][0][m][e >> 2][e & 3], x2 = acc[ai][1][m][e >> 2][e & 3]; o1[e] = (x1 * cc[e] - x2 * ss[e]) * sc; o2[e] = (x1 * ss[e] + x2 * cc[e]) * sc; }
                } else {
#pragma unroll
                    for (int e = 0; e < 8; ++e) { o1[e] = acc[ai][0][m][e >> 2][e & 3] * sc; o2[e] = acc[ai][1][m][e >> 2][e & 3] * sc; }
                }
                if (Q8) { unsigned char* p8 = (isq ? Q8 + (size_t)r * 768 + (col1 - qcol0) : K8 + (size_t)r * 768 + (col1 - kcol0));
                    typedef unsigned u32x2 __attribute__((ext_vector_type(2)));
                    u32x2 w8; w8.x = pk4_fp8(o1[0], o1[1], o1[2], o1[3]); w8.y = pk4_fp8(o1[4], o1[5], o1[6], o1[7]); *(u32x2*)p8 = w8;
                    w8.x = pk4_fp8(o2[0], o2[1], o2[2], o2[3]); w8.y = pk4_fp8(o2[4], o2[5], o2[6], o2[7]); *(u32x2*)(p8 + HD) = w8; continue; }
                bf16_t* rowp = O + (size_t)r * ldc + col1;
                u32x4 w; w.x = cvt_pk_bf16(o1[0], o1[1]); w.y = cvt_pk_bf16(o1[2], o1[3]); w.z = cvt_pk_bf16(o1[4], o1[5]); w.w = cvt_pk_bf16(o1[6], o1[7]);
                *(u32x4*)rowp = w;
                w.x = cvt_pk_bf16(o2[0], o2[1]); w.y = cvt_pk_bf16(o2[2], o2[3]); w.z = cvt_pk_bf16(o2[4], o2[5]); w.w = cvt_pk_bf16(o2[6], o2[7]);
                *(u32x4*)(rowp + HD) = w; }
    }
};
struct EpiSwiGLU {
    static constexpr bool PERM = true, AFTER_DRAIN = false;
    bf16_t* O; int ldc;
    __device__ __forceinline__ void operator()(const f32x4 (&acc)[2][2][4][2], const Unit& u, int wr, int wc, int fr, int fq) const {
        const int row0 = u.pm * BM + wr * 64 + fr, col0 = u.pn * HALF + wc * 32 + 8 * fq;
#pragma unroll
        for (int ai = 0; ai < 2; ++ai)
#pragma unroll
            for (int m = 0; m < 4; ++m) { bf16_t* rowp = O + (size_t)(row0 + ai * HALF + m * 16) * ldc + col0;
                float o[8];
#pragma unroll
                for (int n = 0; n < 2; ++n)
#pragma unroll
                    for (int i = 0; i < 4; ++i) { const float g = acc[ai][0][m][n][i], up = acc[ai][1][m][n][i]; o[n * 4 + i] = g * fast_sigmoid(g) * up; }
                u32x4 w; w.x = cvt_pk_bf16(o[0], o[1]); w.y = cvt_pk_bf16(o[2], o[3]); w.z = cvt_pk_bf16(o[4], o[5]); w.w = cvt_pk_bf16(o[6], o[7]);
                *(u32x4*)rowp = w; }
    }
};
struct EpiSwiGLU8 {
    static constexpr bool PERM = true, AFTER_DRAIN = false;
    unsigned char* O; int ldc; float sc;
    __device__ __forceinline__ void operator()(const f32x4 (&acc)[2][2][4][2], const Unit& u, int wr, int wc, int fr, int fq) const {
        const int row0 = u.pm * BM + wr * 64 + fr, col0 = u.pn * HALF + wc * 32 + 8 * fq;
        const float kx = -1.4426950408889634f * sc, cc = 1.0f / (sc * sc);
#pragma unroll
        for (int ai = 0; ai < 2; ++ai)
#pragma unroll
            for (int m = 0; m < 4; ++m) { unsigned char* rowp = O + (size_t)(row0 + ai * HALF + m * 16) * ldc + col0;
                float o[8];
#pragma unroll
                for (int n = 0; n < 2; ++n)
#pragma unroll
                    for (int i = 0; i < 4; i += 2) { typedef float f32x2e __attribute__((ext_vector_type(2)));
                        const f32x2e ag = {acc[ai][0][m][n][i], acc[ai][0][m][n][i + 1]}, au = {acc[ai][1][m][n][i], acc[ai][1][m][n][i + 1]};
                        const f32x2e x = ag * kx; const f32x2e e = {__builtin_amdgcn_exp2f(x.x), __builtin_amdgcn_exp2f(x.y)};
                        const f32x2e d = e * cc + cc; const f32x2e r = {__builtin_amdgcn_rcpf(d.x), __builtin_amdgcn_rcpf(d.y)};
                        const f32x2e o2 = (ag * au) * r; o[n * 4 + i] = o2.x; o[n * 4 + i + 1] = o2.y; }
                typedef unsigned u32x2 __attribute__((ext_vector_type(2)));
                u32x2 w; w.x = pk4_fp8u(o[0], o[1], o[2], o[3]); w.y = pk4_fp8u(o[4], o[5], o[6], o[7]);
                *(u32x2*)rowp = w; }
    }
};
struct EpiGLU {
    static constexpr bool PERM = true, AFTER_DRAIN = false;
    bf16_t* O; int ldc; const bf16_t* Z; int ldz; const float* bias;
    __device__ __forceinline__ void operator()(const f32x4 (&acc)[2][2][4][2], const Unit& u, int wr, int wc, int fr, int fq) const {
        const int row0 = u.pm * BM + wr * 64 + fr, col0 = u.pn * BM + wc * 32 + 8 * fq;
#pragma unroll
        for (int bj = 0; bj < 2; ++bj) { const f32x4 b0 = *(const f32x4*)(bias + col0 + bj * HALF), b1 = *(const f32x4*)(bias + col0 + bj * HALF + 4);
#pragma unroll
            for (int ai = 0; ai < 2; ++ai)
#pragma unroll
                for (int m = 0; m < 4; ++m) { const size_t r = (size_t)(row0 + ai * HALF + m * 16);
                    const u32x4 zz = *(const u32x4*)(Z + r * ldz + col0 + bj * HALF);
                    const f32x4 v0 = acc[ai][bj][m][0] + b0, v1 = acc[ai][bj][m][1] + b1;
                    u32x4 w; w.x = cvt_pk_bf16(bflo(zz.x) * fast_sigmoid(v0[0]), bfhi(zz.x) * fast_sigmoid(v0[1])); w.y = cvt_pk_bf16(bflo(zz.y) * fast_sigmoid(v0[2]), bfhi(zz.y) * fast_sigmoid(v0[3]));
                    w.z = cvt_pk_bf16(bflo(zz.z) * fast_sigmoid(v1[0]), bfhi(zz.z) * fast_sigmoid(v1[1])); w.w = cvt_pk_bf16(bflo(zz.w) * fast_sigmoid(v1[2]), bfhi(zz.w) * fast_sigmoid(v1[3]));
                    *(u32x4*)(O + r * ldc + col0 + bj * HALF) = w; } }
    }
};
struct RouteEnt { int tok; int slot; float w; int pad; };
struct EpiScatter {
    static constexpr bool PERM = true, AFTER_DRAIN = false;
    const RouteEnt* L; bf16_t* Y; size_t slot_stride; int ldc; float sc;
    __device__ __forceinline__ void operator()(const f32x4 (&acc)[2][2][4][2], const Unit& u, int wr, int wc, int fr, int fq) const {
        const int row0 = u.pm * BM + wr * 64 + fr, col0 = u.pn * BM + wc * 32 + 8 * fq;
#pragma unroll
        for (int ai = 0; ai < 2; ++ai)
#pragma unroll
            for (int m = 0; m < 4; ++m) { const RouteEnt e = L[row0 + ai * HALF + m * 16];
                if (e.tok >= 0) { bf16_t* rowp = Y + (size_t)e.slot * slot_stride + (size_t)e.tok * ldc + col0;
#pragma unroll
                    for (int bj = 0; bj < 2; ++bj) { const float ww = e.w * sc; const f32x4 v0 = acc[ai][bj][m][0] * ww, v1 = acc[ai][bj][m][1] * ww;
                        u32x4 w; w.x = cvt_pk_bf16(v0[0], v0[1]); w.y = cvt_pk_bf16(v0[2], v0[3]); w.z = cvt_pk_bf16(v1[0], v1[1]); w.w = cvt_pk_bf16(v1[2], v1[3]);
                        *(u32x4*)(rowp + bj * HALF) = w; } } }
    }
};
template <class Epi, class Sched, bool ALIGN_EPI = false, bool SP2 = false, bool F8 = false>
__device__ __forceinline__ void gemm_phase(PG8_LAS unsigned char* lds, const Gemm g, const Sched& S, const Epi& E, const int tid) {
    const int wid = __builtin_amdgcn_readfirstlane(tid >> 6), lane = tid & 63, wr = wid >> 2, wc = wid & 3, fr = lane & 15, fq = lane >> 4;
    const int K = g.K, nt = K / BK;
    unsigned voffA[2], voffB[2];
#pragma unroll
    for (int i = 0; i < 2; ++i) { int R, C; stage_rc(tid * 16 + i * 8192, R, C); const int Rb = Epi::PERM ? ((R & ~31) + perm32(R & 31)) : R;
        voffA[i] = (unsigned)(R * K + C) * 2u; voffB[i] = (unsigned)(Rb * K + C) * 2u; }
    const unsigned kstep = (unsigned)(BK * 2);
    const unsigned hstep = (unsigned)HALF * K * 2;
    const unsigned tstep = 2 * hstep;
    const __amdgpu_buffer_rsrc_t rsA = __builtin_amdgcn_make_buffer_rsrc((void*)g.A, 0, 0x7fffffff, 0x00020000), rsB = __builtin_amdgcn_make_buffer_rsrc((void*)g.Bt, 0, 0x7fffffff, 0x00020000);
    const unsigned ldsw = (unsigned)wid * 1024u;
    const int aoff = lds_byte(wr * 64 + fr, fq * 8), boff = lds_byte(wc * 32 + fr, fq * 8);
#define PG8_SA(b, h) (((b) * 2 + (h)) * HTB)
#define PG8_SB(b, h) ((4 + (b) * 2 + (h)) * HTB)
#define PG8_STAGE(rs, bufoff, goff, voff) do { _Pragma("unroll") for (int _i = 0; _i < 2; ++_i) \
        __builtin_amdgcn_raw_ptr_buffer_load_lds(rs, (PG8_LAS unsigned*)(lds + (bufoff) + ldsw + _i * 8192), 16, (int)(voff)[_i], (int)(goff), 0, 0); } while (0)
#define PG8_LDA(dst, b, h) do { if constexpr (F8) { _Pragma("unroll") for (int m = 0; m < 4; ++m) dst##8[m] = __builtin_shufflevector(*(const PG8_LAS v4i_t*)(lds + PG8_SA(b, h) + aoff + m * 2048), *(const PG8_LAS v4i_t*)(lds + PG8_SA(b, h) + aoff + m * 2048 + 1024), 0, 1, 2, 3, 4, 5, 6, 7); } \
    else { _Pragma("unroll") for (int m = 0; m < 4; ++m) _Pragma("unroll") for (int k = 0; k < 2; ++k) dst[m][k] = *(const PG8_LAS bf16x8*)(lds + PG8_SA(b, h) + aoff + m * 2048 + k * 1024); } } while (0)
#define PG8_LDB(dst, b, h) do { if constexpr (F8) { _Pragma("unroll") for (int n = 0; n < 2; ++n) dst##8[n] = __builtin_shufflevector(*(const PG8_LAS v4i_t*)(lds + PG8_SB(b, h) + boff + n * 2048), *(const PG8_LAS v4i_t*)(lds + PG8_SB(b, h) + boff + n * 2048 + 1024), 0, 1, 2, 3, 4, 5, 6, 7); } \
    else { _Pragma("unroll") for (int n = 0; n < 2; ++n) _Pragma("unroll") for (int k = 0; k < 2; ++k) dst[n][k] = *(const PG8_LAS bf16x8*)(lds + PG8_SB(b, h) + boff + n * 2048 + k * 1024); } } while (0)
#define PG8_MMA(ai, bj, At, Bt) do { __builtin_amdgcn_s_setprio(1); _Pragma("unroll") for (int m = 0; m < 4; ++m) _Pragma("unroll") for (int n = 0; n < 2; ++n) { \
        if constexpr (F8) acc[ai][bj][m][n] = __builtin_amdgcn_mfma_scale_f32_16x16x128_f8f6f4(Bt##8[n], At##8[m], acc[ai][bj][m][n], 0, 0, 0, 0x7f7f7f7f, 0, 0x7f7f7f7f); \
        else { _Pragma("unroll") for (int k = 0; k < 2; ++k) acc[ai][bj][m][n] = __builtin_amdgcn_mfma_f32_16x16x32_bf16(Bt[n][k], At[m][k], acc[ai][bj][m][n], 0, 0, 0); } } \
        __builtin_amdgcn_s_setprio(0); } while (0)
#define PG8_WAIT_V(n) asm volatile("s_waitcnt vmcnt(" #n ")" ::: "memory")
#define PG8_WAIT_L(n) asm volatile("s_waitcnt lgkmcnt(" #n ")" ::: "memory")
#define PG8_BAR __builtin_amdgcn_s_barrier()
#define PG8_SCHED __builtin_amdgcn_sched_barrier(0)
    Unit cur, nxt; int ui = 0;
    if (!S.next(0, cur)) return;
    f32x4 acc[2][2][4][2];
#pragma unroll
    for (int a = 0; a < 2; ++a)
#pragma unroll
        for (int b = 0; b < 2; ++b)
#pragma unroll
            for (int m = 0; m < 4; ++m)
#pragma unroll
                for (int n = 0; n < 2; ++n) acc[a][b][m][n] = (f32x4){0.f, 0.f, 0.f, 0.f};
    bf16x8 At[4][2], B0[2][2], B1[2][2]; v8i_t At8[4], B08[2], B18[2];
    unsigned cA = (unsigned)cur.pm * tstep, cB = S.boff(g, cur);
    S.a_ready(cur);
    if constexpr (SP2) {
        PG8_STAGE(rsB, PG8_SB(0, 0), cB, voffB); PG8_STAGE(rsB, PG8_SB(0, 1), cB + hstep, voffB); PG8_STAGE(rsA, PG8_SA(0, 0), cA, voffA); PG8_STAGE(rsA, PG8_SA(0, 1), cA + hstep, voffA);
        if (wr == 1) PG8_BAR;
        PG8_WAIT_V(2); PG8_BAR;
        PG8_STAGE(rsB, PG8_SB(1, 0), cB + kstep, voffB); PG8_STAGE(rsA, PG8_SA(1, 0), cA + kstep, voffA); PG8_STAGE(rsB, PG8_SB(1, 1), cB + hstep + kstep, voffB);
        PG8_WAIT_V(6); PG8_BAR;
    } else {
        PG8_STAGE(rsB, PG8_SB(0, 0), cB, voffB); PG8_STAGE(rsA, PG8_SA(0, 0), cA, voffA); PG8_STAGE(rsB, PG8_SB(0, 1), cB + hstep, voffB); PG8_STAGE(rsA, PG8_SA(0, 1), cA + hstep, voffA);
        if (wr == 1) PG8_BAR;
        PG8_WAIT_V(4); PG8_BAR;
        PG8_STAGE(rsB, PG8_SB(1, 0), cB + kstep, voffB); PG8_STAGE(rsA, PG8_SA(1, 0), cA + kstep, voffA); PG8_STAGE(rsB, PG8_SB(1, 1), cB + hstep + kstep, voffB);
        PG8_WAIT_V(6); PG8_BAR;
    }
    for (;;) {
        const bool has_next = S.next(ui + 1, nxt);
        const unsigned nA = has_next ? (unsigned)nxt.pm * tstep : cA, nB = has_next ? S.boff(g, nxt) : cB;
        for (int t = 0; t < nt; t += 2) {
            const bool last = (t == nt - 2);
            const unsigned a1 = cA + (unsigned)(t + 1) * kstep;
            const unsigned a2 = last ? nA : cA + (unsigned)(t + 2) * kstep, b2 = last ? nB : cB + (unsigned)(t + 2) * kstep;
            const unsigned a3 = a2 + kstep, b3 = b2 + kstep;
            if (last && has_next) S.a_ready(nxt);
            if constexpr (SP2) {
            PG8_LDB(B0, 0, 0); PG8_LDB(B1, 0, 1); PG8_SCHED; PG8_LDA(At, 0, 0); PG8_STAGE(rsA, PG8_SA(1, 1), a1 + hstep, voffA);
            PG8_WAIT_V(8); PG8_WAIT_L(0); PG8_BAR; PG8_MMA(0, 0, At, B0); PG8_MMA(0, 1, At, B1); PG8_BAR; PG8_SCHED;
            PG8_LDA(At, 0, 1); PG8_STAGE(rsB, PG8_SB(0, 0), b2, voffB); PG8_STAGE(rsB, PG8_SB(0, 1), b2 + hstep, voffB); PG8_STAGE(rsA, PG8_SA(0, 0), a2, voffA);
            PG8_WAIT_V(8); PG8_WAIT_L(0); PG8_BAR; PG8_MMA(1, 0, At, B0); PG8_MMA(1, 1, At, B1); PG8_BAR; PG8_SCHED;
            PG8_LDB(B0, 1, 0); PG8_LDB(B1, 1, 1); PG8_SCHED; PG8_LDA(At, 1, 0); PG8_STAGE(rsA, PG8_SA(0, 1), a2 + hstep, voffA);
            PG8_WAIT_V(8); PG8_WAIT_L(0); PG8_BAR; PG8_MMA(0, 0, At, B0); PG8_MMA(0, 1, At, B1); PG8_BAR; PG8_SCHED;
            PG8_LDA(At, 1, 1); PG8_STAGE(rsB, PG8_SB(1, 0), b3, voffB); PG8_STAGE(rsB, PG8_SB(1, 1), b3 + hstep, voffB); PG8_STAGE(rsA, PG8_SA(1, 0), a3, voffA);
            PG8_WAIT_V(8); PG8_WAIT_L(0); PG8_BAR; PG8_MMA(1, 0, At, B0); PG8_MMA(1, 1, At, B1); PG8_BAR; PG8_SCHED;
            } else {
            PG8_LDB(B0, 0, 0); PG8_SCHED; PG8_LDA(At, 0, 0); PG8_STAGE(rsA, PG8_SA(1, 1), a1 + hstep, voffA);
            PG8_WAIT_L(8); PG8_BAR; PG8_WAIT_L(0); PG8_MMA(0, 0, At, B0); PG8_BAR; PG8_SCHED;
            PG8_LDB(B1, 0, 1); PG8_STAGE(rsB, PG8_SB(0, 0), b2, voffB);
            PG8_BAR; PG8_WAIT_L(0); PG8_MMA(0, 1, At, B1); PG8_BAR;
            PG8_LDA(At, 0, 1); PG8_STAGE(rsA, PG8_SA(0, 0), a2, voffA);
            PG8_BAR; PG8_WAIT_L(0); PG8_MMA(1, 0, At, B0); PG8_BAR; PG8_SCHED;
            PG8_STAGE(rsB, PG8_SB(0, 1), b2 + hstep, voffB);
            PG8_WAIT_V(6); PG8_BAR; PG8_MMA(1, 1, At, B1); PG8_BAR;
            PG8_LDB(B0, 1, 0); PG8_SCHED; PG8_LDA(At, 1, 0); PG8_STAGE(rsA, PG8_SA(0, 1), a2 + hstep, voffA);
            PG8_WAIT_L(8); PG8_BAR; PG8_WAIT_L(0); PG8_MMA(0, 0, At, B0); PG8_BAR; PG8_SCHED;
            PG8_LDB(B1, 1, 1); PG8_STAGE(rsB, PG8_SB(1, 0), b3, voffB);
            PG8_BAR; PG8_WAIT_L(0); PG8_MMA(0, 1, At, B1); PG8_BAR;
            PG8_LDA(At, 1, 1); PG8_STAGE(rsA, PG8_SA(1, 0), a3, voffA);
            PG8_BAR; PG8_WAIT_L(0); PG8_MMA(1, 0, At, B0); PG8_BAR; PG8_SCHED;
            PG8_STAGE(rsB, PG8_SB(1, 1), b3 + hstep, voffB);
            PG8_WAIT_V(6); PG8_BAR; PG8_MMA(1, 1, At, B1); PG8_BAR;
            }
        }
        if constexpr (ALIGN_EPI) { if (wr == 0) PG8_BAR; }
        if constexpr (!Epi::AFTER_DRAIN) { E(acc, cur, wr, wc, fr, fq); S.done(cur); }
        if (!has_next) break;
#pragma unroll
        for (int a = 0; a < 2; ++a)
#pragma unroll
            for (int b = 0; b < 2; ++b)
#pragma unroll
                for (int m = 0; m < 4; ++m)
#pragma unroll
                    for (int n = 0; n < 2; ++n) acc[a][b][m][n] = (f32x4){0.f, 0.f, 0.f, 0.f};
        cur = nxt; cA = nA; cB = nB; ++ui;
        if constexpr (ALIGN_EPI) { if (wr == 1) PG8_BAR; }
    }
    PG8_WAIT_V(0);
    if constexpr (!ALIGN_EPI) { if (wr == 0) PG8_BAR; }
    PG8_BAR;
    if constexpr (Epi::AFTER_DRAIN) { E.fused(acc, cur, wr, wc, fr, fq, lds, wid, lane); S.done(cur); }
#undef PG8_SA
#undef PG8_SB
#undef PG8_STAGE
#undef PG8_LDA
#undef PG8_LDB
#undef PG8_MMA
#undef PG8_WAIT_V
#undef PG8_WAIT_L
#undef PG8_BAR
#undef PG8_SCHED
}
}

#define GAS __attribute__((address_space(1)))
#define LAS __attribute__((address_space(3)))
#define XB_TMO      128
#define XB_XCNT(j)  (256  + 64 * (j))
#define XB_XSUB(j)  (1280 + 64 * (j))
#define XB_XGEN(j)  (2304 + 64 * (j))
#define XB_TOP      3328
#define XB_TOPGEN   3392
#define XCD_BAR_WORDS 3456
#define XB_SPIN_CAP (1u << 18)

__device__ __forceinline__ unsigned xb_ld(unsigned* p)              { return __hip_atomic_load(p, __ATOMIC_RELAXED, __HIP_MEMORY_SCOPE_AGENT); }
__device__ __forceinline__ unsigned xb_add(unsigned* p, unsigned v) { return __hip_atomic_fetch_add(p, v, __ATOMIC_RELAXED, __HIP_MEMORY_SCOPE_AGENT); }
__device__ __forceinline__ unsigned xb_xcc_id() { return (unsigned)__builtin_amdgcn_s_getreg((3 << 11) | 20) & 0xFu; }
#define XB_SPIN(cond, bar) do { unsigned _sp = 0; while (cond) { __builtin_amdgcn_s_sleep(1); \
    if ((++_sp & 255u) == 0u) { if (xb_ld(&(bar)[XB_TMO])) break; if (_sp > XB_SPIN_CAP) { atomicAdd(&(bar)[XB_TMO], 1u); break; } } } } while (0)

struct XcdBarrier {
    unsigned* bar; unsigned x;
    volatile LAS unsigned* st;
};

__device__ __forceinline__ XcdBarrier xcd_barrier_post(unsigned* bar, volatile LAS unsigned* st) {
    XcdBarrier b; b.bar = bar; b.x = xb_xcc_id(); b.st = st;
    if (threadIdx.x == 0) (void)xb_add(&bar[XB_XCNT(b.x)], 1u);
    return b;
}
__device__ __forceinline__ void xcd_barrier_complete(unsigned* bar, unsigned x, unsigned& nloc, unsigned& nx) {
    const unsigned G = gridDim.x * gridDim.y * gridDim.z;
    unsigned sum, cnt, mine, sp = 0u;
    for (;;) {
        sum = 0u; cnt = 0u; mine = 0u;
#pragma unroll
        for (unsigned j = 0; j < 16; ++j) { const unsigned c = xb_ld(&bar[XB_XCNT(j)]); sum += c; cnt += (c > 0u) ? 1u : 0u; mine = (j == x) ? c : mine; }
        if (sum == G) break;
        __builtin_amdgcn_s_sleep(1);
        if ((++sp & 255u) == 0u) { if (xb_ld(&bar[XB_TMO])) break; if (sp > XB_SPIN_CAP) { atomicAdd(&bar[XB_TMO], 1u); break; } }
    }
    nloc = mine > 0u ? mine : 1u; nx = cnt > 0u ? cnt : 1u;
}

__device__ __forceinline__ void xcd_barrier(const XcdBarrier& b, const bool leader_thread  ) {
    asm volatile("s_waitcnt vmcnt(0)" ::: "memory");
    __syncthreads();
    if (leader_thread) {
        unsigned* bar = b.bar;
        __builtin_amdgcn_s_waitcnt(0);
        unsigned nloc = b.st[0], nx = b.st[1];
        if (nloc == 0u) { xcd_barrier_complete(bar, b.x, nloc, nx); b.st[0] = nloc; b.st[1] = nx; }
        const unsigned old = xb_add(&bar[XB_XSUB(b.x)], 1u);
        const unsigned gen = old / nloc;
        if (old + 1u == (gen + 1u) * nloc) {
            __builtin_amdgcn_fence(__ATOMIC_RELEASE, "agent");
            asm volatile("s_waitcnt vmcnt(0)" ::: "memory");
            const unsigned og = xb_add(&bar[XB_TOP], 1u);
            const unsigned tg = og / nx;
            if (og + 1u == (tg + 1u) * nx) xb_add(&bar[XB_TOPGEN], 1u);
            else XB_SPIN(xb_ld(&bar[XB_TOPGEN]) == tg, bar);
            __builtin_amdgcn_fence(__ATOMIC_ACQUIRE, "agent");
            xb_add(&bar[XB_XGEN(b.x)], 1u);
            asm volatile("s_waitcnt vmcnt(0)" ::: "memory");
        } else {
            XB_SPIN(xb_ld(&bar[XB_XGEN(b.x)]) == gen, bar);
            __builtin_amdgcn_fence(__ATOMIC_ACQUIRE, "agent");
            asm volatile("s_waitcnt vmcnt(0)" ::: "memory");
        }
    }
    __syncthreads();
}
constexpr int D = 1024, NB = 8, SEQ = 8192, CTXL = 256, TB = SEQ + CTXL, M = NB * TB;
constexpr int EV_IN = 3072, OD_IN = 2560, DFF = 3584, NE = 8, NLAYER = 4;
constexpr int NPANEL = M / 256;
constexpr int PW = 280, MAXP = 536;
constexpr float EPS = 1e-6f;
constexpr size_t MiB = 1u << 20;
constexpr size_t WS_CTL = 0, CTL_ZERO_BYTES = 1 * MiB;
constexpr size_t WS_MOD = 1 * MiB;
constexpr size_t WS_ROPE_R = 2 * MiB, WS_ROPE_D = 2 * MiB + 65536;
constexpr size_t WS_ROUTE = 3 * MiB;
constexpr size_t WS_WGCNT = 5 * MiB;
constexpr size_t WS_PEXP = 5 * MiB + 65536;
constexpr size_t WS_LIST = 6 * MiB;
constexpr size_t WS_W = 20 * MiB;
constexpr size_t WS_X = 116 * MiB;
constexpr size_t WS_H = 248 * MiB;
constexpr size_t WS_Y = 380 * MiB;
constexpr size_t WS_BIG = 644 * MiB;
constexpr size_t WS_W2 = 1044 * MiB;
constexpr size_t WS_END = 1128 * MiB;
constexpr size_t W_IN = 0, W_OUT = 6 * MiB, W_GU = 8 * MiB, W_DN = 16 * MiB;
constexpr size_t W_GLU = 8 * MiB;
constexpr size_t W2_MGU = 0, W2_MDN = 56 * MiB;
constexpr size_t Y_SLOT = (size_t)M * 1024 * 2;
constexpr size_t T_HALF = (size_t)M * 512 * 2;
constexpr size_t T_QUART = (size_t)M * 256 * 2;
constexpr size_t BIG_ACT = 0, BIG_HG = 246 * MiB;
constexpr int CW_TMO = 0, CW_BAR = 4096;
constexpr int RING_BYTES = 131072, LDSCTL_OFF = RING_BYTES + 8192, MISC_OFF = LDSCTL_OFF + 320, LDS_BYTES = 147456;
typedef unsigned short bf16;
typedef unsigned v4u __attribute__((ext_vector_type(4)));
typedef unsigned v2u __attribute__((ext_vector_type(2)));
typedef float f32x4 __attribute__((ext_vector_type(4)));
typedef float f32x16 __attribute__((ext_vector_type(16)));
typedef short bf16x8 __attribute__((ext_vector_type(8)));
typedef short s16x4 __attribute__((ext_vector_type(4)));
#define RLX_AGENT __ATOMIC_RELAXED, __HIP_MEMORY_SCOPE_AGENT
using pg8::cvt_pk_bf16; using pg8::bflo; using pg8::bfhi; using pg8::RouteEnt;
struct RouteRow { int e1, e2; float p1, p2; };
__device__ __forceinline__ float bf2f(bf16 v) { return __uint_as_float((unsigned)v << 16); }
__device__ __forceinline__ float wave_sum(float v) {
#define DPP_ADD(ctrl, rmask) v += __builtin_bit_cast(float, __builtin_amdgcn_update_dpp(0, __builtin_bit_cast(int, v), (ctrl), (rmask), 0xF, false))
    DPP_ADD(0xB1, 0xF); DPP_ADD(0x4E, 0xF); DPP_ADD(0x141, 0xF); DPP_ADD(0x140, 0xF); DPP_ADD(0x142, 0xA); DPP_ADD(0x143, 0xC);
#undef DPP_ADD
    return __builtin_bit_cast(float, __builtin_amdgcn_readlane(__builtin_bit_cast(int, v), 63));
}
__device__ __forceinline__ float gelu_tanh(float x) {
    const float u = 0.7978845608028654f * (x + 0.044715f * x * x * x);
    return x * __builtin_amdgcn_rcpf(1.0f + __builtin_amdgcn_exp2f(-2.0f * 1.4426950408889634f * u));
}
__device__ __forceinline__ float sigmoidf_(float x) { return __builtin_amdgcn_rcpf(1.0f + __builtin_amdgcn_exp2f(-1.4426950408889634f * x)); }
struct Args { const float* in[38]; float* out; unsigned char* ws; int ph_lo, ph_hi, mode, pad; };
struct ArgsI { unsigned long long in[38]; unsigned long long out, ws; int ph_lo, ph_hi, mode, pad; };
typedef __attribute__((address_space(4))) const ArgsI KArgs;
#define INP(k) ((const float*)(GAS const float*)F.A->in[k])
#define OUTP ((float*)(GAS float*)F.A->out)
#define WSG ((unsigned char*)(GAS unsigned char*)F.wsi)
#define FMOD ((float*)(WSG + WS_MOD))
#define FX ((bf16*)(WSG + WS_X))
#define FH ((bf16*)(WSG + WS_H))
#define FWB ((bf16*)(WSG + WS_W))
#define FYB (WSG + WS_Y)
#define FBIG (WSG + WS_BIG)
#define LAUNDER(F) do { asm volatile("" : "+s"(F.wsi), "+s"(F.A), "+s"(F.wave), "+s"(F.bid), "+s"(F.G)); { unsigned z_ = 0u; asm volatile("" : "+v"(z_)); F.lane = (int)__builtin_amdgcn_mbcnt_hi(~0u, __builtin_amdgcn_mbcnt_lo(~0u, z_)); } F.tid = F.wave * 64 + F.lane; } while (0)
__device__ __forceinline__ bool lead0_lane() { unsigned z_ = 0u; asm volatile("" : "+v"(z_)); return __builtin_amdgcn_mbcnt_hi(~0u, __builtin_amdgcn_mbcnt_lo(~0u, z_)) == 0u; }
#define LEAD0(F) ((F).wave == 0 && lead0_lane())
struct Frame {
    LAS unsigned char* lds; unsigned long long wsi;
    int tid, lane, wave, G, bid;
    const KArgs* A;
};
#define LDS_WAIT() asm volatile("s_waitcnt lgkmcnt(0)" ::: "memory")

__device__ __forceinline__ void ph_prologue(Frame& F) {
    LAS float* SL = (LAS float*)F.lds;
    LAS float* RED = (LAS float*)(F.lds + 40960);
    const float* c = INP(1); const float* cc = INP(3); const float* mod_w = INP(4); const float* mod_b = INP(5);
    for (int i = F.tid; i < 9 * 1024; i += 512) { const float v = (i < 8192) ? c[i] : cc[i - 8192]; SL[i] = v * sigmoidf_(v); }
    __syncthreads();
    for (int blk = F.bid; blk < 4 * 96; blk += F.G) {
        const int l = blk / 96, n0 = (blk % 96) * 64;
        const float* wp = mod_w + ((size_t)l * 1024 + (size_t)F.wave * 128) * 6144 + n0 + F.lane;
        float acc[9];
#pragma unroll
        for (int j = 0; j < 9; ++j) acc[j] = 0.f;
        for (int k = 0; k < 128; ++k) { const float w = wp[(size_t)k * 6144];
#pragma unroll
            for (int j = 0; j < 9; ++j) acc[j] += SL[j * 1024 + F.wave * 128 + k] * w; }
#pragma unroll
        for (int j = 0; j < 9; ++j) RED[(F.wave * 9 + j) * 64 + F.lane] = acc[j];
        __syncthreads();
        for (int i = F.tid; i < 9 * 64; i += 512) { const int j = i >> 6, ln = i & 63; float s = mod_b[l * 6144 + n0 + ln];
#pragma unroll
            for (int w = 0; w < 8; ++w) s += RED[(w * 9 + j) * 64 + ln];
            FMOD[((size_t)l * 9 + j) * 6144 + n0 + ln] = s; }
        __syncthreads();
    }
    const int gt = F.bid * 512 + F.tid;
    if (gt < 128 * 32) { const int pos = gt >> 5, dq = gt & 31; const float inv = powf(10000.0f, -(float)dq / 32.0f); float s, cs; sincosf((float)pos * inv, &s, &cs);
        float* T = (float*)(WSG + WS_ROPE_R); T[gt * 2] = cs; T[gt * 2 + 1] = s; }
    else if (gt < 128 * 32 + 128 * 16) { const int g2 = gt - 128 * 32, pos = g2 >> 4, dq = g2 & 15; const float inv = powf(10000.0f, -(float)dq / 16.0f); float s, cs; sincosf((float)pos * inv, &s, &cs);
        float* T = (float*)(WSG + WS_ROPE_D); T[g2 * 2] = cs; T[g2 * 2 + 1] = s; }
}

__device__ __forceinline__ void transpose_item(const float* W, int K, int N, bf16* WT, int drow0, int k0, int n0, LAS float* scr, int lane) {
#pragma unroll
    for (int i = 0; i < 8; ++i) { const int kk = 8 * i + (lane >> 3), nn = (lane & 7) * 4; const f32x4 v = *(const f32x4*)(W + (size_t)(k0 + kk) * N + n0 + nn);
        scr[kk * 33 + nn] = v.x; scr[kk * 33 + nn + 1] = v.y; scr[kk * 33 + nn + 2] = v.z; scr[kk * 33 + nn + 3] = v.w; }
    LDS_WAIT(); asm volatile("" ::: "memory");
    const int c = lane & 7;
#pragma unroll
    for (int j = 0; j < 4; ++j) { const int n = (lane >> 3) + 8 * j; const LAS float* s = scr + (8 * c) * 33 + n;
        v4u o; o.x = cvt_pk_bf16(s[0 * 33], s[1 * 33]); o.y = cvt_pk_bf16(s[2 * 33], s[3 * 33]); o.z = cvt_pk_bf16(s[4 * 33], s[5 * 33]); o.w = cvt_pk_bf16(s[6 * 33], s[7 * 33]);
        *(v4u*)(WT + (size_t)(drow0 + n) * K + k0 + 8 * c) = o; }
    LDS_WAIT(); asm volatile("" ::: "memory");
}
__device__ __forceinline__ void convert_job(Frame& F, const float* W, int K, int N, bf16* WT, int mode) {
    LAS float* scr = (LAS float*)(F.lds + F.wave * 16384);
    const int gw = F.bid * 8 + F.wave, NGW = F.G * 8, nblk = N / 32, nit = (K / 64) * nblk;
    for (int it = gw; it < nit; it += NGW) { const int kb = it / nblk, nb = it % nblk, n0 = nb * 32;
        int drow0 = n0;
        if (mode == 1 || mode == 2) drow0 = (n0 >> 7) * 256 + (n0 & 127) + (mode == 2 ? 128 : 0);
        else if (mode == 3) { const int tile = n0 >> 8, w = n0 & 255; if (tile >= 4 && tile < 8) drow0 = tile * 256 + ((w >> 6) & 1) * 128 + (w >> 7) * 64 + (w & 63); }
        else if (mode == 4) { const int tile = n0 >> 8, w = n0 & 255; if (tile >= 1 && tile < 7) drow0 = tile * 256 + ((w >> 5) & 1) * 128 + (w >> 6) * 32 + (w & 31); }
        transpose_item(W, K, N, WT, drow0, kb * 64, n0, scr, F.lane); }
}
__device__ __forceinline__ void transpose_item_f8(const float* W, int K, int N, unsigned char* WT, int drow0, int k0, int n0, LAS float* scr, int lane, float wscale) {
#pragma unroll
    for (int i = 0; i < 8; ++i) { const int kk = 8 * i + (lane >> 3), nn = (lane & 7) * 4; const f32x4 v = *(const f32x4*)(W + (size_t)(k0 + kk) * N + n0 + nn);
        scr[kk * 33 + nn] = v.x * wscale; scr[kk * 33 + nn + 1] = v.y * wscale; scr[kk * 33 + nn + 2] = v.z * wscale; scr[kk * 33 + nn + 3] = v.w * wscale; }
    LDS_WAIT(); asm volatile("" ::: "memory");
#pragma unroll
    for (int j = 0; j < 2; ++j) { const int idx = lane + 64 * j, n = idx >> 2, c = idx & 3; const LAS float* s = scr + (16 * c) * 33 + n;
        v4u o; o.x = pg8::pk4_fp8(s[0 * 33], s[1 * 33], s[2 * 33], s[3 * 33]); o.y = pg8::pk4_fp8(s[4 * 33], s[5 * 33], s[6 * 33], s[7 * 33]);
        o.z = pg8::pk4_fp8(s[8 * 33], s[9 * 33], s[10 * 33], s[11 * 33]); o.w = pg8::pk4_fp8(s[12 * 33], s[13 * 33], s[14 * 33], s[15 * 33]);
        *(v4u*)(WT + (size_t)(drow0 + n) * K + k0 + 16 * c) = o; }
    LDS_WAIT(); asm volatile("" ::: "memory");
}
constexpr float W8_SCALE = 32.0f, W8_INV = 1.0f / 32.0f;
__device__ __forceinline__ void convert_job_f8(Frame& F, const float* W, int K, int N, unsigned char* WT, int mode, int wg0 = 0, int nwg = 0) {
    LAS float* scr = (LAS float*)(F.lds + F.wave * 16384);
    const int gw = (F.bid - wg0) * 8 + F.wave, NGW = (nwg ? nwg : F.G) * 8, nblk = N / 32, nit = (K / 64) * nblk;
    for (int it = gw; it < nit; it += NGW) { const int kb = it / nblk, nb = it % nblk, n0 = nb * 32;
        int drow0 = n0;
        if (mode == 1 || mode == 2) drow0 = (n0 >> 7) * 256 + (n0 & 127) + (mode == 2 ? 128 : 0);
        transpose_item_f8(W, K, N, WT, drow0, kb * 64, n0, scr, F.lane, W8_SCALE); }
}
__device__ __forceinline__ void ph_convert_moe(Frame& F, int i, int wg0, int nwg, int e0 = 0, int e1 = NE) {
    unsigned char* W2 = WSG + WS_W2;
    for (int e = e0; e < e1; ++e) {
        convert_job_f8(F, INP(35) + ((size_t)i * NE + e) * D * DFF, D, DFF, W2 + W2_MGU + (size_t)e * 7168 * 1024, 1, wg0, nwg);
        convert_job_f8(F, INP(36) + ((size_t)i * NE + e) * D * DFF, D, DFF, W2 + W2_MGU + (size_t)e * 7168 * 1024, 2, wg0, nwg);
        convert_job_f8(F, INP(37) + ((size_t)i * NE + e) * DFF * D, DFF, D, W2 + W2_MDN + (size_t)e * 1024 * 3584, 0, wg0, nwg);
    }
}
__device__ __forceinline__ void ph_convert(Frame& F, int l) {
    const int i = l >> 1; bf16* Wb = FWB;
    if ((l & 1) == 0) {
        convert_job(F, INP(7) + (size_t)i * D * EV_IN, D, EV_IN, Wb + W_IN / 2, 3);
        convert_job(F, INP(15) + (size_t)i * D * D, D, D, Wb + W_OUT / 2, 0);
        convert_job_f8(F, INP(16) + (size_t)i * D * DFF, D, DFF, (unsigned char*)Wb + W_GU, 1);
        convert_job_f8(F, INP(17) + (size_t)i * D * DFF, D, DFF, (unsigned char*)Wb + W_GU, 2);
        convert_job_f8(F, INP(18) + (size_t)i * DFF * D, DFF, D, (unsigned char*)Wb + W_DN, 0);
    } else {
        convert_job(F, INP(19) + (size_t)i * D * OD_IN, D, OD_IN, Wb + W_IN / 2, 4);
        convert_job(F, INP(32) + (size_t)i * D * D, D, D, Wb + W_OUT / 2, 0);
        convert_job(F, INP(28) + (size_t)i * 256 * 256, 256, 256, Wb + W_GLU / 2, 0);
    }
}

struct NormArgs {
    int xin_input, has_y, two, write_x, final_, do_h, do_route, h8;
    const float* gate; const float* gy;
    const float* gh; const float* shift; const float* scale;
    const float* rw; const float* rb;
};
__device__ __forceinline__ void ph_norm(Frame& F, const NormArgs& a) {
    LAS float* RWT = (LAS float*)F.lds;
    LAS int* cnt = (LAS int*)(F.lds + 32768);
    if (a.do_route) {
        for (int idx = F.tid; idx < 8192; idx += 512) RWT[(idx & 7) * 1024 + (idx >> 3)] = a.rw[idx];
        if (F.tid < 8) cnt[F.tid] = 0;
        __syncthreads();
    }
    const int r0 = (int)((long)M * F.bid / F.G), r1 = (int)((long)M * (F.bid + 1) / F.G);
    const bf16* Y0 = (const bf16*)FYB; const bf16* Y1 = (const bf16*)(FYB + Y_SLOT);
    const int c0 = 4 * F.lane;
    f32x4 pgy[4], pgh[4], pgt[4], psh[4], psc[4]; int cur_midx = -1;
#pragma unroll
    for (int j = 0; j < 4; ++j) { pgy[j] = a.has_y ? *(const f32x4*)(a.gy + c0 + 256 * j) : (f32x4){0.f, 0.f, 0.f, 0.f}; pgh[j] = a.do_h ? *(const f32x4*)(a.gh + c0 + 256 * j) : (f32x4){0.f, 0.f, 0.f, 0.f};
        pgt[j] = (f32x4){0.f, 0.f, 0.f, 0.f}; psh[j] = pgt[j]; psc[j] = pgt[j]; }
    f32x4 xn[4]; v2u xb[4], yn[4], zn[4];
#pragma unroll
    for (int j = 0; j < 4; ++j) { xn[j] = (f32x4){0.f, 0.f, 0.f, 0.f}; xb[j] = (v2u){0u, 0u}; yn[j] = (v2u){0u, 0u}; zn[j] = (v2u){0u, 0u}; }
#define NORM_LOAD(mm) do { const int b_ = (mm) / TB, t_ = (mm) - b_ * TB; const bool ic_ = t_ < CTXL; \
        if (a.xin_input) { const float* xi_ = ic_ ? (INP(2) + (size_t)(b_ * CTXL + t_) * D) : (INP(0) + (size_t)(b_ * SEQ + t_ - CTXL) * D); \
            _Pragma("unroll") for (int j = 0; j < 4; ++j) xn[j] = *(const f32x4*)(xi_ + c0 + 256 * j); } \
        else { _Pragma("unroll") for (int j = 0; j < 4; ++j) xb[j] = *(const v2u*)(FX + (size_t)(mm) * D + c0 + 256 * j); } \
        _Pragma("unroll") for (int j = 0; j < 4; ++j) { \
            if (a.has_y) yn[j] = *(const v2u*)(Y0 + (size_t)(mm) * D + c0 + 256 * j); if (a.two) zn[j] = *(const v2u*)(Y1 + (size_t)(mm) * D + c0 + 256 * j); } } while (0)
    int m = r0 + F.wave;
    if (m < r1) NORM_LOAD(m);
    for (; m < r1; m += 8) {
        const int b = m / TB, t = m - b * TB; const bool isctx = t < CTXL; const int midx = isctx ? 8 : b;
        f32x4 x[4]; v2u yv[4], zv[4];
#pragma unroll
        for (int j = 0; j < 4; ++j) { x[j] = a.xin_input ? xn[j] : (f32x4){bflo(xb[j].x), bfhi(xb[j].x), bflo(xb[j].y), bfhi(xb[j].y)}; yv[j] = yn[j]; zv[j] = zn[j]; }
        if (m + 8 < r1) NORM_LOAD(m + 8);
        if (midx != cur_midx) { cur_midx = midx;
#pragma unroll
            for (int j = 0; j < 4; ++j) { if (a.has_y) pgt[j] = *(const f32x4*)(a.gate + (size_t)midx * 6144 + c0 + 256 * j);
                if (a.do_h) { psh[j] = *(const f32x4*)(a.shift + (size_t)midx * 6144 + c0 + 256 * j); psc[j] = *(const f32x4*)(a.scale + (size_t)midx * 6144 + c0 + 256 * j); } } }
        if (a.has_y) {
            f32x4 y[4]; float ss = 0.f;
#pragma unroll
            for (int j = 0; j < 4; ++j) { y[j] = (f32x4){bflo(yv[j].x), bfhi(yv[j].x), bflo(yv[j].y), bfhi(yv[j].y)};
                if (a.two) y[j] += (f32x4){bflo(zv[j].x), bfhi(zv[j].x), bflo(zv[j].y), bfhi(zv[j].y)};
                ss += (y[j].x * y[j].x + y[j].y * y[j].y) + (y[j].z * y[j].z + y[j].w * y[j].w); }
            const float rs = 1.0f / sqrtf(wave_sum(ss) * (1.0f / D) + EPS);
#pragma unroll
            for (int j = 0; j < 4; ++j) x[j] += pgt[j] * (y[j] * rs * pgy[j]);
        }
        if (a.final_) { if (!isctx) { float* o_ = OUTP + (size_t)(b * SEQ + t - CTXL) * D;
#pragma unroll
            for (int j = 0; j < 4; ++j) *(f32x4*)(o_ + c0 + 256 * j) = x[j]; } }
        else if (a.write_x) {
#pragma unroll
            for (int j = 0; j < 4; ++j) { v2u w_; w_.x = cvt_pk_bf16(x[j].x, x[j].y); w_.y = cvt_pk_bf16(x[j].z, x[j].w); *(v2u*)(FX + (size_t)m * D + c0 + 256 * j) = w_; }
        }
        if (a.do_h) {
            float ss = 0.f;
#pragma unroll
            for (int j = 0; j < 4; ++j) ss += (x[j].x * x[j].x + x[j].y * x[j].y) + (x[j].z * x[j].z + x[j].w * x[j].w);
            const float rs = 1.0f / sqrtf(wave_sum(ss) * (1.0f / D) + EPS);
            f32x4 h[4];
#pragma unroll
            for (int j = 0; j < 4; ++j) { h[j] = (x[j] * rs * pgh[j]) * (psc[j] + 1.0f) + psh[j];
                if (a.h8) *(unsigned*)((unsigned char*)FH + (size_t)m * D + c0 + 256 * j) = pg8::pk4_fp8(h[j].x, h[j].y, h[j].z, h[j].w);
                else { v2u w; w.x = cvt_pk_bf16(h[j].x, h[j].y); w.y = cvt_pk_bf16(h[j].z, h[j].w); *(v2u*)(FH + (size_t)m * D + c0 + 256 * j) = w; } }
            if (a.do_route) {
                float lg[8];
#pragma unroll
                for (int e = 0; e < 8; ++e) { float s = 0.f;
#pragma unroll
                    for (int j = 0; j < 4; ++j) { const f32x4 w = *(const LAS f32x4*)(RWT + e * 1024 + c0 + 256 * j); s += (h[j].x * w.x + h[j].y * w.y) + (h[j].z * w.z + h[j].w * w.w); }
                    lg[e] = wave_sum(s) + a.rb[e]; }
                int e1 = 0; float v1 = lg[0];
#pragma unroll
                for (int e = 1; e < 8; ++e) if (lg[e] > v1) { v1 = lg[e]; e1 = e; }
                int e2 = -1; float v2 = -3.0e38f;
#pragma unroll
                for (int e = 0; e < 8; ++e) if (e != e1 && lg[e] > v2) { v2 = lg[e]; e2 = e; }
                const float p1 = 1.0f / (1.0f + expf(v2 - v1));
                if (F.lane == 0) { RouteRow rr; rr.e1 = e1; rr.e2 = e2; rr.p1 = p1; rr.p2 = 1.0f - p1; ((RouteRow*)(WSG + WS_ROUTE))[m] = rr;
                    atomicAdd((int*)&cnt[e1], 1); atomicAdd((int*)&cnt[e2], 1); }
            }
        }
    }
#undef NORM_LOAD
    if (a.do_route) { __syncthreads(); if (F.tid < 8) ((int*)(WSG + WS_WGCNT))[F.bid * 8 + F.tid] = cnt[F.tid]; }
}

__device__ __forceinline__ void ph_assign(Frame& F) {
    LAS int* part = (LAS int*)F.lds;
    LAS int* tot = (LAS int*)(F.lds + 32768);
    const int* WC = (const int*)(WSG + WS_WGCNT);
    int st[8], sb[8];
#pragma unroll
    for (int e = 0; e < 8; ++e) { st[e] = 0; sb[e] = 0; }
    for (int w = F.tid; w < F.G; w += 512) {
#pragma unroll
        for (int e = 0; e < 8; ++e) { const int c = WC[w * 8 + e]; st[e] += c; if (w < F.bid) sb[e] += c; } }
    if (F.tid < 32) tot[F.tid] = 0;
    __syncthreads();
#pragma unroll
    for (int e = 0; e < 8; ++e) { if (st[e]) atomicAdd((int*)&tot[e], st[e]); if (sb[e]) atomicAdd((int*)&tot[8 + e], sb[e]); }
    __syncthreads();
    if (F.tid == 0) { int o = 0; for (int e = 0; e < 8; ++e) { tot[16 + e] = o; o += (tot[e] + 255) & ~255; }
        if (F.bid == 0) { int* PE = (int*)(WSG + WS_PEXP); int p = 0; for (int e = 0; e < 8; ++e) { const int np = (tot[e] + 255) >> 8; for (int q = 0; q < np; ++q) PE[p++] = e; } PE[MAXP] = p; } }
    __syncthreads();
    RouteEnt* L = (RouteEnt*)(WSG + WS_LIST);
    if (F.bid == 0) {
        for (int e = 0; e < 8; ++e) { const int lo = tot[16 + e] + tot[e], hi = tot[16 + e] + ((tot[e] + 255) & ~255);
            for (int p = lo + F.tid; p < hi; p += 512) { RouteEnt z; z.tok = -1; z.slot = 0; z.w = 0.f; z.pad = 0; L[p] = z; } }
    }
    const RouteRow* RR = (const RouteRow*)(WSG + WS_ROUTE);
    const int r0 = (int)((long)M * F.bid / F.G), r1 = (int)((long)M * (F.bid + 1) / F.G);
    for (int m = r0 + F.tid; m < r1; m += 512) { const RouteRow rr = RR[m];
        { const int p = tot[16 + rr.e1] + tot[8 + rr.e1] + atomicAdd((int*)&tot[24 + rr.e1], 1); RouteEnt z; z.tok = m; z.slot = 0; z.w = rr.p1; z.pad = 0; L[p] = z; }
        { const int p = tot[16 + rr.e2] + tot[8 + rr.e2] + atomicAdd((int*)&tot[24 + rr.e2], 1); RouteEnt z; z.tok = m; z.slot = 1; z.w = rr.p2; z.pad = 0; L[p] = z; } }
}
__device__ __forceinline__ void ph_gather(Frame& F, int p0, int p1) {
    const RouteEnt* L = (const RouteEnt*)(WSG + WS_LIST); unsigned char* HG = FBIG + BIG_HG; const unsigned char* H8 = (const unsigned char*)FH;
    const int gw = F.bid * 8 + F.wave, NGW = F.G * 8, n = (p1 - p0) * 256;
    const int nit = gw < n ? (n - gw + NGW - 1) / NGW : 0;
    int mytok = -1; { const int rr = gw + F.lane * NGW; if (rr < n) mytok = L[(size_t)p0 * 256 + rr].tok; }
    for (int it = 0; it < nit; it += 4) { v4u a[4]; int tk[4];
#pragma unroll
        for (int u = 0; u < 4; ++u) { tk[u] = (it + u < nit) ? __builtin_amdgcn_readlane(mytok, it + u) : -2; a[u] = (v4u){0u, 0u, 0u, 0u}; }
#pragma unroll
        for (int u = 0; u < 4; ++u) if (tk[u] >= 0) a[u] = ((const v4u*)(H8 + (size_t)tk[u] * D))[F.lane];
#pragma unroll
        for (int u = 0; u < 4; ++u) if (tk[u] != -2) ((v4u*)(HG + (size_t)(gw + (it + u) * NGW) * D))[F.lane] = a[u]; }
}
__device__ __forceinline__ void rope8(v4u& a, v4u& b, const float* cs, float sc) {
    unsigned* pa = (unsigned*)&a; unsigned* pb = (unsigned*)&b;
#pragma unroll
    for (int k = 0; k < 4; ++k) {
        float x1l = bflo(pa[k]), x1h = bfhi(pa[k]), x2l = bflo(pb[k]), x2h = bfhi(pb[k]);
        float c0 = 1.f, s0 = 0.f, c1 = 1.f, s1 = 0.f;
        if (cs) { c0 = cs[4 * k]; s0 = cs[4 * k + 1]; c1 = cs[4 * k + 2]; s1 = cs[4 * k + 3]; }
        const float o1l = (x1l * c0 - x2l * s0) * sc, o2l = (x1l * s0 + x2l * c0) * sc, o1h = (x1h * c1 - x2h * s1) * sc, o2h = (x1h * s1 + x2h * c1) * sc;
        pa[k] = cvt_pk_bf16(o1l, o1h); pb[k] = cvt_pk_bf16(o2l, o2h);
    }
}
__device__ __forceinline__ void ph_rope(Frame& F, int odd) {
    const int gw = F.bid * 8 + F.wave, NGW = F.G * 8;
    bf16* Z = (bf16*)FBIG;
    if (!odd) {
        const float* T = (const float*)(WSG + WS_ROPE_R);
        const int tensor = F.lane >> 5, head = (F.lane >> 3) & 3, d0 = (F.lane & 7) * 8;
        const float sc = tensor ? 0.08838834764831845f : 1.0f;
        for (int m = gw; m < M; m += NGW) { const int t = m % TB;
            bf16* p = Z + (size_t)m * EV_IN + 1024 + tensor * 512 + head * 128 + d0;
            v4u a = *(v4u*)p, b = *(v4u*)(p + 64);
            if (t >= CTXL) { const int tl = t - CTXL, pos = d0 < 32 ? (tl >> 6) : (tl & 63), dq = d0 & 31; rope8(a, b, T + (pos * 32 + dq) * 2, sc); }
            else { if (!tensor) continue; rope8(a, b, nullptr, sc); }
            *(v4u*)p = a; *(v4u*)(p + 64) = b; }
    } else {
        const float* T = (const float*)(WSG + WS_ROPE_D);
        for (int m = gw; m < M; m += NGW) { const int t = m % TB; if (t < CTXL) continue;
            const int tl = t - CTXL;
            for (int it = F.lane; it < 96; it += 64) { const int tensor = it / 48, r = it % 48, hm = r >> 2, d0 = (r & 3) * 8;
                bf16* p = Z + (size_t)m * OD_IN + 256 + tensor * 768 + hm * 64 + d0;
                v4u a = *(v4u*)p, b = *(v4u*)(p + 32);
                const int pos = d0 < 16 ? (tl >> 6) : (tl & 63), dq = d0 & 15; rope8(a, b, T + (pos * 16 + dq) * 2, 1.0f);
                *(v4u*)p = a; *(v4u*)(p + 32) = b; } }
    }
}
__device__ __forceinline__ void unpack8(const v4u& w, float* f) { f[0] = bflo(w.x); f[1] = bfhi(w.x); f[2] = bflo(w.y); f[3] = bfhi(w.y); f[4] = bflo(w.z); f[5] = bfhi(w.z); f[6] = bflo(w.w); f[7] = bfhi(w.w); }
__device__ __forceinline__ v4u pack8(const float* f) { v4u w; w.x = cvt_pk_bf16(f[0], f[1]); w.y = cvt_pk_bf16(f[2], f[3]); w.z = cvt_pk_bf16(f[4], f[5]); w.w = cvt_pk_bf16(f[6], f[7]); return w; }
__device__ __forceinline__ void ph_merge_even(Frame& F, int i) {
    const int gw = F.bid * 8 + F.wave, NGW = F.G * 8;
    const bf16* Z = (const bf16*)FBIG; const bf16* HF = (const bf16*)FYB; const bf16* HB = (const bf16*)(FYB + T_HALF);
    const bf16* RF = (const bf16*)(FYB + 2 * T_HALF); const bf16* RB = (const bf16*)(FYB + 3 * T_HALF);
    const float* gn = INP(14) + (size_t)i * 512; const int c0 = 8 * F.lane;
    float gnv[8];
#pragma unroll
    for (int k = 0; k < 8; ++k) gnv[k] = gn[c0 + k];
    for (int m = gw; m < M; m += NGW) {
        float a[8], b[8], g[8], o[8];
        unpack8(*(const v4u*)(HF + (size_t)m * 512 + c0), a); unpack8(*(const v4u*)(HB + (size_t)m * 512 + c0), b); unpack8(*(const v4u*)(Z + (size_t)m * EV_IN + 512 + c0), g);
#pragma unroll
        for (int k = 0; k < 8; ++k) o[k] = (a[k] + b[k]) * gelu_tanh(g[k]);
        *(v4u*)(FH + (size_t)m * D + c0) = pack8(o);
        unpack8(*(const v4u*)(RF + (size_t)m * 512 + c0), a); unpack8(*(const v4u*)(RB + (size_t)m * 512 + c0), b); unpack8(*(const v4u*)(Z + (size_t)m * EV_IN + 2560 + c0), g);
        float s = 0.f;
#pragma unroll
        for (int k = 0; k < 8; ++k) { a[k] += b[k]; s += a[k]; }
        s += __shfl_xor(s, 1); s += __shfl_xor(s, 2); s += __shfl_xor(s, 4); s += __shfl_xor(s, 8);
        const float mean = s * (1.0f / 128.0f); float q = 0.f;
#pragma unroll
        for (int k = 0; k < 8; ++k) { a[k] -= mean; q += a[k] * a[k]; }
        q += __shfl_xor(q, 1); q += __shfl_xor(q, 2); q += __shfl_xor(q, 4); q += __shfl_xor(q, 8);
        const float rs = 1.0f / sqrtf(q * (1.0f / 128.0f) + EPS);
#pragma unroll
        for (int k = 0; k < 8; ++k) o[k] = a[k] * rs * gnv[k] * (g[k] * sigmoidf_(g[k]));
        *(v4u*)(FH + (size_t)m * D + 512 + c0) = pack8(o);
    }
}
__device__ __forceinline__ void ph_zpass(Frame& F, int i) {
    const int gw = F.bid * 8 + F.wave, NGW = F.G * 8;
    const bf16* ZI = (const bf16*)FBIG; const bf16* YF = (const bf16*)FYB; const bf16* YB = (const bf16*)(FYB + T_QUART); bf16* ZO = (bf16*)(FYB + 2 * T_QUART);
    const float* dsk = INP(27) + (size_t)i * 256; const int c0 = 4 * F.lane;
    const f32x4 dv = *(const f32x4*)(dsk + c0);
    for (int m = gw; m < M; m += NGW) {
        const v2u a = *(const v2u*)(YF + (size_t)m * 256 + c0), b = *(const v2u*)(YB + (size_t)m * 256 + c0), u = *(const v2u*)(ZI + (size_t)m * OD_IN + c0);
        const float y0 = bflo(a.x) + bflo(b.x) + dv.x * bflo(u.x), y1 = bfhi(a.x) + bfhi(b.x) + dv.y * bfhi(u.x), y2 = bflo(a.y) + bflo(b.y) + dv.z * bflo(u.y), y3 = bfhi(a.y) + bfhi(b.y) + dv.w * bfhi(u.y);
        v2u w; w.x = cvt_pk_bf16(gelu_tanh(y0), gelu_tanh(y1)); w.y = cvt_pk_bf16(gelu_tanh(y2), gelu_tanh(y3));
        *(v2u*)(ZO + (size_t)m * 256 + c0) = w; }
}

constexpr size_t VT_OFF = 128 * MiB, K8_OFF = 180 * MiB;
constexpr size_t Q8_OFF = 332 * MiB;
__device__ __forceinline__ void ph_vt(Frame& F) {
    LAS bf16* T = (LAS bf16*)(F.lds + F.wave * 17408);
    const bf16* Z = (const bf16*)FBIG; unsigned char* VT = FYB + VT_OFF;
    const int gw = F.bid * 8 + F.wave, NGW = F.G * 8, lane = F.lane;
    for (int it = gw; it < NB * 6 * 132; it += NGW) { const int bh = it / 132, t = it % 132, b = bh / 6, h = bh % 6;
        const bf16* src = Z + ((size_t)b * TB + 64 * t) * OD_IN + 1792 + h * 128;
#pragma unroll
        for (int i = 0; i < 16; ++i) { const int row = i * 4 + (lane >> 4), ch = lane & 15; *(LAS v4u*)(T + row * 136 + ch * 8) = *(const v4u*)(src + (size_t)row * OD_IN + ch * 8); }
        LDS_WAIT(); asm volatile("" ::: "memory");
        unsigned char* dst = VT + (size_t)it * 8192;
#pragma unroll
        for (int rr = 0; rr < 2; ++rr) { const int d = lane + 64 * rr;
#pragma unroll
            for (int q = 0; q < 4; ++q) { unsigned w[4];
#pragma unroll
                for (int k = 0; k < 4; ++k) { float v[4];
#pragma unroll
                    for (int e = 0; e < 4; ++e) { const int beta = q * 16 + k * 4 + e, i2 = beta & 31, hh = beta >> 5, key = ((i2 & 15) & 3) + 8 * ((i2 & 15) >> 2) + 4 * hh + 32 * (i2 >> 4); v[e] = bf2f(T[key * 136 + d]); }
                    w[k] = pg8::pk4_fp8(v[0], v[1], v[2], v[3]); }
                *(v4u*)(dst + d * 64 + q * 16) = (v4u){w[0], w[1], w[2], w[3]}; } }
        LDS_WAIT(); asm volatile("" ::: "memory");
    }
}
__device__ __forceinline__ int chunk_tlo(int dir, int c) { return dir == 0 ? 128 * c : (c < 2 ? 128 * (1 - c) : 8576 - 128 * c); }

__device__ __forceinline__ void lru_item(Frame& F, int i, int b, int dir, int blk) {
    LAS unsigned char* lds = F.lds;
    LAS float* UR = (LAS float*)(lds);
    LAS float* AA = (LAS float*)(lds + 98304);
    LAS float* U = (LAS float*)(lds + 36864);
    LAS float* BB = U;
    LAS bf16* UB = (LAS bf16*)(lds + 69632);
    LAS float* SEG = (LAS float*)(lds + 88064);
    LAS float* PRM = (LAS float*)(lds + 92160);
    const int tid = F.tid, lane = F.lane, wave = F.wave, ch = tid & 63, seg = tid >> 6;
    const bf16* Z = (const bf16*)FBIG; bf16* OUT = (bf16*)(FYB + (size_t)dir * T_HALF);
    const float* conv_w = INP(8) + (size_t)i * 4 * 512; const float* conv_b = INP(9) + (size_t)i * 512;
    const float* gate_w = INP(10) + (((size_t)i * 2 + dir) * 2) * 8 * 64 * 64;
    const float* gate_b = INP(11) + (((size_t)i * 2 + dir) * 2) * 512;
    const float* lam = INP(12) + ((size_t)i * 2 + dir) * 512;
    __syncthreads();
    if (tid < 64) { const int cg = blk * 64 + tid;
        PRM[0 * 64 + tid] = conv_w[0 * 512 + cg]; PRM[1 * 64 + tid] = conv_w[1 * 512 + cg]; PRM[2 * 64 + tid] = conv_w[2 * 512 + cg]; PRM[3 * 64 + tid] = conv_w[3 * 512 + cg];
        PRM[4 * 64 + tid] = conv_b[cg]; const float lm = lam[cg]; PRM[5 * 64 + tid] = (-lm > 20.f) ? -lm : log1pf(expf(-lm));
        PRM[6 * 64 + tid] = gate_b[cg]; PRM[7 * 64 + tid] = gate_b[512 + cg]; }
    const int fr = lane & 15, fq = lane >> 4;
    bf16x8 wf[8][2];
#pragma unroll
    for (int nt = 0; nt < 8; ++nt)
#pragma unroll
        for (int ks = 0; ks < 2; ++ks) { const int col = 16 * nt + fr, gate = col >> 6, j = col & 63; const float* wp = gate_w + (((size_t)gate * 8 + blk) * 64 + (32 * ks + 8 * fq)) * 64 + j;
            v4u w; w.x = cvt_pk_bf16(wp[0], wp[64]); w.y = cvt_pk_bf16(wp[128], wp[192]); w.z = cvt_pk_bf16(wp[256], wp[320]); w.w = cvt_pk_bf16(wp[384], wp[448]);
            wf[nt][ks] = __builtin_bit_cast(bf16x8, w); }
    float carry = 0.f;
    const size_t rowbase = (size_t)b * TB;
    v4u pre[3];
#define LRU_LOAD(c_) do { const int tl_ = chunk_tlo(dir, (c_)), lo_ = tl_ < CTXL ? 0 : CTXL, hi_ = tl_ < CTXL ? CTXL : TB; \
        _Pragma("unroll") for (int n_ = 0; n_ < 3; ++n_) { const int it_ = tid + 512 * n_, r_ = it_ >> 3, cc_ = it_ & 7, t_ = tl_ - 2 + r_; \
            pre[n_] = (it_ < 131 * 8 && t_ >= lo_ && t_ < hi_) ? *(const v4u*)(Z + (rowbase + t_) * EV_IN + blk * 64 + cc_ * 8) : (v4u){0u, 0u, 0u, 0u}; } } while (0)
    LRU_LOAD(0);
    __syncthreads();
    for (int c = 0; c < 66; ++c) {
        const int t_lo = chunk_tlo(dir, c);
#pragma unroll
        for (int n = 0; n < 3; ++n) { const int it = tid + 512 * n; if (it < 131 * 8) { const int r = it >> 3, cc = it & 7; float f[8]; unpack8(pre[n], f);
            *(LAS f32x4*)(UR + r * 64 + cc * 8) = (f32x4){f[0], f[1], f[2], f[3]}; *(LAS f32x4*)(UR + r * 64 + cc * 8 + 4) = (f32x4){f[4], f[5], f[6], f[7]}; } }
        if (c + 1 < 66) LRU_LOAD(c + 1);
        __syncthreads();
        { const float w0 = PRM[ch], w1 = PRM[64 + ch], w2 = PRM[128 + ch], w3 = PRM[192 + ch], cb = PRM[256 + ch];
#pragma unroll 4
          for (int k = 0; k < 16; ++k) { const int r = seg * 16 + k; const float u = cb + w0 * UR[r * 64 + ch] + w1 * UR[(r + 1) * 64 + ch] + w2 * UR[(r + 2) * 64 + ch] + w3 * UR[(r + 3) * 64 + ch];
              U[r * 64 + ch] = u; UB[r * 72 + ch] = (bf16)(cvt_pk_bf16(u, 0.f) & 0xffffu); } }
        asm volatile("s_waitcnt lgkmcnt(0)" ::: "memory");
        { f32x4 acc[8];
#pragma unroll
          for (int nt = 0; nt < 8; ++nt) acc[nt] = (f32x4){0.f, 0.f, 0.f, 0.f};
          const bf16x8 a0 = *(const LAS bf16x8*)(UB + (16 * wave + fr) * 72 + 8 * fq), a1 = *(const LAS bf16x8*)(UB + (16 * wave + fr) * 72 + 32 + 8 * fq);
#pragma unroll
          for (int nt = 0; nt < 8; ++nt) { acc[nt] = __builtin_amdgcn_mfma_f32_16x16x32_bf16(a0, wf[nt][0], acc[nt], 0, 0, 0); acc[nt] = __builtin_amdgcn_mfma_f32_16x16x32_bf16(a1, wf[nt][1], acc[nt], 0, 0, 0); }
#pragma unroll
          for (int nt = 0; nt < 4; ++nt) { const int cch = 16 * nt + fr; const float br = PRM[6 * 64 + cch], bi = PRM[7 * 64 + cch], sp = PRM[5 * 64 + cch];
#pragma unroll
              for (int rg = 0; rg < 4; ++rg) { const int r = 16 * wave + 4 * fq + rg; const float rgate = sigmoidf_(acc[nt][rg] + br), igate = sigmoidf_(acc[nt + 4][rg] + bi);
                  const float la = -8.0f * rgate * sp, av = __builtin_amdgcn_exp2f(1.4426950408889634f * la), x2 = 2.0f * la;
                  const float om = (x2 > -0.25f) ? (-x2 * (1.0f + x2 * (0.5f + x2 * (0.16666667f + x2 * (0.041666668f + x2 * 0.0083333338f))))) : (1.0f - av * av);
                  const float bv = __builtin_amdgcn_sqrtf(om) * (igate * U[r * 64 + cch]);
                  AA[r * 64 + cch] = av; BB[r * 64 + cch] = bv; } } }
        __syncthreads();
        float hl[16], ca[16];
        { float h = 0.f, p = 1.f;
#pragma unroll
          for (int k = 0; k < 16; ++k) { const int ip = seg * 16 + k, r = dir == 0 ? ip : 127 - ip; const float av = AA[r * 64 + ch], bv = BB[r * 64 + ch]; h = av * h + bv; p *= av; hl[k] = h; ca[k] = p; }
          SEG[seg * 64 + ch] = p; SEG[512 + seg * 64 + ch] = h; }
        __syncthreads();
        float hin = carry, myin = 0.f;
#pragma unroll
        for (int s = 0; s < 8; ++s) { if (s == seg) myin = hin; hin = SEG[s * 64 + ch] * hin + SEG[512 + s * 64 + ch]; }
        carry = hin;
#pragma unroll
        for (int k = 0; k < 16; ++k) { const int ip = seg * 16 + k, r = dir == 0 ? ip : 127 - ip; const float h = hl[k] + ca[k] * myin;
            OUT[(rowbase + t_lo + r) * 512 + blk * 64 + ch] = (bf16)(cvt_pk_bf16(h, 0.f) & 0xffffu); }
    }
#undef LRU_LOAD
}
__device__ __forceinline__ unsigned off_b(unsigned row, unsigned ch) { return 256u * row + 16u * (ch ^ (((row & 3) << 2) | ((row >> 2) & 3))); }
__device__ __forceinline__ unsigned row_read_addr(unsigned lane, unsigned rb, unsigned s) { return off_b(32 * rb + (lane & 31), 2 * s + (lane >> 5)); }
__device__ __forceinline__ unsigned tr_read_addr(unsigned lane, unsigned c, unsigned ks, unsigned t) {
    const unsigned h = lane >> 5, blk = (lane >> 4) & 1, q = (lane & 15) >> 2, p = lane & 3;
    return off_b(16 * ks + 8 * h + 4 * t + q, 4 * c + 2 * blk + (p >> 1)) + 8 * (p & 1);
}
typedef short v4i16_t __attribute__((ext_vector_type(4)));
__device__ __forceinline__ bf16x8 tr_frag(LAS unsigned char* tile, unsigned lane, unsigned c, unsigned ks) {
    const s16x4 lo = __builtin_bit_cast(s16x4, __builtin_amdgcn_ds_read_tr16_b64_v4i16((LAS v4i16_t*)(tile + tr_read_addr(lane, c, ks, 0))));
    const s16x4 hi = __builtin_bit_cast(s16x4, __builtin_amdgcn_ds_read_tr16_b64_v4i16((LAS v4i16_t*)(tile + tr_read_addr(lane, c, ks, 1))));
    return (bf16x8){lo[0], lo[1], lo[2], lo[3], hi[0], hi[1], hi[2], hi[3]};
}
__device__ __forceinline__ bf16x8 row_frag(LAS unsigned char* tile, unsigned lane, unsigned rb, unsigned s) { return *(const LAS bf16x8*)(tile + row_read_addr(lane, rb, s)); }
#define MFMA32(a, b, c) __builtin_amdgcn_mfma_f32_32x32x16_bf16((a), (b), (c), 0, 0, 0)

constexpr unsigned RT_KB = 0, RT_T2 = 32768, RT_QB = 65536, RT_VB = 98304;
__device__ __forceinline__ s16x4 ds_tr(LAS unsigned char* p) { return __builtin_bit_cast(s16x4, __builtin_amdgcn_ds_read_tr16_b64_v4i16((LAS v4i16_t*)p)); }
#define TRF(base0, base1, off) ({ const s16x4 lo_ = ds_tr(F.lds + (base0) + (off)), hi_ = ds_tr(F.lds + (base1) + (off)); (bf16x8){lo_[0], lo_[1], lo_[2], lo_[3], hi_[0], hi_[1], hi_[2], hi_[3]}; })
#define RWF(base, off) (*(const LAS bf16x8*)(F.lds + (base) + (off)))
__device__ __forceinline__ void ret_item(Frame& F, int li, int b, int head, int dir, int z) {
    const int tid = F.tid, lane = F.lane, wave = F.wave, ib = wave & 3, xw = wave >> 2, eb = 2 * z + xw, r = lane & 31, h = lane >> 5;
    const bf16* Z = (const bf16*)FBIG; bf16* OUT = (bf16*)(FYB + (size_t)(2 + dir) * T_HALF);
    const float theta = INP(13)[((size_t)li * 2 + dir) * 4 + head];
    const float log_g = -((-theta > 20.f) ? -theta : log1pf(expf(-theta)));
    const float g1 = expf(log_g), g127 = expf(127.0f * log_g);
    const size_t rowbase = (size_t)b * TB;
    unsigned xsI[8], xsT[8], xsJ[8];
    { const unsigned swz = ((r & 3) << 2) | ((r >> 2) & 3);
#pragma unroll
      for (int s = 0; s < 8; ++s) { const unsigned x = 256u * r + 16u * ((unsigned)(2 * s + h) ^ swz); xsI[s] = x + 8192u * ib + RT_QB; xsT[s] = x + 8192u * eb; xsJ[s] = x + 16384u * xw; } }
    const unsigned tK0 = RT_KB + tr_read_addr(lane, ib, 0, 0), tK1 = RT_KB + tr_read_addr(lane, ib, 0, 1);
    const unsigned tV0 = RT_VB + tr_read_addr(lane, eb, 0, 0), tV1 = RT_VB + tr_read_addr(lane, eb, 0, 1);
    __syncthreads();
    for (int it = tid; it < 2048; it += 512) *(LAS v4u*)(F.lds + RT_T2 + it * 16) = (v4u){0u, 0u, 0u, 0u};
    f32x16 SA = f32x16{};
    v4u pq[4], pk[4], pv[2];
#define RET_LOAD(c_) do { const int tl_ = chunk_tlo(dir, (c_)); _Pragma("unroll") for (int n_ = 0; n_ < 4; ++n_) { const int it_ = tid + 512 * n_, row_ = it_ >> 4, cn_ = it_ & 15; \
        const bf16* p_ = Z + (rowbase + tl_ + (dir == 0 ? row_ : 127 - row_)) * EV_IN + 1024 + head * 128 + cn_ * 8; pq[n_] = *(const v4u*)p_; pk[n_] = *(const v4u*)(p_ + 512); } \
        _Pragma("unroll") for (int n_ = 0; n_ < 2; ++n_) { const int it_ = tid + 512 * n_, row_ = it_ >> 3, cn_ = 8 * z + (it_ & 7); \
        pv[n_] = *(const v4u*)(Z + (rowbase + tl_ + (dir == 0 ? row_ : 127 - row_)) * EV_IN + 2048 + head * 128 + cn_ * 8); } } while (0)
    RET_LOAD(0);
#pragma nounroll
    for (int c = 0; c < 66; ++c) {
        const int t_lo = chunk_tlo(dir, c);
        __syncthreads();
#pragma unroll
        for (int n = 0; n < 4; ++n) { const int it = tid + 512 * n, row = it >> 4, cn = it & 15; const float sc = __builtin_amdgcn_exp2f(-(float)row * (log_g * 1.4426950408889634f)); const unsigned wo = off_b(row, cn);
            float f[8]; unpack8(pk[n], f);
#pragma unroll
            for (int k = 0; k < 8; ++k) f[k] *= sc;
            *(LAS v4u*)(F.lds + RT_QB + wo) = pq[n]; *(LAS v4u*)(F.lds + RT_KB + wo) = pack8(f); }
#pragma unroll
        for (int n = 0; n < 2; ++n) { const int it = tid + 512 * n, row = it >> 3, cn = 8 * z + (it & 7); *(LAS v4u*)(F.lds + RT_VB + off_b(row, cn)) = pv[n]; }
        if (c + 1 < 66) RET_LOAD(c + 1);
        __syncthreads();
        f32x16 OT = f32x16{}, ST[2]; ST[0] = f32x16{}; ST[1] = f32x16{};
#pragma unroll
        for (int s = 0; s < 8; ++s) { const bf16x8 qf = RWF(xsI[s], 0);
            OT = MFMA32(RWF(xsT[s], RT_T2), qf, OT);
            if (2 * xw <= ib) ST[0] = MFMA32(RWF(xsJ[s], RT_KB), qf, ST[0]);
            if (2 * xw + 1 <= ib) ST[1] = MFMA32(RWF(xsJ[s], RT_KB + 8192), qf, ST[1]); }
#pragma unroll
        for (int q = 0; q < 16; ++q) SA[q] *= g1;
#pragma unroll
        for (int ks = 0; ks < 8; ++ks) SA = MFMA32(TRF(tK0, tK1, ks * 4096), TRF(tV0, tV1, ks * 4096), SA);
#pragma unroll
        for (int q = 0; q < 16; ++q) SA[q] *= g127;
        __syncthreads();
        const int irow = 32 * ib + r;
#pragma unroll
        for (int y = 0; y < 2; ++y) { const int jb = 2 * xw + y;
#pragma unroll
            for (int gq = 0; gq < 4; ++gq) { const int j0 = 32 * jb + 8 * gq + 4 * h; float p0 = ST[y][4 * gq], p1 = ST[y][4 * gq + 1], p2 = ST[y][4 * gq + 2], p3 = ST[y][4 * gq + 3];
                if (j0 > irow) p0 = 0.f; if (j0 + 1 > irow) p1 = 0.f; if (j0 + 2 > irow) p2 = 0.f; if (j0 + 3 > irow) p3 = 0.f;
                v2u w; w.x = cvt_pk_bf16(p0, p1); w.y = cvt_pk_bf16(p2, p3);
                *(LAS v2u*)(F.lds + RT_QB + off_b(irow, 4 * jb + gq) + 8 * h) = w; } }
        { const int erow = 32 * eb + r;
#pragma unroll
            for (int gq = 0; gq < 4; ++gq) { v2u w; w.x = cvt_pk_bf16(SA[4 * gq] * g1, SA[4 * gq + 1] * g1); w.y = cvt_pk_bf16(SA[4 * gq + 2] * g1, SA[4 * gq + 3] * g1);
                *(LAS v2u*)(F.lds + RT_T2 + off_b(erow, 4 * ib + gq) + 8 * h) = w; } }
        __syncthreads();
#pragma unroll
        for (int s = 0; s < 8; ++s) OT = MFMA32(TRF(tV0, tV1, s * 4096), RWF(xsI[s], 0), OT);
        { const float gi = __builtin_amdgcn_exp2f((float)irow * (log_g * 1.4426950408889634f)); const int t = t_lo + (dir == 0 ? irow : 127 - irow);
          bf16* op = OUT + (rowbase + t) * 512 + head * 128;
#pragma unroll
          for (int gq = 0; gq < 4; ++gq) { v2u w; w.x = cvt_pk_bf16(OT[4 * gq] * gi, OT[4 * gq + 1] * gi); w.y = cvt_pk_bf16(OT[4 * gq + 2] * gi, OT[4 * gq + 3] * gi);
              *(v2u*)(op + 32 * eb + 8 * gq + 4 * h) = w; } }
    }
#undef RET_LOAD
}
#undef TRF
#undef RWF
#if DBG_SCAN
#define DBGCHK(stage, v) do { if (!(fabsf(v) < 1e30f)) atomicMax((unsigned*)(WSG + WS_CTL) + 2049, 100u - (unsigned)(stage)); } while (0)
#else
#define DBGCHK(stage, v) do {} while (0)
#endif
typedef float f32x2 __attribute__((ext_vector_type(2)));
__device__ __forceinline__ f32x2 cmul_add(f32x2 a, f32x2 h, f32x2 c) {
    f32x2 t = (f32x2){a.x, a.x} * h + c; return (f32x2){-a.y, a.y} * (f32x2){h.y, h.x} + t; }
__device__ __forceinline__ void s5_item(Frame& F, int li, int b, int dir, int g) {
    LAS unsigned char* lds = F.lds;
    LAS f32x2* SEG = (LAS f32x2*)(lds + 8192);
    LAS unsigned* HS = (LAS unsigned*)(lds + 12288);
    const int tid = F.tid, lane = F.lane, wave = F.wave, fr = lane & 15, fq = lane >> 4;
    const int j = lane & 31, h = lane >> 5, tb = wave >> 1, sb = wave & 1, p = 32 * sb + j;
    LAS f32x2* QE = (LAS f32x2*)(lds + 49152) + wave * 256;
    const bf16* Z = (const bf16*)FBIG; bf16* OUT = (bf16*)(FYB + (size_t)dir * T_QUART);
    const size_t pb = ((size_t)li * 2 + dir) * 16 + g;
    const float lre = INP(20)[pb * 64 + p], lim = INP(21)[pb * 64 + p], dt = expf(INP(22)[pb]);
    const float x = lre * dt, y = lim * dt, ex = expf(x); float sy, cy; sincosf(y, &sy, &cy);
    const f32x2 a = (f32x2){ex * cy, ex * sy};
    const float sh = sinf(0.5f * y), am1r = expm1f(x) * cy - 2.0f * sh * sh, am1i = a.y;
    const float den = 1.0f / (lre * lre + lim * lim), cr = (am1r * lre + am1i * lim) * den, ci = (am1i * lre - am1r * lim) * den;
    bf16x8 bfre, bfim, bfre2, bfim2;
    { float vr[8], vi[8];
#pragma unroll
      for (int k = 0; k < 8; ++k) { const float br = INP(23)[(pb * 64 + p) * 16 + 8 * h + k], bi = INP(24)[(pb * 64 + p) * 16 + 8 * h + k]; vr[k] = cr * br - ci * bi; vi[k] = cr * bi + ci * br; }
      const v4u pr = pack8(vr), pi = pack8(vi); bfre = __builtin_bit_cast(bf16x8, pr); bfim = __builtin_bit_cast(bf16x8, pi);
      float hr[8], hi_[8]; unpack8(pr, hr); unpack8(pi, hi_);
#pragma unroll
      for (int k = 0; k < 8; ++k) { vr[k] -= hr[k]; vi[k] -= hi_[k]; }
      bfre2 = __builtin_bit_cast(bf16x8, pack8(vr)); bfim2 = __builtin_bit_cast(bf16x8, pack8(vi)); }
    const f32x2 zero2 = (f32x2){0.f, 0.f};
    const f32x2 a2 = cmul_add(a, a, zero2), a3 = cmul_add(a2, a, zero2), a4 = cmul_add(a2, a2, zero2);
    f32x2 a32 = a4;
#pragma unroll
    for (int k = 0; k < 3; ++k) a32 = cmul_add(a32, a32, zero2);
    bf16x8 cf[4];
#pragma unroll
    for (int ks = 0; ks < 4; ++ks) { float v[8];
#pragma unroll
        for (int jj = 0; jj < 8; ++jj) { const int k = 32 * ks + 8 * fq + jj, pp = k >> 1; v[jj] = (k & 1) ? -INP(26)[(pb * 16 + fr) * 64 + pp] : INP(25)[(pb * 16 + fr) * 64 + pp]; }
        cf[ks] = __builtin_bit_cast(bf16x8, pack8(v)); }
    f32x2 hc = zero2;
    const size_t rowbase = (size_t)b * TB;
    v4u pu = (v4u){0u, 0u, 0u, 0u};
#define S5_LOAD(c_) do { const int tl_ = chunk_tlo(dir, (c_)), ip_ = 32 * tb + j; pu = *(const v4u*)(Z + (rowbase + tl_ + (dir == 0 ? ip_ : 127 - ip_)) * OD_IN + g * 16 + 8 * h); } while (0)
    S5_LOAD(0);
    __syncthreads();
    for (int c = 0; c < 66; ++c) {
        const int t_lo = chunk_tlo(dir, c);
        const bf16x8 au = __builtin_bit_cast(bf16x8, pu);
        if (c + 1 < 66) S5_LOAD(c + 1);
        f32x16 Bre = __builtin_amdgcn_mfma_f32_32x32x16_bf16(au, bfre2, f32x16{}, 0, 0, 0), Bim = __builtin_amdgcn_mfma_f32_32x32x16_bf16(au, bfim2, f32x16{}, 0, 0, 0);
        Bre = __builtin_amdgcn_mfma_f32_32x32x16_bf16(au, bfre, Bre, 0, 0, 0); Bim = __builtin_amdgcn_mfma_f32_32x32x16_bf16(au, bfim, Bim, 0, 0, 0);
        f32x2 eq[8];
#pragma unroll
        for (int q = 0; q < 4; ++q) { f32x2 sr = zero2;
#pragma unroll
            for (int e = 0; e < 4; ++e) { sr = cmul_add(a, sr, (f32x2){Bre[4 * q + e], Bim[4 * q + e]}); Bre[4 * q + e] = sr.x; Bim[4 * q + e] = sr.y; }
            QE[(2 * q + h) * 32 + j] = sr; }
        asm volatile("s_waitcnt lgkmcnt(0)" ::: "memory");
#pragma unroll
        for (int Q = 0; Q < 8; ++Q) eq[Q] = QE[Q * 32 + j];
        { f32x2 sq = zero2;
#pragma unroll
          for (int Q = 0; Q < 8; ++Q) sq = cmul_add(a4, sq, eq[Q]);
          if (h == 0) SEG[tb * 64 + p] = sq; }
        __syncthreads();
        f32x2 hin = zero2;
#pragma unroll
        for (int b2 = 0; b2 < 4; ++b2) { if (b2 == tb) hin = hc; hc = cmul_add(a32, hc, SEG[b2 * 64 + p]); }
        { f32x2 tq = hin;
#pragma unroll
          for (int Q = 0; Q < 8; ++Q) {
              if ((Q & 1) == h) { const int q = Q >> 1;
#pragma unroll
                  for (int e = 0; e < 4; ++e) { const f32x2 pw = e == 0 ? a : (e == 1 ? a2 : (e == 2 ? a3 : a4)); const f32x2 v = cmul_add(pw, tq, (f32x2){Bre[4 * q + e], Bim[4 * q + e]});
                      HS[(32 * tb + 8 * q + 4 * h + e) * 68 + p] = cvt_pk_bf16(v.x, v.y); } }
              tq = cmul_add(a4, tq, eq[Q]); } }
        __syncthreads();
        { pg8::f32x4 acc = (pg8::f32x4){0.f, 0.f, 0.f, 0.f};
#pragma unroll
          for (int ks = 0; ks < 4; ++ks) { const bf16x8 af = *(const LAS bf16x8*)(HS + (16 * wave + fr) * 68 + 16 * ks + 4 * fq); acc = __builtin_amdgcn_mfma_f32_16x16x32_bf16(cf[ks], af, acc, 0, 0, 0); }
          const int ip = 16 * wave + fr, t = t_lo + (dir == 0 ? ip : 127 - ip);
          v2u w; w.x = cvt_pk_bf16(acc[0], acc[1]); w.y = cvt_pk_bf16(acc[2], acc[3]);
          *(v2u*)(OUT + (rowbase + t) * 256 + g * 16 + 4 * fq) = w; }
    }
#undef S5_LOAD
}
namespace att {
constexpr int KVBLK = 64, LD = OD_IN;
#define SBAR() __builtin_amdgcn_sched_barrier(0)
__device__ __forceinline__ int crow(int r, int hi) { return (r & 3) + 8 * (r >> 2) + 4 * hi; }
constexpr float THRL = 5.0f, POFF = 3.0f;
constexpr float KP0 = 8.0f * (POFF + 7.0f) - 0.094f, LIM8 = KP0 + 8.0f * THRL;
#define MX3(a, b, c) __builtin_fmaxf(__builtin_fmaxf((a), (b)), (c))
typedef int v8i_a __attribute__((ext_vector_type(8)));
typedef int v4i_a __attribute__((ext_vector_type(4)));
typedef float f32x4_a __attribute__((ext_vector_type(4)));
typedef __attribute__((address_space(3))) v4i_a lds_v4i;
#define LDSV(a_) (*(const lds_v4i*)(a_))
#define CAT8(x_, y_) __builtin_shufflevector((x_), (y_), 0, 1, 2, 3, 4, 5, 6, 7)
#define QKMF(x_, y_, c_) __builtin_amdgcn_mfma_scale_f32_32x32x64_f8f6f4(CAT8(x_, y_), qf, (c_), 0, 0, 0, 0x7f7f7f7f, 0, 0x80808080)
#define PVMF(pf_, acc_, x_, y_) __builtin_amdgcn_mfma_scale_f32_32x32x64_f8f6f4(pf_, CAT8(x_, y_), (acc_), 0, 0, 0, 0x7f7f7f7f, 0, 0x7f7f7f7f)
#define EXPB1(P_, r_, w_) w_ = (int)__builtin_amdgcn_cvt_pk_u8_f32(P_[r_], (r_) & 3, (unsigned)w_)
#define EXPW(P_, q_, W_, wi_) do { int w_; asm volatile("" : "=v"(w_)); EXPB1(P_, 4 * (q_), w_); EXPB1(P_, 4 * (q_) + 1, w_); EXPB1(P_, 4 * (q_) + 2, w_); EXPB1(P_, 4 * (q_) + 3, w_); asm volatile("" : "+v"(w_)); W_[wi_] = w_; } while (0)
#define EXPS(P_, h_, W_, w0_) do { EXPW(P_, 2 * (h_), W_, (w0_) + 2 * (h_)); EXPW(P_, 2 * (h_) + 1, W_, (w0_) + 2 * (h_) + 1); } while (0)
template <int MAP> __device__ __forceinline__ void unit(const unsigned char* q8, size_t row0, int qcol, const unsigned char* k8, size_t krow0, const unsigned char* vtb, unsigned vtoff, bf16* __restrict__ Ob, int seq, char* lds,
                                     float lam, float gsc, const float* __restrict__ gn, const int tid) {
  const int wid = __builtin_amdgcn_readfirstlane(tid >> 6), lane = tid & 63, r32 = lane & 31, hi = lane >> 5, wq = wid & 3; constexpr int map = MAP;
  constexpr int SLOT = 16384, VOFF = 8192;
  float* ws = (float*)(lds + 8 * SLOT) + wid * 64; float* al_l = ws + 32;
  f32x16 o[4] = {}; f32x4_a lacc = {};
  v8i_a qf;
  { const v4i_a* qp = (const v4i_a*)(q8 + (row0 + wq * 32 + r32) * 768 + qcol + map * 64 + hi * 32); const v4i_a x0 = qp[0], x1 = qp[1]; qf = CAT8(x0, x1); }
  asm volatile("s_waitcnt vmcnt(0)" ::: "memory");
  const int on_ = ((lane & 15) == ((lane >> 4) & 1)) ? 0x38383838 : 0;
  v8i_a ones = {on_, on_, on_, on_, on_, on_, on_, on_}; asm volatile("" : "+v"(ones));
  const int krow = wid * 8 + (lane >> 3); const unsigned voK = (unsigned)(krow * 768 + (((lane & 7) ^ ((krow >> 1) & 7)) * 16));
  const int vrow = wid * 16 + (lane >> 2); const unsigned voV = (unsigned)(vrow * 64 + (((lane & 3) ^ ((vrow >> 2) & 3)) * 16));
  const __amdgpu_buffer_rsrc_t rsK = __builtin_amdgcn_make_buffer_rsrc((void*)k8, 0, 0x7fffffff, 0x00020000), rsV = __builtin_amdgcn_make_buffer_rsrc((void*)vtb, 0, 0x7fffffff, 0x00020000);
  const unsigned koff = (unsigned)(krow0 * 768 + qcol);
  typedef __attribute__((address_space(3))) unsigned lds_u32;
  const int NT = seq / KVBLK;
#define DMA_TILE(t) do { const int tt_ = (t) < NT ? (t) : NT - 1; const int sl_ = ((t) & 7) * SLOT + wid * 1024; \
    __builtin_amdgcn_raw_ptr_buffer_load_lds(rsK, (lds_u32*)(lds + sl_), 16, (int)voK, (int)(koff + (unsigned)tt_ * (unsigned)(KVBLK * 768)), 0, 0); \
    __builtin_amdgcn_raw_ptr_buffer_load_lds(rsV, (lds_u32*)(lds + sl_ + VOFF), 16, (int)voV, (int)(vtoff + (unsigned)tt_ * 8192u), 0, 0); } while (0)
#define WAITB() asm volatile("s_waitcnt vmcnt(2)\n\ts_barrier" ::: "memory")
#define RESC(X0, X1) do { if (__builtin_expect(__any(dl8 > 0.f), 0)) { if (hi == 0) al_l[r32] = __builtin_amdgcn_exp2f(-0.125f * dl8); asm volatile("s_waitcnt lgkmcnt(0)" ::: "memory"); \
    _Pragma("unroll") for (int r = 0; r < 4; ++r) lacc[r] *= al_l[4 * (lane >> 4) + r + 16 * (lane & 1)]; \
    _Pragma("unroll") for (int r = 0; r < 16; ++r) { const float f_ = al_l[crow(r, hi)]; _Pragma("unroll") for (int d = 0; d < 4; ++d) o[d][r] *= f_; } \
    _Pragma("unroll") for (int r = 0; r < 16; ++r) { X0[r] -= dl8; X1[r] -= dl8; CKP[r] -= dl8; } } } while (0)
  const int kb0 = (int)(uintptr_t)lds + r32 * 128 + (((4 * map + 2 * hi) ^ ((r32 >> 1) & 7)) * 16);
  const int vb0 = (int)(uintptr_t)lds + VOFF + r32 * 64 + (((2 * hi) ^ ((r32 >> 2) & 3)) * 16);
  const int kb0x = kb0 ^ 16, vb0x = vb0 ^ 16;
  f32x16 pA0, pA1, pB0, pB1, CKP; v8i_a pf; float dl8 = 0.f;
#define ROWMAX_A(X0) mxa_ = MX3(X0[0], X0[1], X0[2]); mxb_ = MX3(X0[3], X0[4], X0[5]); mxa_ = MX3(mxa_, X0[6], X0[7]); mxb_ = MX3(mxb_, X0[8], X0[9]); mxa_ = MX3(mxa_, X0[10], X0[11]); mxb_ = MX3(mxb_, X0[12], X0[13]); mxa_ = MX3(mxa_, X0[14], X0[15]);
#define ROWMAX_B(X1) mxb_ = MX3(mxb_, X1[0], X1[1]); mxa_ = MX3(mxa_, X1[2], X1[3]); mxb_ = MX3(mxb_, X1[4], X1[5]); mxa_ = MX3(mxa_, X1[6], X1[7]); mxb_ = MX3(mxb_, X1[8], X1[9]); mxa_ = MX3(mxa_, X1[10], X1[11]); mxb_ = MX3(mxb_, X1[12], X1[13]); \
    mxa_ = MX3(mxa_, X1[14], X1[15]); rm_ = __builtin_fmaxf(mxa_, mxb_); \
    { auto rr_ = __builtin_amdgcn_permlane32_swap(__float_as_uint(rm_), __float_as_uint(rm_), false, false); rm_ = __builtin_fmaxf(__uint_as_float(rr_[0]), __uint_as_float(rr_[1])); }
#define PIN(x_) asm volatile("" : "+v"(x_))
  v4i_a va0_, va1_, vc0_, vc1_, vd0_, vd1_, ve0_, ve1_;
#define VREADS(t_) do { const int so_ = ((t_) & 7) * SLOT; const int vb_ = vb0 + so_, vx_ = vb0x + so_; va0_ = LDSV(vb_); va1_ = LDSV(vx_); vc0_ = LDSV(vb_ + 2048); vc1_ = LDSV(vx_ + 2048); \
    vd0_ = LDSV(vb_ + 4096); vd1_ = LDSV(vx_ + 4096); ve0_ = LDSV(vb_ + 6144); ve1_ = LDSV(vx_ + 6144); } while (0)
#define INTERVAL(X0, X1, Y0, Y1, j_) do { float mxa_ = 0.f, mxb_ = 0.f, rm_ = 0.f; \
    WAITB(); \
    const int kb_ = kb0 + ((j_) & 7) * SLOT, kx_ = kb0x + ((j_) & 7) * SLOT; \
    v4i_a ka0_ = LDSV(kb_), ka1_ = LDSV(kx_), kc0_ = LDSV(kb_ + 4096), kc1_ = LDSV(kx_ + 4096); \
    DMA_TILE((j_) + 2); \
    SBAR(); EXPS(Y0, 0, pf, 0); EXPS(Y0, 1, pf, 0); SBAR(); \
    PIN(ka0_); X0 = QKMF(ka0_, ka1_, CKP); PIN(X0); SBAR(); \
    EXPS(Y1, 0, pf, 4); EXPS(Y1, 1, pf, 4); SBAR(); \
    PIN(kc0_); X1 = QKMF(kc0_, kc1_, CKP); PIN(X1); SBAR(); \
    PIN(va0_); o[0] = PVMF(pf, o[0], va0_, va1_); PIN(o[0]); SBAR(); \
    ROWMAX_A(X0) \
    SBAR(); PIN(vc0_); o[1] = PVMF(pf, o[1], vc0_, vc1_); PIN(o[1]); SBAR(); \
    ROWMAX_B(X1) \
    dl8 = rm_ > LIM8 ? rm_ - KP0 : 0.f; \
    SBAR(); PIN(vd0_); o[2] = PVMF(pf, o[2], vd0_, vd1_); PIN(o[2]); SBAR(); \
    PIN(ve0_); o[3] = PVMF(pf, o[3], ve0_, ve1_); PIN(o[3]); SBAR(); \
    PIN(pf); lacc = __builtin_amdgcn_mfma_scale_f32_16x16x128_f8f6f4(pf, ones, lacc, 0, 0, 0, 0x7f7f7f7f, 0, 0x7f7f7f7f); PIN(lacc); SBAR(); \
    VREADS(j_); SBAR(); \
    RESC(X0, X1); } while (0)
  DMA_TILE(0); DMA_TILE(1);
  WAITB();
  DMA_TILE(2);
  { const v4i_a ka0_ = LDSV(kb0), ka1_ = LDSV(kb0 ^ 16), kc0_ = LDSV(kb0 + 4096), kc1_ = LDSV((kb0 + 4096) ^ 16);
    pA0 = QKMF(ka0_, ka1_, f32x16{}); pA1 = QKMF(kc0_, kc1_, f32x16{}); float mxa_, mxb_, rm_;
    ROWMAX_A(pA0) ROWMAX_B(pA1)
    const float kp0_ = KP0 - rm_;
#pragma unroll
    for (int r = 0; r < 16; ++r) { CKP[r] = kp0_; pA0[r] += kp0_; pA1[r] += kp0_; }
    PIN(CKP); VREADS(0); }
  for (int j = 1; j + 1 < NT; j += 2) {
    INTERVAL(pB0, pB1, pA0, pA1, j);
    INTERVAL(pA0, pA1, pB0, pB1, j + 1); }
  INTERVAL(pB0, pB1, pA0, pA1, NT - 1);
  { EXPS(pB0, 0, pf, 0); EXPS(pB0, 1, pf, 0); EXPS(pB1, 0, pf, 4); EXPS(pB1, 1, pf, 4);
    o[0] = PVMF(pf, o[0], va0_, va1_); o[1] = PVMF(pf, o[1], vc0_, vc1_); o[2] = PVMF(pf, o[2], vd0_, vd1_); o[3] = PVMF(pf, o[3], ve0_, ve1_);
    lacc = __builtin_amdgcn_mfma_scale_f32_16x16x128_f8f6f4(pf, ones, lacc, 0, 0, 0, 0x7f7f7f7f, 0, 0x7f7f7f7f); }
  asm volatile("s_waitcnt vmcnt(0)" ::: "memory");
#undef INTERVAL
#undef VREADS
#undef PIN
#undef ROWMAX_A
#undef ROWMAX_B
#undef DMA_TILE
#undef WAITB
  float rli[16];
  if ((lane & 15) < 2) {
#pragma unroll
    for (int r = 0; r < 4; ++r) ws[16 * (lane & 15) + 4 * (lane >> 4) + r] = lacc[r]; }
  asm volatile("s_waitcnt lgkmcnt(0)" ::: "memory");
#pragma unroll
  for (int r = 0; r < 16; ++r) rli[r] = __builtin_amdgcn_rcpf(ws[crow(r, hi)]);
  __syncthreads();
  int zz = 0; asm volatile("" : "+v"(zz));
  float* EX = (float*)lds;
  const int eb = wq * 4096 + lane + zz;
  if constexpr (MAP == 1) {
#pragma unroll
    for (int d0 = 0; d0 < 4; ++d0)
#pragma unroll
      for (int r = 0; r < 16; ++r) EX[eb + (d0 * 16 + r) * 64] = -lam * o[d0][r] * rli[r];
  }
  __syncthreads();
  if constexpr (MAP == 0) {
    float ss[16];
#pragma unroll
    for (int r = 0; r < 16; ++r) ss[r] = 0.f;
#pragma unroll
    for (int d0 = 0; d0 < 4; ++d0)
#pragma unroll
      for (int r = 0; r < 16; ++r) { const float v = o[d0][r] * rli[r] + EX[eb + (d0 * 16 + r) * 64]; o[d0][r] = v; ss[r] += v * v; }
#pragma unroll
    for (int r = 0; r < 16; ++r) { float s = ss[r]; s += __shfl_xor(s, 1); s += __shfl_xor(s, 2); s += __shfl_xor(s, 4); s += __shfl_xor(s, 8); s += __shfl_xor(s, 16);
      ss[r] = gsc / sqrtf(s * (1.0f / 128.0f) + EPS); }
    bf16* Ow = Ob + (long)(wq * 32 + 4 * hi) * 1024 + r32 + zz;
#pragma unroll
    for (int d0 = 0; d0 < 4; ++d0) { const float gv = gn[d0 * 32 + r32];
#pragma unroll
      for (int r = 0; r < 16; ++r) Ow[((r & 3) + 8 * (r >> 2)) * 1024 + d0 * 32] = (bf16)(cvt_pk_bf16(o[d0][r] * ss[r] * gv, 0.f) & 0xffffu); }
  }
  __syncthreads();
#undef RESC
#undef LDSV
#undef CAT8
#undef QKMF
#undef PVMF
#undef EXPS
#undef EXPW
#undef EXPB1
}
#undef MX3
#undef SBAR
}
#ifdef PROBE_SUB
#define SUB_T0 const unsigned long long sub_t0_ = __builtin_amdgcn_s_memrealtime()
#define SUB_SPIN(id) do { if (PROBE_SUB == (id)) { const unsigned long long t1_ = __builtin_amdgcn_s_memrealtime(), d_ = 9ull * (t1_ - sub_t0_); while (__builtin_amdgcn_s_memrealtime() - t1_ < d_) __builtin_amdgcn_s_sleep(8); } } while (0)
#else
#define SUB_T0 do {} while (0)
#define SUB_SPIN(id) do {} while (0)
#endif
__device__ __forceinline__ void ph_mix_even(Frame& F, int i) {
    SUB_T0;
    if (!(F.A->mode & 4)) for (int it = F.bid; it < 256; it += F.G) { LAUNDER(F);
#ifndef NO_RET
        if (it < 128) ret_item(F, i, it >> 4, (it >> 2) & 3, (it >> 1) & 1, it & 1);
#endif
#ifndef NO_LRU
        if (it >= 128) { const int j = it - 128; lru_item(F, i, j >> 4, (j >> 3) & 1, j & 7); }
#endif
        __syncthreads();
    }
    SUB_SPIN(3);
#ifdef PROBE_SUB
    if (F.bid < 128) { SUB_SPIN(5); } else { SUB_SPIN(6); }
#endif
}
__device__ __forceinline__ void ph_mix_odd(Frame& F, int l, int ctx_out) {
    const int i = l >> 1;
    { SUB_T0;
#ifndef NO_S5
    if (!(F.A->mode & 1)) for (int it = F.bid; it < 256; it += F.G) { LAUNDER(F); s5_item(F, i, it >> 5, (it >> 4) & 1, it & 15); __syncthreads(); }
#endif
    SUB_SPIN(1); }
    SUB_T0;
    const float* lp = INP(30) + (size_t)i * 256;
    const float s01 = wave_sum(lp[F.lane] * lp[64 + F.lane]), s23 = wave_sum(lp[128 + F.lane] * lp[192 + F.lane]);
    const float lam_init = 0.8f - 0.6f * expf(-0.3f * (float)l), lam = expf(s01) - expf(s23) + lam_init, gsc = 1.0f - lam_init;
    const bf16* Z = (const bf16*)FBIG; const float* gn = INP(31) + (size_t)i * 768;
    const int vcu = (F.G % 8 == 0) ? (F.bid % 8) * (F.G / 8) + F.bid / 8 : F.bid;
    const int nx = NB * 6 * 64, nc = ctx_out ? NB * 6 * 2 : 0;
    if (!(F.A->mode & 2)) for (int u = vcu; u < nx + nc; u += F.G) { LAUNDER(F);
        int bh, qb, row0, seq;
        if (u < nx) { bh = u >> 6; qb = u & 63;
            if (F.G == 256) { const int k = u >> 8; bh = 8 * (k >> 1) + (F.bid & 7); qb = 32 * (k & 1) + (F.bid >> 3); }
            row0 = (bh / 6) * TB + CTXL + 128 * qb; seq = TB; }
        else { const int v = u - nx; bh = v >> 1; qb = v & 1; row0 = (bh / 6) * TB + 128 * qb; seq = CTXL; }
        const int b = bh / 6, h = bh % 6;
#ifndef NO_ATTN
        if (F.wave < 4) att::unit<0>(FBIG + Q8_OFF, (size_t)row0, h * 128, FYB + K8_OFF, (size_t)b * TB, FYB + VT_OFF, (unsigned)((size_t)bh * 132 * 8192),
                  FH + (size_t)row0 * D + 256 + h * 128, seq, (char*)F.lds, lam, gsc, gn + h * 128, F.tid);
        else att::unit<1>(FBIG + Q8_OFF, (size_t)row0, h * 128, FYB + K8_OFF, (size_t)b * TB, FYB + VT_OFF, (unsigned)((size_t)bh * 132 * 8192),
                  FH + (size_t)row0 * D + 256 + h * 128, seq, (char*)F.lds, lam, gsc, gn + h * 128, F.tid);
#endif
    }
    SUB_SPIN(2);
}

constexpr int PH_PER_LAYER = 18, PH_TOTAL = 2 + NLAYER * PH_PER_LAYER;
#define IN(k) (lo <= (k) && (k) < hi)
#ifndef PROBE_PARITY
#define PROBE_PARITY (-1)
#endif
#ifdef PROBE_SPIN_KINDS
#define PH0 const unsigned long long ph_t0_ = __builtin_amdgcn_s_memrealtime()
#define SEAM(k) do { if (IN((k) + 1)) xcd_barrier(bar, LEAD0(F)); { const int kk_ = ((k) - 1) % PH_PER_LAYER; if (((k) > 0) && ((PROBE_SPIN_KINDS >> kk_) & 1) && (PROBE_PARITY < 0 || ((((k) - 1) / PH_PER_LAYER) & 1) == PROBE_PARITY)) { const unsigned long long t1_ = __builtin_amdgcn_s_memrealtime(), d_ = 9ull * (t1_ - ph_t0_); \
        while (__builtin_amdgcn_s_memrealtime() - t1_ < d_) __builtin_amdgcn_s_sleep(8); } } } while (0)
#else
#define PH0 do {} while (0)
#define SEAM(k) do { if (IN((k) + 1)) xcd_barrier(bar, LEAD0(F)); } while (0)
#endif
template <int l> __device__ __forceinline__ void run_layer(Frame& F, const XcdBarrier& bar, const int lo, const int hi) {
        constexpr int P = 1 + PH_PER_LAYER * l, i = l >> 1; constexpr bool odd = l & 1; constexpr int ctx_out = l < NLAYER - 1;
        const float* MODl = FMOD + (size_t)l * 9 * 6144; const float* ng = INP(6) + (size_t)l * 4 * 1024;
        if (IN(P + 0)) { LAUNDER(F); PH0;
            ph_convert(F, l);
#ifdef PROBE_CONVERT
            __syncthreads(); ph_convert(F, l);
#endif
            NormArgs a{}; a.xin_input = (l == 0); a.has_y = (l > 0); a.two = (l > 0) && ((l - 1) & 1); a.write_x = (l > 0); a.final_ = 0; a.do_h = 1; a.do_route = 0;
            if (l > 0) { a.gate = FMOD + (size_t)(l - 1) * 9 * 6144 + 5 * 1024; a.gy = INP(6) + (size_t)(l - 1) * 4 * 1024 + 3 * 1024; }
            a.gh = ng; a.shift = MODl; a.scale = MODl + 1024;
            __syncthreads(); ph_norm(F, a); SEAM(P + 0);
        }
        if (IN(P + 1)) { LAUNDER(F); PH0;
            constexpr int N = odd ? OD_IN : EV_IN, HD = odd ? 32 : 64;
            pg8::Gemm g{FH, FWB + W_IN / 2, M, N, D}; pg8::StaticOrder S; S.init(M, N, F.G, F.bid);
            pg8::EpiWin<HD> E{(bf16*)FBIG, N, (const float*)(WSG + (odd ? WS_ROPE_D : WS_ROPE_R)), odd ? 1 : 4, odd ? 4 : 6, odd ? 4 : 6, odd ? 7 : 8, odd ? 4.0f * 0.125f * 1.4426950408889634f : 1.0f, odd ? 1.0f : 0.08838834764831845f,
                                 odd ? FBIG + Q8_OFF : (unsigned char*)nullptr, odd ? FYB + K8_OFF : (unsigned char*)nullptr, 256, 1024};
            pg8::gemm_phase<pg8::EpiWin<HD>, pg8::StaticOrder, true, true>(F.lds, g, S, E, F.tid);
            if (odd) { SEAM(P + 1); } else { SEAM(P + 2); }
        }
        if (odd && IN(P + 2)) { LAUNDER(F); PH0; ph_vt(F); SEAM(P + 2); }
        if (IN(P + 3)) { LAUNDER(F); PH0;
            if (!odd) { ph_mix_even(F, i); }
            else ph_mix_odd(F, l, ctx_out);
            SEAM(P + 3); }
        if (IN(P + 4)) { LAUNDER(F); PH0; if (!odd) ph_merge_even(F, i); else ph_zpass(F, i); SEAM(P + 4); }
        if (odd && IN(P + 5)) { LAUNDER(F); PH0;
            int kglu = 256; asm volatile("" : "+s"(kglu));
            pg8::Gemm g{(const bf16*)(FYB + 2 * T_QUART), FWB + W_GLU / 2, M, 256, kglu}; pg8::StaticOrder S; S.init(M, 256, F.G, F.bid);
            pg8::EpiGLU E{FH, D, (const bf16*)(FYB + 2 * T_QUART), 256, INP(29) + (size_t)i * 256};
            pg8::gemm_phase<pg8::EpiGLU, pg8::StaticOrder, true, true>(F.lds, g, S, E, F.tid);
            SEAM(P + 5);
        }
        if (IN(P + 6)) { LAUNDER(F); PH0;
            pg8::Gemm g{FH, FWB + W_OUT / 2, M, D, D}; pg8::StaticOrder S; S.init(M, D, F.G, F.bid);
            pg8::EpiPlain E{(bf16*)FYB, D, 1.0f};
            pg8::gemm_phase<pg8::EpiPlain, pg8::StaticOrder, true, true>(F.lds, g, S, E, F.tid);
            if (!odd) { const int tw = ((M / 256) * (D / 256)) % F.G; if (tw == 0 || F.bid >= tw) { __syncthreads(); ph_convert_moe(F, i, tw, F.G - tw, 0, 3); } }
            SEAM(P + 6);
        }
        if (IN(P + 7)) { LAUNDER(F); PH0;
            NormArgs a{}; a.xin_input = (l == 0); a.has_y = 1; a.two = 0; a.write_x = 1; a.final_ = 0; a.do_h = 1; a.do_route = odd; a.h8 = 1;
            a.gate = MODl + 2 * 1024; a.gy = ng + 1024; a.gh = ng + 2 * 1024; a.shift = MODl + 3 * 1024; a.scale = MODl + 4 * 1024;
            a.rw = INP(33) + (size_t)i * 8192; a.rb = INP(34) + (size_t)i * 8;
            ph_norm(F, a); SEAM(P + 7);
        }
        if (!odd) {
            if (IN(P + 9)) { LAUNDER(F); PH0;
                int k8 = D / 2; asm volatile("" : "+s"(k8));
                pg8::Gemm g{FH, (const bf16*)((const unsigned char*)FWB + W_GU), M, 2 * DFF, k8}; pg8::StaticOrder S; S.init(M, 2 * DFF, F.G, F.bid);
                pg8::EpiSwiGLU8 E{FBIG + BIG_ACT, DFF, W8_INV};
                pg8::gemm_phase<pg8::EpiSwiGLU8, pg8::StaticOrder, true, true, true>(F.lds, g, S, E, F.tid);
                SEAM(P + 9);
            }
            if (IN(P + 10)) { LAUNDER(F); PH0;
                int k8 = DFF / 2; asm volatile("" : "+s"(k8));
                pg8::Gemm g{(const bf16*)(FBIG + BIG_ACT), (const bf16*)((const unsigned char*)FWB + W_DN), M, D, k8}; pg8::StaticOrder S; S.init(M, D, F.G, F.bid);
                pg8::EpiPlain E{(bf16*)FYB, D, W8_INV};
                pg8::gemm_phase<pg8::EpiPlain, pg8::StaticOrder, true, true, true>(F.lds, g, S, E, F.tid);
                { const int tw = ((M / 256) * (D / 256)) % F.G; if (tw == 0 || F.bid >= tw) { __syncthreads(); ph_convert_moe(F, i, tw, F.G - tw, 3, NE); } }
                SEAM(P + 10);
            }
        } else {
            if (IN(P + 8)) { LAUNDER(F); PH0; ph_assign(F); SEAM(P + 8); }
#pragma nounroll
            for (int w = 0; w < 2; ++w) {
                const int* PE = (const int*)(WSG + WS_PEXP);
                if (IN(P + 9 + 3 * w)) { LAUNDER(F); PH0; const int np = PE[MAXP], p0 = min(np, 256 * w), p1 = (w == 0) ? min(np, 256) : np; ph_gather(F, p0, p1); SEAM(P + 9 + 3 * w); }
                if (IN(P + 10 + 3 * w)) { LAUNDER(F); PH0; const int np = PE[MAXP], p0 = min(np, 256 * w), p1 = (w == 0) ? min(np, 256) : np;
                    int k8 = D / 2; asm volatile("" : "+s"(k8));
                    pg8::Gemm g{(const bf16*)(FBIG + BIG_HG), (const bf16*)(WSG + WS_W2 + W2_MGU), (p1 - p0) * 256, 2 * DFF, k8};
                    pg8::ExpertOrder S; S.init((p1 - p0) * 256, 2 * DFF, F.G, F.bid); S.pexp = PE + p0; S.estride = (size_t)7168 * 1024; S.tab = (LAS int*)(F.lds + RING_BYTES); __syncthreads(); S.fill(F.tid); __syncthreads();
                    pg8::EpiSwiGLU8 E{FBIG + BIG_ACT, DFF, W8_INV};
                    pg8::gemm_phase<pg8::EpiSwiGLU8, pg8::ExpertOrder, true, true, true>(F.lds, g, S, E, F.tid);
                    SEAM(P + 10 + 3 * w); }
                if (IN(P + 11 + 3 * w)) { LAUNDER(F); PH0; const int np = PE[MAXP], p0 = min(np, 256 * w), p1 = (w == 0) ? min(np, 256) : np;
                    int k8 = DFF / 2; asm volatile("" : "+s"(k8));
                    pg8::Gemm g{(const bf16*)(FBIG + BIG_ACT), (const bf16*)(WSG + WS_W2 + W2_MDN), (p1 - p0) * 256, D, k8};
                    pg8::ExpertOrder S; S.init((p1 - p0) * 256, D, F.G, F.bid); S.pexp = PE + p0; S.estride = (size_t)1024 * 3584; S.tab = (LAS int*)(F.lds + RING_BYTES); __syncthreads(); S.fill(F.tid); __syncthreads();
                    pg8::EpiScatter E{(const RouteEnt*)(WSG + WS_LIST) + (size_t)p0 * 256, (bf16*)FYB, (size_t)M * 1024, D, W8_INV};
                    pg8::gemm_phase<pg8::EpiScatter, pg8::ExpertOrder, true, true, true>(F.lds, g, S, E, F.tid);
                    if (w == 0) { SEAM(P + 11); } else { if (IN(P + PH_PER_LAYER)) xcd_barrier(bar, LEAD0(F)); } }
            }
        }
    }
#undef IN
#undef SEAM
__global__ void __launch_bounds__(512, 2) hybrid_fwd(Args args) {
    extern __shared__ __attribute__((aligned(16))) unsigned char lds_raw[];
    Frame F;
    F.lds = (LAS unsigned char*)lds_raw;
    F.tid = threadIdx.x; F.lane = F.tid & 63; F.wave = __builtin_amdgcn_readfirstlane(F.tid >> 6); F.G = gridDim.x; F.bid = blockIdx.x;
    F.A = (KArgs*)__builtin_amdgcn_kernarg_segment_ptr(); F.wsi = F.A->ws;
    volatile LAS unsigned* MISC = (volatile LAS unsigned*)(F.lds + MISC_OFF);
    for (int u = F.tid; u < (LDS_BYTES - LDSCTL_OFF) / 4; u += 512) ((LAS unsigned*)(F.lds + LDSCTL_OFF))[u] = 0u;
    __syncthreads();
    const int lo = args.ph_lo, hi = args.ph_hi;
    const bool multi = (hi - lo) > 1;
    unsigned* ctl = (unsigned*)(WSG + WS_CTL);
    XcdBarrier bar; bar.bar = ctl + CW_BAR; bar.x = 0; bar.st = nullptr;
    if (multi) bar = xcd_barrier_post(ctl + CW_BAR, MISC + 8);
#define IN(k) (lo <= (k) && (k) < hi)
#ifdef PROBE_SPIN_KINDS
#define PH0 const unsigned long long ph_t0_ = __builtin_amdgcn_s_memrealtime()
#define SEAM(k) do { if (IN((k) + 1)) xcd_barrier(bar, LEAD0(F)); { const int kk_ = ((k) - 1) % PH_PER_LAYER; if (((k) > 0) && ((PROBE_SPIN_KINDS >> kk_) & 1) && (PROBE_PARITY < 0 || ((((k) - 1) / PH_PER_LAYER) & 1) == PROBE_PARITY)) { const unsigned long long t1_ = __builtin_amdgcn_s_memrealtime(), d_ = 9ull * (t1_ - ph_t0_); \
        while (__builtin_amdgcn_s_memrealtime() - t1_ < d_) __builtin_amdgcn_s_sleep(8); } } } while (0)
#else
#define PH0 do {} while (0)
#define SEAM(k) do { if (IN((k) + 1)) xcd_barrier(bar, LEAD0(F)); } while (0)
#endif
#if defined(UBENCH) && UBENCH == 6
    { typedef int ub_v8i __attribute__((ext_vector_type(8)));
      ub_v8i ua = {(int)F.tid, 1, 2, 3, 4, 5, 6, 7}, ub = {7, 6, 5, 4, 3, 2, 1, (int)F.tid}; f32x16 c0 = {}, c1 = {}, c2 = {}, c3 = {};
      for (int i = 0; i < UB_N; ++i) { asm volatile("" : "+v"(ua), "+v"(ub));
        c0 = __builtin_amdgcn_mfma_scale_f32_32x32x64_f8f6f4(ua, ub, c0, 0, 0, 0, 0x7f7f7f7f, 0, 0x7f7f7f7f); c1 = __builtin_amdgcn_mfma_scale_f32_32x32x64_f8f6f4(ua, ub, c1, 0, 0, 0, 0x7f7f7f7f, 0, 0x7f7f7f7f);
        c2 = __builtin_amdgcn_mfma_scale_f32_32x32x64_f8f6f4(ua, ub, c2, 0, 0, 0, 0x7f7f7f7f, 0, 0x7f7f7f7f); c3 = __builtin_amdgcn_mfma_scale_f32_32x32x64_f8f6f4(ua, ub, c3, 0, 0, 0, 0x7f7f7f7f, 0, 0x7f7f7f7f); }
      asm volatile("" :: "v"(c0), "v"(c1), "v"(c2), "v"(c3)); }
#elif defined(UBENCH) && UBENCH == 7
    { typedef int ub_v8i __attribute__((ext_vector_type(8)));
      ub_v8i ua = {(int)F.tid, 1, 2, 3, 4, 5, 6, 7}, ub = {7, 6, 5, 4, 3, 2, 1, (int)F.tid}; f32x16 c0 = {}, c1 = {}, c2 = {}, c3 = {};
      float a0 = (float)F.tid, a1 = a0 + 1.f, a2 = a0 + 2.f, a3 = a0 + 3.f, a4 = a0 + 4.f, a5 = a0 + 5.f, a6 = a0 + 6.f;
#define UBF(r) "v_fma_f32 " r ", " r ", " r ", " r "\n\t"
#define UBF14 UBF("%0") UBF("%1") UBF("%2") UBF("%3") UBF("%4") UBF("%5") UBF("%6") UBF("%0") UBF("%1") UBF("%2") UBF("%3") UBF("%4") UBF("%5") UBF("%6")
#define UBV() asm volatile(UBF14 : "+v"(a0), "+v"(a1), "+v"(a2), "+v"(a3), "+v"(a4), "+v"(a5), "+v"(a6))
      for (int i = 0; i < UB_N; ++i) { asm volatile("" : "+v"(ua), "+v"(ub));
        c0 = __builtin_amdgcn_mfma_scale_f32_32x32x64_f8f6f4(ua, ub, c0, 0, 0, 0, 0x7f7f7f7f, 0, 0x7f7f7f7f); asm volatile("" : "+v"(c0)); UBV();
        c1 = __builtin_amdgcn_mfma_scale_f32_32x32x64_f8f6f4(ua, ub, c1, 0, 0, 0, 0x7f7f7f7f, 0, 0x7f7f7f7f); asm volatile("" : "+v"(c1)); UBV();
        c2 = __builtin_amdgcn_mfma_scale_f32_32x32x64_f8f6f4(ua, ub, c2, 0, 0, 0, 0x7f7f7f7f, 0, 0x7f7f7f7f); asm volatile("" : "+v"(c2)); UBV();
        c3 = __builtin_amdgcn_mfma_scale_f32_32x32x64_f8f6f4(ua, ub, c3, 0, 0, 0, 0x7f7f7f7f, 0, 0x7f7f7f7f); asm volatile("" : "+v"(c3)); UBV(); }
      asm volatile("" :: "v"(c0), "v"(c1), "v"(c2), "v"(c3), "v"(a0), "v"(a1), "v"(a2), "v"(a3), "v"(a4), "v"(a5), "v"(a6)); }
#elif defined(UBENCH)
    { float a0 = (float)F.tid, a1 = a0 + 1.f, a2 = a0 + 2.f, a3 = a0 + 3.f, a4 = a0 + 4.f, a5 = a0 + 5.f, a6 = a0 + 6.f, a7 = a0 + 7.f;
#if UBENCH == 1
#define UB1(r) "v_fma_f32 " r ", " r ", " r ", " r "\n\t"
#elif UBENCH == 2
#define UB1(r) "v_cvt_u32_f32 " r ", " r "\n\t"
#elif UBENCH == 3
#define UB1(r) "v_cvt_pk_fp8_f32 " r ", " r ", " r "\n\t"
#elif UBENCH == 4
#define UB1(r) "v_exp_f32 " r ", " r "\n\t"
#elif UBENCH == 10
#define UB1(r) "v_cvt_pk_u8_f32 " r ", " r ", 1, " r "\n\t"
#elif UBENCH == 9
#define UB1(r) "v_fma_f32 %0, %0, %0, %0\n\t"
#elif UBENCH == 5
#define UB1(r) "v_max3_f32 " r ", " r ", " r ", " r "\n\t"
#endif
#define UB8 UB1("%0") UB1("%1") UB1("%2") UB1("%3") UB1("%4") UB1("%5") UB1("%6") UB1("%7")
      for (int i = 0; i < UB_N; ++i) asm volatile(UB8 UB8 UB8 UB8 : "+v"(a0), "+v"(a1), "+v"(a2), "+v"(a3), "+v"(a4), "+v"(a5), "+v"(a6), "+v"(a7));
      asm volatile("" :: "v"(a0), "v"(a1), "v"(a2), "v"(a3), "v"(a4), "v"(a5), "v"(a6), "v"(a7)); }
#endif
    if (IN(0)) { LAUNDER(F); PH0; ph_prologue(F); SEAM(0); }
    run_layer<0>(F, bar, lo, hi); run_layer<1>(F, bar, lo, hi); run_layer<2>(F, bar, lo, hi); run_layer<3>(F, bar, lo, hi);
    if (IN(PH_TOTAL - 1)) { LAUNDER(F); PH0;
        NormArgs a{}; a.xin_input = 0; a.has_y = 1; a.two = 1; a.write_x = 1; a.final_ = 1; a.do_h = 0; a.do_route = 0;
        a.gate = FMOD + (size_t)3 * 9 * 6144 + 5 * 1024; a.gy = INP(6) + (size_t)3 * 4 * 1024 + 3 * 1024;
        ph_norm(F, a);
    }
#undef IN
#undef SEAM
}


#ifndef DBG_SCAN
#define DBG_SCAN 0
#endif
#if DBG_SCAN
constexpr int CW_DBG = 2048;
__global__ void __launch_bounds__(256) dbg_scan(unsigned char* ws, const float* out, int phase) {
    unsigned* flag = (unsigned*)(ws + WS_CTL) + CW_DBG; bool bad = false;
    const size_t gt = (size_t)blockIdx.x * 256 + threadIdx.x, gs = (size_t)gridDim.x * 256;
    { const uint4* p = (const uint4*)(ws + WS_W); const size_t n = (WS_END - WS_W) / 16;
      for (size_t i = gt; i < n; i += gs) { const uint4 v = p[i]; const unsigned w[4] = {v.x, v.y, v.z, v.w};
#pragma unroll
          for (int k = 0; k < 4; ++k) { if ((w[k] & 0x7F80u) == 0x7F80u || (w[k] & 0x7F800000u) == 0x7F800000u) bad = true; } } }
    { const uint4* p = (const uint4*)(ws + WS_MOD); const size_t n = 4 * 9 * 6144 / 4;
      for (size_t i = gt; i < n; i += gs) { const uint4 v = p[i]; if ((v.x & 0x7F800000u) == 0x7F800000u || (v.y & 0x7F800000u) == 0x7F800000u || (v.z & 0x7F800000u) == 0x7F800000u || (v.w & 0x7F800000u) == 0x7F800000u) bad = true; } }
    { const uint4* p = (const uint4*)out; const size_t n = (size_t)NB * SEQ * D / 4;
      for (size_t i = gt; i < n; i += gs) { const uint4 v = p[i]; if ((v.x & 0x7F800000u) == 0x7F800000u || (v.y & 0x7F800000u) == 0x7F800000u || (v.z & 0x7F800000u) == 0x7F800000u || (v.w & 0x7F800000u) == 0x7F800000u) bad = true; } }
    { const unsigned* p = (const unsigned*)(ws + WS_MOD); const size_t n = 4 * 9 * 6144;
      for (size_t i = gt; i < n; i += gs) if ((p[i] & 0x7F800000u) == 0x7F800000u) bad = true; }
    if (bad) atomicMax(flag, 1000u - (unsigned)phase);
}
__global__ void __launch_bounds__(256) dbg_emit(unsigned char* ws, float* out) {
    const unsigned f = ((const unsigned*)(ws + WS_CTL))[CW_DBG], f2 = ((const unsigned*)(ws + WS_CTL))[CW_DBG + 1]; if (f == 0u && f2 == 0u) return;
    const int p = f2 ? 40 + (100 - (int)f2) : 1000 - (int)f;
    const size_t n = (size_t)NB * SEQ * D;
    for (size_t i = (size_t)blockIdx.x * 256 + threadIdx.x; i < n; i += (size_t)gridDim.x * 256) out[i] = (i == 0) ? ldexpf(1.0f, 14 + p) : 0.f;
}
#endif
static bool phase_exists(int ph) {
    if (ph == 0 || ph == PH_TOTAL - 1) return true;
    const int l = (ph - 1) / PH_PER_LAYER, k = (ph - 1) % PH_PER_LAYER; const bool odd = l & 1;
    if (k == 2) return odd;
    if (odd) return k <= 14;
    return k <= 1 || k == 3 || k == 4 || k == 6 || k == 7 || k == 9 || k == 10;
}
#ifndef MK_ONE_LAUNCH
#define MK_ONE_LAUNCH 1
#endif
extern "C" void kernel_launch(void* const* d_in, const int* in_sizes, int n_in, void* d_out, int out_size, void* d_ws, size_t ws_size, hipStream_t stream) {
    static int grid = 0;
    if (grid == 0) {
        if (n_in != 38 || in_sizes[0] != NB * SEQ * D || out_size != NB * SEQ * D || ws_size < WS_END) { fprintf(stderr, "kernel_launch: unexpected shapes / workspace (%d inputs, ws %zu)\n", n_in, ws_size); grid = -1; return; }
        int dev = 0, cus = 0, per_cu = 0;
        if (hipGetDevice(&dev) != hipSuccess || hipDeviceGetAttribute(&cus, hipDeviceAttributeMultiprocessorCount, dev) != hipSuccess) { grid = -1; return; }
        if (hipFuncSetAttribute((const void*)hybrid_fwd, hipFuncAttributeMaxDynamicSharedMemorySize, LDS_BYTES) != hipSuccess) { fprintf(stderr, "kernel_launch: hipFuncSetAttribute failed\n"); grid = -1; return; }
        if (hipOccupancyMaxActiveBlocksPerMultiprocessor(&per_cu, (const void*)hybrid_fwd, 512, LDS_BYTES) != hipSuccess || per_cu < 1) fprintf(stderr, "kernel_launch: occupancy query reports %d workgroups per CU\n", per_cu);
        (void)hipGetLastError();
        grid = cus;
    }
    if (grid < 0) return;
    if (hipMemsetAsync((char*)d_ws + WS_CTL, 0, CTL_ZERO_BYTES, stream) != hipSuccess) return;
#if DBG_SCAN
    (void)hipMemsetAsync(d_ws, 0, WS_END, stream); (void)hipMemsetAsync(d_out, 0, (size_t)out_size * 4, stream);
#endif
    Args a{};
    for (int i = 0; i < 38; ++i) a.in[i] = (const float*)d_in[i];
    a.out = (float*)d_out; a.ws = (unsigned char*)d_ws;
    if (MK_ONE_LAUNCH) { a.ph_lo = 0; a.ph_hi = PH_TOTAL; hipLaunchKernelGGL(hybrid_fwd, dim3(grid), dim3(512), LDS_BYTES, stream, a); }
    else for (int ph = 0; ph < PH_TOTAL; ++ph) { if (!phase_exists(ph)) continue; a.ph_lo = ph; a.ph_hi = ph + 1;
        int reps = 1;
#ifdef PROBE_REPEAT
        if (ph > 0 && ph < PH_TOTAL - 1) { const int k = (ph - 1) % PH_PER_LAYER; if ((PROBE_REPEAT >> k) & 1) reps = 2; }
#endif
        for (int rp = 0; rp < reps; ++rp) {
#ifdef PROBE_MODE
            a.mode = rp ? PROBE_MODE : 0;
#endif
            hipLaunchKernelGGL(hybrid_fwd, dim3(grid), dim3(512), LDS_BYTES, stream, a); }
        a.mode = 0;
#if DBG_SCAN
        hipLaunchKernelGGL(dbg_scan, dim3(2048), dim3(256), 0, stream, (unsigned char*)d_ws, (const float*)d_out, ph);
#endif
    }
#if DBG_SCAN
    hipLaunchKernelGGL(dbg_emit, dim3(2048), dim3(256), 0, stream, (unsigned char*)d_ws, (float*)d_out);
#endif
    const hipError_t le = hipPeekAtLastError();
    if (le != hipSuccess) fprintf(stderr, "kernel_launch: launch failed: %s\n", hipGetErrorName(le));
}
```

```cpp
#include <hip/hip_runtime.h>
#include <cstdio>
#include <cstdint>
#include <cmath>
#define DBG_SCAN 0
namespace pg8 {
#define PG8_LAS __attribute__((address_space(3)))
typedef unsigned short bf16_t;
typedef short bf16x8 __attribute__((ext_vector_type(8)));
typedef float f32x4 __attribute__((ext_vector_type(4)));
typedef unsigned u32x4 __attribute__((ext_vector_type(4)));
typedef int v4i_t __attribute__((ext_vector_type(4)));
typedef int v8i_t __attribute__((ext_vector_type(8)));
constexpr int BM = 256, BK = 64, HALF = 128, HTB = HALF * BK * 2  , STAGE_BYTES = 8 * HTB, NXCD = 8, WGM = 8;

__host__ __device__ __forceinline__ int lds_byte(int r, int c) { const int st = (r >> 4) * 2 + (c >> 5), rr = r & 15, cc = c & 31, ob = rr * 64 + cc * 2; return st * 1024 + (ob ^ (((ob >> 9) & 1) << 5)); }
__host__ __device__ __forceinline__ void stage_rc(int b, int& R, int& C) { const int st = b / 1024, sb = b % 1024, swz = sb ^ (((sb >> 9) & 1) << 5); R = (st >> 1) * 16 + swz / 64; C = (st & 1) * 32 + (swz % 64) / 2; }
__host__ __device__ __forceinline__ int perm32(int rho) { const int n = rho >> 4, i = rho & 15; return 8 * (i >> 2) + 4 * n + (i & 3); }

struct Unit { int pm, pn, e; };
struct Gemm { const bf16_t* A; const bf16_t* Bt; int M, N, K; };

typedef float f32x2_cv __attribute__((ext_vector_type(2))); typedef __bf16 bf16x2_cv __attribute__((ext_vector_type(2)));
__device__ __forceinline__ unsigned cvt_pk_bf16(float lo, float hi) { const f32x2_cv v = {lo, hi}; const bf16x2_cv b = __builtin_convertvector(v, bf16x2_cv); return __builtin_bit_cast(unsigned, b); }
struct StaticOrder {
    int nM, nN, nwg, G, c;
    __host__ __device__ void init(int M, int N, int G_, int c_) { nM = M / BM; nN = N / BM; nwg = nM * nN; G = G_; c = c_; }
    __host__ __device__ bool next(int i, Unit& u) const {
        const long L = (long)i * G + c; if (L >= nwg) return false;
        int wgid = (int)L; { const int q = nwg / NXCD, r = nwg % NXCD, xcd = wgid % NXCD, off = wgid / NXCD; wgid = (xcd < r ? xcd * (q + 1) : r * (q + 1) + (xcd - r) * q) + off; }
        const int nig = WGM * nN, gid = wgid / nig, fm = gid * WGM, gsz = (nM - fm) < WGM ? (nM - fm) : WGM;
        u.pm = fm + ((wgid % nig) % gsz); u.pn = (wgid % nig) / gsz; return true;
    }
    __device__ __forceinline__ unsigned boff(const Gemm& g, const Unit& u) const { return (unsigned)u.pn * (unsigned)(BM * g.K * 2); }
    __device__ __forceinline__ void a_ready(const Unit&) const {}
    __device__ __forceinline__ void done(const Unit&) const {}
};
struct ExpertOrder : StaticOrder {
    const int* pexp; size_t estride; PG8_LAS int* tab;
    __device__ __forceinline__ void fill(int tid) const { Unit u; if (StaticOrder::next(tid, u)) tab[tid] = pexp[u.pm]; }
    __device__ __forceinline__ bool next(int i, Unit& u) const { const bool ok = StaticOrder::next(i, u); u.e = ok ? tab[i] : 0; return ok; }
    __device__ __forceinline__ unsigned boff(const Gemm& g, const Unit& u) const { return (unsigned)__builtin_amdgcn_readfirstlane(u.e) * (unsigned)estride + (unsigned)u.pn * (unsigned)(BM * g.K * 2); }
};
__device__ __forceinline__ float fast_sigmoid(float x) { return __builtin_amdgcn_rcpf(1.0f + __builtin_amdgcn_exp2f(-1.4426950408889634f * x)); }
__device__ __forceinline__ float bflo(unsigned w) { return __uint_as_float(w << 16); }
__device__ __forceinline__ float bfhi(unsigned w) { return __uint_as_float(w & 0xffff0000u); }
struct EpiPlain {
    static constexpr bool PERM = true, AFTER_DRAIN = false;
    bf16_t* O; int ldc; float sc;
    __device__ __forceinline__ void operator()(const f32x4 (&acc)[2][2][4][2], const Unit& u, int wr, int wc, int fr, int fq) const {
        const int row0 = u.pm * BM + wr * 64 + fr, col0 = u.pn * BM + wc * 32 + 8 * fq;
#pragma unroll
        for (int ai = 0; ai < 2; ++ai)
#pragma unroll
            for (int m = 0; m < 4; ++m) { bf16_t* rowp = O + (size_t)(row0 + ai * HALF + m * 16) * ldc + col0;
#pragma unroll
                for (int bj = 0; bj < 2; ++bj) { const f32x4 v0 = acc[ai][bj][m][0], v1 = acc[ai][bj][m][1];
                    u32x4 w; w.x = cvt_pk_bf16(v0[0], v0[1]); w.y = cvt_pk_bf16(v0[2], v0[3]); w.z = cvt_pk_bf16(v1[0], v1[1]); w.w = cvt_pk_bf16(v1[2], v1[3]);
                    *(u32x4*)(rowp + bj * HALF) = w; } }
    }
};
__device__ __forceinline__ unsigned pk4_fp8u(float a, float b, float c, float d) { int r; asm volatile("" : "=v"(r)); r = __builtin_amdgcn_cvt_pk_fp8_f32(a, b, r, false); r = __builtin_amdgcn_cvt_pk_fp8_f32(c, d, r, true); return (unsigned)r; }
__device__ __forceinline__ unsigned pk4_fp8(float a, float b, float c, float d) { int r = __builtin_amdgcn_cvt_pk_fp8_f32(a, b, 0, false); r = __builtin_amdgcn_cvt_pk_fp8_f32(c, d, r, true); return (unsigned)r; }
template <int HD> struct EpiWin {
    static constexpr bool PERM = true, AFTER_DRAIN = false;
    bf16_t* O; int ldc; const float* T; int qlo, qhi, klo, khi; float qsc, ksc;
    unsigned char* Q8; unsigned char* K8; int qcol0, kcol0;
    __device__ __forceinline__ void operator()(const f32x4 (&acc)[2][2][4][2], const Unit& u, int wr, int wc, int fr, int fq) const {
        const int row0 = u.pm * BM + wr * 64 + fr;
        const bool isq = u.pn >= qlo && u.pn < qhi, isk = u.pn >= klo && u.pn < khi;
        if (!isq && !isk) {
            const int col0 = u.pn * BM + wc * 32 + 8 * fq;
#pragma unroll
            for (int ai = 0; ai < 2; ++ai)
#pragma unroll
                for (int m = 0; m < 4; ++m) { bf16_t* rowp = O + (size_t)(row0 + ai * HALF + m * 16) * ldc + col0;
#pragma unroll
                    for (int bj = 0; bj < 2; ++bj) { const f32x4 v0 = acc[ai][bj][m][0], v1 = acc[ai][bj][m][1];
                        u32x4 w; w.x = cvt_pk_bf16(v0[0], v0[1]); w.y = cvt_pk_bf16(v0[2], v0[3]); w.z = cvt_pk_bf16(v1[0], v1[1]); w.w = cvt_pk_bf16(v1[2], v1[3]);
                        *(u32x4*)(rowp + bj * HALF) = w; } }
            return;
        }
        const float sc = isq ? qsc : ksc;
        const int jj0 = wc * 32 + 8 * fq, g = jj0 / HD, d0 = jj0 % HD, Q = HD / 2;
        const int col1 = u.pn * BM + g * (2 * HD) + d0, dq = d0 % Q; const bool byrow = d0 < Q;
#pragma unroll
        for (int ai = 0; ai < 2; ++ai)
#pragma unroll
            for (int m = 0; m < 4; ++m) { const int r = row0 + ai * HALF + m * 16, t = r % 8448;
                float o1[8], o2[8];
                if (t >= 256) { const int tl = t - 256, pos = byrow ? (tl >> 6) : (tl & 63); const f32x4* cs = (const f32x4*)(T + (size_t)(pos * Q + dq) * 2);
                    const f32x4 c0 = cs[0], c1 = cs[1], c2 = cs[2], c3 = cs[3];
                    const float cc[8] = {c0[0], c0[2], c1[0], c1[2], c2[0], c2[2], c3[0], c3[2]}, ss[8] = {c0[1], c0[3], c1[1], c1[3], c2[1], c2[3], c3[1], c3[3]};
#pragma unroll
                    for (int e = 0; e < 8; ++e) { const float x1 = acc[ai][0][m][e >> 2][e & 3], x2 = acc[ai][1][m][e >> 2][e & 3]; o1[e] = (x1 * cc[e] - x2 * ss[e]) * sc; o2[e] = (x1 * ss[e] + x2 * cc[e]) * sc; }
                } else {
#pragma unroll
                    for (int e = 0; e < 8; ++e) { o1[e] = acc[ai][0][m][e >> 2][e & 3] * sc; o2[e] = acc[ai][1][m][e >> 2][e & 3] * sc; }
                }
                if (Q8) { unsigned char* p8 = (isq ? Q8 + (size_t)r * 768 + (col1 - qcol0) : K8 + (size_t)r * 768 + (col1 - kcol0));
                    typedef unsigned u32x2 __attribute__((ext_vector_type(2)));
                    u32x2 w8; w8.x = pk4_fp8(o1[0], o1[1], o1[2], o1[3]); w8.y = pk4_fp8(o1[4], o1[5], o1[6], o1[7]); *(u32x2*)p8 = w8;
                    w8.x = pk4_fp8(o2[0], o2[1], o2[2], o2[3]); w8.y = pk4_fp8(o2[4], o2[5], o2[6], o2[7]); *(u32x2*)(p8 + HD) = w8; continue; }
                bf16_t* rowp = O + (size_t)r * ldc + col1;
                u32x4 w; w.x = cvt_pk_bf16(o1[0], o1[1]); w.y = cvt_pk_bf16(o1[2], o1[3]); w.z = cvt_pk_bf16(o1[4], o1[5]); w.w = cvt_pk_bf16(o1[6], o1[7]);
                *(u32x4*)rowp = w;
                w.x = cvt_pk_bf16(o2[0], o2[1]); w.y = cvt_pk_bf16(o2[2], o2[3]); w.z = cvt_pk_bf16(o2[4], o2[5]); w.w = cvt_pk_bf16(o2[6], o2[7]);
                *(u32x4*)(rowp + HD) = w; }
    }
};
struct EpiSwiGLU {
    static constexpr bool PERM = true, AFTER_DRAIN = false;
    bf16_t* O; int ldc;
    __device__ __forceinline__ void operator()(const f32x4 (&acc)[2][2][4][2], const Unit& u, int wr, int wc, int fr, int fq) const {
        const int row0 = u.pm * BM + wr * 64 + fr, col0 = u.pn * HALF + wc * 32 + 8 * fq;
#pragma unroll
        for (int ai = 0; ai < 2; ++ai)
#pragma unroll
            for (int m = 0; m < 4; ++m) { bf16_t* rowp = O + (size_t)(row0 + ai * HALF + m * 16) * ldc + col0;
                float o[8];
#pragma unroll
                for (int n = 0; n < 2; ++n)
#pragma unroll
                    for (int i = 0; i < 4; ++i) { const float g = acc[ai][0][m][n][i], up = acc[ai][1][m][n][i]; o[n * 4 + i] = g * fast_sigmoid(g) * up; }
                u32x4 w; w.x = cvt_pk_bf16(o[0], o[1]); w.y = cvt_pk_bf16(o[2], o[3]); w.z = cvt_pk_bf16(o[4], o[5]); w.w = cvt_pk_bf16(o[6], o[7]);
                *(u32x4*)rowp = w; }
    }
};
struct EpiSwiGLU8 {
    static constexpr bool PERM = true, AFTER_DRAIN = false;
    unsigned char* O; int ldc; float sc;
    __device__ __forceinline__ void operator()(const f32x4 (&acc)[2][2][4][2], const Unit& u, int wr, int wc, int fr, int fq) const {
        const int row0 = u.pm * BM + wr * 64 + fr, col0 = u.pn * HALF + wc * 32 + 8 * fq;
        const float kx = -1.4426950408889634f * sc, cc = 1.0f / (sc * sc);
#pragma unroll
        for (int ai = 0; ai < 2; ++ai)
#pragma unroll
            for (int m = 0; m < 4; ++m) { unsigned char* rowp = O + (size_t)(row0 + ai * HALF + m * 16) * ldc + col0;
                float o[8];
#pragma unroll
                for (int n = 0; n < 2; ++n)
#pragma unroll
                    for (int i = 0; i < 4; i += 2) { typedef float f32x2e __attribute__((ext_vector_type(2)));
                        const f32x2e ag = {acc[ai][0][m][n][i], acc[ai][0][m][n][i + 1]}, au = {acc[ai][1][m][n][i], acc[ai][1][m][n][i + 1]};
                        const f32x2e x = ag * kx; const f32x2e e = {__builtin_amdgcn_exp2f(x.x), __builtin_amdgcn_exp2f(x.y)};
                        const f32x2e d = e * cc + cc; const f32x2e r = {__builtin_amdgcn_rcpf(d.x), __builtin_amdgcn_rcpf(d.y)};
                        const f32x2e o2 = (ag * au) * r; o[n * 4 + i] = o2.x; o[n * 4 + i + 1] = o2.y; }
                typedef unsigned u32x2 __attribute__((ext_vector_type(2)));
                u32x2 w; w.x = pk4_fp8u(o[0], o[1], o[2], o[3]); w.y = pk4_fp8u(o[4], o[5], o[6], o[7]);
                *(u32x2*)rowp = w; }
    }
};
struct EpiGLU {
    static constexpr bool PERM = true, AFTER_DRAIN = false;
    bf16_t* O; int ldc; const bf16_t* Z; int ldz; const float* bias;
    __device__ __forceinline__ void operator()(const f32x4 (&acc)[2][2][4][2], const Unit& u, int wr, int wc, int fr, int fq) const {
        const int row0 = u.pm * BM + wr * 64 + fr, col0 = u.pn * BM + wc * 32 + 8 * fq;
#pragma unroll
        for (int bj = 0; bj < 2; ++bj) { const f32x4 b0 = *(const f32x4*)(bias + col0 + bj * HALF), b1 = *(const f32x4*)(bias + col0 + bj * HALF + 4);
#pragma unroll
            for (int ai = 0; ai < 2; ++ai)
#pragma unroll
                for (int m = 0; m < 4; ++m) { const size_t r = (size_t)(row0 + ai * HALF + m * 16);
                    const u32x4 zz = *(const u32x4*)(Z + r * ldz + col0 + bj * HALF);
                    const f32x4 v0 = acc[ai][bj][m][0] + b0, v1 = acc[ai][bj][m][1] + b1;
                    u32x4 w; w.x = cvt_pk_bf16(bflo(zz.x) * fast_sigmoid(v0[0]), bfhi(zz.x) * fast_sigmoid(v0[1])); w.y = cvt_pk_bf16(bflo(zz.y) * fast_sigmoid(v0[2]), bfhi(zz.y) * fast_sigmoid(v0[3]));
                    w.z = cvt_pk_bf16(bflo(zz.z) * fast_sigmoid(v1[0]), bfhi(zz.z) * fast_sigmoid(v1[1])); w.w = cvt_pk_bf16(bflo(zz.w) * fast_sigmoid(v1[2]), bfhi(zz.w) * fast_sigmoid(v1[3]));
                    *(u32x4*)(O + r * ldc + col0 + bj * HALF) = w; } }
    }
};
struct RouteEnt { int tok; int slot; float w; int pad; };
struct EpiScatter {
    static constexpr bool PERM = true, AFTER_DRAIN = false;
    const RouteEnt* L; bf16_t* Y; size_t slot_stride; int ldc; float sc;
    __device__ __forceinline__ void operator()(const f32x4 (&acc)[2][2][4][2], const Unit& u, int wr, int wc, int fr, int fq) const {
        const int row0 = u.pm * BM + wr * 64 + fr, col0 = u.pn * BM + wc * 32 + 8 * fq;
#pragma unroll
        for (int ai = 0; ai < 2; ++ai)
#pragma unroll
            for (int m = 0; m < 4; ++m) { const RouteEnt e = L[row0 + ai * HALF + m * 16];
                if (e.tok >= 0) { bf16_t* rowp = Y + (size_t)e.slot * slot_stride + (size_t)e.tok * ldc + col0;
#pragma unroll
                    for (int bj = 0; bj < 2; ++bj) { const float ww = e.w * sc; const f32x4 v0 = acc[ai][bj][m][0] * ww, v1 = acc[ai][bj][m][1] * ww;
                        u32x4 w; w.x = cvt_pk_bf16(v0[0], v0[1]); w.y = cvt_pk_bf16(v0[2], v0[3]); w.z = cvt_pk_bf16(v1[0], v1[1]); w.w = cvt_pk_bf16(v1[2], v1[3]);
                        *(u32x4*)(rowp + bj * HALF) = w; } } }
    }
};
template <class Epi, class Sched, bool ALIGN_EPI = false, bool SP2 = false, bool F8 = false>
__device__ __forceinline__ void gemm_phase(PG8_LAS unsigned char* lds, const Gemm g, const Sched& S, const Epi& E, const int tid) {
    const int wid = __builtin_amdgcn_readfirstlane(tid >> 6), lane = tid & 63, wr = wid >> 2, wc = wid & 3, fr = lane & 15, fq = lane >> 4;
    const int K = g.K, nt = K / BK;
    unsigned voffA[2], voffB[2];
#pragma unroll
    for (int i = 0; i < 2; ++i) { int R, C; stage_rc(tid * 16 + i * 8192, R, C); const int Rb = Epi::PERM ? ((R & ~31) + perm32(R & 31)) : R;
        voffA[i] = (unsigned)(R * K + C) * 2u; voffB[i] = (unsigned)(Rb * K + C) * 2u; }
    const unsigned kstep = (unsigned)(BK * 2);
    const unsigned hstep = (unsigned)HALF * K * 2;
    const unsigned tstep = 2 * hstep;
    const __amdgpu_buffer_rsrc_t rsA = __builtin_amdgcn_make_buffer_rsrc((void*)g.A, 0, 0x7fffffff, 0x00020000), rsB = __builtin_amdgcn_make_buffer_rsrc((void*)g.Bt, 0, 0x7fffffff, 0x00020000);
    const unsigned ldsw = (unsigned)wid * 1024u;
    const int aoff = lds_byte(wr * 64 + fr, fq * 8), boff = lds_byte(wc * 32 + fr, fq * 8);
#define PG8_SA(b, h) (((b) * 2 + (h)) * HTB)
#define PG8_SB(b, h) ((4 + (b) * 2 + (h)) * HTB)
#define PG8_STAGE(rs, bufoff, goff, voff) do { _Pragma("unroll") for (int _i = 0; _i < 2; ++_i) \
        __builtin_amdgcn_raw_ptr_buffer_load_lds(rs, (PG8_LAS unsigned*)(lds + (bufoff) + ldsw + _i * 8192), 16, (int)(voff)[_i], (int)(goff), 0, 0); } while (0)
#define PG8_LDA(dst, b, h) do { if constexpr (F8) { _Pragma("unroll") for (int m = 0; m < 4; ++m) dst##8[m] = __builtin_shufflevector(*(const PG8_LAS v4i_t*)(lds + PG8_SA(b, h) + aoff + m * 2048), *(const PG8_LAS v4i_t*)(lds + PG8_SA(b, h) + aoff + m * 2048 + 1024), 0, 1, 2, 3, 4, 5, 6, 7); } \
    else { _Pragma("unroll") for (int m = 0; m < 4; ++m) _Pragma("unroll") for (int k = 0; k < 2; ++k) dst[m][k] = *(const PG8_LAS bf16x8*)(lds + PG8_SA(b, h) + aoff + m * 2048 + k * 1024); } } while (0)
#define PG8_LDB(dst, b, h) do { if constexpr (F8) { _Pragma("unroll") for (int n = 0; n < 2; ++n) dst##8[n] = __builtin_shufflevector(*(const PG8_LAS v4i_t*)(lds + PG8_SB(b, h) + boff + n * 2048), *(const PG8_LAS v4i_t*)(lds + PG8_SB(b, h) + boff + n * 2048 + 1024), 0, 1, 2, 3, 4, 5, 6, 7); } \
    else { _Pragma("unroll") for (int n = 0; n < 2; ++n) _Pragma("unroll") for (int k = 0; k < 2; ++k) dst[n][k] = *(const PG8_LAS bf16x8*)(lds + PG8_SB(b, h) + boff + n * 2048 + k * 1024); } } while (0)
#define PG8_MMA(ai, bj, At, Bt) do { __builtin_amdgcn_s_setprio(1); _Pragma("unroll") for (int m = 0; m < 4; ++m) _Pragma("unroll") for (int n = 0; n < 2; ++n) { \
        if constexpr (F8) acc[ai][bj][m][n] = __builtin_amdgcn_mfma_scale_f32_16x16x128_f8f6f4(Bt##8[n], At##8[m], acc[ai][bj][m][n], 0, 0, 0, 0x7f7f7f7f, 0, 0x7f7f7f7f); \
        else { _Pragma("unroll") for (int k = 0; k < 2; ++k) acc[ai][bj][m][n] = __builtin_amdgcn_mfma_f32_16x16x32_bf16(Bt[n][k], At[m][k], acc[ai][bj][m][n], 0, 0, 0); } } \
        __builtin_amdgcn_s_setprio(0); } while (0)
#define PG8_WAIT_V(n) asm volatile("s_waitcnt vmcnt(" #n ")" ::: "memory")
#define PG8_WAIT_L(n) asm volatile("s_waitcnt lgkmcnt(" #n ")" ::: "memory")
#define PG8_BAR __builtin_amdgcn_s_barrier()
#define PG8_SCHED __builtin_amdgcn_sched_barrier(0)
    Unit cur, nxt; int ui = 0;
    if (!S.next(0, cur)) return;
    f32x4 acc[2][2][4][2];
#pragma unroll
    for (int a = 0; a < 2; ++a)
#pragma unroll
        for (int b = 0; b < 2; ++b)
#pragma unroll
            for (int m = 0; m < 4; ++m)
#pragma unroll
                for (int n = 0; n < 2; ++n) acc[a][b][m][n] = (f32x4){0.f, 0.f, 0.f, 0.f};
    bf16x8 At[4][2], B0[2][2], B1[2][2]; v8i_t At8[4], B08[2], B18[2];
    unsigned cA = (unsigned)cur.pm * tstep, cB = S.boff(g, cur);
    S.a_ready(cur);
    if constexpr (SP2) {
        PG8_STAGE(rsB, PG8_SB(0, 0), cB, voffB); PG8_STAGE(rsB, PG8_SB(0, 1), cB + hstep, voffB); PG8_STAGE(rsA, PG8_SA(0, 0), cA, voffA); PG8_STAGE(rsA, PG8_SA(0, 1), cA + hstep, voffA);
        if (wr == 1) PG8_BAR;
        PG8_WAIT_V(2); PG8_BAR;
        PG8_STAGE(rsB, PG8_SB(1, 0), cB + kstep, voffB); PG8_STAGE(rsA, PG8_SA(1, 0), cA + kstep, voffA); PG8_STAGE(rsB, PG8_SB(1, 1), cB + hstep + kstep, voffB);
        PG8_WAIT_V(6); PG8_BAR;
    } else {
        PG8_STAGE(rsB, PG8_SB(0, 0), cB, voffB); PG8_STAGE(rsA, PG8_SA(0, 0), cA, voffA); PG8_STAGE(rsB, PG8_SB(0, 1), cB + hstep, voffB); PG8_STAGE(rsA, PG8_SA(0, 1), cA + hstep, voffA);
        if (wr == 1) PG8_BAR;
        PG8_WAIT_V(4); PG8_BAR;
        PG8_STAGE(rsB, PG8_SB(1, 0), cB + kstep, voffB); PG8_STAGE(rsA, PG8_SA(1, 0), cA + kstep, voffA); PG8_STAGE(rsB, PG8_SB(1, 1), cB + hstep + kstep, voffB);
        PG8_WAIT_V(6); PG8_BAR;
    }
    for (;;) {
        const bool has_next = S.next(ui + 1, nxt);
        const unsigned nA = has_next ? (unsigned)nxt.pm * tstep : cA, nB = has_next ? S.boff(g, nxt) : cB;
        for (int t = 0; t < nt; t += 2) {
            const bool last = (t == nt - 2);
            const unsigned a1 = cA + (unsigned)(t + 1) * kstep;
            const unsigned a2 = last ? nA : cA + (unsigned)(t + 2) * kstep, b2 = last ? nB : cB + (unsigned)(t + 2) * kstep;
            const unsigned a3 = a2 + kstep, b3 = b2 + kstep;
            if (last && has_next) S.a_ready(nxt);
            if constexpr (SP2) {
            PG8_LDB(B0, 0, 0); PG8_LDB(B1, 0, 1); PG8_SCHED; PG8_LDA(At, 0, 0); PG8_STAGE(rsA, PG8_SA(1, 1), a1 + hstep, voffA);
            PG8_WAIT_V(8); PG8_WAIT_L(0); PG8_BAR; PG8_MMA(0, 0, At, B0); PG8_MMA(0, 1, At, B1); PG8_BAR; PG8_SCHED;
            PG8_LDA(At, 0, 1); PG8_STAGE(rsB, PG8_SB(0, 0), b2, voffB); PG8_STAGE(rsB, PG8_SB(0, 1), b2 + hstep, voffB); PG8_STAGE(rsA, PG8_SA(0, 0), a2, voffA);
            PG8_WAIT_V(8); PG8_WAIT_L(0); PG8_BAR; PG8_MMA(1, 0, At, B0); PG8_MMA(1, 1, At, B1); PG8_BAR; PG8_SCHED;
            PG8_LDB(B0, 1, 0); PG8_LDB(B1, 1, 1); PG8_SCHED; PG8_LDA(At, 1, 0); PG8_STAGE(rsA, PG8_SA(0, 1), a2 + hstep, voffA);
            PG8_WAIT_V(8); PG8_WAIT_L(0); PG8_BAR; PG8_MMA(0, 0, At, B0); PG8_MMA(0, 1, At, B1); PG8_BAR; PG8_SCHED;
            PG8_LDA(At, 1, 1); PG8_STAGE(rsB, PG8_SB(1, 0), b3, voffB); PG8_STAGE(rsB, PG8_SB(1, 1), b3 + hstep, voffB); PG8_STAGE(rsA, PG8_SA(1, 0), a3, voffA);
            PG8_WAIT_V(8); PG8_WAIT_L(0); PG8_BAR; PG8_MMA(1, 0, At, B0); PG8_MMA(1, 1, At, B1); PG8_BAR; PG8_SCHED;
            } else {
            PG8_LDB(B0, 0, 0); PG8_SCHED; PG8_LDA(At, 0, 0); PG8_STAGE(rsA, PG8_SA(1, 1), a1 + hstep, voffA);
            PG8_WAIT_L(8); PG8_BAR; PG8_WAIT_L(0); PG8_MMA(0, 0, At, B0); PG8_BAR; PG8_SCHED;
            PG8_LDB(B1, 0, 1); PG8_STAGE(rsB, PG8_SB(0, 0), b2, voffB);
            PG8_BAR; PG8_WAIT_L(0); PG8_MMA(0, 1, At, B1); PG8_BAR;
            PG8_LDA(At, 0, 1); PG8_STAGE(rsA, PG8_SA(0, 0), a2, voffA);
            PG8_BAR; PG8_WAIT_L(0); PG8_MMA(1, 0, At, B0); PG8_BAR; PG8_SCHED;
            PG8_STAGE(rsB, PG8_SB(0, 1), b2 + hstep, voffB);
            PG8_WAIT_V(6); PG8_BAR; PG8_MMA(1, 1, At, B1); PG8_BAR;
            PG8_LDB(B0, 1, 0); PG8_SCHED; PG8_LDA(At, 1, 0); PG8_STAGE(rsA, PG8_SA(0, 1), a2 + hstep, voffA);
            PG8_WAIT_L(8); PG8_BAR; PG8_WAIT_L(0); PG8_MMA(0, 0, At, B0); PG8_BAR; PG8_SCHED;
            PG8_LDB(B1, 1, 1); PG8_STAGE(rsB, PG8_SB(1, 0), b3, voffB);
            PG8_BAR; PG8_WAIT_L(0); PG8_MMA(0, 1, At, B1); PG8_BAR;
            PG8_LDA(At, 1, 1); PG8_STAGE(rsA, PG8_SA(1, 0), a3, voffA);
            PG8_BAR; PG8_WAIT_L(0); PG8_MMA(1, 0, At, B0); PG8_BAR; PG8_SCHED;
            PG8_STAGE(rsB, PG8_SB(1, 1), b3 + hstep, voffB);
            PG8_WAIT_V(6); PG8_BAR; PG8_MMA(1, 1, At, B1); PG8_BAR;
            }
        }
        if constexpr (ALIGN_EPI) { if (wr == 0) PG8_BAR; }
        if constexpr (!Epi::AFTER_DRAIN) { E(acc, cur, wr, wc, fr, fq); S.done(cur); }
        if (!has_next) break;
#pragma unroll
        for (int a = 0; a < 2; ++a)
#pragma unroll
            for (int b = 0; b < 2; ++b)
#pragma unroll
                for (int m = 0; m < 4; ++m)
#pragma unroll
                    for (int n = 0; n < 2; ++n) acc[a][b][m][n] = (f32x4){0.f, 0.f, 0.f, 0.f};
        cur = nxt; cA = nA; cB = nB; ++ui;
        if constexpr (ALIGN_EPI) { if (wr == 1) PG8_BAR; }
    }
    PG8_WAIT_V(0);
    if constexpr (!ALIGN_EPI) { if (wr == 0) PG8_BAR; }
    PG8_BAR;
    if constexpr (Epi::AFTER_DRAIN) { E.fused(acc, cur, wr, wc, fr, fq, lds, wid, lane); S.done(cur); }
#undef PG8_SA
#undef PG8_SB
#undef PG8_STAGE
#undef PG8_LDA
#undef PG8_LDB
#undef PG8_MMA
#undef PG8_WAIT_V
#undef PG8_WAIT_L
#undef PG8_BAR
#undef PG8_SCHED
}
}

#define GAS __attribute__((address_space(1)))
#define LAS __attribute__((address_space(3)))
#define XB_TMO      128
#define XB_XCNT(j)  (256  + 64 * (j))
#define XB_XSUB(j)  (1280 + 64 * (j))
#define XB_XGEN(j)  (2304 + 64 * (j))
#define XB_TOP      3328
#define XB_TOPGEN   3392
#define XCD_BAR_WORDS 3456
#define XB_SPIN_CAP (1u << 18)

__device__ __forceinline__ unsigned xb_ld(unsigned* p)              { return __hip_atomic_load(p, __ATOMIC_RELAXED, __HIP_MEMORY_SCOPE_AGENT); }
__device__ __forceinline__ unsigned xb_add(unsigned* p, unsigned v) { return __hip_atomic_fetch_add(p, v, __ATOMIC_RELAXED, __HIP_MEMORY_SCOPE_AGENT); }
__device__ __forceinline__ unsigned xb_xcc_id() { return (unsigned)__builtin_amdgcn_s_getreg((3 << 11) | 20) & 0xFu; }
#define XB_SPIN(cond, bar) do { unsigned _sp = 0; while (cond) { __builtin_amdgcn_s_sleep(1); \
    if ((++_sp & 255u) == 0u) { if (xb_ld(&(bar)[XB_TMO])) break; if (_sp > XB_SPIN_CAP) { atomicAdd(&(bar)[XB_TMO], 1u); break; } } } } while (0)

struct XcdBarrier {
    unsigned* bar; unsigned x;
    volatile LAS unsigned* st;
};

__device__ __forceinline__ XcdBarrier xcd_barrier_post(unsigned* bar, volatile LAS unsigned* st) {
    XcdBarrier b; b.bar = bar; b.x = xb_xcc_id(); b.st = st;
    if (threadIdx.x == 0) (void)xb_add(&bar[XB_XCNT(b.x)], 1u);
    return b;
}
__device__ __forceinline__ void xcd_barrier_complete(unsigned* bar, unsigned x, unsigned& nloc, unsigned& nx) {
    const unsigned G = gridDim.x * gridDim.y * gridDim.z;
    unsigned sum, cnt, mine, sp = 0u;
    for (;;) {
        sum = 0u; cnt = 0u; mine = 0u;
#pragma unroll
        for (unsigned j = 0; j < 16; ++j) { const unsigned c = xb_ld(&bar[XB_XCNT(j)]); sum += c; cnt += (c > 0u) ? 1u : 0u; mine = (j == x) ? c : mine; }
        if (sum == G) break;
        __builtin_amdgcn_s_sleep(1);
        if ((++sp & 255u) == 0u) { if (xb_ld(&bar[XB_TMO])) break; if (sp > XB_SPIN_CAP) { atomicAdd(&bar[XB_TMO], 1u); break; } }
    }
    nloc = mine > 0u ? mine : 1u; nx = cnt > 0u ? cnt : 1u;
}

__device__ __forceinline__ void xcd_barrier(const XcdBarrier& b, const bool leader_thread  ) {
    asm volatile("s_waitcnt vmcnt(0)" ::: "memory");
    __syncthreads();
    if (leader_thread) {
        unsigned* bar = b.bar;
        __builtin_amdgcn_s_waitcnt(0);
        unsigned nloc = b.st[0], nx = b.st[1];
        if (nloc == 0u) { xcd_barrier_complete(bar, b.x, nloc, nx); b.st[0] = nloc; b.st[1] = nx; }
        const unsigned old = xb_add(&bar[XB_XSUB(b.x)], 1u);
        const unsigned gen = old / nloc;
        if (old + 1u == (gen + 1u) * nloc) {
            __builtin_amdgcn_fence(__ATOMIC_RELEASE, "agent");
            asm volatile("s_waitcnt vmcnt(0)" ::: "memory");
            const unsigned og = xb_add(&bar[XB_TOP], 1u);
            const unsigned tg = og / nx;
            if (og + 1u == (tg + 1u) * nx) xb_add(&bar[XB_TOPGEN], 1u);
            else XB_SPIN(xb_ld(&bar[XB_TOPGEN]) == tg, bar);
            __builtin_amdgcn_fence(__ATOMIC_ACQUIRE, "agent");
            xb_add(&bar[XB_XGEN(b.x)], 1u);
            asm volatile("s_waitcnt vmcnt(0)" ::: "memory");
        } else {
            XB_SPIN(xb_ld(&bar[XB_XGEN(b.x)]) == gen, bar);
            __builtin_amdgcn_fence(__ATOMIC_ACQUIRE, "agent");
            asm volatile("s_waitcnt vmcnt(0)" ::: "memory");
        }
    }
    __syncthreads();
}
constexpr int D = 1024, NB = 8, SEQ = 8192, CTXL = 256, TB = SEQ + CTXL, M = NB * TB;
constexpr int EV_IN = 3072, OD_IN = 2560, DFF = 3584, NE = 8, NLAYER = 4;
constexpr int NPANEL = M / 256;
constexpr int PW = 280, MAXP = 536;
constexpr float EPS = 1e-6f;
constexpr size_t MiB = 1u << 20;
constexpr size_t WS_CTL = 0, CTL_ZERO_BYTES = 1 * MiB;
constexpr size_t WS_MOD = 1 * MiB;
constexpr size_t WS_ROPE_R = 2 * MiB, WS_ROPE_D = 2 * MiB + 65536;
constexpr size_t WS_ROUTE = 3 * MiB;
constexpr size_t WS_WGCNT = 5 * MiB;
constexpr size_t WS_PEXP = 5 * MiB + 65536;
constexpr size_t WS_LIST = 6 * MiB;
constexpr size_t WS_W = 20 * MiB;
constexpr size_t WS_X = 116 * MiB;
constexpr size_t WS_H = 248 * MiB;
constexpr size_t WS_Y = 380 * MiB;
constexpr size_t WS_BIG = 644 * MiB;
constexpr size_t WS_W2 = 1044 * MiB;
constexpr size_t WS_END = 1128 * MiB;
constexpr size_t W_IN = 0, W_OUT = 6 * MiB, W_GU = 8 * MiB, W_DN = 16 * MiB;
constexpr size_t W_GLU = 8 * MiB;
constexpr size_t W2_MGU = 0, W2_MDN = 56 * MiB;
constexpr size_t Y_SLOT = (size_t)M * 1024 * 2;
constexpr size_t T_HALF = (size_t)M * 512 * 2;
constexpr size_t T_QUART = (size_t)M * 256 * 2;
constexpr size_t BIG_ACT = 0, BIG_HG = 246 * MiB;
constexpr int CW_TMO = 0, CW_BAR = 4096;
constexpr int RING_BYTES = 131072, LDSCTL_OFF = RING_BYTES + 8192, MISC_OFF = LDSCTL_OFF + 320, LDS_BYTES = 147456;
typedef unsigned short bf16;
typedef unsigned v4u __attribute__((ext_vector_type(4)));
typedef unsigned v2u __attribute__((ext_vector_type(2)));
typedef float f32x4 __attribute__((ext_vector_type(4)));
typedef float f32x16 __attribute__((ext_vector_type(16)));
typedef short bf16x8 __attribute__((ext_vector_type(8)));
typedef short s16x4 __attribute__((ext_vector_type(4)));
#define RLX_AGENT __ATOMIC_RELAXED, __HIP_MEMORY_SCOPE_AGENT
using pg8::cvt_pk_bf16; using pg8::bflo; using pg8::bfhi; using pg8::RouteEnt;
struct RouteRow { int e1, e2; float p1, p2; };
__device__ __forceinline__ float bf2f(bf16 v) { return __uint_as_float((unsigned)v << 16); }
__device__ __forceinline__ float wave_sum(float v) {
#define DPP_ADD(ctrl, rmask) v += __builtin_bit_cast(float, __builtin_amdgcn_update_dpp(0, __builtin_bit_cast(int, v), (ctrl), (rmask), 0xF, false))
    DPP_ADD(0xB1, 0xF); DPP_ADD(0x4E, 0xF); DPP_ADD(0x141, 0xF); DPP_ADD(0x140, 0xF); DPP_ADD(0x142, 0xA); DPP_ADD(0x143, 0xC);
#undef DPP_ADD
    return __builtin_bit_cast(float, __builtin_amdgcn_readlane(__builtin_bit_cast(int, v), 63));
}
__device__ __forceinline__ float gelu_tanh(float x) {
    const float u = 0.7978845608028654f * (x + 0.044715f * x * x * x);
    return x * __builtin_amdgcn_rcpf(1.0f + __builtin_amdgcn_exp2f(-2.0f * 1.4426950408889634f * u));
}
__device__ __forceinline__ float sigmoidf_(float x) { return __builtin_amdgcn_rcpf(1.0f + __builtin_amdgcn_exp2f(-1.4426950408889634f * x)); }
struct Args { const float* in[38]; float* out; unsigned char* ws; int ph_lo, ph_hi, mode, pad; };
struct ArgsI { unsigned long long in[38]; unsigned long long out, ws; int ph_lo, ph_hi, mode, pad; };
typedef __attribute__((address_space(4))) const ArgsI KArgs;
#define INP(k) ((const float*)(GAS const float*)F.A->in[k])
#define OUTP ((float*)(GAS float*)F.A->out)
#define WSG ((unsigned char*)(GAS unsigned char*)F.wsi)
#define FMOD ((float*)(WSG + WS_MOD))
#define FX ((bf16*)(WSG + WS_X))
#define FH ((bf16*)(WSG + WS_H))
#define FWB ((bf16*)(WSG + WS_W))
#define FYB (WSG + WS_Y)
#define FBIG (WSG + WS_BIG)
#define LAUNDER(F) do { asm volatile("" : "+s"(F.wsi), "+s"(F.A), "+s"(F.wave), "+s"(F.bid), "+s"(F.G)); { unsigned z_ = 0u; asm volatile("" : "+v"(z_)); F.lane = (int)__builtin_amdgcn_mbcnt_hi(~0u, __builtin_amdgcn_mbcnt_lo(~0u, z_)); } F.tid = F.wave * 64 + F.lane; } while (0)
__device__ __forceinline__ bool lead0_lane() { unsigned z_ = 0u; asm volatile("" : "+v"(z_)); return __builtin_amdgcn_mbcnt_hi(~0u, __builtin_amdgcn_mbcnt_lo(~0u, z_)) == 0u; }
#define LEAD0(F) ((F).wave == 0 && lead0_lane())
struct Frame {
    LAS unsigned char* lds; unsigned long long wsi;
    int tid, lane, wave, G, bid;
    const KArgs* A;
};
#define LDS_WAIT() asm volatile("s_waitcnt lgkmcnt(0)" ::: "memory")

__device__ __forceinline__ void ph_prologue(Frame& F) {
    LAS float* SL = (LAS float*)F.lds;
    LAS float* RED = (LAS float*)(F.lds + 40960);
    const float* c = INP(1); const float* cc = INP(3); const float* mod_w = INP(4); const float* mod_b = INP(5);
    for (int i = F.tid; i < 9 * 1024; i += 512) { const float v = (i < 8192) ? c[i] : cc[i - 8192]; SL[i] = v * sigmoidf_(v); }
    __syncthreads();
    for (int blk = F.bid; blk < 4 * 96; blk += F.G) {
        const int l = blk / 96, n0 = (blk % 96) * 64;
        const float* wp = mod_w + ((size_t)l * 1024 + (size_t)F.wave * 128) * 6144 + n0 + F.lane;
        float acc[9];
#pragma unroll
        for (int j = 0; j < 9; ++j) acc[j] = 0.f;
        for (int k = 0; k < 128; ++k) { const float w = wp[(size_t)k * 6144];
#pragma unroll
            for (int j = 0; j < 9; ++j) acc[j] += SL[j * 1024 + F.wave * 128 + k] * w; }
#pragma unroll
        for (int j = 0; j < 9; ++j) RED[(F.wave * 9 + j) * 64 + F.lane] = acc[j];
        __syncthreads();
        for (int i = F.tid; i < 9 * 64; i += 512) { const int j = i >> 6, ln = i & 63; float s = mod_b[l * 6144 + n0 + ln];
#pragma unroll
            for (int w = 0; w < 8; ++w) s += RED[(w * 9 + j) * 64 + ln];
            FMOD[((size_t)l * 9 + j) * 6144 + n0 + ln] = s; }
        __syncthreads();
    }
    const int gt = F.bid * 512 + F.tid;
    if (gt < 128 * 32) { const int pos = gt >> 5, dq = gt & 31; const float inv = powf(10000.0f, -(float)dq / 32.0f); float s, cs; sincosf((float)pos * inv, &s, &cs);
        float* T = (float*)(WSG + WS_ROPE_R); T[gt * 2] = cs; T[gt * 2 + 1] = s; }
    else if (gt < 128 * 32 + 128 * 16) { const int g2 = gt - 128 * 32, pos = g2 >> 4, dq = g2 & 15; const float inv = powf(10000.0f, -(float)dq / 16.0f); float s, cs; sincosf((float)pos * inv, &s, &cs);
        float* T = (float*)(WSG + WS_ROPE_D); T[g2 * 2] = cs; T[g2 * 2 + 1] = s; }
}

__device__ __forceinline__ void transpose_item(const float* W, int K, int N, bf16* WT, int drow0, int k0, int n0, LAS float* scr, int lane) {
#pragma unroll
    for (int i = 0; i < 8; ++i) { const int kk = 8 * i + (lane >> 3), nn = (lane & 7) * 4; const f32x4 v = *(const f32x4*)(W + (size_t)(k0 + kk) * N + n0 + nn);
        scr[kk * 33 + nn] = v.x; scr[kk * 33 + nn + 1] = v.y; scr[kk * 33 + nn + 2] = v.z; scr[kk * 33 + nn + 3] = v.w; }
    LDS_WAIT(); asm volatile("" ::: "memory");
    const int c = lane & 7;
#pragma unroll
    for (int j = 0; j < 4; ++j) { const int n = (lane >> 3) + 8 * j; const LAS float* s = scr + (8 * c) * 33 + n;
        v4u o; o.x = cvt_pk_bf16(s[0 * 33], s[1 * 33]); o.y = cvt_pk_bf16(s[2 * 33], s[3 * 33]); o.z = cvt_pk_bf16(s[4 * 33], s[5 * 33]); o.w = cvt_pk_bf16(s[6 * 33], s[7 * 33]);
        *(v4u*)(WT + (size_t)(drow0 + n) * K + k0 + 8 * c) = o; }
    LDS_WAIT(); asm volatile("" ::: "memory");
}
__device__ __forceinline__ void convert_job(Frame& F, const float* W, int K, int N, bf16* WT, int mode) {
    LAS float* scr = (LAS float*)(F.lds + F.wave * 16384);
    const int gw = F.bid * 8 + F.wave, NGW = F.G * 8, nblk = N / 32, nit = (K / 64) * nblk;
    for (int it = gw; it < nit; it += NGW) { const int kb = it / nblk, nb = it % nblk, n0 = nb * 32;
        int drow0 = n0;
        if (mode == 1 || mode == 2) drow0 = (n0 >> 7) * 256 + (n0 & 127) + (mode == 2 ? 128 : 0);
        else if (mode == 3) { const int tile = n0 >> 8, w = n0 & 255; if (tile >= 4 && tile < 8) drow0 = tile * 256 + ((w >> 6) & 1) * 128 + (w >> 7) * 64 + (w & 63); }
        else if (mode == 4) { const int tile = n0 >> 8, w = n0 & 255; if (tile >= 1 && tile < 7) drow0 = tile * 256 + ((w >> 5) & 1) * 128 + (w >> 6) * 32 + (w & 31); }
        transpose_item(W, K, N, WT, drow0, kb * 64, n0, scr, F.lane); }
}
__device__ __forceinline__ void transpose_item_f8(const float* W, int K, int N, unsigned char* WT, int drow0, int k0, int n0, LAS float* scr, int lane, float wscale) {
#pragma unroll
    for (int i = 0; i < 8; ++i) { const int kk = 8 * i + (lane >> 3), nn = (lane & 7) * 4; const f32x4 v = *(const f32x4*)(W + (size_t)(k0 + kk) * N + n0 + nn);
        scr[kk * 33 + nn] = v.x * wscale; scr[kk * 33 + nn + 1] = v.y * wscale; scr[kk * 33 + nn + 2] = v.z * wscale; scr[kk * 33 + nn + 3] = v.w * wscale; }
    LDS_WAIT(); asm volatile("" ::: "memory");
#pragma unroll
    for (int j = 0; j < 2; ++j) { const int idx = lane + 64 * j, n = idx >> 2, c = idx & 3; const LAS float* s = scr + (16 * c) * 33 + n;
        v4u o; o.x = pg8::pk4_fp8(s[0 * 33], s[1 * 33], s[2 * 33], s[3 * 33]); o.y = pg8::pk4_fp8(s[4 * 33], s[5 * 33], s[6 * 33], s[7 * 33]);
        o.z = pg8::pk4_fp8(s[8 * 33], s[9 * 33], s[10 * 33], s[11 * 33]); o.w = pg8::pk4_fp8(s[12 * 33], s[13 * 33], s[14 * 33], s[15 * 33]);
        *(v4u*)(WT + (size_t)(drow0 + n) * K + k0 + 16 * c) = o; }
    LDS_WAIT(); asm volatile("" ::: "memory");
}
constexpr float W8_SCALE = 32.0f, W8_INV = 1.0f / 32.0f;
__device__ __forceinline__ void convert_job_f8(Frame& F, const float* W, int K, int N, unsigned char* WT, int mode, int wg0 = 0, int nwg = 0) {
    LAS float* scr = (LAS float*)(F.lds + F.wave * 16384);
    const int gw = (F.bid - wg0) * 8 + F.wave, NGW = (nwg ? nwg : F.G) * 8, nblk = N / 32, nit = (K / 64) * nblk;
    for (int it = gw; it < nit; it += NGW) { const int kb = it / nblk, nb = it % nblk, n0 = nb * 32;
        int drow0 = n0;
        if (mode == 1 || mode == 2) drow0 = (n0 >> 7) * 256 + (n0 & 127) + (mode == 2 ? 128 : 0);
        transpose_item_f8(W, K, N, WT, drow0, kb * 64, n0, scr, F.lane, W8_SCALE); }
}
__device__ __forceinline__ void ph_convert_moe(Frame& F, int i, int wg0, int nwg, int e0 = 0, int e1 = NE) {
    unsigned char* W2 = WSG + WS_W2;
    for (int e = e0; e < e1; ++e) {
        convert_job_f8(F, INP(35) + ((size_t)i * NE + e) * D * DFF, D, DFF, W2 + W2_MGU + (size_t)e * 7168 * 1024, 1, wg0, nwg);
        convert_job_f8(F, INP(36) + ((size_t)i * NE + e) * D * DFF, D, DFF, W2 + W2_MGU + (size_t)e * 7168 * 1024, 2, wg0, nwg);
        convert_job_f8(F, INP(37) + ((size_t)i * NE + e) * DFF * D, DFF, D, W2 + W2_MDN + (size_t)e * 1024 * 3584, 0, wg0, nwg);
    }
}
__device__ __forceinline__ void ph_convert(Frame& F, int l) {
    const int i = l >> 1; bf16* Wb = FWB;
    if ((l & 1) == 0) {
        convert_job(F, INP(7) + (size_t)i * D * EV_IN, D, EV_IN, Wb + W_IN / 2, 3);
        convert_job(F, INP(15) + (size_t)i * D * D, D, D, Wb + W_OUT / 2, 0);
        convert_job_f8(F, INP(16) + (size_t)i * D * DFF, D, DFF, (unsigned char*)Wb + W_GU, 1);
        convert_job_f8(F, INP(17) + (size_t)i * D * DFF, D, DFF, (unsigned char*)Wb + W_GU, 2);
        convert_job_f8(F, INP(18) + (size_t)i * DFF * D, DFF, D, (unsigned char*)Wb + W_DN, 0);
    } else {
        convert_job(F, INP(19) + (size_t)i * D * OD_IN, D, OD_IN, Wb + W_IN / 2, 4);
        convert_job(F, INP(32) + (size_t)i * D * D, D, D, Wb + W_OUT / 2, 0);
        convert_job(F, INP(28) + (size_t)i * 256 * 256, 256, 256, Wb + W_GLU / 2, 0);
    }
}

struct NormArgs {
    int xin_input, has_y, two, write_x, final_, do_h, do_route, h8;
    const float* gate; const float* gy;
    const float* gh; const float* shift; const float* scale;
    const float* rw; const float* rb;
};
__device__ __forceinline__ void ph_norm(Frame& F, const NormArgs& a) {
    LAS float* RWT = (LAS float*)F.lds;
    LAS int* cnt = (LAS int*)(F.lds + 32768);
    if (a.do_route) {
        for (int idx = F.tid; idx < 8192; idx += 512) RWT[(idx & 7) * 1024 + (idx >> 3)] = a.rw[idx];
        if (F.tid < 8) cnt[F.tid] = 0;
        __syncthreads();
    }
    const int r0 = (int)((long)M * F.bid / F.G), r1 = (int)((long)M * (F.bid + 1) / F.G);
    const bf16* Y0 = (const bf16*)FYB; const bf16* Y1 = (const bf16*)(FYB + Y_SLOT);
    const int c0 = 4 * F.lane;
    f32x4 pgy[4], pgh[4], pgt[4], psh[4], psc[4]; int cur_midx = -1;
#pragma unroll
    for (int j = 0; j < 4; ++j) { pgy[j] = a.has_y ? *(const f32x4*)(a.gy + c0 + 256 * j) : (f32x4){0.f, 0.f, 0.f, 0.f}; pgh[j] = a.do_h ? *(const f32x4*)(a.gh + c0 + 256 * j) : (f32x4){0.f, 0.f, 0.f, 0.f};
        pgt[j] = (f32x4){0.f, 0.f, 0.f, 0.f}; psh[j] = pgt[j]; psc[j] = pgt[j]; }
    f32x4 xn[4]; v2u xb[4], yn[4], zn[4];
#pragma unroll
    for (int j = 0; j < 4; ++j) { xn[j] = (f32x4){0.f, 0.f, 0.f, 0.f}; xb[j] = (v2u){0u, 0u}; yn[j] = (v2u){0u, 0u}; zn[j] = (v2u){0u, 0u}; }
#define NORM_LOAD(mm) do { const int b_ = (mm) / TB, t_ = (mm) - b_ * TB; const bool ic_ = t_ < CTXL; \
        if (a.xin_input) { const float* xi_ = ic_ ? (INP(2) + (size_t)(b_ * CTXL + t_) * D) : (INP(0) + (size_t)(b_ * SEQ + t_ - CTXL) * D); \
            _Pragma("unroll") for (int j = 0; j < 4; ++j) xn[j] = *(const f32x4*)(xi_ + c0 + 256 * j); } \
        else { _Pragma("unroll") for (int j = 0; j < 4; ++j) xb[j] = *(const v2u*)(FX + (size_t)(mm) * D + c0 + 256 * j); } \
        _Pragma("unroll") for (int j = 0; j < 4; ++j) { \
            if (a.has_y) yn[j] = *(const v2u*)(Y0 + (size_t)(mm) * D + c0 + 256 * j); if (a.two) zn[j] = *(const v2u*)(Y1 + (size_t)(mm) * D + c0 + 256 * j); } } while (0)
    int m = r0 + F.wave;
    if (m < r1) NORM_LOAD(m);
    for (; m < r1; m += 8) {
        const int b = m / TB, t = m - b * TB; const bool isctx = t < CTXL; const int midx = isctx ? 8 : b;
        f32x4 x[4]; v2u yv[4], zv[4];
#pragma unroll
        for (int j = 0; j < 4; ++j) { x[j] = a.xin_input ? xn[j] : (f32x4){bflo(xb[j].x), bfhi(xb[j].x), bflo(xb[j].y), bfhi(xb[j].y)}; yv[j] = yn[j]; zv[j] = zn[j]; }
        if (m + 8 < r1) NORM_LOAD(m + 8);
        if (midx != cur_midx) { cur_midx = midx;
#pragma unroll
            for (int j = 0; j < 4; ++j) { if (a.has_y) pgt[j] = *(const f32x4*)(a.gate + (size_t)midx * 6144 + c0 + 256 * j);
                if (a.do_h) { psh[j] = *(const f32x4*)(a.shift + (size_t)midx * 6144 + c0 + 256 * j); psc[j] = *(const f32x4*)(a.scale + (size_t)midx * 6144 + c0 + 256 * j); } } }
        if (a.has_y) {
            f32x4 y[4]; float ss = 0.f;
#pragma unroll
            for (int j = 0; j < 4; ++j) { y[j] = (f32x4){bflo(yv[j].x), bfhi(yv[j].x), bflo(yv[j].y), bfhi(yv[j].y)};
                if (a.two) y[j] += (f32x4){bflo(zv[j].x), bfhi(zv[j].x), bflo(zv[j].y), bfhi(zv[j].y)};
                ss += (y[j].x * y[j].x + y[j].y * y[j].y) + (y[j].z * y[j].z + y[j].w * y[j].w); }
            const float rs = 1.0f / sqrtf(wave_sum(ss) * (1.0f / D) + EPS);
#pragma unroll
            for (int j = 0; j < 4; ++j) x[j] += pgt[j] * (y[j] * rs * pgy[j]);
        }
        if (a.final_) { if (!isctx) { float* o_ = OUTP + (size_t)(b * SEQ + t - CTXL) * D;
#pragma unroll
            for (int j = 0; j < 4; ++j) *(f32x4*)(o_ + c0 + 256 * j) = x[j]; } }
        else if (a.write_x) {
#pragma unroll
            for (int j = 0; j < 4; ++j) { v2u w_; w_.x = cvt_pk_bf16(x[j].x, x[j].y); w_.y = cvt_pk_bf16(x[j].z, x[j].w); *(v2u*)(FX + (size_t)m * D + c0 + 256 * j) = w_; }
        }
        if (a.do_h) {
            float ss = 0.f;
#pragma unroll
            for (int j = 0; j < 4; ++j) ss += (x[j].x * x[j].x + x[j].y * x[j].y) + (x[j].z * x[j].z + x[j].w * x[j].w);
            const float rs = 1.0f / sqrtf(wave_sum(ss) * (1.0f / D) + EPS);
            f32x4 h[4];
#pragma unroll
            for (int j = 0; j < 4; ++j) { h[j] = (x[j] * rs * pgh[j]) * (psc[j] + 1.0f) + psh[j];
                if (a.h8) *(unsigned*)((unsigned char*)FH + (size_t)m * D + c0 + 256 * j) = pg8::pk4_fp8(h[j].x, h[j].y, h[j].z, h[j].w);
                else { v2u w; w.x = cvt_pk_bf16(h[j].x, h[j].y); w.y = cvt_pk_bf16(h[j].z, h[j].w); *(v2u*)(FH + (size_t)m * D + c0 + 256 * j) = w; } }
            if (a.do_route) {
                float lg[8];
#pragma unroll
                for (int e = 0; e < 8; ++e) { float s = 0.f;
#pragma unroll
                    for (int j = 0; j < 4; ++j) { const f32x4 w = *(const LAS f32x4*)(RWT + e * 1024 + c0 + 256 * j); s += (h[j].x * w.x + h[j].y * w.y) + (h[j].z * w.z + h[j].w * w.w); }
                    lg[e] = wave_sum(s) + a.rb[e]; }
                int e1 = 0; float v1 = lg[0];
#pragma unroll
                for (int e = 1; e < 8; ++e) if (lg[e] > v1) { v1 = lg[e]; e1 = e; }
                int e2 = -1; float v2 = -3.0e38f;
#pragma unroll
                for (int e = 0; e < 8; ++e) if (e != e1 && lg[e] > v2) { v2 = lg[e]; e2 = e; }
                const float p1 = 1.0f / (1.0f + expf(v2 - v1));
                if (F.lane == 0) { RouteRow rr; rr.e1 = e1; rr.e2 = e2; rr.p1 = p1; rr.p2 = 1.0f - p1; ((RouteRow*)(WSG + WS_ROUTE))[m] = rr;
                    atomicAdd((int*)&cnt[e1], 1); atomicAdd((int*)&cnt[e2], 1); }
            }
        }
    }
#undef NORM_LOAD
    if (a.do_route) { __syncthreads(); if (F.tid < 8) ((int*)(WSG + WS_WGCNT))[F.bid * 8 + F.tid] = cnt[F.tid]; }
}

__device__ __forceinline__ void ph_assign(Frame& F) {
    LAS int* part = (LAS int*)F.lds;
    LAS int* tot = (LAS int*)(F.lds + 32768);
    const int* WC = (const int*)(WSG + WS_WGCNT);
    int st[8], sb[8];
#pragma unroll
    for (int e = 0; e < 8; ++e) { st[e] = 0; sb[e] = 0; }
    for (int w = F.tid; w < F.G; w += 512) {
#pragma unroll
        for (int e = 0; e < 8; ++e) { const int c = WC[w * 8 + e]; st[e] += c; if (w < F.bid) sb[e] += c; } }
    if (F.tid < 32) tot[F.tid] = 0;
    __syncthreads();
#pragma unroll
    for (int e = 0; e < 8; ++e) { if (st[e]) atomicAdd((int*)&tot[e], st[e]); if (sb[e]) atomicAdd((int*)&tot[8 + e], sb[e]); }
    __syncthreads();
    if (F.tid == 0) { int o = 0; for (int e = 0; e < 8; ++e) { tot[16 + e] = o; o += (tot[e] + 255) & ~255; }
        if (F.bid == 0) { int* PE = (int*)(WSG + WS_PEXP); int p = 0; for (int e = 0; e < 8; ++e) { const int np = (tot[e] + 255) >> 8; for (int q = 0; q < np; ++q) PE[p++] = e; } PE[MAXP] = p; } }
    __syncthreads();
    RouteEnt* L = (RouteEnt*)(WSG + WS_LIST);
    if (F.bid == 0) {
        for (int e = 0; e < 8; ++e) { const int lo = tot[16 + e] + tot[e], hi = tot[16 + e] + ((tot[e] + 255) & ~255);
            for (int p = lo + F.tid; p < hi; p += 512) { RouteEnt z; z.tok = -1; z.slot = 0; z.w = 0.f; z.pad = 0; L[p] = z; } }
    }
    const RouteRow* RR = (const RouteRow*)(WSG + WS_ROUTE);
    const int r0 = (int)((long)M * F.bid / F.G), r1 = (int)((long)M * (F.bid + 1) / F.G);
    for (int m = r0 + F.tid; m < r1; m += 512) { const RouteRow rr = RR[m];
        { const int p = tot[16 + rr.e1] + tot[8 + rr.e1] + atomicAdd((int*)&tot[24 + rr.e1], 1); RouteEnt z; z.tok = m; z.slot = 0; z.w = rr.p1; z.pad = 0; L[p] = z; }
        { const int p = tot[16 + rr.e2] + tot[8 + rr.e2] + atomicAdd((int*)&tot[24 + rr.e2], 1); RouteEnt z; z.tok = m; z.slot = 1; z.w = rr.p2; z.pad = 0; L[p] = z; } }
}
__device__ __forceinline__ void ph_gather(Frame& F, int p0, int p1) {
    const RouteEnt* L = (const RouteEnt*)(WSG + WS_LIST); unsigned char* HG = FBIG + BIG_HG; const unsigned char* H8 = (const unsigned char*)FH;
    const int gw = F.bid * 8 + F.wave, NGW = F.G * 8, n = (p1 - p0) * 256;
    const int nit = gw < n ? (n - gw + NGW - 1) / NGW : 0;
    int mytok = -1; { const int rr = gw + F.lane * NGW; if (rr < n) mytok = L[(size_t)p0 * 256 + rr].tok; }
    for (int it = 0; it < nit; it += 4) { v4u a[4]; int tk[4];
#pragma unroll
        for (int u = 0; u < 4; ++u) { tk[u] = (it + u < nit) ? __builtin_amdgcn_readlane(mytok, it + u) : -2; a[u] = (v4u){0u, 0u, 0u, 0u}; }
#pragma unroll
        for (int u = 0; u < 4; ++u) if (tk[u] >= 0) a[u] = ((const v4u*)(H8 + (size_t)tk[u] * D))[F.lane];
#pragma unroll
        for (int u = 0; u < 4; ++u) if (tk[u] != -2) ((v4u*)(HG + (size_t)(gw + (it + u) * NGW) * D))[F.lane] = a[u]; }
}
__device__ __forceinline__ void rope8(v4u& a, v4u& b, const float* cs, float sc) {
    unsigned* pa = (unsigned*)&a; unsigned* pb = (unsigned*)&b;
#pragma unroll
    for (int k = 0; k < 4; ++k) {
        float x1l = bflo(pa[k]), x1h = bfhi(pa[k]), x2l = bflo(pb[k]), x2h = bfhi(pb[k]);
        float c0 = 1.f, s0 = 0.f, c1 = 1.f, s1 = 0.f;
        if (cs) { c0 = cs[4 * k]; s0 = cs[4 * k + 1]; c1 = cs[4 * k + 2]; s1 = cs[4 * k + 3]; }
        const float o1l = (x1l * c0 - x2l * s0) * sc, o2l = (x1l * s0 + x2l * c0) * sc, o1h = (x1h * c1 - x2h * s1) * sc, o2h = (x1h * s1 + x2h * c1) * sc;
        pa[k] = cvt_pk_bf16(o1l, o1h); pb[k] = cvt_pk_bf16(o2l, o2h);
    }
}
__device__ __forceinline__ void ph_rope(Frame& F, int odd) {
    const int gw = F.bid * 8 + F.wave, NGW = F.G * 8;
    bf16* Z = (bf16*)FBIG;
    if (!odd) {
        const float* T = (const float*)(WSG + WS_ROPE_R);
        const int tensor = F.lane >> 5, head = (F.lane >> 3) & 3, d0 = (F.lane & 7) * 8;
        const float sc = tensor ? 0.08838834764831845f : 1.0f;
        for (int m = gw; m < M; m += NGW) { const int t = m % TB;
            bf16* p = Z + (size_t)m * EV_IN + 1024 + tensor * 512 + head * 128 + d0;
            v4u a = *(v4u*)p, b = *(v4u*)(p + 64);
            if (t >= CTXL) { const int tl = t - CTXL, pos = d0 < 32 ? (tl >> 6) : (tl & 63), dq = d0 & 31; rope8(a, b, T + (pos * 32 + dq) * 2, sc); }
            else { if (!tensor) continue; rope8(a, b, nullptr, sc); }
            *(v4u*)p = a; *(v4u*)(p + 64) = b; }
    } else {
        const float* T = (const float*)(WSG + WS_ROPE_D);
        for (int m = gw; m < M; m += NGW) { const int t = m % TB; if (t < CTXL) continue;
            const int tl = t - CTXL;
            for (int it = F.lane; it < 96; it += 64) { const int tensor = it / 48, r = it % 48, hm = r >> 2, d0 = (r & 3) * 8;
                bf16* p = Z + (size_t)m * OD_IN + 256 + tensor * 768 + hm * 64 + d0;
                v4u a = *(v4u*)p, b = *(v4u*)(p + 32);
                const int pos = d0 < 16 ? (tl >> 6) : (tl & 63), dq = d0 & 15; rope8(a, b, T + (pos * 16 + dq) * 2, 1.0f);
                *(v4u*)p = a; *(v4u*)(p + 32) = b; } }
    }
}
__device__ __forceinline__ void unpack8(const v4u& w, float* f) { f[0] = bflo(w.x); f[1] = bfhi(w.x); f[2] = bflo(w.y); f[3] = bfhi(w.y); f[4] = bflo(w.z); f[5] = bfhi(w.z); f[6] = bflo(w.w); f[7] = bfhi(w.w); }
__device__ __forceinline__ v4u pack8(const float* f) { v4u w; w.x = cvt_pk_bf16(f[0], f[1]); w.y = cvt_pk_bf16(f[2], f[3]); w.z = cvt_pk_bf16(f[4], f[5]); w.w = cvt_pk_bf16(f[6], f[7]); return w; }
__device__ __forceinline__ void ph_merge_even(Frame& F, int i) {
    const int gw = F.bid * 8 + F.wave, NGW = F.G * 8;
    const bf16* Z = (const bf16*)FBIG; const bf16* HF = (const bf16*)FYB; const bf16* HB = (const bf16*)(FYB + T_HALF);
    const bf16* RF = (const bf16*)(FYB + 2 * T_HALF); const bf16* RB = (const bf16*)(FYB + 3 * T_HALF);
    const float* gn = INP(14) + (size_t)i * 512; const int c0 = 8 * F.lane;
    float gnv[8];
#pragma unroll
    for (int k = 0; k < 8; ++k) gnv[k] = gn[c0 + k];
    for (int m = gw; m < M; m += NGW) {
        float a[8], b[8], g[8], o[8];
        unpack8(*(const v4u*)(HF + (size_t)m * 512 + c0), a); unpack8(*(const v4u*)(HB + (size_t)m * 512 + c0), b); unpack8(*(const v4u*)(Z + (size_t)m * EV_IN + 512 + c0), g);
#pragma unroll
        for (int k = 0; k < 8; ++k) o[k] = (a[k] + b[k]) * gelu_tanh(g[k]);
        *(v4u*)(FH + (size_t)m * D + c0) = pack8(o);
        unpack8(*(const v4u*)(RF + (size_t)m * 512 + c0), a); unpack8(*(const v4u*)(RB + (size_t)m * 512 + c0), b); unpack8(*(const v4u*)(Z + (size_t)m * EV_IN + 2560 + c0), g);
        float s = 0.f;
#pragma unroll
        for (int k = 0; k < 8; ++k) { a[k] += b[k]; s += a[k]; }
        s += __shfl_xor(s, 1); s += __shfl_xor(s, 2); s += __shfl_xor(s, 4); s += __shfl_xor(s, 8);
        const float mean = s * (1.0f / 128.0f); float q = 0.f;
#pragma unroll
        for (int k = 0; k < 8; ++k) { a[k] -= mean; q += a[k] * a[k]; }
        q += __shfl_xor(q, 1); q += __shfl_xor(q, 2); q += __shfl_xor(q, 4); q += __shfl_xor(q, 8);
        const float rs = 1.0f / sqrtf(q * (1.0f / 128.0f) + EPS);
#pragma unroll
        for (int k = 0; k < 8; ++k) o[k] = a[k] * rs * gnv[k] * (g[k] * sigmoidf_(g[k]));
        *(v4u*)(FH + (size_t)m * D + 512 + c0) = pack8(o);
    }
}
__device__ __forceinline__ void ph_zpass(Frame& F, int i) {
    const int gw = F.bid * 8 + F.wave, NGW = F.G * 8;
    const bf16* ZI = (const bf16*)FBIG; const bf16* YF = (const bf16*)FYB; const bf16* YB = (const bf16*)(FYB + T_QUART); bf16* ZO = (bf16*)(FYB + 2 * T_QUART);
    const float* dsk = INP(27) + (size_t)i * 256; const int c0 = 4 * F.lane;
    const f32x4 dv = *(const f32x4*)(dsk + c0);
    for (int m = gw; m < M; m += NGW) {
        const v2u a = *(const v2u*)(YF + (size_t)m * 256 + c0), b = *(const v2u*)(YB + (size_t)m * 256 + c0), u = *(const v2u*)(ZI + (size_t)m * OD_IN + c0);
        const float y0 = bflo(a.x) + bflo(b.x) + dv.x * bflo(u.x), y1 = bfhi(a.x) + bfhi(b.x) + dv.y * bfhi(u.x), y2 = bflo(a.y) + bflo(b.y) + dv.z * bflo(u.y), y3 = bfhi(a.y) + bfhi(b.y) + dv.w * bfhi(u.y);
        v2u w; w.x = cvt_pk_bf16(gelu_tanh(y0), gelu_tanh(y1)); w.y = cvt_pk_bf16(gelu_tanh(y2), gelu_tanh(y3));
        *(v2u*)(ZO + (size_t)m * 256 + c0) = w; }
}

constexpr size_t VT_OFF = 128 * MiB, K8_OFF = 180 * MiB;
constexpr size_t Q8_OFF = 332 * MiB;
__device__ __forceinline__ void ph_vt(Frame& F) {
    LAS bf16* T = (LAS bf16*)(F.lds + F.wave * 17408);
    const bf16* Z = (const bf16*)FBIG; unsigned char* VT = FYB + VT_OFF;
    const int gw = F.bid * 8 + F.wave, NGW = F.G * 8, lane = F.lane;
    for (int it = gw; it < NB * 6 * 132; it += NGW) { const int bh = it / 132, t = it % 132, b = bh / 6, h = bh % 6;
        const bf16* src = Z + ((size_t)b * TB + 64 * t) * OD_IN + 1792 + h * 128;
#pragma unroll
        for (int i = 0; i < 16; ++i) { const int row = i * 4 + (lane >> 4), ch = lane & 15; *(LAS v4u*)(T + row * 136 + ch * 8) = *(const v4u*)(src + (size_t)row * OD_IN + ch * 8); }
        LDS_WAIT(); asm volatile("" ::: "memory");
        unsigned char* dst = VT + (size_t)it * 8192;
#pragma unroll
        for (int rr = 0; rr < 2; ++rr) { const int d = lane + 64 * rr;
#pragma unroll
            for (int q = 0; q < 4; ++q) { unsigned w[4];
#pragma unroll
                for (int k = 0; k < 4; ++k) { float v[4];
#pragma unroll
                    for (int e = 0; e < 4; ++e) { const int beta = q * 16 + k * 4 + e, i2 = beta & 31, hh = beta >> 5, key = ((i2 & 15) & 3) + 8 * ((i2 & 15) >> 2) + 4 * hh + 32 * (i2 >> 4); v[e] = bf2f(T[key * 136 + d]); }
                    w[k] = pg8::pk4_fp8(v[0], v[1], v[2], v[3]); }
                *(v4u*)(dst + d * 64 + q * 16) = (v4u){w[0], w[1], w[2], w[3]}; } }
        LDS_WAIT(); asm volatile("" ::: "memory");
    }
}
__device__ __forceinline__ int chunk_tlo(int dir, int c) { return dir == 0 ? 128 * c : (c < 2 ? 128 * (1 - c) : 8576 - 128 * c); }

__device__ __forceinline__ void lru_item(Frame& F, int i, int b, int dir, int blk) {
    LAS unsigned char* lds = F.lds;
    LAS float* UR = (LAS float*)(lds);
    LAS float* AA = (LAS float*)(lds + 98304);
    LAS float* U = (LAS float*)(lds + 36864);
    LAS float* BB = U;
    LAS bf16* UB = (LAS bf16*)(lds + 69632);
    LAS float* SEG = (LAS float*)(lds + 88064);
    LAS float* PRM = (LAS float*)(lds + 92160);
    const int tid = F.tid, lane = F.lane, wave = F.wave, ch = tid & 63, seg = tid >> 6;
    const bf16* Z = (const bf16*)FBIG; bf16* OUT = (bf16*)(FYB + (size_t)dir * T_HALF);
    const float* conv_w = INP(8) + (size_t)i * 4 * 512; const float* conv_b = INP(9) + (size_t)i * 512;
    const float* gate_w = INP(10) + (((size_t)i * 2 + dir) * 2) * 8 * 64 * 64;
    const float* gate_b = INP(11) + (((size_t)i * 2 + dir) * 2) * 512;
    const float* lam = INP(12) + ((size_t)i * 2 + dir) * 512;
    __syncthreads();
    if (tid < 64) { const int cg = blk * 64 + tid;
        PRM[0 * 64 + tid] = conv_w[0 * 512 + cg]; PRM[1 * 64 + tid] = conv_w[1 * 512 + cg]; PRM[2 * 64 + tid] = conv_w[2 * 512 + cg]; PRM[3 * 64 + tid] = conv_w[3 * 512 + cg];
        PRM[4 * 64 + tid] = conv_b[cg]; const float lm = lam[cg]; PRM[5 * 64 + tid] = (-lm > 20.f) ? -lm : log1pf(expf(-lm));
        PRM[6 * 64 + tid] = gate_b[cg]; PRM[7 * 64 + tid] = gate_b[512 + cg]; }
    const int fr = lane & 15, fq = lane >> 4;
    bf16x8 wf[8][2];
#pragma unroll
    for (int nt = 0; nt < 8; ++nt)
#pragma unroll
        for (int ks = 0; ks < 2; ++ks) { const int col = 16 * nt + fr, gate = col >> 6, j = col & 63; const float* wp = gate_w + (((size_t)gate * 8 + blk) * 64 + (32 * ks + 8 * fq)) * 64 + j;
            v4u w; w.x = cvt_pk_bf16(wp[0], wp[64]); w.y = cvt_pk_bf16(wp[128], wp[192]); w.z = cvt_pk_bf16(wp[256], wp[320]); w.w = cvt_pk_bf16(wp[384], wp[448]);
            wf[nt][ks] = __builtin_bit_cast(bf16x8, w); }
    float carry = 0.f;
    const size_t rowbase = (size_t)b * TB;
    v4u pre[3];
#define LRU_LOAD(c_) do { const int tl_ = chunk_tlo(dir, (c_)), lo_ = tl_ < CTXL ? 0 : CTXL, hi_ = tl_ < CTXL ? CTXL : TB; \
        _Pragma("unroll") for (int n_ = 0; n_ < 3; ++n_) { const int it_ = tid + 512 * n_, r_ = it_ >> 3, cc_ = it_ & 7, t_ = tl_ - 2 + r_; \
            pre[n_] = (it_ < 131 * 8 && t_ >= lo_ && t_ < hi_) ? *(const v4u*)(Z + (rowbase + t_) * EV_IN + blk * 64 + cc_ * 8) : (v4u){0u, 0u, 0u, 0u}; } } while (0)
    LRU_LOAD(0);
    __syncthreads();
    for (int c = 0; c < 66; ++c) {
        const int t_lo = chunk_tlo(dir, c);
#pragma unroll
        for (int n = 0; n < 3; ++n) { const int it = tid + 512 * n; if (it < 131 * 8) { const int r = it >> 3, cc = it & 7; float f[8]; unpack8(pre[n], f);
            *(LAS f32x4*)(UR + r * 64 + cc * 8) = (f32x4){f[0], f[1], f[2], f[3]}; *(LAS f32x4*)(UR + r * 64 + cc * 8 + 4) = (f32x4){f[4], f[5], f[6], f[7]}; } }
        if (c + 1 < 66) LRU_LOAD(c + 1);
        __syncthreads();
        { const float w0 = PRM[ch], w1 = PRM[64 + ch], w2 = PRM[128 + ch], w3 = PRM[192 + ch], cb = PRM[256 + ch];
#pragma unroll 4
          for (int k = 0; k < 16; ++k) { const int r = seg * 16 + k; const float u = cb + w0 * UR[r * 64 + ch] + w1 * UR[(r + 1) * 64 + ch] + w2 * UR[(r + 2) * 64 + ch] + w3 * UR[(r + 3) * 64 + ch];
              U[r * 64 + ch] = u; UB[r * 72 + ch] = (bf16)(cvt_pk_bf16(u, 0.f) & 0xffffu); } }
        asm volatile("s_waitcnt lgkmcnt(0)" ::: "memory");
        { f32x4 acc[8];
#pragma unroll
          for (int nt = 0; nt < 8; ++nt) acc[nt] = (f32x4){0.f, 0.f, 0.f, 0.f};
          const bf16x8 a0 = *(const LAS bf16x8*)(UB + (16 * wave + fr) * 72 + 8 * fq), a1 = *(const LAS bf16x8*)(UB + (16 * wave + fr) * 72 + 32 + 8 * fq);
#pragma unroll
          for (int nt = 0; nt < 8; ++nt) { acc[nt] = __builtin_amdgcn_mfma_f32_16x16x32_bf16(a0, wf[nt][0], acc[nt], 0, 0, 0); acc[nt] = __builtin_amdgcn_mfma_f32_16x16x32_bf16(a1, wf[nt][1], acc[nt], 0, 0, 0); }
#pragma unroll
          for (int nt = 0; nt < 4; ++nt) { const int cch = 16 * nt + fr; const float br = PRM[6 * 64 + cch], bi = PRM[7 * 64 + cch], sp = PRM[5 * 64 + cch];
#pragma unroll
              for (int rg = 0; rg < 4; ++rg) { const int r = 16 * wave + 4 * fq + rg; const float rgate = sigmoidf_(acc[nt][rg] + br), igate = sigmoidf_(acc[nt + 4][rg] + bi);
                  const float la = -8.0f * rgate * sp, av = __builtin_amdgcn_exp2f(1.4426950408889634f * la), x2 = 2.0f * la;
                  const float om = (x2 > -0.25f) ? (-x2 * (1.0f + x2 * (0.5f + x2 * (0.16666667f + x2 * (0.041666668f + x2 * 0.0083333338f))))) : (1.0f - av * av);
                  const float bv = __builtin_amdgcn_sqrtf(om) * (igate * U[r * 64 + cch]);
                  AA[r * 64 + cch] = av; BB[r * 64 + cch] = bv; } } }
        __syncthreads();
        float hl[16], ca[16];
        { float h = 0.f, p = 1.f;
#pragma unroll
          for (int k = 0; k < 16; ++k) { const int ip = seg * 16 + k, r = dir == 0 ? ip : 127 - ip; const float av = AA[r * 64 + ch], bv = BB[r * 64 + ch]; h = av * h + bv; p *= av; hl[k] = h; ca[k] = p; }
          SEG[seg * 64 + ch] = p; SEG[512 + seg * 64 + ch] = h; }
        __syncthreads();
        float hin = carry, myin = 0.f;
#pragma unroll
        for (int s = 0; s < 8; ++s) { if (s == seg) myin = hin; hin = SEG[s * 64 + ch] * hin + SEG[512 + s * 64 + ch]; }
        carry = hin;
#pragma unroll
        for (int k = 0; k < 16; ++k) { const int ip = seg * 16 + k, r = dir == 0 ? ip : 127 - ip; const float h = hl[k] + ca[k] * myin;
            OUT[(rowbase + t_lo + r) * 512 + blk * 64 + ch] = (bf16)(cvt_pk_bf16(h, 0.f) & 0xffffu); }
    }
#undef LRU_LOAD
}
__device__ __forceinline__ unsigned off_b(unsigned row, unsigned ch) { return 256u * row + 16u * (ch ^ (((row & 3) << 2) | ((row >> 2) & 3))); }
__device__ __forceinline__ unsigned row_read_addr(unsigned lane, unsigned rb, unsigned s) { return off_b(32 * rb + (lane & 31), 2 * s + (lane >> 5)); }
__device__ __forceinline__ unsigned tr_read_addr(unsigned lane, unsigned c, unsigned ks, unsigned t) {
    const unsigned h = lane >> 5, blk = (lane >> 4) & 1, q = (lane & 15) >> 2, p = lane & 3;
    return off_b(16 * ks + 8 * h + 4 * t + q, 4 * c + 2 * blk + (p >> 1)) + 8 * (p & 1);
}
typedef short v4i16_t __attribute__((ext_vector_type(4)));
__device__ __forceinline__ bf16x8 tr_frag(LAS unsigned char* tile, unsigned lane, unsigned c, unsigned ks) {
    const s16x4 lo = __builtin_bit_cast(s16x4, __builtin_amdgcn_ds_read_tr16_b64_v4i16((LAS v4i16_t*)(tile + tr_read_addr(lane, c, ks, 0))));
    const s16x4 hi = __builtin_bit_cast(s16x4, __builtin_amdgcn_ds_read_tr16_b64_v4i16((LAS v4i16_t*)(tile + tr_read_addr(lane, c, ks, 1))));
    return (bf16x8){lo[0], lo[1], lo[2], lo[3], hi[0], hi[1], hi[2], hi[3]};
}
__device__ __forceinline__ bf16x8 row_frag(LAS unsigned char* tile, unsigned lane, unsigned rb, unsigned s) { return *(const LAS bf16x8*)(tile + row_read_addr(lane, rb, s)); }
#define MFMA32(a, b, c) __builtin_amdgcn_mfma_f32_32x32x16_bf16((a), (b), (c), 0, 0, 0)

constexpr unsigned RT_KB = 0, RT_T2 = 32768, RT_QB = 65536, RT_VB = 98304;
__device__ __forceinline__ s16x4 ds_tr(LAS unsigned char* p) { return __builtin_bit_cast(s16x4, __builtin_amdgcn_ds_read_tr16_b64_v4i16((LAS v4i16_t*)p)); }
#define TRF(base0, base1, off) ({ const s16x4 lo_ = ds_tr(F.lds + (base0) + (off)), hi_ = ds_tr(F.lds + (base1) + (off)); (bf16x8){lo_[0], lo_[1], lo_[2], lo_[3], hi_[0], hi_[1], hi_[2], hi_[3]}; })
#define RWF(base, off) (*(const LAS bf16x8*)(F.lds + (base) + (off)))
__device__ __forceinline__ void ret_item(Frame& F, int li, int b, int head, int dir, int z) {
    const int tid = F.tid, lane = F.lane, wave = F.wave, ib = wave & 3, xw = wave >> 2, eb = 2 * z + xw, r = lane & 31, h = lane >> 5;
    const bf16* Z = (const bf16*)FBIG; bf16* OUT = (bf16*)(FYB + (size_t)(2 + dir) * T_HALF);
    const float theta = INP(13)[((size_t)li * 2 + dir) * 4 + head];
    const float log_g = -((-theta > 20.f) ? -theta : log1pf(expf(-theta)));
    const float g1 = expf(log_g), g127 = expf(127.0f * log_g);
    const size_t rowbase = (size_t)b * TB;
    unsigned xsI[8], xsT[8], xsJ[8];
    { const unsigned swz = ((r & 3) << 2) | ((r >> 2) & 3);
#pragma unroll
      for (int s = 0; s < 8; ++s) { const unsigned x = 256u * r + 16u * ((unsigned)(2 * s + h) ^ swz); xsI[s] = x + 8192u * ib + RT_QB; xsT[s] = x + 8192u * eb; xsJ[s] = x + 16384u * xw; } }
    const unsigned tK0 = RT_KB + tr_read_addr(lane, ib, 0, 0), tK1 = RT_KB + tr_read_addr(lane, ib, 0, 1);
    const unsigned tV0 = RT_VB + tr_read_addr(lane, eb, 0, 0), tV1 = RT_VB + tr_read_addr(lane, eb, 0, 1);
    __syncthreads();
    for (int it = tid; it < 2048; it += 512) *(LAS v4u*)(F.lds + RT_T2 + it * 16) = (v4u){0u, 0u, 0u, 0u};
    f32x16 SA = f32x16{};
    v4u pq[4], pk[4], pv[2];
#define RET_LOAD(c_) do { const int tl_ = chunk_tlo(dir, (c_)); _Pragma("unroll") for (int n_ = 0; n_ < 4; ++n_) { const int it_ = tid + 512 * n_, row_ = it_ >> 4, cn_ = it_ & 15; \
        const bf16* p_ = Z + (rowbase + tl_ + (dir == 0 ? row_ : 127 - row_)) * EV_IN + 1024 + head * 128 + cn_ * 8; pq[n_] = *(const v4u*)p_; pk[n_] = *(const v4u*)(p_ + 512); } \
        _Pragma("unroll") for (int n_ = 0; n_ < 2; ++n_) { const int it_ = tid + 512 * n_, row_ = it_ >> 3, cn_ = 8 * z + (it_ & 7); \
        pv[n_] = *(const v4u*)(Z + (rowbase + tl_ + (dir == 0 ? row_ : 127 - row_)) * EV_IN + 2048 + head * 128 + cn_ * 8); } } while (0)
    RET_LOAD(0);
#pragma nounroll
    for (int c = 0; c < 66; ++c) {
        const int t_lo = chunk_tlo(dir, c);
        __syncthreads();
#pragma unroll
        for (int n = 0; n < 4; ++n) { const int it = tid + 512 * n, row = it >> 4, cn = it & 15; const float sc = __builtin_amdgcn_exp2f(-(float)row * (log_g * 1.4426950408889634f)); const unsigned wo = off_b(row, cn);
            float f[8]; unpack8(pk[n], f);
#pragma unroll
            for (int k = 0; k < 8; ++k) f[k] *= sc;
            *(LAS v4u*)(F.lds + RT_QB + wo) = pq[n]; *(LAS v4u*)(F.lds + RT_KB + wo) = pack8(f); }
#pragma unroll
        for (int n = 0; n < 2; ++n) { const int it = tid + 512 * n, row = it >> 3, cn = 8 * z + (it & 7); *(LAS v4u*)(F.lds + RT_VB + off_b(row, cn)) = pv[n]; }
        if (c + 1 < 66) RET_LOAD(c + 1);
        __syncthreads();
        f32x16 OT = f32x16{}, ST[2]; ST[0] = f32x16{}; ST[1] = f32x16{};
#pragma unroll
        for (int s = 0; s < 8; ++s) { const bf16x8 qf = RWF(xsI[s], 0);
            OT = MFMA32(RWF(xsT[s], RT_T2), qf, OT);
            if (2 * xw <= ib) ST[0] = MFMA32(RWF(xsJ[s], RT_KB), qf, ST[0]);
            if (2 * xw + 1 <= ib) ST[1] = MFMA32(RWF(xsJ[s], RT_KB + 8192), qf, ST[1]); }
#pragma unroll
        for (int q = 0; q < 16; ++q) SA[q] *= g1;
#pragma unroll
        for (int ks = 0; ks < 8; ++ks) SA = MFMA32(TRF(tK0, tK1, ks * 4096), TRF(tV0, tV1, ks * 4096), SA);
#pragma unroll
        for (int q = 0; q < 16; ++q) SA[q] *= g127;
        __syncthreads();
        const int irow = 32 * ib + r;
#pragma unroll
        for (int y = 0; y < 2; ++y) { const int jb = 2 * xw + y;
#pragma unroll
            for (int gq = 0; gq < 4; ++gq) { const int j0 = 32 * jb + 8 * gq + 4 * h; float p0 = ST[y][4 * gq], p1 = ST[y][4 * gq + 1], p2 = ST[y][4 * gq + 2], p3 = ST[y][4 * gq + 3];
                if (j0 > irow) p0 = 0.f; if (j0 + 1 > irow) p1 = 0.f; if (j0 + 2 > irow) p2 = 0.f; if (j0 + 3 > irow) p3 = 0.f;
                v2u w; w.x = cvt_pk_bf16(p0, p1); w.y = cvt_pk_bf16(p2, p3);
                *(LAS v2u*)(F.lds + RT_QB + off_b(irow, 4 * jb + gq) + 8 * h) = w; } }
        { const int erow = 32 * eb + r;
#pragma unroll
            for (int gq = 0; gq < 4; ++gq) { v2u w; w.x = cvt_pk_bf16(SA[4 * gq] * g1, SA[4 * gq + 1] * g1); w.y = cvt_pk_bf16(SA[4 * gq + 2] * g1, SA[4 * gq + 3] * g1);
                *(LAS v2u*)(F.lds + RT_T2 + off_b(erow, 4 * ib + gq) + 8 * h) = w; } }
        __syncthreads();
#pragma unroll
        for (int s = 0; s < 8; ++s) OT = MFMA32(TRF(tV0, tV1, s * 4096), RWF(xsI[s], 0), OT);
        { const float gi = __builtin_amdgcn_exp2f((float)irow * (log_g * 1.4426950408889634f)); const int t = t_lo + (dir == 0 ? irow : 127 - irow);
          bf16* op = OUT + (rowbase + t) * 512 + head * 128;
#pragma unroll
          for (int gq = 0; gq < 4; ++gq) { v2u w; w.x = cvt_pk_bf16(OT[4 * gq] * gi, OT[4 * gq + 1] * gi); w.y = cvt_pk_bf16(OT[4 * gq + 2] * gi, OT[4 * gq + 3] * gi);
              *(v2u*)(op + 32 * eb + 8 * gq + 4 * h) = w; } }
    }
#undef RET_LOAD
}
#undef TRF
#undef RWF
#if DBG_SCAN
#define DBGCHK(stage, v) do { if (!(fabsf(v) < 1e30f)) atomicMax((unsigned*)(WSG + WS_CTL) + 2049, 100u - (unsigned)(stage)); } while (0)
#else
#define DBGCHK(stage, v) do {} while (0)
#endif
typedef float f32x2 __attribute__((ext_vector_type(2)));
__device__ __forceinline__ f32x2 cmul_add(f32x2 a, f32x2 h, f32x2 c) {
    f32x2 t = (f32x2){a.x, a.x} * h + c; return (f32x2){-a.y, a.y} * (f32x2){h.y, h.x} + t; }
__device__ __forceinline__ void s5_item(Frame& F, int li, int b, int dir, int g) {
    LAS unsigned char* lds = F.lds;
    LAS f32x2* SEG = (LAS f32x2*)(lds + 8192);
    LAS unsigned* HS = (LAS unsigned*)(lds + 12288);
    const int tid = F.tid, lane = F.lane, wave = F.wave, fr = lane & 15, fq = lane >> 4;
    const int j = lane & 31, h = lane >> 5, tb = wave >> 1, sb = wave & 1, p = 32 * sb + j;
    LAS f32x2* QE = (LAS f32x2*)(lds + 49152) + wave * 256;
    const bf16* Z = (const bf16*)FBIG; bf16* OUT = (bf16*)(FYB + (size_t)dir * T_QUART);
    const size_t pb = ((size_t)li * 2 + dir) * 16 + g;
    const float lre = INP(20)[pb * 64 + p], lim = INP(21)[pb * 64 + p], dt = expf(INP(22)[pb]);
    const float x = lre * dt, y = lim * dt, ex = expf(x); float sy, cy; sincosf(y, &sy, &cy);
    const f32x2 a = (f32x2){ex * cy, ex * sy};
    const float sh = sinf(0.5f * y), am1r = expm1f(x) * cy - 2.0f * sh * sh, am1i = a.y;
    const float den = 1.0f / (lre * lre + lim * lim), cr = (am1r * lre + am1i * lim) * den, ci = (am1i * lre - am1r * lim) * den;
    bf16x8 bfre, bfim, bfre2, bfim2;
    { float vr[8], vi[8];
#pragma unroll
      for (int k = 0; k < 8; ++k) { const float br = INP(23)[(pb * 64 + p) * 16 + 8 * h + k], bi = INP(24)[(pb * 64 + p) * 16 + 8 * h + k]; vr[k] = cr * br - ci * bi; vi[k] = cr * bi + ci * br; }
      const v4u pr = pack8(vr), pi = pack8(vi); bfre = __builtin_bit_cast(bf16x8, pr); bfim = __builtin_bit_cast(bf16x8, pi);
      float hr[8], hi_[8]; unpack8(pr, hr); unpack8(pi, hi_);
#pragma unroll
      for (int k = 0; k < 8; ++k) { vr[k] -= hr[k]; vi[k] -= hi_[k]; }
      bfre2 = __builtin_bit_cast(bf16x8, pack8(vr)); bfim2 = __builtin_bit_cast(bf16x8, pack8(vi)); }
    const f32x2 zero2 = (f32x2){0.f, 0.f};
    const f32x2 a2 = cmul_add(a, a, zero2), a3 = cmul_add(a2, a, zero2), a4 = cmul_add(a2, a2, zero2);
    f32x2 a32 = a4;
#pragma unroll
    for (int k = 0; k < 3; ++k) a32 = cmul_add(a32, a32, zero2);
    bf16x8 cf[4];
#pragma unroll
    for (int ks = 0; ks < 4; ++ks) { float v[8];
#pragma unroll
        for (int jj = 0; jj < 8; ++jj) { const int k = 32 * ks + 8 * fq + jj, pp = k >> 1; v[jj] = (k & 1) ? -INP(26)[(pb * 16 + fr) * 64 + pp] : INP(25)[(pb * 16 + fr) * 64 + pp]; }
        cf[ks] = __builtin_bit_cast(bf16x8, pack8(v)); }
    f32x2 hc = zero2;
    const size_t rowbase = (size_t)b * TB;
    v4u pu = (v4u){0u, 0u, 0u, 0u};
#define S5_LOAD(c_) do { const int tl_ = chunk_tlo(dir, (c_)), ip_ = 32 * tb + j; pu = *(const v4u*)(Z + (rowbase + tl_ + (dir == 0 ? ip_ : 127 - ip_)) * OD_IN + g * 16 + 8 * h); } while (0)
    S5_LOAD(0);
    __syncthreads();
    for (int c = 0; c < 66; ++c) {
        const int t_lo = chunk_tlo(dir, c);
        const bf16x8 au = __builtin_bit_cast(bf16x8, pu);
        if (c + 1 < 66) S5_LOAD(c + 1);
        f32x16 Bre = __builtin_amdgcn_mfma_f32_32x32x16_bf16(au, bfre2, f32x16{}, 0, 0, 0), Bim = __builtin_amdgcn_mfma_f32_32x32x16_bf16(au, bfim2, f32x16{}, 0, 0, 0);
        Bre = __builtin_amdgcn_mfma_f32_32x32x16_bf16(au, bfre, Bre, 0, 0, 0); Bim = __builtin_amdgcn_mfma_f32_32x32x16_bf16(au, bfim, Bim, 0, 0, 0);
        f32x2 eq[8];
#pragma unroll
        for (int q = 0; q < 4; ++q) { f32x2 sr = zero2;
#pragma unroll
            for (int e = 0; e < 4; ++e) { sr = cmul_add(a, sr, (f32x2){Bre[4 * q + e], Bim[4 * q + e]}); Bre[4 * q + e] = sr.x; Bim[4 * q + e] = sr.y; }
            QE[(2 * q + h) * 32 + j] = sr; }
        asm volatile("s_waitcnt lgkmcnt(0)" ::: "memory");
#pragma unroll
        for (int Q = 0; Q < 8; ++Q) eq[Q] = QE[Q * 32 + j];
        { f32x2 sq = zero2;
#pragma unroll
          for (int Q = 0; Q < 8; ++Q) sq = cmul_add(a4, sq, eq[Q]);
          if (h == 0) SEG[tb * 64 + p] = sq; }
        __syncthreads();
        f32x2 hin = zero2;
#pragma unroll
        for (int b2 = 0; b2 < 4; ++b2) { if (b2 == tb) hin = hc; hc = cmul_add(a32, hc, SEG[b2 * 64 + p]); }
        { f32x2 tq = hin, ts[4];
#pragma unroll
          for (int Q = 0; Q < 8; ++Q) { if ((Q & 1) == 0) ts[Q >> 1] = tq; else if (h) ts[Q >> 1] = tq;
              tq = cmul_add(a4, tq, eq[Q]); }
#pragma unroll
          for (int q = 0; q < 4; ++q)
#pragma unroll
              for (int e = 0; e < 4; ++e) { const f32x2 pw = e == 0 ? a : (e == 1 ? a2 : (e == 2 ? a3 : a4)); const f32x2 v = cmul_add(pw, ts[q], (f32x2){Bre[4 * q + e], Bim[4 * q + e]});
                  HS[(32 * tb + 8 * q + 4 * h + e) * 68 + p] = cvt_pk_bf16(v.x, v.y); } }
        __syncthreads();
        { pg8::f32x4 acc = (pg8::f32x4){0.f, 0.f, 0.f, 0.f};
#pragma unroll
          for (int ks = 0; ks < 4; ++ks) { const bf16x8 af = *(const LAS bf16x8*)(HS + (16 * wave + fr) * 68 + 16 * ks + 4 * fq); acc = __builtin_amdgcn_mfma_f32_16x16x32_bf16(cf[ks], af, acc, 0, 0, 0); }
          const int ip = 16 * wave + fr, t = t_lo + (dir == 0 ? ip : 127 - ip);
          v2u w; w.x = cvt_pk_bf16(acc[0], acc[1]); w.y = cvt_pk_bf16(acc[2], acc[3]);
          *(v2u*)(OUT + (rowbase + t) * 256 + g * 16 + 4 * fq) = w; }
    }
#undef S5_LOAD
}
namespace att {
constexpr int KVBLK = 64, LD = OD_IN;
#define SBAR() __builtin_amdgcn_sched_barrier(0)
__device__ __forceinline__ int crow(int r, int hi) { return (r & 3) + 8 * (r >> 2) + 4 * hi; }
constexpr float THRL = 5.0f, POFF = 3.0f;
constexpr float KP0 = 8.0f * (POFF + 7.0f) - 0.094f, LIM8 = KP0 + 8.0f * THRL;
#define MX3(a, b, c) __builtin_fmaxf(__builtin_fmaxf((a), (b)), (c))
typedef int v8i_a __attribute__((ext_vector_type(8)));
typedef int v4i_a __attribute__((ext_vector_type(4)));
typedef float f32x4_a __attribute__((ext_vector_type(4)));
typedef __attribute__((address_space(3))) v4i_a lds_v4i;
#define LDSV(a_) (*(const lds_v4i*)(a_))
#define CAT8(x_, y_) __builtin_shufflevector((x_), (y_), 0, 1, 2, 3, 4, 5, 6, 7)
#define QKMF(x_, y_, c_) __builtin_amdgcn_mfma_scale_f32_32x32x64_f8f6f4(CAT8(x_, y_), qf, (c_), 0, 0, 0, 0x7f7f7f7f, 0, 0x80808080)
#define PVMF(pf_, acc_, x_, y_) __builtin_amdgcn_mfma_scale_f32_32x32x64_f8f6f4(pf_, CAT8(x_, y_), (acc_), 0, 0, 0, 0x7f7f7f7f, 0, 0x7f7f7f7f)
#define EXPB1(P_, r_, w_) w_ = (int)__builtin_amdgcn_cvt_pk_u8_f32(P_[r_], (r_) & 3, (unsigned)w_)
#define EXPW(P_, q_, W_, wi_) do { int w_; asm volatile("" : "=v"(w_)); EXPB1(P_, 4 * (q_), w_); EXPB1(P_, 4 * (q_) + 1, w_); EXPB1(P_, 4 * (q_) + 2, w_); EXPB1(P_, 4 * (q_) + 3, w_); asm volatile("" : "+v"(w_)); W_[wi_] = w_; } while (0)
#define EXPS(P_, h_, W_, w0_) do { EXPW(P_, 2 * (h_), W_, (w0_) + 2 * (h_)); EXPW(P_, 2 * (h_) + 1, W_, (w0_) + 2 * (h_) + 1); } while (0)
template <int MAP> __device__ __forceinline__ void unit(const unsigned char* q8, size_t row0, int qcol, const unsigned char* k8, size_t krow0, const unsigned char* vtb, unsigned vtoff, bf16* __restrict__ Ob, int seq, char* lds,
                                     float lam, float gsc, const float* __restrict__ gn, const int tid) {
  const int wid = __builtin_amdgcn_readfirstlane(tid >> 6), lane = tid & 63, r32 = lane & 31, hi = lane >> 5, wq = wid & 3; constexpr int map = MAP;
  constexpr int SLOT = 16384, VOFF = 8192;
  float* ws = (float*)(lds + 8 * SLOT) + wid * 64; float* al_l = ws + 32;
  f32x16 o[4] = {}; f32x4_a lacc = {};
  v8i_a qf;
  { const v4i_a* qp = (const v4i_a*)(q8 + (row0 + wq * 32 + r32) * 768 + qcol + map * 64 + hi * 32); const v4i_a x0 = qp[0], x1 = qp[1]; qf = CAT8(x0, x1); }
  asm volatile("s_waitcnt vmcnt(0)" ::: "memory");
  const int on_ = ((lane & 15) == ((lane >> 4) & 1)) ? 0x38383838 : 0;
  v8i_a ones = {on_, on_, on_, on_, on_, on_, on_, on_}; asm volatile("" : "+v"(ones));
  const int krow = wid * 8 + (lane >> 3); const unsigned voK = (unsigned)(krow * 768 + (((lane & 7) ^ ((krow >> 1) & 7)) * 16));
  const int vrow = wid * 16 + (lane >> 2); const unsigned voV = (unsigned)(vrow * 64 + (((lane & 3) ^ ((vrow >> 2) & 3)) * 16));
  const __amdgpu_buffer_rsrc_t rsK = __builtin_amdgcn_make_buffer_rsrc((void*)k8, 0, 0x7fffffff, 0x00020000), rsV = __builtin_amdgcn_make_buffer_rsrc((void*)vtb, 0, 0x7fffffff, 0x00020000);
  const unsigned koff = (unsigned)(krow0 * 768 + qcol);
  typedef __attribute__((address_space(3))) unsigned lds_u32;
  const int NT = seq / KVBLK;
#define DMA_TILE(t) do { const int tt_ = (t) < NT ? (t) : NT - 1; const int sl_ = ((t) & 7) * SLOT + wid * 1024; \
    __builtin_amdgcn_raw_ptr_buffer_load_lds(rsK, (lds_u32*)(lds + sl_), 16, (int)voK, (int)(koff + (unsigned)tt_ * (unsigned)(KVBLK * 768)), 0, 0); \
    __builtin_amdgcn_raw_ptr_buffer_load_lds(rsV, (lds_u32*)(lds + sl_ + VOFF), 16, (int)voV, (int)(vtoff + (unsigned)tt_ * 8192u), 0, 0); } while (0)
#define WAITB() asm volatile("s_waitcnt vmcnt(2)\n\ts_barrier" ::: "memory")
#define RESC(X0, X1) do { if (__builtin_expect(__any(dl8 > 0.f), 0)) { if (hi == 0) al_l[r32] = __builtin_amdgcn_exp2f(-0.125f * dl8); asm volatile("s_waitcnt lgkmcnt(0)" ::: "memory"); \
    _Pragma("unroll") for (int r = 0; r < 4; ++r) lacc[r] *= al_l[4 * (lane >> 4) + r + 16 * (lane & 1)]; \
    _Pragma("unroll") for (int r = 0; r < 16; ++r) { const float f_ = al_l[crow(r, hi)]; _Pragma("unroll") for (int d = 0; d < 4; ++d) o[d][r] *= f_; } \
    _Pragma("unroll") for (int r = 0; r < 16; ++r) { X0[r] -= dl8; X1[r] -= dl8; CKP[r] -= dl8; } } } while (0)
  const int kb0 = (int)(uintptr_t)lds + r32 * 128 + (((4 * map + 2 * hi) ^ ((r32 >> 1) & 7)) * 16);
  const int vb0 = (int)(uintptr_t)lds + VOFF + r32 * 64 + (((2 * hi) ^ ((r32 >> 2) & 3)) * 16);
  const int kb0x = kb0 ^ 16, vb0x = vb0 ^ 16;
  f32x16 pA0, pA1, pB0, pB1, CKP; v8i_a pf; float dl8 = 0.f;
#define ROWMAX_A(X0) mxa_ = MX3(X0[0], X0[1], X0[2]); mxb_ = MX3(X0[3], X0[4], X0[5]); mxa_ = MX3(mxa_, X0[6], X0[7]); mxb_ = MX3(mxb_, X0[8], X0[9]); mxa_ = MX3(mxa_, X0[10], X0[11]); mxb_ = MX3(mxb_, X0[12], X0[13]); mxa_ = MX3(mxa_, X0[14], X0[15]);
#define ROWMAX_B(X1) mxb_ = MX3(mxb_, X1[0], X1[1]); mxa_ = MX3(mxa_, X1[2], X1[3]); mxb_ = MX3(mxb_, X1[4], X1[5]); mxa_ = MX3(mxa_, X1[6], X1[7]); mxb_ = MX3(mxb_, X1[8], X1[9]); mxa_ = MX3(mxa_, X1[10], X1[11]); mxb_ = MX3(mxb_, X1[12], X1[13]); \
    mxa_ = MX3(mxa_, X1[14], X1[15]); rm_ = __builtin_fmaxf(mxa_, mxb_); \
    { auto rr_ = __builtin_amdgcn_permlane32_swap(__float_as_uint(rm_), __float_as_uint(rm_), false, false); rm_ = __builtin_fmaxf(__uint_as_float(rr_[0]), __uint_as_float(rr_[1])); }
#define PIN(x_) asm volatile("" : "+v"(x_))
  v4i_a va0_, va1_, vc0_, vc1_, vd0_, vd1_, ve0_, ve1_;
#define VREADS(t_) do { const int so_ = ((t_) & 7) * SLOT; const int vb_ = vb0 + so_, vx_ = vb0x + so_; va0_ = LDSV(vb_); va1_ = LDSV(vx_); vc0_ = LDSV(vb_ + 2048); vc1_ = LDSV(vx_ + 2048); \
    vd0_ = LDSV(vb_ + 4096); vd1_ = LDSV(vx_ + 4096); ve0_ = LDSV(vb_ + 6144); ve1_ = LDSV(vx_ + 6144); } while (0)
#define INTERVAL(X0, X1, Y0, Y1, j_) do { float mxa_ = 0.f, mxb_ = 0.f, rm_ = 0.f; \
    WAITB(); \
    const int kb_ = kb0 + ((j_) & 7) * SLOT, kx_ = kb0x + ((j_) & 7) * SLOT; \
    v4i_a ka0_ = LDSV(kb_), ka1_ = LDSV(kx_), kc0_ = LDSV(kb_ + 4096), kc1_ = LDSV(kx_ + 4096); \
    DMA_TILE((j_) + 2); \
    SBAR(); EXPS(Y0, 0, pf, 0); EXPS(Y0, 1, pf, 0); SBAR(); \
    PIN(ka0_); X0 = QKMF(ka0_, ka1_, CKP); PIN(X0); SBAR(); \
    EXPS(Y1, 0, pf, 4); EXPS(Y1, 1, pf, 4); SBAR(); \
    PIN(kc0_); X1 = QKMF(kc0_, kc1_, CKP); PIN(X1); SBAR(); \
    PIN(va0_); o[0] = PVMF(pf, o[0], va0_, va1_); PIN(o[0]); SBAR(); \
    ROWMAX_A(X0) \
    SBAR(); PIN(vc0_); o[1] = PVMF(pf, o[1], vc0_, vc1_); PIN(o[1]); SBAR(); \
    ROWMAX_B(X1) \
    dl8 = rm_ > LIM8 ? rm_ - KP0 : 0.f; \
    SBAR(); PIN(vd0_); o[2] = PVMF(pf, o[2], vd0_, vd1_); PIN(o[2]); SBAR(); \
    PIN(ve0_); o[3] = PVMF(pf, o[3], ve0_, ve1_); PIN(o[3]); SBAR(); \
    PIN(pf); lacc = __builtin_amdgcn_mfma_scale_f32_16x16x128_f8f6f4(pf, ones, lacc, 0, 0, 0, 0x7f7f7f7f, 0, 0x7f7f7f7f); PIN(lacc); SBAR(); \
    VREADS(j_); SBAR(); \
    RESC(X0, X1); } while (0)
  DMA_TILE(0); DMA_TILE(1);
  WAITB();
  DMA_TILE(2);
  { const v4i_a ka0_ = LDSV(kb0), ka1_ = LDSV(kb0 ^ 16), kc0_ = LDSV(kb0 + 4096), kc1_ = LDSV((kb0 + 4096) ^ 16);
    pA0 = QKMF(ka0_, ka1_, f32x16{}); pA1 = QKMF(kc0_, kc1_, f32x16{}); float mxa_, mxb_, rm_;
    ROWMAX_A(pA0) ROWMAX_B(pA1)
    const float kp0_ = KP0 - rm_;
#pragma unroll
    for (int r = 0; r < 16; ++r) { CKP[r] = kp0_; pA0[r] += kp0_; pA1[r] += kp0_; }
    PIN(CKP); VREADS(0); }
  for (int j = 1; j + 1 < NT; j += 2) {
    INTERVAL(pB0, pB1, pA0, pA1, j);
    INTERVAL(pA0, pA1, pB0, pB1, j + 1); }
  INTERVAL(pB0, pB1, pA0, pA1, NT - 1);
  { EXPS(pB0, 0, pf, 0); EXPS(pB0, 1, pf, 0); EXPS(pB1, 0, pf, 4); EXPS(pB1, 1, pf, 4);
    o[0] = PVMF(pf, o[0], va0_, va1_); o[1] = PVMF(pf, o[1], vc0_, vc1_); o[2] = PVMF(pf, o[2], vd0_, vd1_); o[3] = PVMF(pf, o[3], ve0_, ve1_);
    lacc = __builtin_amdgcn_mfma_scale_f32_16x16x128_f8f6f4(pf, ones, lacc, 0, 0, 0, 0x7f7f7f7f, 0, 0x7f7f7f7f); }
  asm volatile("s_waitcnt vmcnt(0)" ::: "memory");
#undef INTERVAL
#undef VREADS
#undef PIN
#undef ROWMAX_A
#undef ROWMAX_B
#undef DMA_TILE
#undef WAITB
  float rli[16];
  if ((lane & 15) < 2) {
#pragma unroll
    for (int r = 0; r < 4; ++r) ws[16 * (lane & 15) + 4 * (lane >> 4) + r] = lacc[r]; }
  asm volatile("s_waitcnt lgkmcnt(0)" ::: "memory");
#pragma unroll
  for (int r = 0; r < 16; ++r) rli[r] = __builtin_amdgcn_rcpf(ws[crow(r, hi)]);
  __syncthreads();
  int zz = 0; asm volatile("" : "+v"(zz));
  float* EX = (float*)lds;
  const int eb = wq * 4096 + lane + zz;
  if constexpr (MAP == 1) {
#pragma unroll
    for (int d0 = 0; d0 < 4; ++d0)
#pragma unroll
      for (int r = 0; r < 16; ++r) EX[eb + (d0 * 16 + r) * 64] = -lam * o[d0][r] * rli[r];
  }
  __syncthreads();
  if constexpr (MAP == 0) {
    float ss[16];
#pragma unroll
    for (int r = 0; r < 16; ++r) ss[r] = 0.f;
#pragma unroll
    for (int d0 = 0; d0 < 4; ++d0)
#pragma unroll
      for (int r = 0; r < 16; ++r) { const float v = o[d0][r] * rli[r] + EX[eb + (d0 * 16 + r) * 64]; o[d0][r] = v; ss[r] += v * v; }
#pragma unroll
    for (int r = 0; r < 16; ++r) { float s = ss[r]; s += __shfl_xor(s, 1); s += __shfl_xor(s, 2); s += __shfl_xor(s, 4); s += __shfl_xor(s, 8); s += __shfl_xor(s, 16);
      ss[r] = gsc / sqrtf(s * (1.0f / 128.0f) + EPS); }
    bf16* Ow = Ob + (long)(wq * 32 + 4 * hi) * 1024 + r32 + zz;
#pragma unroll
    for (int d0 = 0; d0 < 4; ++d0) { const float gv = gn[d0 * 32 + r32];
#pragma unroll
      for (int r = 0; r < 16; ++r) Ow[((r & 3) + 8 * (r >> 2)) * 1024 + d0 * 32] = (bf16)(cvt_pk_bf16(o[d0][r] * ss[r] * gv, 0.f) & 0xffffu); }
  }
  __syncthreads();
#undef RESC
#undef LDSV
#undef CAT8
#undef QKMF
#undef PVMF
#undef EXPS
#undef EXPW
#undef EXPB1
}
#undef MX3
#undef SBAR
}
#ifdef PROBE_SUB
#define SUB_T0 const unsigned long long sub_t0_ = __builtin_amdgcn_s_memrealtime()
#define SUB_SPIN(id) do { if (PROBE_SUB == (id)) { const unsigned long long t1_ = __builtin_amdgcn_s_memrealtime(), d_ = 9ull * (t1_ - sub_t0_); while (__builtin_amdgcn_s_memrealtime() - t1_ < d_) __builtin_amdgcn_s_sleep(8); } } while (0)
#else
#define SUB_T0 do {} while (0)
#define SUB_SPIN(id) do {} while (0)
#endif
__device__ __forceinline__ void ph_mix_even(Frame& F, int i) {
    SUB_T0;
    if (!(F.A->mode & 4)) for (int it = F.bid; it < 256; it += F.G) { LAUNDER(F);
#ifndef NO_RET
        if (it < 128) ret_item(F, i, it >> 4, (it >> 2) & 3, (it >> 1) & 1, it & 1);
#endif
#ifndef NO_LRU
        if (it >= 128) { const int j = it - 128; lru_item(F, i, j >> 4, (j >> 3) & 1, j & 7); }
#endif
        __syncthreads();
    }
    SUB_SPIN(3);
#ifdef PROBE_SUB
    if (F.bid < 128) { SUB_SPIN(5); } else { SUB_SPIN(6); }
#endif
}
__device__ __forceinline__ void ph_mix_odd(Frame& F, int l, int ctx_out) {
    const int i = l >> 1;
    { SUB_T0;
#ifndef NO_S5
    if (!(F.A->mode & 1)) for (int it = F.bid; it < 256; it += F.G) { LAUNDER(F); s5_item(F, i, it >> 5, (it >> 4) & 1, it & 15); __syncthreads(); }
#endif
    SUB_SPIN(1); }
    SUB_T0;
    const float* lp = INP(30) + (size_t)i * 256;
    const float s01 = wave_sum(lp[F.lane] * lp[64 + F.lane]), s23 = wave_sum(lp[128 + F.lane] * lp[192 + F.lane]);
    const float lam_init = 0.8f - 0.6f * expf(-0.3f * (float)l), lam = expf(s01) - expf(s23) + lam_init, gsc = 1.0f - lam_init;
    const bf16* Z = (const bf16*)FBIG; const float* gn = INP(31) + (size_t)i * 768;
    const int vcu = (F.G % 8 == 0) ? (F.bid % 8) * (F.G / 8) + F.bid / 8 : F.bid;
    const int nx = NB * 6 * 64, nc = ctx_out ? NB * 6 * 2 : 0;
    if (!(F.A->mode & 2)) for (int u = vcu; u < nx + nc; u += F.G) { LAUNDER(F);
        int bh, qb, row0, seq;
        if (u < nx) { bh = u >> 6; qb = u & 63; row0 = (bh / 6) * TB + CTXL + 128 * qb; seq = TB; }
        else { const int v = u - nx; bh = v >> 1; qb = v & 1; row0 = (bh / 6) * TB + 128 * qb; seq = CTXL; }
        const int b = bh / 6, h = bh % 6;
#ifndef NO_ATTN
        if (F.wave < 4) att::unit<0>(FBIG + Q8_OFF, (size_t)row0, h * 128, FYB + K8_OFF, (size_t)b * TB, FYB + VT_OFF, (unsigned)((size_t)bh * 132 * 8192),
                  FH + (size_t)row0 * D + 256 + h * 128, seq, (char*)F.lds, lam, gsc, gn + h * 128, F.tid);
        else att::unit<1>(FBIG + Q8_OFF, (size_t)row0, h * 128, FYB + K8_OFF, (size_t)b * TB, FYB + VT_OFF, (unsigned)((size_t)bh * 132 * 8192),
                  FH + (size_t)row0 * D + 256 + h * 128, seq, (char*)F.lds, lam, gsc, gn + h * 128, F.tid);
#endif
    }
    SUB_SPIN(2);
}

constexpr int PH_PER_LAYER = 18, PH_TOTAL = 2 + NLAYER * PH_PER_LAYER;
#define IN(k) (lo <= (k) && (k) < hi)
#ifndef PROBE_PARITY
#define PROBE_PARITY (-1)
#endif
#ifdef PROBE_SPIN_KINDS
#define PH0 const unsigned long long ph_t0_ = __builtin_amdgcn_s_memrealtime()
#define SEAM(k) do { if (IN((k) + 1)) xcd_barrier(bar, LEAD0(F)); { const int kk_ = ((k) - 1) % PH_PER_LAYER; if (((k) > 0) && ((PROBE_SPIN_KINDS >> kk_) & 1) && (PROBE_PARITY < 0 || ((((k) - 1) / PH_PER_LAYER) & 1) == PROBE_PARITY)) { const unsigned long long t1_ = __builtin_amdgcn_s_memrealtime(), d_ = 9ull * (t1_ - ph_t0_); \
        while (__builtin_amdgcn_s_memrealtime() - t1_ < d_) __builtin_amdgcn_s_sleep(8); } } } while (0)
#else
#define PH0 do {} while (0)
#define SEAM(k) do { if (IN((k) + 1)) xcd_barrier(bar, LEAD0(F)); } while (0)
#endif
template <int l> __device__ __forceinline__ void run_layer(Frame& F, const XcdBarrier& bar, const int lo, const int hi) {
        constexpr int P = 1 + PH_PER_LAYER * l, i = l >> 1; constexpr bool odd = l & 1; constexpr int ctx_out = l < NLAYER - 1;
        const float* MODl = FMOD + (size_t)l * 9 * 6144; const float* ng = INP(6) + (size_t)l * 4 * 1024;
        if (IN(P + 0)) { LAUNDER(F); PH0;
            ph_convert(F, l);
#ifdef PROBE_CONVERT
            __syncthreads(); ph_convert(F, l);
#endif
            NormArgs a{}; a.xin_input = (l == 0); a.has_y = (l > 0); a.two = (l > 0) && ((l - 1) & 1); a.write_x = (l > 0); a.final_ = 0; a.do_h = 1; a.do_route = 0;
            if (l > 0) { a.gate = FMOD + (size_t)(l - 1) * 9 * 6144 + 5 * 1024; a.gy = INP(6) + (size_t)(l - 1) * 4 * 1024 + 3 * 1024; }
            a.gh = ng; a.shift = MODl; a.scale = MODl + 1024;
            __syncthreads(); ph_norm(F, a); SEAM(P + 0);
        }
        if (IN(P + 1)) { LAUNDER(F); PH0;
            constexpr int N = odd ? OD_IN : EV_IN, HD = odd ? 32 : 64;
            pg8::Gemm g{FH, FWB + W_IN / 2, M, N, D}; pg8::StaticOrder S; S.init(M, N, F.G, F.bid);
            pg8::EpiWin<HD> E{(bf16*)FBIG, N, (const float*)(WSG + (odd ? WS_ROPE_D : WS_ROPE_R)), odd ? 1 : 4, odd ? 4 : 6, odd ? 4 : 6, odd ? 7 : 8, odd ? 4.0f * 0.125f * 1.4426950408889634f : 1.0f, odd ? 1.0f : 0.08838834764831845f,
                                 odd ? FBIG + Q8_OFF : (unsigned char*)nullptr, odd ? FYB + K8_OFF : (unsigned char*)nullptr, 256, 1024};
            pg8::gemm_phase<pg8::EpiWin<HD>, pg8::StaticOrder, true, true>(F.lds, g, S, E, F.tid);
            if (odd) { SEAM(P + 1); } else { SEAM(P + 2); }
        }
        if (odd && IN(P + 2)) { LAUNDER(F); PH0; ph_vt(F); SEAM(P + 2); }
        if (IN(P + 3)) { LAUNDER(F); PH0;
            if (!odd) { ph_mix_even(F, i); }
            else ph_mix_odd(F, l, ctx_out);
            SEAM(P + 3); }
        if (IN(P + 4)) { LAUNDER(F); PH0; if (!odd) ph_merge_even(F, i); else ph_zpass(F, i); SEAM(P + 4); }
        if (odd && IN(P + 5)) { LAUNDER(F); PH0;
            int kglu = 256; asm volatile("" : "+s"(kglu));
            pg8::Gemm g{(const bf16*)(FYB + 2 * T_QUART), FWB + W_GLU / 2, M, 256, kglu}; pg8::StaticOrder S; S.init(M, 256, F.G, F.bid);
            pg8::EpiGLU E{FH, D, (const bf16*)(FYB + 2 * T_QUART), 256, INP(29) + (size_t)i * 256};
            pg8::gemm_phase<pg8::EpiGLU, pg8::StaticOrder, true, true>(F.lds, g, S, E, F.tid);
            SEAM(P + 5);
        }
        if (IN(P + 6)) { LAUNDER(F); PH0;
            pg8::Gemm g{FH, FWB + W_OUT / 2, M, D, D}; pg8::StaticOrder S; S.init(M, D, F.G, F.bid);
            pg8::EpiPlain E{(bf16*)FYB, D, 1.0f};
            pg8::gemm_phase<pg8::EpiPlain, pg8::StaticOrder, true, true>(F.lds, g, S, E, F.tid);
            if (!odd) { const int tw = ((M / 256) * (D / 256)) % F.G; if (tw == 0 || F.bid >= tw) { __syncthreads(); ph_convert_moe(F, i, tw, F.G - tw, 0, 3); } }
            SEAM(P + 6);
        }
        if (IN(P + 7)) { LAUNDER(F); PH0;
            NormArgs a{}; a.xin_input = (l == 0); a.has_y = 1; a.two = 0; a.write_x = 1; a.final_ = 0; a.do_h = 1; a.do_route = odd; a.h8 = 1;
            a.gate = MODl + 2 * 1024; a.gy = ng + 1024; a.gh = ng + 2 * 1024; a.shift = MODl + 3 * 1024; a.scale = MODl + 4 * 1024;
            a.rw = INP(33) + (size_t)i * 8192; a.rb = INP(34) + (size_t)i * 8;
            ph_norm(F, a); SEAM(P + 7);
        }
        if (!odd) {
            if (IN(P + 9)) { LAUNDER(F); PH0;
                int k8 = D / 2; asm volatile("" : "+s"(k8));
                pg8::Gemm g{FH, (const bf16*)((const unsigned char*)FWB + W_GU), M, 2 * DFF, k8}; pg8::StaticOrder S; S.init(M, 2 * DFF, F.G, F.bid);
                pg8::EpiSwiGLU8 E{FBIG + BIG_ACT, DFF, W8_INV};
                pg8::gemm_phase<pg8::EpiSwiGLU8, pg8::StaticOrder, true, true, true>(F.lds, g, S, E, F.tid);
                SEAM(P + 9);
            }
            if (IN(P + 10)) { LAUNDER(F); PH0;
                int k8 = DFF / 2; asm volatile("" : "+s"(k8));
                pg8::Gemm g{(const bf16*)(FBIG + BIG_ACT), (const bf16*)((const unsigned char*)FWB + W_DN), M, D, k8}; pg8::StaticOrder S; S.init(M, D, F.G, F.bid);
                pg8::EpiPlain E{(bf16*)FYB, D, W8_INV};
                pg8::gemm_phase<pg8::EpiPlain, pg8::StaticOrder, true, true, true>(F.lds, g, S, E, F.tid);
                { const int tw = ((M / 256) * (D / 256)) % F.G; if (tw == 0 || F.bid >= tw) { __syncthreads(); ph_convert_moe(F, i, tw, F.G - tw, 3, NE); } }
                SEAM(P + 10);
            }
        } else {
            if (IN(P + 8)) { LAUNDER(F); PH0; ph_assign(F); SEAM(P + 8); }
#pragma nounroll
            for (int w = 0; w < 2; ++w) {
                const int* PE = (const int*)(WSG + WS_PEXP);
                if (IN(P + 9 + 3 * w)) { LAUNDER(F); PH0; const int np = PE[MAXP], p0 = min(np, 256 * w), p1 = (w == 0) ? min(np, 256) : np; ph_gather(F, p0, p1); SEAM(P + 9 + 3 * w); }
                if (IN(P + 10 + 3 * w)) { LAUNDER(F); PH0; const int np = PE[MAXP], p0 = min(np, 256 * w), p1 = (w == 0) ? min(np, 256) : np;
                    int k8 = D / 2; asm volatile("" : "+s"(k8));
                    pg8::Gemm g{(const bf16*)(FBIG + BIG_HG), (const bf16*)(WSG + WS_W2 + W2_MGU), (p1 - p0) * 256, 2 * DFF, k8};
                    pg8::ExpertOrder S; S.init((p1 - p0) * 256, 2 * DFF, F.G, F.bid); S.pexp = PE + p0; S.estride = (size_t)7168 * 1024; S.tab = (LAS int*)(F.lds + RING_BYTES); __syncthreads(); S.fill(F.tid); __syncthreads();
                    pg8::EpiSwiGLU8 E{FBIG + BIG_ACT, DFF, W8_INV};
                    pg8::gemm_phase<pg8::EpiSwiGLU8, pg8::ExpertOrder, true, true, true>(F.lds, g, S, E, F.tid);
                    SEAM(P + 10 + 3 * w); }
                if (IN(P + 11 + 3 * w)) { LAUNDER(F); PH0; const int np = PE[MAXP], p0 = min(np, 256 * w), p1 = (w == 0) ? min(np, 256) : np;
                    int k8 = DFF / 2; asm volatile("" : "+s"(k8));
                    pg8::Gemm g{(const bf16*)(FBIG + BIG_ACT), (const bf16*)(WSG + WS_W2 + W2_MDN), (p1 - p0) * 256, D, k8};
                    pg8::ExpertOrder S; S.init((p1 - p0) * 256, D, F.G, F.bid); S.pexp = PE + p0; S.estride = (size_t)1024 * 3584; S.tab = (LAS int*)(F.lds + RING_BYTES); __syncthreads(); S.fill(F.tid); __syncthreads();
                    pg8::EpiScatter E{(const RouteEnt*)(WSG + WS_LIST) + (size_t)p0 * 256, (bf16*)FYB, (size_t)M * 1024, D, W8_INV};
                    pg8::gemm_phase<pg8::EpiScatter, pg8::ExpertOrder, true, true, true>(F.lds, g, S, E, F.tid);
                    if (w == 0) { SEAM(P + 11); } else { if (IN(P + PH_PER_LAYER)) xcd_barrier(bar, LEAD0(F)); } }
            }
        }
    }
#undef IN
#undef SEAM
__global__ void __launch_bounds__(512, 2) hybrid_fwd(Args args) {
    extern __shared__ __attribute__((aligned(16))) unsigned char lds_raw[];
    Frame F;
    F.lds = (LAS unsigned char*)lds_raw;
    F.tid = threadIdx.x; F.lane = F.tid & 63; F.wave = __builtin_amdgcn_readfirstlane(F.tid >> 6); F.G = gridDim.x; F.bid = blockIdx.x;
    F.A = (KArgs*)__builtin_amdgcn_kernarg_segment_ptr(); F.wsi = F.A->ws;
    volatile LAS unsigned* MISC = (volatile LAS unsigned*)(F.lds + MISC_OFF);
    for (int u = F.tid; u < (LDS_BYTES - LDSCTL_OFF) / 4; u += 512) ((LAS unsigned*)(F.lds + LDSCTL_OFF))[u] = 0u;
    __syncthreads();
    const int lo = args.ph_lo, hi = args.ph_hi;
    const bool multi = (hi - lo) > 1;
    unsigned* ctl = (unsigned*)(WSG + WS_CTL);
    XcdBarrier bar; bar.bar = ctl + CW_BAR; bar.x = 0; bar.st = nullptr;
    if (multi) bar = xcd_barrier_post(ctl + CW_BAR, MISC + 8);
#define IN(k) (lo <= (k) && (k) < hi)
#ifdef PROBE_SPIN_KINDS
#define PH0 const unsigned long long ph_t0_ = __builtin_amdgcn_s_memrealtime()
#define SEAM(k) do { if (IN((k) + 1)) xcd_barrier(bar, LEAD0(F)); { const int kk_ = ((k) - 1) % PH_PER_LAYER; if (((k) > 0) && ((PROBE_SPIN_KINDS >> kk_) & 1) && (PROBE_PARITY < 0 || ((((k) - 1) / PH_PER_LAYER) & 1) == PROBE_PARITY)) { const unsigned long long t1_ = __builtin_amdgcn_s_memrealtime(), d_ = 9ull * (t1_ - ph_t0_); \
        while (__builtin_amdgcn_s_memrealtime() - t1_ < d_) __builtin_amdgcn_s_sleep(8); } } } while (0)
#else
#define PH0 do {} while (0)
#define SEAM(k) do { if (IN((k) + 1)) xcd_barrier(bar, LEAD0(F)); } while (0)
#endif
#if defined(UBENCH) && UBENCH == 6
    { typedef int ub_v8i __attribute__((ext_vector_type(8)));
      ub_v8i ua = {(int)F.tid, 1, 2, 3, 4, 5, 6, 7}, ub = {7, 6, 5, 4, 3, 2, 1, (int)F.tid}; f32x16 c0 = {}, c1 = {}, c2 = {}, c3 = {};
      for (int i = 0; i < UB_N; ++i) { asm volatile("" : "+v"(ua), "+v"(ub));
        c0 = __builtin_amdgcn_mfma_scale_f32_32x32x64_f8f6f4(ua, ub, c0, 0, 0, 0, 0x7f7f7f7f, 0, 0x7f7f7f7f); c1 = __builtin_amdgcn_mfma_scale_f32_32x32x64_f8f6f4(ua, ub, c1, 0, 0, 0, 0x7f7f7f7f, 0, 0x7f7f7f7f);
        c2 = __builtin_amdgcn_mfma_scale_f32_32x32x64_f8f6f4(ua, ub, c2, 0, 0, 0, 0x7f7f7f7f, 0, 0x7f7f7f7f); c3 = __builtin_amdgcn_mfma_scale_f32_32x32x64_f8f6f4(ua, ub, c3, 0, 0, 0, 0x7f7f7f7f, 0, 0x7f7f7f7f); }
      asm volatile("" :: "v"(c0), "v"(c1), "v"(c2), "v"(c3)); }
#elif defined(UBENCH) && UBENCH == 7
    { typedef int ub_v8i __attribute__((ext_vector_type(8)));
      ub_v8i ua = {(int)F.tid, 1, 2, 3, 4, 5, 6, 7}, ub = {7, 6, 5, 4, 3, 2, 1, (int)F.tid}; f32x16 c0 = {}, c1 = {}, c2 = {}, c3 = {};
      float a0 = (float)F.tid, a1 = a0 + 1.f, a2 = a0 + 2.f, a3 = a0 + 3.f, a4 = a0 + 4.f, a5 = a0 + 5.f, a6 = a0 + 6.f;
#define UBF(r) "v_fma_f32 " r ", " r ", " r ", " r "\n\t"
#define UBF14 UBF("%0") UBF("%1") UBF("%2") UBF("%3") UBF("%4") UBF("%5") UBF("%6") UBF("%0") UBF("%1") UBF("%2") UBF("%3") UBF("%4") UBF("%5") UBF("%6")
#define UBV() asm volatile(UBF14 : "+v"(a0), "+v"(a1), "+v"(a2), "+v"(a3), "+v"(a4), "+v"(a5), "+v"(a6))
      for (int i = 0; i < UB_N; ++i) { asm volatile("" : "+v"(ua), "+v"(ub));
        c0 = __builtin_amdgcn_mfma_scale_f32_32x32x64_f8f6f4(ua, ub, c0, 0, 0, 0, 0x7f7f7f7f, 0, 0x7f7f7f7f); asm volatile("" : "+v"(c0)); UBV();
        c1 = __builtin_amdgcn_mfma_scale_f32_32x32x64_f8f6f4(ua, ub, c1, 0, 0, 0, 0x7f7f7f7f, 0, 0x7f7f7f7f); asm volatile("" : "+v"(c1)); UBV();
        c2 = __builtin_amdgcn_mfma_scale_f32_32x32x64_f8f6f4(ua, ub, c2, 0, 0, 0, 0x7f7f7f7f, 0, 0x7f7f7f7f); asm volatile("" : "+v"(c2)); UBV();
        c3 = __builtin_amdgcn_mfma_scale_f32_32x32x64_f8f6f4(ua, ub, c3, 0, 0, 0, 0x7f7f7f7f, 0, 0x7f7f7f7f); asm volatile("" : "+v"(c3)); UBV(); }
      asm volatile("" :: "v"(c0), "v"(c1), "v"(c2), "v"(c3), "v"(a0), "v"(a1), "v"(a2), "v"(a3), "v"(a4), "v"(a5), "v"(a6)); }
#elif defined(UBENCH)
    { float a0 = (float)F.tid, a1 = a0 + 1.f, a2 = a0 + 2.f, a3 = a0 + 3.f, a4 = a0 + 4.f, a5 = a0 + 5.f, a6 = a0 + 6.f, a7 = a0 + 7.f;
#if UBENCH == 1
#define UB1(r) "v_fma_f32 " r ", " r ", " r ", " r "\n\t"
#elif UBENCH == 2
#define UB1(r) "v_cvt_u32_f32 " r ", " r "\n\t"
#elif UBENCH == 3
#define UB1(r) "v_cvt_pk_fp8_f32 " r ", " r ", " r "\n\t"
#elif UBENCH == 4
#define UB1(r) "v_exp_f32 " r ", " r "\n\t"
#elif UBENCH == 10
#define UB1(r) "v_cvt_pk_u8_f32 " r ", " r ", 1, " r "\n\t"
#elif UBENCH == 9
#define UB1(r) "v_fma_f32 %0, %0, %0, %0\n\t"
#elif UBENCH == 5
#define UB1(r) "v_max3_f32 " r ", " r ", " r ", " r "\n\t"
#endif
#define UB8 UB1("%0") UB1("%1") UB1("%2") UB1("%3") UB1("%4") UB1("%5") UB1("%6") UB1("%7")
      for (int i = 0; i < UB_N; ++i) asm volatile(UB8 UB8 UB8 UB8 : "+v"(a0), "+v"(a1), "+v"(a2), "+v"(a3), "+v"(a4), "+v"(a5), "+v"(a6), "+v"(a7));
      asm volatile("" :: "v"(a0), "v"(a1), "v"(a2), "v"(a3), "v"(a4), "v"(a5), "v"(a6), "v"(a7)); }
#endif
    if (IN(0)) { LAUNDER(F); PH0; ph_prologue(F); SEAM(0); }
    run_layer<0>(F, bar, lo, hi); run_layer<1>(F, bar, lo, hi); run_layer<2>(F, bar, lo, hi); run_layer<3>(F, bar, lo, hi);
    if (IN(PH_TOTAL - 1)) { LAUNDER(F); PH0;
        NormArgs a{}; a.xin_input = 0; a.has_y = 1; a.two = 1; a.write_x = 1; a.final_ = 1; a.do_h = 0; a.do_route = 0;
        a.gate = FMOD + (size_t)3 * 9 * 6144 + 5 * 1024; a.gy = INP(6) + (size_t)3 * 4 * 1024 + 3 * 1024;
        ph_norm(F, a);
    }
#undef IN
#undef SEAM
}


#ifndef DBG_SCAN
#define DBG_SCAN 0
#endif
#if DBG_SCAN
constexpr int CW_DBG = 2048;
__global__ void __launch_bounds__(256) dbg_scan(unsigned char* ws, const float* out, int phase) {
    unsigned* flag = (unsigned*)(ws + WS_CTL) + CW_DBG; bool bad = false;
    const size_t gt = (size_t)blockIdx.x * 256 + threadIdx.x, gs = (size_t)gridDim.x * 256;
    { const uint4* p = (const uint4*)(ws + WS_W); const size_t n = (WS_END - WS_W) / 16;
      for (size_t i = gt; i < n; i += gs) { const uint4 v = p[i]; const unsigned w[4] = {v.x, v.y, v.z, v.w};
#pragma unroll
          for (int k = 0; k < 4; ++k) { if ((w[k] & 0x7F80u) == 0x7F80u || (w[k] & 0x7F800000u) == 0x7F800000u) bad = true; } } }
    { const uint4* p = (const uint4*)(ws + WS_MOD); const size_t n = 4 * 9 * 6144 / 4;
      for (size_t i = gt; i < n; i += gs) { const uint4 v = p[i]; if ((v.x & 0x7F800000u) == 0x7F800000u || (v.y & 0x7F800000u) == 0x7F800000u || (v.z & 0x7F800000u) == 0x7F800000u || (v.w & 0x7F800000u) == 0x7F800000u) bad = true; } }
    { const uint4* p = (const uint4*)out; const size_t n = (size_t)NB * SEQ * D / 4;
      for (size_t i = gt; i < n; i += gs) { const uint4 v = p[i]; if ((v.x & 0x7F800000u) == 0x7F800000u || (v.y & 0x7F800000u) == 0x7F800000u || (v.z & 0x7F800000u) == 0x7F800000u || (v.w & 0x7F800000u) == 0x7F800000u) bad = true; } }
    { const unsigned* p = (const unsigned*)(ws + WS_MOD); const size_t n = 4 * 9 * 6144;
      for (size_t i = gt; i < n; i += gs) if ((p[i] & 0x7F800000u) == 0x7F800000u) bad = true; }
    if (bad) atomicMax(flag, 1000u - (unsigned)phase);
}
__global__ void __launch_bounds__(256) dbg_emit(unsigned char* ws, float* out) {
    const unsigned f = ((const unsigned*)(ws + WS_CTL))[CW_DBG], f2 = ((const unsigned*)(ws + WS_CTL))[CW_DBG + 1]; if (f == 0u && f2 == 0u) return;
    const int p = f2 ? 40 + (100 - (int)f2) : 1000 - (int)f;
    const size_t n = (size_t)NB * SEQ * D;
    for (size_t i = (size_t)blockIdx.x * 256 + threadIdx.x; i < n; i += (size_t)gridDim.x * 256) out[i] = (i == 0) ? ldexpf(1.0f, 14 + p) : 0.f;
}
#endif
static bool phase_exists(int ph) {
    if (ph == 0 || ph == PH_TOTAL - 1) return true;
    const int l = (ph - 1) / PH_PER_LAYER, k = (ph - 1) % PH_PER_LAYER; const bool odd = l & 1;
    if (k == 2) return odd;
    if (odd) return k <= 14;
    return k <= 1 || k == 3 || k == 4 || k == 6 || k == 7 || k == 9 || k == 10;
}
#ifndef MK_ONE_LAUNCH
#define MK_ONE_LAUNCH 1
#endif
extern "C" void kernel_launch(void* const* d_in, const int* in_sizes, int n_in, void* d_out, int out_size, void* d_ws, size_t ws_size, hipStream_t stream) {
    static int grid = 0;
    if (grid == 0) {
        if (n_in != 38 || in_sizes[0] != NB * SEQ * D || out_size != NB * SEQ * D || ws_size < WS_END) { fprintf(stderr, "kernel_launch: unexpected shapes / workspace (%d inputs, ws %zu)\n", n_in, ws_size); grid = -1; return; }
        int dev = 0, cus = 0, per_cu = 0;
        if (hipGetDevice(&dev) != hipSuccess || hipDeviceGetAttribute(&cus, hipDeviceAttributeMultiprocessorCount, dev) != hipSuccess) { grid = -1; return; }
        if (hipFuncSetAttribute((const void*)hybrid_fwd, hipFuncAttributeMaxDynamicSharedMemorySize, LDS_BYTES) != hipSuccess) { fprintf(stderr, "kernel_launch: hipFuncSetAttribute failed\n"); grid = -1; return; }
        if (hipOccupancyMaxActiveBlocksPerMultiprocessor(&per_cu, (const void*)hybrid_fwd, 512, LDS_BYTES) != hipSuccess || per_cu < 1) fprintf(stderr, "kernel_launch: occupancy query reports %d workgroups per CU\n", per_cu);
        (void)hipGetLastError();
        grid = cus;
    }
    if (grid < 0) return;
    if (hipMemsetAsync((char*)d_ws + WS_CTL, 0, CTL_ZERO_BYTES, stream) != hipSuccess) return;
#if DBG_SCAN
    (void)hipMemsetAsync(d_ws, 0, WS_END, stream); (void)hipMemsetAsync(d_out, 0, (size_t)out_size * 4, stream);
#endif
    Args a{};
    for (int i = 0; i < 38; ++i) a.in[i] = (const float*)d_in[i];
    a.out = (float*)d_out; a.ws = (unsigned char*)d_ws;
    if (MK_ONE_LAUNCH) { a.ph_lo = 0; a.ph_hi = PH_TOTAL; hipLaunchKernelGGL(hybrid_fwd, dim3(grid), dim3(512), LDS_BYTES, stream, a); }
    else for (int ph = 0; ph < PH_TOTAL; ++ph) { if (!phase_exists(ph)) continue; a.ph_lo = ph; a.ph_hi = ph + 1;
        int reps = 1;
#ifdef PROBE_REPEAT
        if (ph > 0 && ph < PH_TOTAL - 1) { const int k = (ph - 1) % PH_PER_LAYER; if ((PROBE_REPEAT >> k) & 1) reps = 2; }
#endif
        for (int rp = 0; rp < reps; ++rp) {
#ifdef PROBE_MODE
            a.mode = rp ? PROBE_MODE : 0;
#endif
            hipLaunchKernelGGL(hybrid_fwd, dim3(grid), dim3(512), LDS_BYTES, stream, a); }
        a.mode = 0;
#if DBG_SCAN
        hipLaunchKernelGGL(dbg_scan, dim3(2048), dim3(256), 0, stream, (unsigned char*)d_ws, (const float*)d_out, ph);
#endif
    }
#if DBG_SCAN
    hipLaunchKernelGGL(dbg_emit, dim3(2048), dim3(256), 0, stream, (unsigned char*)d_ws, (float*)d_out);
#endif
    const hipError_t le = hipPeekAtLastError();
    if (le != hipSuccess) fprintf(stderr, "kernel_launch: launch failed: %s\n", hipGetErrorName(le));
}
```

```cpp
#include <hip/hip_runtime.h>
#include <cstdio>
#include <cstdint>
#include <cmath>
#define DBG_SCAN 0
namespace pg8 {
#define PG8_LAS __attribute__((address_space(3)))
typedef unsigned short bf16_t;
typedef short bf16x8 __attribute__((ext_vector_type(8)));
typedef float f32x4 __attribute__((ext_vector_type(4)));
typedef unsigned u32x4 __attribute__((ext_vector_type(4)));
typedef int v4i_t __attribute__((ext_vector_type(4)));
typedef int v8i_t __attribute__((ext_vector_type(8)));
constexpr int BM = 256, BK = 64, HALF = 128, HTB = HALF * BK * 2  , STAGE_BYTES = 8 * HTB, NXCD = 8, WGM = 8;

__host__ __device__ __forceinline__ int lds_byte(int r, int c) { const int st = (r >> 4) * 2 + (c >> 5), rr = r & 15, cc = c & 31, ob = rr * 64 + cc * 2; return st * 1024 + (ob ^ (((ob >> 9) & 1) << 5)); }
__host__ __device__ __forceinline__ void stage_rc(int b, int& R, int& C) { const int st = b / 1024, sb = b % 1024, swz = sb ^ (((sb >> 9) & 1) << 5); R = (st >> 1) * 16 + swz / 64; C = (st & 1) * 32 + (swz % 64) / 2; }
__host__ __device__ __forceinline__ int perm32(int rho) { const int n = rho >> 4, i = rho & 15; return 8 * (i >> 2) + 4 * n + (i & 3); }

struct Unit { int pm, pn, e; };
struct Gemm { const bf16_t* A; const bf16_t* Bt; int M, N, K; };

typedef float f32x2_cv __attribute__((ext_vector_type(2))); typedef __bf16 bf16x2_cv __attribute__((ext_vector_type(2)));
__device__ __forceinline__ unsigned cvt_pk_bf16(float lo, float hi) { const f32x2_cv v = {lo, hi}; const bf16x2_cv b = __builtin_convertvector(v, bf16x2_cv); return __builtin_bit_cast(unsigned, b); }
struct StaticOrder {
    int nM, nN, nwg, G, c;
    __host__ __device__ void init(int M, int N, int G_, int c_) { nM = M / BM; nN = N / BM; nwg = nM * nN; G = G_; c = c_; }
    __host__ __device__ bool next(int i, Unit& u) const {
        const long L = (long)i * G + c; if (L >= nwg) return false;
        int wgid = (int)L; { const int q = nwg / NXCD, r = nwg % NXCD, xcd = wgid % NXCD, off = wgid / NXCD; wgid = (xcd < r ? xcd * (q + 1) : r * (q + 1) + (xcd - r) * q) + off; }
        const int nig = WGM * nN, gid = wgid / nig, fm = gid * WGM, gsz = (nM - fm) < WGM ? (nM - fm) : WGM;
        u.pm = fm + ((wgid % nig) % gsz); u.pn = (wgid % nig) / gsz; return true;
    }
    __device__ __forceinline__ unsigned boff(const Gemm& g, const Unit& u) const { return (unsigned)u.pn * (unsigned)(BM * g.K * 2); }
    __device__ __forceinline__ void a_ready(const Unit&) const {}
    __device__ __forceinline__ void done(const Unit&) const {}
};
struct ExpertOrder : StaticOrder {
    const int* pexp; size_t estride; PG8_LAS int* tab;
    __device__ __forceinline__ void fill(int tid) const { Unit u; if (StaticOrder::next(tid, u)) tab[tid] = pexp[u.pm]; }
    __device__ __forceinline__ bool next(int i, Unit& u) const { const bool ok = StaticOrder::next(i, u); u.e = ok ? tab[i] : 0; return ok; }
    __device__ __forceinline__ unsigned boff(const Gemm& g, const Unit& u) const { return (unsigned)__builtin_amdgcn_readfirstlane(u.e) * (unsigned)estride + (unsigned)u.pn * (unsigned)(BM * g.K * 2); }
};
__device__ __forceinline__ float fast_sigmoid(float x) { return __builtin_amdgcn_rcpf(1.0f + __builtin_amdgcn_exp2f(-1.4426950408889634f * x)); }
__device__ __forceinline__ float bflo(unsigned w) { return __uint_as_float(w << 16); }
__device__ __forceinline__ float bfhi(unsigned w) { return __uint_as_float(w & 0xffff0000u); }
struct EpiPlain {
    static constexpr bool PERM = true, AFTER_DRAIN = false;
    bf16_t* O; int ldc; float sc;
    __device__ __forceinline__ void operator()(const f32x4 (&acc)[2][2][4][2], const Unit& u, int wr, int wc, int fr, int fq) const {
        const int row0 = u.pm * BM + wr * 64 + fr, col0 = u.pn * BM + wc * 32 + 8 * fq;
#pragma unroll
        for (int ai = 0; ai < 2; ++ai)
#pragma unroll
            for (int m = 0; m < 4; ++m) { bf16_t* rowp = O + (size_t)(row0 + ai * HALF + m * 16) * ldc + col0;
#pragma unroll
                for (int bj = 0; bj < 2; ++bj) { const f32x4 v0 = acc[ai][bj][m][0], v1 = acc[ai][bj][m][1];
                    u32x4 w; w.x = cvt_pk_bf16(v0[0], v0[1]); w.y = cvt_pk_bf16(v0[2], v0[3]); w.z = cvt_pk_bf16(v1[0], v1[1]); w.w = cvt_pk_bf16(v1[2], v1[3]);
                    *(u32x4*)(rowp + bj * HALF) = w; } }
    }
};
__device__ __forceinline__ unsigned pk4_fp8u(float a, float b, float c, float d) { int r; asm volatile("" : "=v"(r)); r = __builtin_amdgcn_cvt_pk_fp8_f32(a, b, r, false); r = __builtin_amdgcn_cvt_pk_fp8_f32(c, d, r, true); return (unsigned)r; }
__device__ __forceinline__ unsigned pk4_fp8(float a, float b, float c, float d) { int r = __builtin_amdgcn_cvt_pk_fp8_f32(a, b, 0, false); r = __builtin_amdgcn_cvt_pk_fp8_f32(c, d, r, true); return (unsigned)r; }
template <int HD> struct EpiWin {
    static constexpr bool PERM = true, AFTER_DRAIN = false;
    bf16_t* O; int ldc; const float* T; int qlo, qhi, klo, khi; float qsc, ksc;
    unsigned char* Q8; unsigned char* K8; int qcol0, kcol0;
    __device__ __forceinline__ void operator()(const f32x4 (&acc)[2][2][4][2], const Unit& u, int wr, int wc, int fr, int fq) const {
        const int row0 = u.pm * BM + wr * 64 + fr;
        const bool isq = u.pn >= qlo && u.pn < qhi, isk = u.pn >= klo && u.pn < khi;
        if (!isq && !isk) {
            const int col0 = u.pn * BM + wc * 32 + 8 * fq;
#pragma unroll
            for (int ai = 0; ai < 2; ++ai)
#pragma unroll
                for (int m = 0; m < 4; ++m) { bf16_t* rowp = O + (size_t)(row0 + ai * HALF + m * 16) * ldc + col0;
#pragma unroll
                    for (int bj = 0; bj < 2; ++bj) { const f32x4 v0 = acc[ai][bj][m][0], v1 = acc[ai][bj][m][1];
                        u32x4 w; w.x = cvt_pk_bf16(v0[0], v0[1]); w.y = cvt_pk_bf16(v0[2], v0[3]); w.z = cvt_pk_bf16(v1[0], v1[1]); w.w = cvt_pk_bf16(v1[2], v1[3]);
                        *(u32x4*)(rowp + bj * HALF) = w; } }
            return;
        }
        const float sc = isq ? qsc : ksc;
        const int jj0 = wc * 32 + 8 * fq, g = jj0 / HD, d0 = jj0 % HD, Q = HD / 2;
        const int col1 = u.pn * BM + g * (2 * HD) + d0, dq = d0 % Q; const bool byrow = d0 < Q;
#pragma unroll
        for (int ai = 0; ai < 2; ++ai)
#pragma unroll
            for (int m = 0; m < 4; ++m) { const int r = row0 + ai * HALF + m * 16, t = r % 8448;
                float o1[8], o2[8];
                if (t >= 256) { const int tl = t - 256, pos = byrow ? (tl >> 6) : (tl & 63); const f32x4* cs = (const f32x4*)(T + (size_t)(pos * Q + dq) * 2);
                    const f32x4 c0 = cs[0], c1 = cs[1], c2 = cs[2], c3 = cs[3];
                    const float cc[8] = {c0[0], c0[2], c1[0], c1[2], c2[0], c2[2], c3[0], c3[2]}, ss[8] = {c0[1], c0[3], c1[1], c1[3], c2[1], c2[3], c3[1], c3[3]};
#pragma unroll
                    for (int e = 0; e < 8; ++e) { const float x1 = acc[ai][0][m][e >> 2][e & 3], x2 = acc[ai][1][m][e >> 2][e & 3]; o1[e] = (x1 * cc[e] - x2 * ss[e]) * sc; o2[e] = (x1 * ss[e] + x2 * cc[e]) * sc; }
                } else {
#pragma unroll
                    for (int e = 0; e < 8; ++e) { o1[e] = acc[ai][0][m][e >> 2][e & 3] * sc; o2[e] = acc[ai][1][m][e >> 2][e & 3] * sc; }
                }
                if (Q8) { unsigned char* p8 = (isq ? Q8 + (size_t)r * 768 + (col1 - qcol0) : K8 + (size_t)r * 768 + (col1 - kcol0));
                    typedef unsigned u32x2 __attribute__((ext_vector_type(2)));
                    u32x2 w8; w8.x = pk4_fp8(o1[0], o1[1], o1[2], o1[3]); w8.y = pk4_fp8(o1[4], o1[5], o1[6], o1[7]); *(u32x2*)p8 = w8;
                    w8.x = pk4_fp8(o2[0], o2[1], o2[2], o2[3]); w8.y = pk4_fp8(o2[4], o2[5], o2[6], o2[7]); *(u32x2*)(p8 + HD) = w8; continue; }
                bf16_t* rowp = O + (size_t)r * ldc + col1;
                u32x4 w; w.x = cvt_pk_bf16(o1[0], o1[1]); w.y = cvt_pk_bf16(o1[2], o1[3]); w.z = cvt_pk_bf16(o1[4], o1[5]); w.w = cvt_pk_bf16(o1[6], o1[7]);
                *(u32x4*)rowp = w;
                w.x = cvt_pk_bf16(o2[0], o2[1]); w.y = cvt_pk_bf16(o2[2], o2[3]); w.z = cvt_pk_bf16(o2[4], o2[5]); w.w = cvt_pk_bf16(o2[6], o2[7]);
                *(u32x4*)(rowp + HD) = w; }
    }
};
struct EpiSwiGLU {
    static constexpr bool PERM = true, AFTER_DRAIN = false;
    bf16_t* O; int ldc;
    __device__ __forceinline__ void operator()(const f32x4 (&acc)[2][2][4][2], const Unit& u, int wr, int wc, int fr, int fq) const {
        const int row0 = u.pm * BM + wr * 64 + fr, col0 = u.pn * HALF + wc * 32 + 8 * fq;
#pragma unroll
        for (int ai = 0; ai < 2; ++ai)
#pragma unroll
            for (int m = 0; m < 4; ++m) { bf16_t* rowp = O + (size_t)(row0 + ai * HALF + m * 16) * ldc + col0;
                float o[8];
#pragma unroll
                for (int n = 0; n < 2; ++n)
#pragma unroll
                    for (int i = 0; i < 4; ++i) { const float g = acc[ai][0][m][n][i], up = acc[ai][1][m][n][i]; o[n * 4 + i] = g * fast_sigmoid(g) * up; }
                u32x4 w; w.x = cvt_pk_bf16(o[0], o[1]); w.y = cvt_pk_bf16(o[2], o[3]); w.z = cvt_pk_bf16(o[4], o[5]); w.w = cvt_pk_bf16(o[6], o[7]);
                *(u32x4*)rowp = w; }
    }
};
struct EpiSwiGLU8 {
    static constexpr bool PERM = true, AFTER_DRAIN = false;
    unsigned char* O; int ldc; float sc;
    __device__ __forceinline__ void operator()(const f32x4 (&acc)[2][2][4][2], const Unit& u, int wr, int wc, int fr, int fq) const {
        const int row0 = u.pm * BM + wr * 64 + fr, col0 = u.pn * HALF + wc * 32 + 8 * fq;
        const float kx = -1.4426950408889634f * sc, cc = 1.0f / (sc * sc);
#pragma unroll
        for (int ai = 0; ai < 2; ++ai)
#pragma unroll
            for (int m = 0; m < 4; ++m) { unsigned char* rowp = O + (size_t)(row0 + ai * HALF + m * 16) * ldc + col0;
                float o[8];
#pragma unroll
                for (int n = 0; n < 2; ++n)
#pragma unroll
                    for (int i = 0; i < 4; i += 2) { typedef float f32x2e __attribute__((ext_vector_type(2)));
                        const f32x2e ag = {acc[ai][0][m][n][i], acc[ai][0][m][n][i + 1]}, au = {acc[ai][1][m][n][i], acc[ai][1][m][n][i + 1]};
                        const f32x2e x = ag * kx; const f32x2e e = {__builtin_amdgcn_exp2f(x.x), __builtin_amdgcn_exp2f(x.y)};
                        const f32x2e d = e * cc + cc; const f32x2e r = {__builtin_amdgcn_rcpf(d.x), __builtin_amdgcn_rcpf(d.y)};
                        const f32x2e o2 = (ag * au) * r; o[n * 4 + i] = o2.x; o[n * 4 + i + 1] = o2.y; }
                typedef unsigned u32x2 __attribute__((ext_vector_type(2)));
                u32x2 w; w.x = pk4_fp8u(o[0], o[1], o[2], o[3]); w.y = pk4_fp8u(o[4], o[5], o[6], o[7]);
                *(u32x2*)rowp = w; }
    }
};
struct EpiGLU {
    static constexpr bool PERM = true, AFTER_DRAIN = false;
    bf16_t* O; int ldc; const bf16_t* Z; int ldz; const float* bias;
    __device__ __forceinline__ void operator()(const f32x4 (&acc)[2][2][4][2], const Unit& u, int wr, int wc, int fr, int fq) const {
        const int row0 = u.pm * BM + wr * 64 + fr, col0 = u.pn * BM + wc * 32 + 8 * fq;
#pragma unroll
        for (int bj = 0; bj < 2; ++bj) { const f32x4 b0 = *(const f32x4*)(bias + col0 + bj * HALF), b1 = *(const f32x4*)(bias + col0 + bj * HALF + 4);
#pragma unroll
            for (int ai = 0; ai < 2; ++ai)
#pragma unroll
                for (int m = 0; m < 4; ++m) { const size_t r = (size_t)(row0 + ai * HALF + m * 16);
                    const u32x4 zz = *(const u32x4*)(Z + r * ldz + col0 + bj * HALF);
                    const f32x4 v0 = acc[ai][bj][m][0] + b0, v1 = acc[ai][bj][m][1] + b1;
                    u32x4 w; w.x = cvt_pk_bf16(bflo(zz.x) * fast_sigmoid(v0[0]), bfhi(zz.x) * fast_sigmoid(v0[1])); w.y = cvt_pk_bf16(bflo(zz.y) * fast_sigmoid(v0[2]), bfhi(zz.y) * fast_sigmoid(v0[3]));
                    w.z = cvt_pk_bf16(bflo(zz.z) * fast_sigmoid(v1[0]), bfhi(zz.z) * fast_sigmoid(v1[1])); w.w = cvt_pk_bf16(bflo(zz.w) * fast_sigmoid(v1[2]), bfhi(zz.w) * fast_sigmoid(v1[3]));
                    *(u32x4*)(O + r * ldc + col0 + bj * HALF) = w; } }
    }
};
struct RouteEnt { int tok; int slot; float w; int pad; };
struct EpiScatter {
    static constexpr bool PERM = true, AFTER_DRAIN = false;
    const RouteEnt* L; bf16_t* Y; size_t slot_stride; int ldc; float sc;
    __device__ __forceinline__ void operator()(const f32x4 (&acc)[2][2][4][2], const Unit& u, int wr, int wc, int fr, int fq) const {
        const int row0 = u.pm * BM + wr * 64 + fr, col0 = u.pn * BM + wc * 32 + 8 * fq;
#pragma unroll
        for (int ai = 0; ai < 2; ++ai)
#pragma unroll
            for (int m = 0; m < 4; ++m) { const RouteEnt e = L[row0 + ai * HALF + m * 16];
                if (e.tok >= 0) { bf16_t* rowp = Y + (size_t)e.slot * slot_stride + (size_t)e.tok * ldc + col0;
#pragma unroll
                    for (int bj = 0; bj < 2; ++bj) { const float ww = e.w * sc; const f32x4 v0 = acc[ai][bj][m][0] * ww, v1 = acc[ai][bj][m][1] * ww;
                        u32x4 w; w.x = cvt_pk_bf16(v0[0], v0[1]); w.y = cvt_pk_bf16(v0[2], v0[3]); w.z = cvt_pk_bf16(v1[0], v1[1]); w.w = cvt_pk_bf16(v1[2], v1[3]);
                        *(u32x4*)(rowp + bj * HALF) = w; } } }
    }
};
template <class Epi, class Sched, bool ALIGN_EPI = false, bool SP2 = false, bool F8 = false>
__device__ __forceinline__ void gemm_phase(PG8_LAS unsigned char* lds, const Gemm g, const Sched& S, const Epi& E, const int tid) {
    const int wid = __builtin_amdgcn_readfirstlane(tid >> 6), lane = tid & 63, wr = wid >> 2, wc = wid & 3, fr = lane & 15, fq = lane >> 4;
    const int K = g.K, nt = K / BK;
    unsigned voffA[2], voffB[2];
#pragma unroll
    for (int i = 0; i < 2; ++i) { int R, C; stage_rc(tid * 16 + i * 8192, R, C); const int Rb = Epi::PERM ? ((R & ~31) + perm32(R & 31)) : R;
        voffA[i] = (unsigned)(R * K + C) * 2u; voffB[i] = (unsigned)(Rb * K + C) * 2u; }
    const unsigned kstep = (unsigned)(BK * 2);
    const unsigned hstep = (unsigned)HALF * K * 2;
    const unsigned tstep = 2 * hstep;
    const __amdgpu_buffer_rsrc_t rsA = __builtin_amdgcn_make_buffer_rsrc((void*)g.A, 0, 0x7fffffff, 0x00020000), rsB = __builtin_amdgcn_make_buffer_rsrc((void*)g.Bt, 0, 0x7fffffff, 0x00020000);
    const unsigned ldsw = (unsigned)wid * 1024u;
    const int aoff = lds_byte(wr * 64 + fr, fq * 8), boff = lds_byte(wc * 32 + fr, fq * 8);
#define PG8_SA(b, h) (((b) * 2 + (h)) * HTB)
#define PG8_SB(b, h) ((4 + (b) * 2 + (h)) * HTB)
#define PG8_STAGE(rs, bufoff, goff, voff) do { _Pragma("unroll") for (int _i = 0; _i < 2; ++_i) \
        __builtin_amdgcn_raw_ptr_buffer_load_lds(rs, (PG8_LAS unsigned*)(lds + (bufoff) + ldsw + _i * 8192), 16, (int)(voff)[_i], (int)(goff), 0, 0); } while (0)
#define PG8_LDA(dst, b, h) do { if constexpr (F8) { _Pragma("unroll") for (int m = 0; m < 4; ++m) dst##8[m] = __builtin_shufflevector(*(const PG8_LAS v4i_t*)(lds + PG8_SA(b, h) + aoff + m * 2048), *(const PG8_LAS v4i_t*)(lds + PG8_SA(b, h) + aoff + m * 2048 + 1024), 0, 1, 2, 3, 4, 5, 6, 7); } \
    else { _Pragma("unroll") for (int m = 0; m < 4; ++m) _Pragma("unroll") for (int k = 0; k < 2; ++k) dst[m][k] = *(const PG8_LAS bf16x8*)(lds + PG8_SA(b, h) + aoff + m * 2048 + k * 1024); } } while (0)
#define PG8_LDB(dst, b, h) do { if constexpr (F8) { _Pragma("unroll") for (int n = 0; n < 2; ++n) dst##8[n] = __builtin_shufflevector(*(const PG8_LAS v4i_t*)(lds + PG8_SB(b, h) + boff + n * 2048), *(const PG8_LAS v4i_t*)(lds + PG8_SB(b, h) + boff + n * 2048 + 1024), 0, 1, 2, 3, 4, 5, 6, 7); } \
    else { _Pragma("unroll") for (int n = 0; n < 2; ++n) _Pragma("unroll") for (int k = 0; k < 2; ++k) dst[n][k] = *(const PG8_LAS bf16x8*)(lds + PG8_SB(b, h) + boff + n * 2048 + k * 1024); } } while (0)
#define PG8_MMA(ai, bj, At, Bt) do { __builtin_amdgcn_s_setprio(1); _Pragma("unroll") for (int m = 0; m < 4; ++m) _Pragma("unroll") for (int n = 0; n < 2; ++n) { \
        if constexpr (F8) acc[ai][bj][m][n] = __builtin_amdgcn_mfma_scale_f32_16x16x128_f8f6f4(Bt##8[n], At##8[m], acc[ai][bj][m][n], 0, 0, 0, 0x7f7f7f7f, 0, 0x7f7f7f7f); \
        else { _Pragma("unroll") for (int k = 0; k < 2; ++k) acc[ai][bj][m][n] = __builtin_amdgcn_mfma_f32_16x16x32_bf16(Bt[n][k], At[m][k], acc[ai][bj][m][n], 0, 0, 0); } } \
        __builtin_amdgcn_s_setprio(0); } while (0)
#define PG8_WAIT_V(n) asm volatile("s_waitcnt vmcnt(" #n ")" ::: "memory")
#define PG8_WAIT_L(n) asm volatile("s_waitcnt lgkmcnt(" #n ")" ::: "memory")
#define PG8_BAR __builtin_amdgcn_s_barrier()
#define PG8_SCHED __builtin_amdgcn_sched_barrier(0)
    Unit cur, nxt; int ui = 0;
    if (!S.next(0, cur)) return;
    f32x4 acc[2][2][4][2];
#pragma unroll
    for (int a = 0; a < 2; ++a)
#pragma unroll
        for (int b = 0; b < 2; ++b)
#pragma unroll
            for (int m = 0; m < 4; ++m)
#pragma unroll
                for (int n = 0; n < 2; ++n) acc[a][b][m][n] = (f32x4){0.f, 0.f, 0.f, 0.f};
    bf16x8 At[4][2], B0[2][2], B1[2][2]; v8i_t At8[4], B08[2], B18[2];
    unsigned cA = (unsigned)cur.pm * tstep, cB = S.boff(g, cur);
    S.a_ready(cur);
    if constexpr (SP2) {
        PG8_STAGE(rsB, PG8_SB(0, 0), cB, voffB); PG8_STAGE(rsB, PG8_SB(0, 1), cB + hstep, voffB); PG8_STAGE(rsA, PG8_SA(0, 0), cA, voffA); PG8_STAGE(rsA, PG8_SA(0, 1), cA + hstep, voffA);
        if (wr == 1) PG8_BAR;
        PG8_WAIT_V(2); PG8_BAR;
        PG8_STAGE(rsB, PG8_SB(1, 0), cB + kstep, voffB); PG8_STAGE(rsA, PG8_SA(1, 0), cA + kstep, voffA); PG8_STAGE(rsB, PG8_SB(1, 1), cB + hstep + kstep, voffB);
        PG8_WAIT_V(6); PG8_BAR;
    } else {
        PG8_STAGE(rsB, PG8_SB(0, 0), cB, voffB); PG8_STAGE(rsA, PG8_SA(0, 0), cA, voffA); PG8_STAGE(rsB, PG8_SB(0, 1), cB + hstep, voffB); PG8_STAGE(rsA, PG8_SA(0, 1), cA + hstep, voffA);
        if (wr == 1) PG8_BAR;
        PG8_WAIT_V(4); PG8_BAR;
        PG8_STAGE(rsB, PG8_SB(1, 0), cB + kstep, voffB); PG8_STAGE(rsA, PG8_SA(1, 0), cA + kstep, voffA); PG8_STAGE(rsB, PG8_SB(1, 1), cB + hstep + kstep, voffB);
        PG8_WAIT_V(6); PG8_BAR;
    }
    for (;;) {
        const bool has_next = S.next(ui + 1, nxt);
        const unsigned nA = has_next ? (unsigned)nxt.pm * tstep : cA, nB = has_next ? S.boff(g, nxt) : cB;
        for (int t = 0; t < nt; t += 2) {
            const bool last = (t == nt - 2);
            const unsigned a1 = cA + (unsigned)(t + 1) * kstep;
            const unsigned a2 = last ? nA : cA + (unsigned)(t + 2) * kstep, b2 = last ? nB : cB + (unsigned)(t + 2) * kstep;
            const unsigned a3 = a2 + kstep, b3 = b2 + kstep;
            if (last && has_next) S.a_ready(nxt);
            if constexpr (SP2) {
            PG8_LDB(B0, 0, 0); PG8_LDB(B1, 0, 1); PG8_SCHED; PG8_LDA(At, 0, 0); PG8_STAGE(rsA, PG8_SA(1, 1), a1 + hstep, voffA);
            PG8_WAIT_V(8); PG8_WAIT_L(0); PG8_BAR; PG8_MMA(0, 0, At, B0); PG8_MMA(0, 1, At, B1); PG8_BAR; PG8_SCHED;
            PG8_LDA(At, 0, 1); PG8_STAGE(rsB, PG8_SB(0, 0), b2, voffB); PG8_STAGE(rsB, PG8_SB(0, 1), b2 + hstep, voffB); PG8_STAGE(rsA, PG8_SA(0, 0), a2, voffA);
            PG8_WAIT_V(8); PG8_WAIT_L(0); PG8_BAR; PG8_MMA(1, 0, At, B0); PG8_MMA(1, 1, At, B1); PG8_BAR; PG8_SCHED;
            PG8_LDB(B0, 1, 0); PG8_LDB(B1, 1, 1); PG8_SCHED; PG8_LDA(At, 1, 0); PG8_STAGE(rsA, PG8_SA(0, 1), a2 + hstep, voffA);
            PG8_WAIT_V(8); PG8_WAIT_L(0); PG8_BAR; PG8_MMA(0, 0, At, B0); PG8_MMA(0, 1, At, B1); PG8_BAR; PG8_SCHED;
            PG8_LDA(At, 1, 1); PG8_STAGE(rsB, PG8_SB(1, 0), b3, voffB); PG8_STAGE(rsB, PG8_SB(1, 1), b3 + hstep, voffB); PG8_STAGE(rsA, PG8_SA(1, 0), a3, voffA);
            PG8_WAIT_V(8); PG8_WAIT_L(0); PG8_BAR; PG8_MMA(1, 0, At, B0); PG8_MMA(1, 1, At, B1); PG8_BAR; PG8_SCHED;
            } else {
            PG8_LDB(B0, 0, 0); PG8_SCHED; PG8_LDA(At, 0, 0); PG8_STAGE(rsA, PG8_SA(1, 1), a1 + hstep, voffA);
            PG8_WAIT_L(8); PG8_BAR; PG8_WAIT_L(0); PG8_MMA(0, 0, At, B0); PG8_BAR; PG8_SCHED;
            PG8_LDB(B1, 0, 1); PG8_STAGE(rsB, PG8_SB(0, 0), b2, voffB);
            PG8_BAR; PG8_WAIT_L(0); PG8_MMA(0, 1, At, B1); PG8_BAR;
            PG8_LDA(At, 0, 1); PG8_STAGE(rsA, PG8_SA(0, 0), a2, voffA);
            PG8_BAR; PG8_WAIT_L(0); PG8_MMA(1, 0, At, B0); PG8_BAR; PG8_SCHED;
            PG8_STAGE(rsB, PG8_SB(0, 1), b2 + hstep, voffB);
            PG8_WAIT_V(6); PG8_BAR; PG8_MMA(1, 1, At, B1); PG8_BAR;
            PG8_LDB(B0, 1, 0); PG8_SCHED; PG8_LDA(At, 1, 0); PG8_STAGE(rsA, PG8_SA(0, 1), a2 + hstep, voffA);
            PG8_WAIT_L(8); PG8_BAR; PG8_WAIT_L(0); PG8_MMA(0, 0, At, B0); PG8_BAR; PG8_SCHED;
            PG8_LDB(B1, 1, 1); PG8_STAGE(rsB, PG8_SB(1, 0), b3, voffB);
            PG8_BAR; PG8_WAIT_L(0); PG8_MMA(0, 1, At, B1); PG8_BAR;
            PG8_LDA(At, 1, 1); PG8_STAGE(rsA, PG8_SA(1, 0), a3, voffA);
            PG8_BAR; PG8_WAIT_L(0); PG8_MMA(1, 0, At, B0); PG8_BAR; PG8_SCHED;
            PG8_STAGE(rsB, PG8_SB(1, 1), b3 + hstep, voffB);
            PG8_WAIT_V(6); PG8_BAR; PG8_MMA(1, 1, At, B1); PG8_BAR;
            }
        }
        if constexpr (ALIGN_EPI) { if (wr == 0) PG8_BAR; }
        if constexpr (!Epi::AFTER_DRAIN) { E(acc, cur, wr, wc, fr, fq); S.done(cur); }
        if (!has_next) break;
#pragma unroll
        for (int a = 0; a < 2; ++a)
#pragma unroll
            for (int b = 0; b < 2; ++b)
#pragma unroll
                for (int m = 0; m < 4; ++m)
#pragma unroll
                    for (int n = 0; n < 2; ++n) acc[a][b][m][n] = (f32x4){0.f, 0.f, 0.f, 0.f};
        cur = nxt; cA = nA; cB = nB; ++ui;
        if constexpr (ALIGN_EPI) { if (wr == 1) PG8_BAR; }
    }
    PG8_WAIT_V(0);
    if constexpr (!ALIGN_EPI) { if (wr == 0) PG8_BAR; }
    PG8_BAR;
    if constexpr (Epi::AFTER_DRAIN) { E.fused(acc, cur, wr, wc, fr, fq, lds, wid, lane); S.done(cur); }
#undef PG8_SA
#undef PG8_SB
#undef PG8_STAGE
#undef PG8_LDA
#undef PG8_LDB
#undef PG8_MMA
#undef PG8_WAIT_V
#undef PG8_WAIT_L
#undef PG8_BAR
#undef PG8_SCHED
}
}

#define GAS __attribute__((address_space(1)))
#define LAS __attribute__((address_space(3)))
#define XB_TMO      128
#define XB_XCNT(j)  (256  + 64 * (j))
#define XB_XSUB(j)  (1280 + 64 * (j))
#define XB_XGEN(j)  (2304 + 64 * (j))
#define XB_TOP      3328
#define XB_TOPGEN   3392
#define XCD_BAR_WORDS 3456
#define XB_SPIN_CAP (1u << 18)

__device__ __forceinline__ unsigned xb_ld(unsigned* p)              { return __hip_atomic_load(p, __ATOMIC_RELAXED, __HIP_MEMORY_SCOPE_AGENT); }
__device__ __forceinline__ unsigned xb_add(unsigned* p, unsigned v) { return __hip_atomic_fetch_add(p, v, __ATOMIC_RELAXED, __HIP_MEMORY_SCOPE_AGENT); }
__device__ __forceinline__ unsigned xb_xcc_id() { return (unsigned)__builtin_amdgcn_s_getreg((3 << 11) | 20) & 0xFu; }
#define XB_SPIN(cond, bar) do { unsigned _sp = 0; while (cond) { __builtin_amdgcn_s_sleep(1); \
    if ((++_sp & 255u) == 0u) { if (xb_ld(&(bar)[XB_TMO])) break; if (_sp > XB_SPIN_CAP) { atomicAdd(&(bar)[XB_TMO], 1u); break; } } } } while (0)

struct XcdBarrier {
    unsigned* bar; unsigned x;
    volatile LAS unsigned* st;
};

__device__ __forceinline__ XcdBarrier xcd_barrier_post(unsigned* bar, volatile LAS unsigned* st) {
    XcdBarrier b; b.bar = bar; b.x = xb_xcc_id(); b.st = st;
    if (threadIdx.x == 0) (void)xb_add(&bar[XB_XCNT(b.x)], 1u);
    return b;
}
__device__ __forceinline__ void xcd_barrier_complete(unsigned* bar, unsigned x, unsigned& nloc, unsigned& nx) {
    const unsigned G = gridDim.x * gridDim.y * gridDim.z;
    unsigned sum, cnt, mine, sp = 0u;
    for (;;) {
        sum = 0u; cnt = 0u; mine = 0u;
#pragma unroll
        for (unsigned j = 0; j < 16; ++j) { const unsigned c = xb_ld(&bar[XB_XCNT(j)]); sum += c; cnt += (c > 0u) ? 1u : 0u; mine = (j == x) ? c : mine; }
        if (sum == G) break;
        __builtin_amdgcn_s_sleep(1);
        if ((++sp & 255u) == 0u) { if (xb_ld(&bar[XB_TMO])) break; if (sp > XB_SPIN_CAP) { atomicAdd(&bar[XB_TMO], 1u); break; } }
    }
    nloc = mine > 0u ? mine : 1u; nx = cnt > 0u ? cnt : 1u;
}

__device__ __forceinline__ void xcd_barrier(const XcdBarrier& b, const bool leader_thread  ) {
    asm volatile("s_waitcnt vmcnt(0)" ::: "memory");
    __syncthreads();
    if (leader_thread) {
        unsigned* bar = b.bar;
        __builtin_amdgcn_s_waitcnt(0);
        unsigned nloc = b.st[0], nx = b.st[1];
        if (nloc == 0u) { xcd_barrier_complete(bar, b.x, nloc, nx); b.st[0] = nloc; b.st[1] = nx; }
        const unsigned old = xb_add(&bar[XB_XSUB(b.x)], 1u);
        const unsigned gen = old / nloc;
        if (old + 1u == (gen + 1u) * nloc) {
            __builtin_amdgcn_fence(__ATOMIC_RELEASE, "agent");
            asm volatile("s_waitcnt vmcnt(0)" ::: "memory");
            const unsigned og = xb_add(&bar[XB_TOP], 1u);
            const unsigned tg = og / nx;
            if (og + 1u == (tg + 1u) * nx) xb_add(&bar[XB_TOPGEN], 1u);
            else XB_SPIN(xb_ld(&bar[XB_TOPGEN]) == tg, bar);
            __builtin_amdgcn_fence(__ATOMIC_ACQUIRE, "agent");
            xb_add(&bar[XB_XGEN(b.x)], 1u);
            asm volatile("s_waitcnt vmcnt(0)" ::: "memory");
        } else {
            XB_SPIN(xb_ld(&bar[XB_XGEN(b.x)]) == gen, bar);
            __builtin_amdgcn_fence(__ATOMIC_ACQUIRE, "agent");
            asm volatile("s_waitcnt vmcnt(0)" ::: "memory");
        }
    }
    __syncthreads();
}
constexpr int D = 1024, NB = 8, SEQ = 8192, CTXL = 256, TB = SEQ + CTXL, M = NB * TB;
constexpr int EV_IN = 3072, OD_IN = 2560, DFF = 3584, NE = 8, NLAYER = 4;
constexpr int NPANEL = M / 256;
constexpr int PW = 280, MAXP = 536;
constexpr float EPS = 1e-6f;
constexpr size_t MiB = 1u << 20;
constexpr size_t WS_CTL = 0, CTL_ZERO_BYTES = 1 * MiB;
constexpr size_t WS_MOD = 1 * MiB;
constexpr size_t WS_ROPE_R = 2 * MiB, WS_ROPE_D = 2 * MiB + 65536;
constexpr size_t WS_ROUTE = 3 * MiB;
constexpr size_t WS_WGCNT = 5 * MiB;
constexpr size_t WS_PEXP = 5 * MiB + 65536;
constexpr size_t WS_LIST = 6 * MiB;
constexpr size_t WS_W = 20 * MiB;
constexpr size_t WS_X = 116 * MiB;
constexpr size_t WS_H = 248 * MiB;
constexpr size_t WS_Y = 380 * MiB;
constexpr size_t WS_BIG = 644 * MiB;
constexpr size_t WS_W2 = 1044 * MiB;
constexpr size_t WS_END = 1128 * MiB;
constexpr size_t W_IN = 0, W_OUT = 6 * MiB, W_GU = 8 * MiB, W_DN = 16 * MiB;
constexpr size_t W_GLU = 8 * MiB;
constexpr size_t W2_MGU = 0, W2_MDN = 56 * MiB;
constexpr size_t Y_SLOT = (size_t)M * 1024 * 2;
constexpr size_t T_HALF = (size_t)M * 512 * 2;
constexpr size_t T_QUART = (size_t)M * 256 * 2;
constexpr size_t BIG_ACT = 0, BIG_HG = 246 * MiB;
constexpr int CW_TMO = 0, CW_BAR = 4096;
constexpr int RING_BYTES = 131072, LDSCTL_OFF = RING_BYTES + 8192, MISC_OFF = LDSCTL_OFF + 320, LDS_BYTES = 147456;
typedef unsigned short bf16;
typedef unsigned v4u __attribute__((ext_vector_type(4)));
typedef unsigned v2u __attribute__((ext_vector_type(2)));
typedef float f32x4 __attribute__((ext_vector_type(4)));
typedef float f32x16 __attribute__((ext_vector_type(16)));
typedef short bf16x8 __attribute__((ext_vector_type(8)));
typedef short s16x4 __attribute__((ext_vector_type(4)));
#define RLX_AGENT __ATOMIC_RELAXED, __HIP_MEMORY_SCOPE_AGENT
using pg8::cvt_pk_bf16; using pg8::bflo; using pg8::bfhi; using pg8::RouteEnt;
struct RouteRow { int e1, e2; float p1, p2; };
__device__ __forceinline__ float bf2f(bf16 v) { return __uint_as_float((unsigned)v << 16); }
__device__ __forceinline__ float wave_sum(float v) {
#define DPP_ADD(ctrl, rmask) v += __builtin_bit_cast(float, __builtin_amdgcn_update_dpp(0, __builtin_bit_cast(int, v), (ctrl), (rmask), 0xF, false))
    DPP_ADD(0xB1, 0xF); DPP_ADD(0x4E, 0xF); DPP_ADD(0x141, 0xF); DPP_ADD(0x140, 0xF); DPP_ADD(0x142, 0xA); DPP_ADD(0x143, 0xC);
#undef DPP_ADD
    return __builtin_bit_cast(float, __builtin_amdgcn_readlane(__builtin_bit_cast(int, v), 63));
}
__device__ __forceinline__ float gelu_tanh(float x) {
    const float u = 0.7978845608028654f * (x + 0.044715f * x * x * x);
    return x * __builtin_amdgcn_rcpf(1.0f + __builtin_amdgcn_exp2f(-2.0f * 1.4426950408889634f * u));
}
__device__ __forceinline__ float sigmoidf_(float x) { return __builtin_amdgcn_rcpf(1.0f + __builtin_amdgcn_exp2f(-1.4426950408889634f * x)); }
struct Args { const float* in[38]; float* out; unsigned char* ws; int ph_lo, ph_hi, mode, pad; };
struct ArgsI { unsigned long long in[38]; unsigned long long out, ws; int ph_lo, ph_hi, mode, pad; };
typedef __attribute__((address_space(4))) const ArgsI KArgs;
#define INP(k) ((const float*)(GAS const float*)F.A->in[k])
#define OUTP ((float*)(GAS float*)F.A->out)
#define WSG ((unsigned char*)(GAS unsigned char*)F.wsi)
#define FMOD ((float*)(WSG + WS_MOD))
#define FX ((bf16*)(WSG + WS_X))
#define FH ((bf16*)(WSG + WS_H))
#define FWB ((bf16*)(WSG + WS_W))
#define FYB (WSG + WS_Y)
#define FBIG (WSG + WS_BIG)
#define LAUNDER(F) do { asm volatile("" : "+s"(F.wsi), "+s"(F.A), "+s"(F.wave), "+s"(F.bid), "+s"(F.G)); { unsigned z_ = 0u; asm volatile("" : "+v"(z_)); F.lane = (int)__builtin_amdgcn_mbcnt_hi(~0u, __builtin_amdgcn_mbcnt_lo(~0u, z_)); } F.tid = F.wave * 64 + F.lane; } while (0)
__device__ __forceinline__ bool lead0_lane() { unsigned z_ = 0u; asm volatile("" : "+v"(z_)); return __builtin_amdgcn_mbcnt_hi(~0u, __builtin_amdgcn_mbcnt_lo(~0u, z_)) == 0u; }
#define LEAD0(F) ((F).wave == 0 && lead0_lane())
struct Frame {
    LAS unsigned char* lds; unsigned long long wsi;
    int tid, lane, wave, G, bid;
    const KArgs* A;
};
#define LDS_WAIT() asm volatile("s_waitcnt lgkmcnt(0)" ::: "memory")

__device__ __forceinline__ void ph_prologue(Frame& F) {
    LAS float* SL = (LAS float*)F.lds;
    LAS float* RED = (LAS float*)(F.lds + 40960);
    const float* c = INP(1); const float* cc = INP(3); const float* mod_w = INP(4); const float* mod_b = INP(5);
    for (int i = F.tid; i < 9 * 1024; i += 512) { const float v = (i < 8192) ? c[i] : cc[i - 8192]; SL[i] = v * sigmoidf_(v); }
    __syncthreads();
    for (int blk = F.bid; blk < 4 * 96; blk += F.G) {
        const int l = blk / 96, n0 = (blk % 96) * 64;
        const float* wp = mod_w + ((size_t)l * 1024 + (size_t)F.wave * 128) * 6144 + n0 + F.lane;
        float acc[9];
#pragma unroll
        for (int j = 0; j < 9; ++j) acc[j] = 0.f;
        for (int k = 0; k < 128; ++k) { const float w = wp[(size_t)k * 6144];
#pragma unroll
            for (int j = 0; j < 9; ++j) acc[j] += SL[j * 1024 + F.wave * 128 + k] * w; }
#pragma unroll
        for (int j = 0; j < 9; ++j) RED[(F.wave * 9 + j) * 64 + F.lane] = acc[j];
        __syncthreads();
        for (int i = F.tid; i < 9 * 64; i += 512) { const int j = i >> 6, ln = i & 63; float s = mod_b[l * 6144 + n0 + ln];
#pragma unroll
            for (int w = 0; w < 8; ++w) s += RED[(w * 9 + j) * 64 + ln];
            FMOD[((size_t)l * 9 + j) * 6144 + n0 + ln] = s; }
        __syncthreads();
    }
    const int gt = F.bid * 512 + F.tid;
    if (gt < 128 * 32) { const int pos = gt >> 5, dq = gt & 31; const float inv = powf(10000.0f, -(float)dq / 32.0f); float s, cs; sincosf((float)pos * inv, &s, &cs);
        float* T = (float*)(WSG + WS_ROPE_R); T[gt * 2] = cs; T[gt * 2 + 1] = s; }
    else if (gt < 128 * 32 + 128 * 16) { const int g2 = gt - 128 * 32, pos = g2 >> 4, dq = g2 & 15; const float inv = powf(10000.0f, -(float)dq / 16.0f); float s, cs; sincosf((float)pos * inv, &s, &cs);
        float* T = (float*)(WSG + WS_ROPE_D); T[g2 * 2] = cs; T[g2 * 2 + 1] = s; }
}

__device__ __forceinline__ void transpose_item(const float* W, int K, int N, bf16* WT, int drow0, int k0, int n0, LAS float* scr, int lane) {
#pragma unroll
    for (int i = 0; i < 8; ++i) { const int kk = 8 * i + (lane >> 3), nn = (lane & 7) * 4; const f32x4 v = *(const f32x4*)(W + (size_t)(k0 + kk) * N + n0 + nn);
        scr[kk * 33 + nn] = v.x; scr[kk * 33 + nn + 1] = v.y; scr[kk * 33 + nn + 2] = v.z; scr[kk * 33 + nn + 3] = v.w; }
    LDS_WAIT(); asm volatile("" ::: "memory");
    const int c = lane & 7;
#pragma unroll
    for (int j = 0; j < 4; ++j) { const int n = (lane >> 3) + 8 * j; const LAS float* s = scr + (8 * c) * 33 + n;
        v4u o; o.x = cvt_pk_bf16(s[0 * 33], s[1 * 33]); o.y = cvt_pk_bf16(s[2 * 33], s[3 * 33]); o.z = cvt_pk_bf16(s[4 * 33], s[5 * 33]); o.w = cvt_pk_bf16(s[6 * 33], s[7 * 33]);
        *(v4u*)(WT + (size_t)(drow0 + n) * K + k0 + 8 * c) = o; }
    LDS_WAIT(); asm volatile("" ::: "memory");
}
__device__ __forceinline__ void convert_job(Frame& F, const float* W, int K, int N, bf16* WT, int mode) {
    LAS float* scr = (LAS float*)(F.lds + F.wave * 16384);
    const int gw = F.bid * 8 + F.wave, NGW = F.G * 8, nblk = N / 32, nit = (K / 64) * nblk;
    for (int it = gw; it < nit; it += NGW) { const int kb = it / nblk, nb = it % nblk, n0 = nb * 32;
        int drow0 = n0;
        if (mode == 1 || mode == 2) drow0 = (n0 >> 7) * 256 + (n0 & 127) + (mode == 2 ? 128 : 0);
        else if (mode == 3) { const int tile = n0 >> 8, w = n0 & 255; if (tile >= 4 && tile < 8) drow0 = tile * 256 + ((w >> 6) & 1) * 128 + (w >> 7) * 64 + (w & 63); }
        else if (mode == 4) { const int tile = n0 >> 8, w = n0 & 255; if (tile >= 1 && tile < 7) drow0 = tile * 256 + ((w >> 5) & 1) * 128 + (w >> 6) * 32 + (w & 31); }
        transpose_item(W, K, N, WT, drow0, kb * 64, n0, scr, F.lane); }
}
__device__ __forceinline__ void transpose_item_f8(const float* W, int K, int N, unsigned char* WT, int drow0, int k0, int n0, LAS float* scr, int lane, float wscale) {
#pragma unroll
    for (int i = 0; i < 8; ++i) { const int kk = 8 * i + (lane >> 3), nn = (lane & 7) * 4; const f32x4 v = *(const f32x4*)(W + (size_t)(k0 + kk) * N + n0 + nn);
        scr[kk * 33 + nn] = v.x * wscale; scr[kk * 33 + nn + 1] = v.y * wscale; scr[kk * 33 + nn + 2] = v.z * wscale; scr[kk * 33 + nn + 3] = v.w * wscale; }
    LDS_WAIT(); asm volatile("" ::: "memory");
#pragma unroll
    for (int j = 0; j < 2; ++j) { const int idx = lane + 64 * j, n = idx >> 2, c = idx & 3; const LAS float* s = scr + (16 * c) * 33 + n;
        v4u o; o.x = pg8::pk4_fp8(s[0 * 33], s[1 * 33], s[2 * 33], s[3 * 33]); o.y = pg8::pk4_fp8(s[4 * 33], s[5 * 33], s[6 * 33], s[7 * 33]);
        o.z = pg8::pk4_fp8(s[8 * 33], s[9 * 33], s[10 * 33], s[11 * 33]); o.w = pg8::pk4_fp8(s[12 * 33], s[13 * 33], s[14 * 33], s[15 * 33]);
        *(v4u*)(WT + (size_t)(drow0 + n) * K + k0 + 16 * c) = o; }
    LDS_WAIT(); asm volatile("" ::: "memory");
}
constexpr float W8_SCALE = 32.0f, W8_INV = 1.0f / 32.0f;
__device__ __forceinline__ void convert_job_f8(Frame& F, const float* W, int K, int N, unsigned char* WT, int mode, int wg0 = 0, int nwg = 0) {
    LAS float* scr = (LAS float*)(F.lds + F.wave * 16384);
    const int gw = (F.bid - wg0) * 8 + F.wave, NGW = (nwg ? nwg : F.G) * 8, nblk = N / 32, nit = (K / 64) * nblk;
    for (int it = gw; it < nit; it += NGW) { const int kb = it / nblk, nb = it % nblk, n0 = nb * 32;
        int drow0 = n0;
        if (mode == 1 || mode == 2) drow0 = (n0 >> 7) * 256 + (n0 & 127) + (mode == 2 ? 128 : 0);
        transpose_item_f8(W, K, N, WT, drow0, kb * 64, n0, scr, F.lane, W8_SCALE); }
}
__device__ __forceinline__ void ph_convert_moe(Frame& F, int i, int wg0, int nwg, int e0 = 0, int e1 = NE) {
    unsigned char* W2 = WSG + WS_W2;
    for (int e = e0; e < e1; ++e) {
        convert_job_f8(F, INP(35) + ((size_t)i * NE + e) * D * DFF, D, DFF, W2 + W2_MGU + (size_t)e * 7168 * 1024, 1, wg0, nwg);
        convert_job_f8(F, INP(36) + ((size_t)i * NE + e) * D * DFF, D, DFF, W2 + W2_MGU + (size_t)e * 7168 * 1024, 2, wg0, nwg);
        convert_job_f8(F, INP(37) + ((size_t)i * NE + e) * DFF * D, DFF, D, W2 + W2_MDN + (size_t)e * 1024 * 3584, 0, wg0, nwg);
    }
}
__device__ __forceinline__ void ph_convert(Frame& F, int l) {
    const int i = l >> 1; bf16* Wb = FWB;
    if ((l & 1) == 0) {
        convert_job(F, INP(7) + (size_t)i * D * EV_IN, D, EV_IN, Wb + W_IN / 2, 3);
        convert_job(F, INP(15) + (size_t)i * D * D, D, D, Wb + W_OUT / 2, 0);
        convert_job_f8(F, INP(16) + (size_t)i * D * DFF, D, DFF, (unsigned char*)Wb + W_GU, 1);
        convert_job_f8(F, INP(17) + (size_t)i * D * DFF, D, DFF, (unsigned char*)Wb + W_GU, 2);
        convert_job_f8(F, INP(18) + (size_t)i * DFF * D, DFF, D, (unsigned char*)Wb + W_DN, 0);
    } else {
        convert_job(F, INP(19) + (size_t)i * D * OD_IN, D, OD_IN, Wb + W_IN / 2, 4);
        convert_job(F, INP(32) + (size_t)i * D * D, D, D, Wb + W_OUT / 2, 0);
        convert_job(F, INP(28) + (size_t)i * 256 * 256, 256, 256, Wb + W_GLU / 2, 0);
    }
}

struct NormArgs {
    int xin_input, has_y, two, write_x, final_, do_h, do_route, h8;
    const float* gate; const float* gy;
    const float* gh; const float* shift; const float* scale;
    const float* rw; const float* rb;
};
__device__ __forceinline__ void ph_norm(Frame& F, const NormArgs& a) {
    LAS float* RWT = (LAS float*)F.lds;
    LAS int* cnt = (LAS int*)(F.lds + 32768);
    if (a.do_route) {
        for (int idx = F.tid; idx < 8192; idx += 512) RWT[(idx & 7) * 1024 + (idx >> 3)] = a.rw[idx];
        if (F.tid < 8) cnt[F.tid] = 0;
        __syncthreads();
    }
    const int r0 = (int)((long)M * F.bid / F.G), r1 = (int)((long)M * (F.bid + 1) / F.G);
    const bf16* Y0 = (const bf16*)FYB; const bf16* Y1 = (const bf16*)(FYB + Y_SLOT);
    const int c0 = 4 * F.lane;
    f32x4 pgy[4], pgh[4], pgt[4], psh[4], psc[4]; int cur_midx = -1;
#pragma unroll
    for (int j = 0; j < 4; ++j) { pgy[j] = a.has_y ? *(const f32x4*)(a.gy + c0 + 256 * j) : (f32x4){0.f, 0.f, 0.f, 0.f}; pgh[j] = a.do_h ? *(const f32x4*)(a.gh + c0 + 256 * j) : (f32x4){0.f, 0.f, 0.f, 0.f};
        pgt[j] = (f32x4){0.f, 0.f, 0.f, 0.f}; psh[j] = pgt[j]; psc[j] = pgt[j]; }
    f32x4 xn[4]; v2u xb[4], yn[4], zn[4];
#pragma unroll
    for (int j = 0; j < 4; ++j) { xn[j] = (f32x4){0.f, 0.f, 0.f, 0.f}; xb[j] = (v2u){0u, 0u}; yn[j] = (v2u){0u, 0u}; zn[j] = (v2u){0u, 0u}; }
#define NORM_LOAD(mm) do { const int b_ = (mm) / TB, t_ = (mm) - b_ * TB; const bool ic_ = t_ < CTXL; \
        if (a.xin_input) { const float* xi_ = ic_ ? (INP(2) + (size_t)(b_ * CTXL + t_) * D) : (INP(0) + (size_t)(b_ * SEQ + t_ - CTXL) * D); \
            _Pragma("unroll") for (int j = 0; j < 4; ++j) xn[j] = *(const f32x4*)(xi_ + c0 + 256 * j); } \
        else { _Pragma("unroll") for (int j = 0; j < 4; ++j) xb[j] = *(const v2u*)(FX + (size_t)(mm) * D + c0 + 256 * j); } \
        _Pragma("unroll") for (int j = 0; j < 4; ++j) { \
            if (a.has_y) yn[j] = *(const v2u*)(Y0 + (size_t)(mm) * D + c0 + 256 * j); if (a.two) zn[j] = *(const v2u*)(Y1 + (size_t)(mm) * D + c0 + 256 * j); } } while (0)
    int m = r0 + F.wave;
    if (m < r1) NORM_LOAD(m);
    for (; m < r1; m += 8) {
        const int b = m / TB, t = m - b * TB; const bool isctx = t < CTXL; const int midx = isctx ? 8 : b;
        f32x4 x[4]; v2u yv[4], zv[4];
#pragma unroll
        for (int j = 0; j < 4; ++j) { x[j] = a.xin_input ? xn[j] : (f32x4){bflo(xb[j].x), bfhi(xb[j].x), bflo(xb[j].y), bfhi(xb[j].y)}; yv[j] = yn[j]; zv[j] = zn[j]; }
        if (m + 8 < r1) NORM_LOAD(m + 8);
        if (midx != cur_midx) { cur_midx = midx;
#pragma unroll
            for (int j = 0; j < 4; ++j) { if (a.has_y) pgt[j] = *(const f32x4*)(a.gate + (size_t)midx * 6144 + c0 + 256 * j);
                if (a.do_h) { psh[j] = *(const f32x4*)(a.shift + (size_t)midx * 6144 + c0 + 256 * j); psc[j] = *(const f32x4*)(a.scale + (size_t)midx * 6144 + c0 + 256 * j); } } }
        if (a.has_y) {
            f32x4 y[4]; float ss = 0.f;
#pragma unroll
            for (int j = 0; j < 4; ++j) { y[j] = (f32x4){bflo(yv[j].x), bfhi(yv[j].x), bflo(yv[j].y), bfhi(yv[j].y)};
                if (a.two) y[j] += (f32x4){bflo(zv[j].x), bfhi(zv[j].x), bflo(zv[j].y), bfhi(zv[j].y)};
                ss += (y[j].x * y[j].x + y[j].y * y[j].y) + (y[j].z * y[j].z + y[j].w * y[j].w); }
            const float rs = 1.0f / sqrtf(wave_sum(ss) * (1.0f / D) + EPS);
#pragma unroll
            for (int j = 0; j < 4; ++j) x[j] += pgt[j] * (y[j] * rs * pgy[j]);
        }
        if (a.final_) { if (!isctx) { float* o_ = OUTP + (size_t)(b * SEQ + t - CTXL) * D;
#pragma unroll
            for (int j = 0; j < 4; ++j) *(f32x4*)(o_ + c0 + 256 * j) = x[j]; } }
        else if (a.write_x) {
#pragma unroll
            for (int j = 0; j < 4; ++j) { v2u w_; w_.x = cvt_pk_bf16(x[j].x, x[j].y); w_.y = cvt_pk_bf16(x[j].z, x[j].w); *(v2u*)(FX + (size_t)m * D + c0 + 256 * j) = w_; }
        }
        if (a.do_h) {
            float ss = 0.f;
#pragma unroll
            for (int j = 0; j < 4; ++j) ss += (x[j].x * x[j].x + x[j].y * x[j].y) + (x[j].z * x[j].z + x[j].w * x[j].w);
            const float rs = 1.0f / sqrtf(wave_sum(ss) * (1.0f / D) + EPS);
            f32x4 h[4];
#pragma unroll
            for (int j = 0; j < 4; ++j) { h[j] = (x[j] * rs * pgh[j]) * (psc[j] + 1.0f) + psh[j];
                if (a.h8) *(unsigned*)((unsigned char*)FH + (size_t)m * D + c0 + 256 * j) = pg8::pk4_fp8(h[j].x, h[j].y, h[j].z, h[j].w);
                else { v2u w; w.x = cvt_pk_bf16(h[j].x, h[j].y); w.y = cvt_pk_bf16(h[j].z, h[j].w); *(v2u*)(FH + (size_t)m * D + c0 + 256 * j) = w; } }
            if (a.do_route) {
                float lg[8];
#pragma unroll
                for (int e = 0; e < 8; ++e) { float s = 0.f;
#pragma unroll
                    for (int j = 0; j < 4; ++j) { const f32x4 w = *(const LAS f32x4*)(RWT + e * 1024 + c0 + 256 * j); s += (h[j].x * w.x + h[j].y * w.y) + (h[j].z * w.z + h[j].w * w.w); }
                    lg[e] = wave_sum(s) + a.rb[e]; }
                int e1 = 0; float v1 = lg[0];
#pragma unroll
                for (int e = 1; e < 8; ++e) if (lg[e] > v1) { v1 = lg[e]; e1 = e; }
                int e2 = -1; float v2 = -3.0e38f;
#pragma unroll
                for (int e = 0; e < 8; ++e) if (e != e1 && lg[e] > v2) { v2 = lg[e]; e2 = e; }
                const float p1 = 1.0f / (1.0f + expf(v2 - v1));
                if (F.lane == 0) { RouteRow rr; rr.e1 = e1; rr.e2 = e2; rr.p1 = p1; rr.p2 = 1.0f - p1; ((RouteRow*)(WSG + WS_ROUTE))[m] = rr;
                    atomicAdd((int*)&cnt[e1], 1); atomicAdd((int*)&cnt[e2], 1); }
            }
        }
    }
#undef NORM_LOAD
    if (a.do_route) { __syncthreads(); if (F.tid < 8) ((int*)(WSG + WS_WGCNT))[F.bid * 8 + F.tid] = cnt[F.tid]; }
}

__device__ __forceinline__ void ph_assign(Frame& F) {
    LAS int* part = (LAS int*)F.lds;
    LAS int* tot = (LAS int*)(F.lds + 32768);
    const int* WC = (const int*)(WSG + WS_WGCNT);
    int st[8], sb[8];
#pragma unroll
    for (int e = 0; e < 8; ++e) { st[e] = 0; sb[e] = 0; }
    for (int w = F.tid; w < F.G; w += 512) {
#pragma unroll
        for (int e = 0; e < 8; ++e) { const int c = WC[w * 8 + e]; st[e] += c; if (w < F.bid) sb[e] += c; } }
    if (F.tid < 32) tot[F.tid] = 0;
    __syncthreads();
#pragma unroll
    for (int e = 0; e < 8; ++e) { if (st[e]) atomicAdd((int*)&tot[e], st[e]); if (sb[e]) atomicAdd((int*)&tot[8 + e], sb[e]); }
    __syncthreads();
    if (F.tid == 0) { int o = 0; for (int e = 0; e < 8; ++e) { tot[16 + e] = o; o += (tot[e] + 255) & ~255; }
        if (F.bid == 0) { int* PE = (int*)(WSG + WS_PEXP); int p = 0; for (int e = 0; e < 8; ++e) { const int np = (tot[e] + 255) >> 8; for (int q = 0; q < np; ++q) PE[p++] = e; } PE[MAXP] = p; } }
    __syncthreads();
    RouteEnt* L = (RouteEnt*)(WSG + WS_LIST);
    if (F.bid == 0) {
        for (int e = 0; e < 8; ++e) { const int lo = tot[16 + e] + tot[e], hi = tot[16 + e] + ((tot[e] + 255) & ~255);
            for (int p = lo + F.tid; p < hi; p += 512) { RouteEnt z; z.tok = -1; z.slot = 0; z.w = 0.f; z.pad = 0; L[p] = z; } }
    }
    const RouteRow* RR = (const RouteRow*)(WSG + WS_ROUTE);
    const int r0 = (int)((long)M * F.bid / F.G), r1 = (int)((long)M * (F.bid + 1) / F.G);
    for (int m = r0 + F.tid; m < r1; m += 512) { const RouteRow rr = RR[m];
        { const int p = tot[16 + rr.e1] + tot[8 + rr.e1] + atomicAdd((int*)&tot[24 + rr.e1], 1); RouteEnt z; z.tok = m; z.slot = 0; z.w = rr.p1; z.pad = 0; L[p] = z; }
        { const int p = tot[16 + rr.e2] + tot[8 + rr.e2] + atomicAdd((int*)&tot[24 + rr.e2], 1); RouteEnt z; z.tok = m; z.slot = 1; z.w = rr.p2; z.pad = 0; L[p] = z; } }
}
__device__ __forceinline__ void ph_gather(Frame& F, int p0, int p1) {
    const RouteEnt* L = (const RouteEnt*)(WSG + WS_LIST); unsigned char* HG = FBIG + BIG_HG; const unsigned char* H8 = (const unsigned char*)FH;
    const int gw = F.bid * 8 + F.wave, NGW = F.G * 8, n = (p1 - p0) * 256;
    const int nit = gw < n ? (n - gw + NGW - 1) / NGW : 0;
    int mytok = -1; { const int rr = gw + F.lane * NGW; if (rr < n) mytok = L[(size_t)p0 * 256 + rr].tok; }
    for (int it = 0; it < nit; it += 4) { v4u a[4]; int tk[4];
#pragma unroll
        for (int u = 0; u < 4; ++u) { tk[u] = (it + u < nit) ? __builtin_amdgcn_readlane(mytok, it + u) : -2; a[u] = (v4u){0u, 0u, 0u, 0u}; }
#pragma unroll
        for (int u = 0; u < 4; ++u) if (tk[u] >= 0) a[u] = ((const v4u*)(H8 + (size_t)tk[u] * D))[F.lane];
#pragma unroll
        for (int u = 0; u < 4; ++u) if (tk[u] != -2) ((v4u*)(HG + (size_t)(gw + (it + u) * NGW) * D))[F.lane] = a[u]; }
}
__device__ __forceinline__ void rope8(v4u& a, v4u& b, const float* cs, float sc) {
    unsigned* pa = (unsigned*)&a; unsigned* pb = (unsigned*)&b;
#pragma unroll
    for (int k = 0; k < 4; ++k) {
        float x1l = bflo(pa[k]), x1h = bfhi(pa[k]), x2l = bflo(pb[k]), x2h = bfhi(pb[k]);
        float c0 = 1.f, s0 = 0.f, c1 = 1.f, s1 = 0.f;
        if (cs) { c0 = cs[4 * k]; s0 = cs[4 * k + 1]; c1 = cs[4 * k + 2]; s1 = cs[4 * k + 3]; }
        const float o1l = (x1l * c0 - x2l * s0) * sc, o2l = (x1l * s0 + x2l * c0) * sc, o1h = (x1h * c1 - x2h * s1) * sc, o2h = (x1h * s1 + x2h * c1) * sc;
        pa[k] = cvt_pk_bf16(o1l, o1h); pb[k] = cvt_pk_bf16(o2l, o2h);
    }
}
__device__ __forceinline__ void ph_rope(Frame& F, int odd) {
    const int gw = F.bid * 8 + F.wave, NGW = F.G * 8;
    bf16* Z = (bf16*)FBIG;
    if (!odd) {
        const float* T = (const float*)(WSG + WS_ROPE_R);
        const int tensor = F.lane >> 5, head = (F.lane >> 3) & 3, d0 = (F.lane & 7) * 8;
        const float sc = tensor ? 0.08838834764831845f : 1.0f;
        for (int m = gw; m < M; m += NGW) { const int t = m % TB;
            bf16* p = Z + (size_t)m * EV_IN + 1024 + tensor * 512 + head * 128 + d0;
            v4u a = *(v4u*)p, b = *(v4u*)(p + 64);
            if (t >= CTXL) { const int tl = t - CTXL, pos = d0 < 32 ? (tl >> 6) : (tl & 63), dq = d0 & 31; rope8(a, b, T + (pos * 32 + dq) * 2, sc); }
            else { if (!tensor) continue; rope8(a, b, nullptr, sc); }
            *(v4u*)p = a; *(v4u*)(p + 64) = b; }
    } else {
        const float* T = (const float*)(WSG + WS_ROPE_D);
        for (int m = gw; m < M; m += NGW) { const int t = m % TB; if (t < CTXL) continue;
            const int tl = t - CTXL;
            for (int it = F.lane; it < 96; it += 64) { const int tensor = it / 48, r = it % 48, hm = r >> 2, d0 = (r & 3) * 8;
                bf16* p = Z + (size_t)m * OD_IN + 256 + tensor * 768 + hm * 64 + d0;
                v4u a = *(v4u*)p, b = *(v4u*)(p + 32);
                const int pos = d0 < 16 ? (tl >> 6) : (tl & 63), dq = d0 & 15; rope8(a, b, T + (pos * 16 + dq) * 2, 1.0f);
                *(v4u*)p = a; *(v4u*)(p + 32) = b; } }
    }
}
__device__ __forceinline__ void unpack8(const v4u& w, float* f) { f[0] = bflo(w.x); f[1] = bfhi(w.x); f[2] = bflo(w.y); f[3] = bfhi(w.y); f[4] = bflo(w.z); f[5] = bfhi(w.z); f[6] = bflo(w.w); f[7] = bfhi(w.w); }
__device__ __forceinline__ v4u pack8(const float* f) { v4u w; w.x = cvt_pk_bf16(f[0], f[1]); w.y = cvt_pk_bf16(f[2], f[3]); w.z = cvt_pk_bf16(f[4], f[5]); w.w = cvt_pk_bf16(f[6], f[7]); return w; }
__device__ __forceinline__ void ph_merge_even(Frame& F, int i) {
    const int gw = F.bid * 8 + F.wave, NGW = F.G * 8;
    const bf16* Z = (const bf16*)FBIG; const bf16* HF = (const bf16*)FYB; const bf16* HB = (const bf16*)(FYB + T_HALF);
    const bf16* RF = (const bf16*)(FYB + 2 * T_HALF); const bf16* RB = (const bf16*)(FYB + 3 * T_HALF);
    const float* gn = INP(14) + (size_t)i * 512; const int c0 = 8 * F.lane;
    float gnv[8];
#pragma unroll
    for (int k = 0; k < 8; ++k) gnv[k] = gn[c0 + k];
    for (int m = gw; m < M; m += NGW) {
        float a[8], b[8], g[8], o[8];
        unpack8(*(const v4u*)(HF + (size_t)m * 512 + c0), a); unpack8(*(const v4u*)(HB + (size_t)m * 512 + c0), b); unpack8(*(const v4u*)(Z + (size_t)m * EV_IN + 512 + c0), g);
#pragma unroll
        for (int k = 0; k < 8; ++k) o[k] = (a[k] + b[k]) * gelu_tanh(g[k]);
        *(v4u*)(FH + (size_t)m * D + c0) = pack8(o);
        unpack8(*(const v4u*)(RF + (size_t)m * 512 + c0), a); unpack8(*(const v4u*)(RB + (size_t)m * 512 + c0), b); unpack8(*(const v4u*)(Z + (size_t)m * EV_IN + 2560 + c0), g);
        float s = 0.f;
#pragma unroll
        for (int k = 0; k < 8; ++k) { a[k] += b[k]; s += a[k]; }
        s += __shfl_xor(s, 1); s += __shfl_xor(s, 2); s += __shfl_xor(s, 4); s += __shfl_xor(s, 8);
        const float mean = s * (1.0f / 128.0f); float q = 0.f;
#pragma unroll
        for (int k = 0; k < 8; ++k) { a[k] -= mean; q += a[k] * a[k]; }
        q += __shfl_xor(q, 1); q += __shfl_xor(q, 2); q += __shfl_xor(q, 4); q += __shfl_xor(q, 8);
        const float rs = 1.0f / sqrtf(q * (1.0f / 128.0f) + EPS);
#pragma unroll
        for (int k = 0; k < 8; ++k) o[k] = a[k] * rs * gnv[k] * (g[k] * sigmoidf_(g[k]));
        *(v4u*)(FH + (size_t)m * D + 512 + c0) = pack8(o);
    }
}
__device__ __forceinline__ void ph_zpass(Frame& F, int i) {
    const int gw = F.bid * 8 + F.wave, NGW = F.G * 8;
    const bf16* ZI = (const bf16*)FBIG; const bf16* YF = (const bf16*)FYB; const bf16* YB = (const bf16*)(FYB + T_QUART); bf16* ZO = (bf16*)(FYB + 2 * T_QUART);
    const float* dsk = INP(27) + (size_t)i * 256; const int c0 = 4 * F.lane;
    const f32x4 dv = *(const f32x4*)(dsk + c0);
    for (int m = gw; m < M; m += NGW) {
        const v2u a = *(const v2u*)(YF + (size_t)m * 256 + c0), b = *(const v2u*)(YB + (size_t)m * 256 + c0), u = *(const v2u*)(ZI + (size_t)m * OD_IN + c0);
        const float y0 = bflo(a.x) + bflo(b.x) + dv.x * bflo(u.x), y1 = bfhi(a.x) + bfhi(b.x) + dv.y * bfhi(u.x), y2 = bflo(a.y) + bflo(b.y) + dv.z * bflo(u.y), y3 = bfhi(a.y) + bfhi(b.y) + dv.w * bfhi(u.y);
        v2u w; w.x = cvt_pk_bf16(gelu_tanh(y0), gelu_tanh(y1)); w.y = cvt_pk_bf16(gelu_tanh(y2), gelu_tanh(y3));
        *(v2u*)(ZO + (size_t)m * 256 + c0) = w; }
}

constexpr size_t VT_OFF = 128 * MiB, K8_OFF = 180 * MiB;
constexpr size_t Q8_OFF = 332 * MiB;
__device__ __forceinline__ void ph_vt(Frame& F) {
    LAS bf16* T = (LAS bf16*)(F.lds + F.wave * 17408);
    const bf16* Z = (const bf16*)FBIG; unsigned char* VT = FYB + VT_OFF;
    const int gw = F.bid * 8 + F.wave, NGW = F.G * 8, lane = F.lane;
    for (int it = gw; it < NB * 6 * 132; it += NGW) { const int bh = it / 132, t = it % 132, b = bh / 6, h = bh % 6;
        const bf16* src = Z + ((size_t)b * TB + 64 * t) * OD_IN + 1792 + h * 128;
#pragma unroll
        for (int i = 0; i < 16; ++i) { const int row = i * 4 + (lane >> 4), ch = lane & 15; *(LAS v4u*)(T + row * 136 + ch * 8) = *(const v4u*)(src + (size_t)row * OD_IN + ch * 8); }
        LDS_WAIT(); asm volatile("" ::: "memory");
        unsigned char* dst = VT + (size_t)it * 8192;
#pragma unroll
        for (int rr = 0; rr < 2; ++rr) { const int d = lane + 64 * rr;
#pragma unroll
            for (int q = 0; q < 4; ++q) { unsigned w[4];
#pragma unroll
                for (int k = 0; k < 4; ++k) { float v[4];
#pragma unroll
                    for (int e = 0; e < 4; ++e) { const int beta = q * 16 + k * 4 + e, i2 = beta & 31, hh = beta >> 5, key = ((i2 & 15) & 3) + 8 * ((i2 & 15) >> 2) + 4 * hh + 32 * (i2 >> 4); v[e] = bf2f(T[key * 136 + d]); }
                    w[k] = pg8::pk4_fp8(v[0], v[1], v[2], v[3]); }
                *(v4u*)(dst + d * 64 + q * 16) = (v4u){w[0], w[1], w[2], w[3]}; } }
        LDS_WAIT(); asm volatile("" ::: "memory");
    }
}
__device__ __forceinline__ int chunk_tlo(int dir, int c) { return dir == 0 ? 128 * c : (c < 2 ? 128 * (1 - c) : 8576 - 128 * c); }

__device__ __forceinline__ void lru_item(Frame& F, int i, int b, int dir, int blk) {
    LAS unsigned char* lds = F.lds;
    LAS float* UR = (LAS float*)(lds);
    LAS float* AA = (LAS float*)(lds + 98304);
    LAS float* U = (LAS float*)(lds + 36864);
    LAS float* BB = U;
    LAS bf16* UB = (LAS bf16*)(lds + 69632);
    LAS float* SEG = (LAS float*)(lds + 88064);
    LAS float* PRM = (LAS float*)(lds + 92160);
    const int tid = F.tid, lane = F.lane, wave = F.wave, ch = tid & 63, seg = tid >> 6;
    const bf16* Z = (const bf16*)FBIG; bf16* OUT = (bf16*)(FYB + (size_t)dir * T_HALF);
    const float* conv_w = INP(8) + (size_t)i * 4 * 512; const float* conv_b = INP(9) + (size_t)i * 512;
    const float* gate_w = INP(10) + (((size_t)i * 2 + dir) * 2) * 8 * 64 * 64;
    const float* gate_b = INP(11) + (((size_t)i * 2 + dir) * 2) * 512;
    const float* lam = INP(12) + ((size_t)i * 2 + dir) * 512;
    __syncthreads();
    if (tid < 64) { const int cg = blk * 64 + tid;
        PRM[0 * 64 + tid] = conv_w[0 * 512 + cg]; PRM[1 * 64 + tid] = conv_w[1 * 512 + cg]; PRM[2 * 64 + tid] = conv_w[2 * 512 + cg]; PRM[3 * 64 + tid] = conv_w[3 * 512 + cg];
        PRM[4 * 64 + tid] = conv_b[cg]; const float lm = lam[cg]; PRM[5 * 64 + tid] = -8.0f * 1.4426950408889634f * ((-lm > 20.f) ? -lm : log1pf(expf(-lm)));
        PRM[6 * 64 + tid] = -1.4426950408889634f * gate_b[cg]; PRM[7 * 64 + tid] = -1.4426950408889634f * gate_b[512 + cg]; }
    const int fr = lane & 15, fq = lane >> 4;
    bf16x8 wf[8][2];
#pragma unroll
    for (int nt = 0; nt < 8; ++nt)
#pragma unroll
        for (int ks = 0; ks < 2; ++ks) { const int col = 16 * nt + fr, gate = col >> 6, j = col & 63; const float* wp = gate_w + (((size_t)gate * 8 + blk) * 64 + (32 * ks + 8 * fq)) * 64 + j;
            v4u w; w.x = cvt_pk_bf16(wp[0], wp[64]); w.y = cvt_pk_bf16(wp[128], wp[192]); w.z = cvt_pk_bf16(wp[256], wp[320]); w.w = cvt_pk_bf16(wp[384], wp[448]);
            wf[nt][ks] = __builtin_bit_cast(bf16x8, w); }
    float carry = 0.f;
    const size_t rowbase = (size_t)b * TB;
    v4u pre[3];
#define LRU_LOAD(c_) do { const int tl_ = chunk_tlo(dir, (c_)), lo_ = tl_ < CTXL ? 0 : CTXL, hi_ = tl_ < CTXL ? CTXL : TB; \
        _Pragma("unroll") for (int n_ = 0; n_ < 3; ++n_) { const int it_ = tid + 512 * n_, r_ = it_ >> 3, cc_ = it_ & 7, t_ = tl_ - 2 + r_; \
            pre[n_] = (it_ < 131 * 8 && t_ >= lo_ && t_ < hi_) ? *(const v4u*)(Z + (rowbase + t_) * EV_IN + blk * 64 + cc_ * 8) : (v4u){0u, 0u, 0u, 0u}; } } while (0)
    LRU_LOAD(0);
    __syncthreads();
    for (int c = 0; c < 66; ++c) {
        const int t_lo = chunk_tlo(dir, c);
#pragma unroll
        for (int n = 0; n < 3; ++n) { const int it = tid + 512 * n; if (it < 131 * 8) { const int r = it >> 3, cc = it & 7; float f[8]; unpack8(pre[n], f);
            *(LAS f32x4*)(UR + r * 64 + cc * 8) = (f32x4){f[0], f[1], f[2], f[3]}; *(LAS f32x4*)(UR + r * 64 + cc * 8 + 4) = (f32x4){f[4], f[5], f[6], f[7]}; } }
        if (c + 1 < 66) LRU_LOAD(c + 1);
        __syncthreads();
        { const float w0 = PRM[ch], w1 = PRM[64 + ch], w2 = PRM[128 + ch], w3 = PRM[192 + ch], cb = PRM[256 + ch];
#pragma unroll 4
          for (int k = 0; k < 16; ++k) { const int r = seg * 16 + k; const float u = cb + w0 * UR[r * 64 + ch] + w1 * UR[(r + 1) * 64 + ch] + w2 * UR[(r + 2) * 64 + ch] + w3 * UR[(r + 3) * 64 + ch];
              U[r * 64 + ch] = u; UB[r * 72 + ch] = (bf16)(cvt_pk_bf16(u, 0.f) & 0xffffu); } }
        asm volatile("s_waitcnt lgkmcnt(0)" ::: "memory");
        { f32x4 acc[8];
#pragma unroll
          for (int nt = 0; nt < 8; ++nt) acc[nt] = (f32x4){0.f, 0.f, 0.f, 0.f};
          const bf16x8 a0 = *(const LAS bf16x8*)(UB + (16 * wave + fr) * 72 + 8 * fq), a1 = *(const LAS bf16x8*)(UB + (16 * wave + fr) * 72 + 32 + 8 * fq);
#pragma unroll
          for (int nt = 0; nt < 8; ++nt) { acc[nt] = __builtin_amdgcn_mfma_f32_16x16x32_bf16(a0, wf[nt][0], acc[nt], 0, 0, 0); acc[nt] = __builtin_amdgcn_mfma_f32_16x16x32_bf16(a1, wf[nt][1], acc[nt], 0, 0, 0); }
#pragma unroll
          for (int nt = 0; nt < 4; ++nt) { const int cch = 16 * nt + fr; const float br = PRM[6 * 64 + cch], bi = PRM[7 * 64 + cch], sp = PRM[5 * 64 + cch];
#pragma unroll
              for (int rg = 0; rg < 4; ++rg) { const int r = 16 * wave + 4 * fq + rg;
                  const float rgate = __builtin_amdgcn_rcpf(1.0f + __builtin_amdgcn_exp2f(fmaf(acc[nt][rg], -1.4426950408889634f, br))), igate = __builtin_amdgcn_rcpf(1.0f + __builtin_amdgcn_exp2f(fmaf(acc[nt + 4][rg], -1.4426950408889634f, bi)));
                  const float l2a = rgate * sp, av = __builtin_amdgcn_exp2f(l2a), x2 = 1.3862943611198906f * l2a;
                  const float om = (x2 > -0.25f) ? (-x2 * (1.0f + x2 * (0.5f + x2 * (0.16666667f + x2 * (0.041666668f + x2 * 0.0083333338f))))) : (1.0f - av * av);
                  const float bv = __builtin_amdgcn_sqrtf(om) * (igate * U[r * 64 + cch]);
                  AA[r * 64 + cch] = av; BB[r * 64 + cch] = bv; } } }
        __syncthreads();
        float hl[16], ca[16];
        { float h = 0.f, p = 1.f;
#pragma unroll
          for (int k = 0; k < 16; ++k) { const int ip = seg * 16 + k, r = dir == 0 ? ip : 127 - ip; const float av = AA[r * 64 + ch], bv = BB[r * 64 + ch]; h = av * h + bv; p *= av; hl[k] = h; ca[k] = p; }
          SEG[seg * 64 + ch] = p; SEG[512 + seg * 64 + ch] = h; }
        __syncthreads();
        float hin = carry, myin = 0.f;
#pragma unroll
        for (int s = 0; s < 8; ++s) { if (s == seg) myin = hin; hin = SEG[s * 64 + ch] * hin + SEG[512 + s * 64 + ch]; }
        carry = hin;
#pragma unroll
        for (int k = 0; k < 16; ++k) { const int ip = seg * 16 + k, r = dir == 0 ? ip : 127 - ip; const float h = hl[k] + ca[k] * myin;
            OUT[(rowbase + t_lo + r) * 512 + blk * 64 + ch] = (bf16)(cvt_pk_bf16(h, 0.f) & 0xffffu); }
    }
#undef LRU_LOAD
}
__device__ __forceinline__ unsigned off_b(unsigned row, unsigned ch) { return 256u * row + 16u * (ch ^ (((row & 3) << 2) | ((row >> 2) & 3))); }
__device__ __forceinline__ unsigned row_read_addr(unsigned lane, unsigned rb, unsigned s) { return off_b(32 * rb + (lane & 31), 2 * s + (lane >> 5)); }
__device__ __forceinline__ unsigned tr_read_addr(unsigned lane, unsigned c, unsigned ks, unsigned t) {
    const unsigned h = lane >> 5, blk = (lane >> 4) & 1, q = (lane & 15) >> 2, p = lane & 3;
    return off_b(16 * ks + 8 * h + 4 * t + q, 4 * c + 2 * blk + (p >> 1)) + 8 * (p & 1);
}
typedef short v4i16_t __attribute__((ext_vector_type(4)));
__device__ __forceinline__ bf16x8 tr_frag(LAS unsigned char* tile, unsigned lane, unsigned c, unsigned ks) {
    const s16x4 lo = __builtin_bit_cast(s16x4, __builtin_amdgcn_ds_read_tr16_b64_v4i16((LAS v4i16_t*)(tile + tr_read_addr(lane, c, ks, 0))));
    const s16x4 hi = __builtin_bit_cast(s16x4, __builtin_amdgcn_ds_read_tr16_b64_v4i16((LAS v4i16_t*)(tile + tr_read_addr(lane, c, ks, 1))));
    return (bf16x8){lo[0], lo[1], lo[2], lo[3], hi[0], hi[1], hi[2], hi[3]};
}
__device__ __forceinline__ bf16x8 row_frag(LAS unsigned char* tile, unsigned lane, unsigned rb, unsigned s) { return *(const LAS bf16x8*)(tile + row_read_addr(lane, rb, s)); }
#define MFMA32(a, b, c) __builtin_amdgcn_mfma_f32_32x32x16_bf16((a), (b), (c), 0, 0, 0)

constexpr unsigned RT_KB = 0, RT_T2 = 32768, RT_QB = 65536, RT_VB = 98304;
__device__ __forceinline__ s16x4 ds_tr(LAS unsigned char* p) { return __builtin_bit_cast(s16x4, __builtin_amdgcn_ds_read_tr16_b64_v4i16((LAS v4i16_t*)p)); }
#define TRF(base0, base1, off) ({ const s16x4 lo_ = ds_tr(F.lds + (base0) + (off)), hi_ = ds_tr(F.lds + (base1) + (off)); (bf16x8){lo_[0], lo_[1], lo_[2], lo_[3], hi_[0], hi_[1], hi_[2], hi_[3]}; })
#define RWF(base, off) (*(const LAS bf16x8*)(F.lds + (base) + (off)))
__device__ __forceinline__ void ret_item(Frame& F, int li, int b, int head, int dir, int z) {
    const int tid = F.tid, lane = F.lane, wave = F.wave, ib = wave & 3, xw = wave >> 2, eb = 2 * z + xw, r = lane & 31, h = lane >> 5;
    const bf16* Z = (const bf16*)FBIG; bf16* OUT = (bf16*)(FYB + (size_t)(2 + dir) * T_HALF);
    const float theta = INP(13)[((size_t)li * 2 + dir) * 4 + head];
    const float log_g = -((-theta > 20.f) ? -theta : log1pf(expf(-theta)));
    const float g1 = expf(log_g), g127 = expf(127.0f * log_g);
    const size_t rowbase = (size_t)b * TB;
    unsigned xsI[8], xsT[8], xsJ[8];
    { const unsigned swz = ((r & 3) << 2) | ((r >> 2) & 3);
#pragma unroll
      for (int s = 0; s < 8; ++s) { const unsigned x = 256u * r + 16u * ((unsigned)(2 * s + h) ^ swz); xsI[s] = x + 8192u * ib + RT_QB; xsT[s] = x + 8192u * eb; xsJ[s] = x + 16384u * xw; } }
    const unsigned tK0 = RT_KB + tr_read_addr(lane, ib, 0, 0), tK1 = RT_KB + tr_read_addr(lane, ib, 0, 1);
    const unsigned tV0 = RT_VB + tr_read_addr(lane, eb, 0, 0), tV1 = RT_VB + tr_read_addr(lane, eb, 0, 1);
    __syncthreads();
    for (int it = tid; it < 2048; it += 512) *(LAS v4u*)(F.lds + RT_T2 + it * 16) = (v4u){0u, 0u, 0u, 0u};
    f32x16 SA = f32x16{};
    v4u pq[4], pk[4], pv[2];
#define RET_LOAD(c_) do { const int tl_ = chunk_tlo(dir, (c_)); _Pragma("unroll") for (int n_ = 0; n_ < 4; ++n_) { const int it_ = tid + 512 * n_, row_ = it_ >> 4, cn_ = it_ & 15; \
        const bf16* p_ = Z + (rowbase + tl_ + (dir == 0 ? row_ : 127 - row_)) * EV_IN + 1024 + head * 128 + cn_ * 8; pq[n_] = *(const v4u*)p_; pk[n_] = *(const v4u*)(p_ + 512); } \
        _Pragma("unroll") for (int n_ = 0; n_ < 2; ++n_) { const int it_ = tid + 512 * n_, row_ = it_ >> 3, cn_ = 8 * z + (it_ & 7); \
        pv[n_] = *(const v4u*)(Z + (rowbase + tl_ + (dir == 0 ? row_ : 127 - row_)) * EV_IN + 2048 + head * 128 + cn_ * 8); } } while (0)
    RET_LOAD(0);
#pragma nounroll
    for (int c = 0; c < 66; ++c) {
        const int t_lo = chunk_tlo(dir, c);
        __syncthreads();
#pragma unroll
        for (int n = 0; n < 4; ++n) { const int it = tid + 512 * n, row = it >> 4, cn = it & 15; const float sc = __builtin_amdgcn_exp2f(-(float)row * (log_g * 1.4426950408889634f)); const unsigned wo = off_b(row, cn);
            float f[8]; unpack8(pk[n], f);
#pragma unroll
            for (int k = 0; k < 8; ++k) f[k] *= sc;
            *(LAS v4u*)(F.lds + RT_QB + wo) = pq[n]; *(LAS v4u*)(F.lds + RT_KB + wo) = pack8(f); }
#pragma unroll
        for (int n = 0; n < 2; ++n) { const int it = tid + 512 * n, row = it >> 3, cn = 8 * z + (it & 7); *(LAS v4u*)(F.lds + RT_VB + off_b(row, cn)) = pv[n]; }
        if (c + 1 < 66) RET_LOAD(c + 1);
        __syncthreads();
        f32x16 OT = f32x16{}, ST[2]; ST[0] = f32x16{}; ST[1] = f32x16{};
#pragma unroll
        for (int s = 0; s < 8; ++s) { const bf16x8 qf = RWF(xsI[s], 0);
            OT = MFMA32(RWF(xsT[s], RT_T2), qf, OT);
            if (2 * xw <= ib) ST[0] = MFMA32(RWF(xsJ[s], RT_KB), qf, ST[0]);
            if (2 * xw + 1 <= ib) ST[1] = MFMA32(RWF(xsJ[s], RT_KB + 8192), qf, ST[1]); }
#pragma unroll
        for (int q = 0; q < 16; ++q) SA[q] *= g1;
#pragma unroll
        for (int ks = 0; ks < 8; ++ks) SA = MFMA32(TRF(tK0, tK1, ks * 4096), TRF(tV0, tV1, ks * 4096), SA);
#pragma unroll
        for (int q = 0; q < 16; ++q) SA[q] *= g127;
        __syncthreads();
        const int irow = 32 * ib + r;
#pragma unroll
        for (int y = 0; y < 2; ++y) { const int jb = 2 * xw + y;
#pragma unroll
            for (int gq = 0; gq < 4; ++gq) { const int j0 = 32 * jb + 8 * gq + 4 * h; float p0 = ST[y][4 * gq], p1 = ST[y][4 * gq + 1], p2 = ST[y][4 * gq + 2], p3 = ST[y][4 * gq + 3];
                if (j0 > irow) p0 = 0.f; if (j0 + 1 > irow) p1 = 0.f; if (j0 + 2 > irow) p2 = 0.f; if (j0 + 3 > irow) p3 = 0.f;
                v2u w; w.x = cvt_pk_bf16(p0, p1); w.y = cvt_pk_bf16(p2, p3);
                *(LAS v2u*)(F.lds + RT_QB + off_b(irow, 4 * jb + gq) + 8 * h) = w; } }
        { const int erow = 32 * eb + r;
#pragma unroll
            for (int gq = 0; gq < 4; ++gq) { v2u w; w.x = cvt_pk_bf16(SA[4 * gq] * g1, SA[4 * gq + 1] * g1); w.y = cvt_pk_bf16(SA[4 * gq + 2] * g1, SA[4 * gq + 3] * g1);
                *(LAS v2u*)(F.lds + RT_T2 + off_b(erow, 4 * ib + gq) + 8 * h) = w; } }
        __syncthreads();
#pragma unroll
        for (int s = 0; s < 8; ++s) OT = MFMA32(TRF(tV0, tV1, s * 4096), RWF(xsI[s], 0), OT);
        { const float gi = __builtin_amdgcn_exp2f((float)irow * (log_g * 1.4426950408889634f)); const int t = t_lo + (dir == 0 ? irow : 127 - irow);
          bf16* op = OUT + (rowbase + t) * 512 + head * 128;
#pragma unroll
          for (int gq = 0; gq < 4; ++gq) { v2u w; w.x = cvt_pk_bf16(OT[4 * gq] * gi, OT[4 * gq + 1] * gi); w.y = cvt_pk_bf16(OT[4 * gq + 2] * gi, OT[4 * gq + 3] * gi);
              *(v2u*)(op + 32 * eb + 8 * gq + 4 * h) = w; } }
    }
#undef RET_LOAD
}
#undef TRF
#undef RWF
#if DBG_SCAN
#define DBGCHK(stage, v) do { if (!(fabsf(v) < 1e30f)) atomicMax((unsigned*)(WSG + WS_CTL) + 2049, 100u - (unsigned)(stage)); } while (0)
#else
#define DBGCHK(stage, v) do {} while (0)
#endif
typedef float f32x2 __attribute__((ext_vector_type(2)));
__device__ __forceinline__ f32x2 cmul_add(f32x2 a, f32x2 h, f32x2 c) {
    f32x2 t = (f32x2){a.x, a.x} * h + c; return (f32x2){-a.y, a.y} * (f32x2){h.y, h.x} + t; }
__device__ __forceinline__ void s5_item(Frame& F, int li, int b, int dir, int g) {
    LAS unsigned char* lds = F.lds;
    LAS f32x2* SEG = (LAS f32x2*)(lds + 8192);
    LAS unsigned* HS = (LAS unsigned*)(lds + 12288);
    const int tid = F.tid, lane = F.lane, wave = F.wave, fr = lane & 15, fq = lane >> 4;
    const int j = lane & 31, h = lane >> 5, tb = wave >> 1, sb = wave & 1, p = 32 * sb + j;
    LAS f32x2* QE = (LAS f32x2*)(lds + 49152) + wave * 256;
    const bf16* Z = (const bf16*)FBIG; bf16* OUT = (bf16*)(FYB + (size_t)dir * T_QUART);
    const size_t pb = ((size_t)li * 2 + dir) * 16 + g;
    const float lre = INP(20)[pb * 64 + p], lim = INP(21)[pb * 64 + p], dt = expf(INP(22)[pb]);
    const float x = lre * dt, y = lim * dt, ex = expf(x); float sy, cy; sincosf(y, &sy, &cy);
    const f32x2 a = (f32x2){ex * cy, ex * sy};
    const float sh = sinf(0.5f * y), am1r = expm1f(x) * cy - 2.0f * sh * sh, am1i = a.y;
    const float den = 1.0f / (lre * lre + lim * lim), cr = (am1r * lre + am1i * lim) * den, ci = (am1i * lre - am1r * lim) * den;
    bf16x8 bfre, bfim, bfre2, bfim2;
    { float vr[8], vi[8];
#pragma unroll
      for (int k = 0; k < 8; ++k) { const float br = INP(23)[(pb * 64 + p) * 16 + 8 * h + k], bi = INP(24)[(pb * 64 + p) * 16 + 8 * h + k]; vr[k] = cr * br - ci * bi; vi[k] = cr * bi + ci * br; }
      const v4u pr = pack8(vr), pi = pack8(vi); bfre = __builtin_bit_cast(bf16x8, pr); bfim = __builtin_bit_cast(bf16x8, pi);
      float hr[8], hi_[8]; unpack8(pr, hr); unpack8(pi, hi_);
#pragma unroll
      for (int k = 0; k < 8; ++k) { vr[k] -= hr[k]; vi[k] -= hi_[k]; }
      bfre2 = __builtin_bit_cast(bf16x8, pack8(vr)); bfim2 = __builtin_bit_cast(bf16x8, pack8(vi)); }
    const f32x2 zero2 = (f32x2){0.f, 0.f};
    const f32x2 a2 = cmul_add(a, a, zero2), a3 = cmul_add(a2, a, zero2), a4 = cmul_add(a2, a2, zero2);
    f32x2 a32 = a4;
#pragma unroll
    for (int k = 0; k < 3; ++k) a32 = cmul_add(a32, a32, zero2);
    bf16x8 cf[4];
#pragma unroll
    for (int ks = 0; ks < 4; ++ks) { float v[8];
#pragma unroll
        for (int jj = 0; jj < 8; ++jj) { const int k = 32 * ks + 8 * fq + jj, pp = k >> 1; v[jj] = (k & 1) ? -INP(26)[(pb * 16 + fr) * 64 + pp] : INP(25)[(pb * 16 + fr) * 64 + pp]; }
        cf[ks] = __builtin_bit_cast(bf16x8, pack8(v)); }
    f32x2 hc = zero2;
    const size_t rowbase = (size_t)b * TB;
    v4u pu = (v4u){0u, 0u, 0u, 0u};
#define S5_LOAD(c_) do { const int tl_ = chunk_tlo(dir, (c_)), ip_ = 32 * tb + j; pu = *(const v4u*)(Z + (rowbase + tl_ + (dir == 0 ? ip_ : 127 - ip_)) * OD_IN + g * 16 + 8 * h); } while (0)
    S5_LOAD(0);
    __syncthreads();
    for (int c = 0; c < 66; ++c) {
        const int t_lo = chunk_tlo(dir, c);
        const bf16x8 au = __builtin_bit_cast(bf16x8, pu);
        if (c + 1 < 66) S5_LOAD(c + 1);
        f32x16 Bre = __builtin_amdgcn_mfma_f32_32x32x16_bf16(au, bfre2, f32x16{}, 0, 0, 0), Bim = __builtin_amdgcn_mfma_f32_32x32x16_bf16(au, bfim2, f32x16{}, 0, 0, 0);
        Bre = __builtin_amdgcn_mfma_f32_32x32x16_bf16(au, bfre, Bre, 0, 0, 0); Bim = __builtin_amdgcn_mfma_f32_32x32x16_bf16(au, bfim, Bim, 0, 0, 0);
        f32x2 eq[8];
#pragma unroll
        for (int q = 0; q < 4; ++q) { f32x2 sr = zero2;
#pragma unroll
            for (int e = 0; e < 4; ++e) { sr = cmul_add(a, sr, (f32x2){Bre[4 * q + e], Bim[4 * q + e]}); Bre[4 * q + e] = sr.x; Bim[4 * q + e] = sr.y; }
            QE[(2 * q + h) * 32 + j] = sr; }
        asm volatile("s_waitcnt lgkmcnt(0)" ::: "memory");
#pragma unroll
        for (int Q = 0; Q < 8; ++Q) eq[Q] = QE[Q * 32 + j];
        { f32x2 sq = zero2;
#pragma unroll
          for (int Q = 0; Q < 8; ++Q) sq = cmul_add(a4, sq, eq[Q]);
          if (h == 0) SEG[tb * 64 + p] = sq; }
        __syncthreads();
        f32x2 hin = zero2;
#pragma unroll
        for (int b2 = 0; b2 < 4; ++b2) { if (b2 == tb) hin = hc; hc = cmul_add(a32, hc, SEG[b2 * 64 + p]); }
        { f32x2 tq = hin;
#pragma unroll
          for (int Q = 0; Q < 8; ++Q) {
              if ((Q & 1) == h) { const int q = Q >> 1;
#pragma unroll
                  for (int e = 0; e < 4; ++e) { const f32x2 pw = e == 0 ? a : (e == 1 ? a2 : (e == 2 ? a3 : a4)); const f32x2 v = cmul_add(pw, tq, (f32x2){Bre[4 * q + e], Bim[4 * q + e]});
                      HS[(32 * tb + 8 * q + 4 * h + e) * 68 + p] = cvt_pk_bf16(v.x, v.y); } }
              tq = cmul_add(a4, tq, eq[Q]); } }
        __syncthreads();
        { pg8::f32x4 acc = (pg8::f32x4){0.f, 0.f, 0.f, 0.f};
#pragma unroll
          for (int ks = 0; ks < 4; ++ks) { const bf16x8 af = *(const LAS bf16x8*)(HS + (16 * wave + fr) * 68 + 16 * ks + 4 * fq); acc = __builtin_amdgcn_mfma_f32_16x16x32_bf16(cf[ks], af, acc, 0, 0, 0); }
          const int ip = 16 * wave + fr, t = t_lo + (dir == 0 ? ip : 127 - ip);
          v2u w; w.x = cvt_pk_bf16(acc[0], acc[1]); w.y = cvt_pk_bf16(acc[2], acc[3]);
          *(v2u*)(OUT + (rowbase + t) * 256 + g * 16 + 4 * fq) = w; }
    }
#undef S5_LOAD
}
namespace att {
constexpr int KVBLK = 64, LD = OD_IN;
#define SBAR() __builtin_amdgcn_sched_barrier(0)
__device__ __forceinline__ int crow(int r, int hi) { return (r & 3) + 8 * (r >> 2) + 4 * hi; }
constexpr float THRL = 5.0f, POFF = 3.0f;
constexpr float KP0 = 8.0f * (POFF + 7.0f) - 0.094f, LIM8 = KP0 + 8.0f * THRL;
#define MX3(a, b, c) __builtin_fmaxf(__builtin_fmaxf((a), (b)), (c))
typedef int v8i_a __attribute__((ext_vector_type(8)));
typedef int v4i_a __attribute__((ext_vector_type(4)));
typedef float f32x4_a __attribute__((ext_vector_type(4)));
typedef __attribute__((address_space(3))) v4i_a lds_v4i;
#define LDSV(a_) (*(const lds_v4i*)(a_))
#define CAT8(x_, y_) __builtin_shufflevector((x_), (y_), 0, 1, 2, 3, 4, 5, 6, 7)
#define QKMF(x_, y_, c_) __builtin_amdgcn_mfma_scale_f32_32x32x64_f8f6f4(CAT8(x_, y_), qf, (c_), 0, 0, 0, 0x7f7f7f7f, 0, 0x80808080)
#define PVMF(pf_, acc_, x_, y_) __builtin_amdgcn_mfma_scale_f32_32x32x64_f8f6f4(pf_, CAT8(x_, y_), (acc_), 0, 0, 0, 0x7f7f7f7f, 0, 0x7f7f7f7f)
#define EXPB1(P_, r_, w_) w_ = (int)__builtin_amdgcn_cvt_pk_u8_f32(P_[r_], (r_) & 3, (unsigned)w_)
#define EXPW(P_, q_, W_, wi_) do { int w_; asm volatile("" : "=v"(w_)); EXPB1(P_, 4 * (q_), w_); EXPB1(P_, 4 * (q_) + 1, w_); EXPB1(P_, 4 * (q_) + 2, w_); EXPB1(P_, 4 * (q_) + 3, w_); asm volatile("" : "+v"(w_)); W_[wi_] = w_; } while (0)
#define EXPS(P_, h_, W_, w0_) do { EXPW(P_, 2 * (h_), W_, (w0_) + 2 * (h_)); EXPW(P_, 2 * (h_) + 1, W_, (w0_) + 2 * (h_) + 1); } while (0)
template <int MAP> __device__ __forceinline__ void unit(const unsigned char* q8, size_t row0, int qcol, const unsigned char* k8, size_t krow0, const unsigned char* vtb, unsigned vtoff, bf16* __restrict__ Ob, int seq, char* lds,
                                     float lam, float gsc, const float* __restrict__ gn, const int tid) {
  const int wid = __builtin_amdgcn_readfirstlane(tid >> 6), lane = tid & 63, r32 = lane & 31, hi = lane >> 5, wq = wid & 3; constexpr int map = MAP;
  constexpr int SLOT = 16384, VOFF = 8192;
  float* ws = (float*)(lds + 8 * SLOT) + wid * 64; float* al_l = ws + 32;
  f32x16 o[4] = {}; f32x4_a lacc = {};
  v8i_a qf;
  { const v4i_a* qp = (const v4i_a*)(q8 + (row0 + wq * 32 + r32) * 768 + qcol + map * 64 + hi * 32); const v4i_a x0 = qp[0], x1 = qp[1]; qf = CAT8(x0, x1); }
  asm volatile("s_waitcnt vmcnt(0)" ::: "memory");
  const int on_ = ((lane & 15) == ((lane >> 4) & 1)) ? 0x38383838 : 0;
  v8i_a ones = {on_, on_, on_, on_, on_, on_, on_, on_}; asm volatile("" : "+v"(ones));
  const int krow = wid * 8 + (lane >> 3); const unsigned voK = (unsigned)(krow * 768 + (((lane & 7) ^ ((krow >> 1) & 7)) * 16));
  const int vrow = wid * 16 + (lane >> 2); const unsigned voV = (unsigned)(vrow * 64 + (((lane & 3) ^ ((vrow >> 2) & 3)) * 16));
  const __amdgpu_buffer_rsrc_t rsK = __builtin_amdgcn_make_buffer_rsrc((void*)k8, 0, 0x7fffffff, 0x00020000), rsV = __builtin_amdgcn_make_buffer_rsrc((void*)vtb, 0, 0x7fffffff, 0x00020000);
  const unsigned koff = (unsigned)(krow0 * 768 + qcol);
  typedef __attribute__((address_space(3))) unsigned lds_u32;
  const int NT = seq / KVBLK;
#define DMA_TILE(t) do { const int tt_ = (t) < NT ? (t) : NT - 1; const int sl_ = ((t) & 7) * SLOT + wid * 1024; \
    __builtin_amdgcn_raw_ptr_buffer_load_lds(rsK, (lds_u32*)(lds + sl_), 16, (int)voK, (int)(koff + (unsigned)tt_ * (unsigned)(KVBLK * 768)), 0, 0); \
    __builtin_amdgcn_raw_ptr_buffer_load_lds(rsV, (lds_u32*)(lds + sl_ + VOFF), 16, (int)voV, (int)(vtoff + (unsigned)tt_ * 8192u), 0, 0); } while (0)
#define WAITB() asm volatile("s_waitcnt vmcnt(2)\n\ts_barrier" ::: "memory")
#define RESC(X0, X1) do { if (__builtin_expect(__any(dl8 > 0.f), 0)) { if (hi == 0) al_l[r32] = __builtin_amdgcn_exp2f(-0.125f * dl8); asm volatile("s_waitcnt lgkmcnt(0)" ::: "memory"); \
    _Pragma("unroll") for (int r = 0; r < 4; ++r) lacc[r] *= al_l[4 * (lane >> 4) + r + 16 * (lane & 1)]; \
    _Pragma("unroll") for (int r = 0; r < 16; ++r) { const float f_ = al_l[crow(r, hi)]; _Pragma("unroll") for (int d = 0; d < 4; ++d) o[d][r] *= f_; } \
    _Pragma("unroll") for (int r = 0; r < 16; ++r) { X0[r] -= dl8; X1[r] -= dl8; CKP[r] -= dl8; } } } while (0)
  const int kb0 = (int)(uintptr_t)lds + r32 * 128 + (((4 * map + 2 * hi) ^ ((r32 >> 1) & 7)) * 16);
  const int vb0 = (int)(uintptr_t)lds + VOFF + r32 * 64 + (((2 * hi) ^ ((r32 >> 2) & 3)) * 16);
  const int kb0x = kb0 ^ 16, vb0x = vb0 ^ 16;
  f32x16 pA0, pA1, pB0, pB1, CKP; v8i_a pf; float dl8 = 0.f;
#define ROWMAX_A(X0) mxa_ = MX3(X0[0], X0[1], X0[2]); mxb_ = MX3(X0[3], X0[4], X0[5]); mxa_ = MX3(mxa_, X0[6], X0[7]); mxb_ = MX3(mxb_, X0[8], X0[9]); mxa_ = MX3(mxa_, X0[10], X0[11]); mxb_ = MX3(mxb_, X0[12], X0[13]); mxa_ = MX3(mxa_, X0[14], X0[15]);
#define ROWMAX_B(X1) mxb_ = MX3(mxb_, X1[0], X1[1]); mxa_ = MX3(mxa_, X1[2], X1[3]); mxb_ = MX3(mxb_, X1[4], X1[5]); mxa_ = MX3(mxa_, X1[6], X1[7]); mxb_ = MX3(mxb_, X1[8], X1[9]); mxa_ = MX3(mxa_, X1[10], X1[11]); mxb_ = MX3(mxb_, X1[12], X1[13]); \
    mxa_ = MX3(mxa_, X1[14], X1[15]); rm_ = __builtin_fmaxf(mxa_, mxb_); \
    { auto rr_ = __builtin_amdgcn_permlane32_swap(__float_as_uint(rm_), __float_as_uint(rm_), false, false); rm_ = __builtin_fmaxf(__uint_as_float(rr_[0]), __uint_as_float(rr_[1])); }
#define PIN(x_) asm volatile("" : "+v"(x_))
  v4i_a va0_, va1_, vc0_, vc1_, vd0_, vd1_, ve0_, ve1_;
#define VREADS(t_) do { const int so_ = ((t_) & 7) * SLOT; const int vb_ = vb0 + so_, vx_ = vb0x + so_; va0_ = LDSV(vb_); va1_ = LDSV(vx_); vc0_ = LDSV(vb_ + 2048); vc1_ = LDSV(vx_ + 2048); \
    vd0_ = LDSV(vb_ + 4096); vd1_ = LDSV(vx_ + 4096); ve0_ = LDSV(vb_ + 6144); ve1_ = LDSV(vx_ + 6144); } while (0)
#define INTERVAL(X0, X1, Y0, Y1, j_) do { float mxa_ = 0.f, mxb_ = 0.f, rm_ = 0.f; \
    WAITB(); \
    const int kb_ = kb0 + ((j_) & 7) * SLOT, kx_ = kb0x + ((j_) & 7) * SLOT; \
    v4i_a ka0_ = LDSV(kb_), ka1_ = LDSV(kx_), kc0_ = LDSV(kb_ + 4096), kc1_ = LDSV(kx_ + 4096); \
    DMA_TILE((j_) + 2); \
    SBAR(); EXPS(Y0, 0, pf, 0); EXPS(Y0, 1, pf, 0); SBAR(); \
    PIN(ka0_); X0 = QKMF(ka0_, ka1_, CKP); PIN(X0); SBAR(); \
    EXPS(Y1, 0, pf, 4); EXPS(Y1, 1, pf, 4); SBAR(); \
    PIN(kc0_); X1 = QKMF(kc0_, kc1_, CKP); PIN(X1); SBAR(); \
    PIN(va0_); o[0] = PVMF(pf, o[0], va0_, va1_); PIN(o[0]); SBAR(); \
    ROWMAX_A(X0) \
    SBAR(); PIN(vc0_); o[1] = PVMF(pf, o[1], vc0_, vc1_); PIN(o[1]); SBAR(); \
    ROWMAX_B(X1) \
    dl8 = rm_ > LIM8 ? rm_ - KP0 : 0.f; \
    SBAR(); PIN(vd0_); o[2] = PVMF(pf, o[2], vd0_, vd1_); PIN(o[2]); SBAR(); \
    PIN(ve0_); o[3] = PVMF(pf, o[3], ve0_, ve1_); PIN(o[3]); SBAR(); \
    PIN(pf); lacc = __builtin_amdgcn_mfma_scale_f32_16x16x128_f8f6f4(pf, ones, lacc, 0, 0, 0, 0x7f7f7f7f, 0, 0x7f7f7f7f); PIN(lacc); SBAR(); \
    VREADS(j_); SBAR(); \
    RESC(X0, X1); } while (0)
  DMA_TILE(0); DMA_TILE(1);
  WAITB();
  DMA_TILE(2);
  { const v4i_a ka0_ = LDSV(kb0), ka1_ = LDSV(kb0 ^ 16), kc0_ = LDSV(kb0 + 4096), kc1_ = LDSV((kb0 + 4096) ^ 16);
    pA0 = QKMF(ka0_, ka1_, f32x16{}); pA1 = QKMF(kc0_, kc1_, f32x16{}); float mxa_, mxb_, rm_;
    ROWMAX_A(pA0) ROWMAX_B(pA1)
    const float kp0_ = KP0 - rm_;
#pragma unroll
    for (int r = 0; r < 16; ++r) { CKP[r] = kp0_; pA0[r] += kp0_; pA1[r] += kp0_; }
    PIN(CKP); VREADS(0); }
  for (int j = 1; j + 1 < NT; j += 2) {
    INTERVAL(pB0, pB1, pA0, pA1, j);
    INTERVAL(pA0, pA1, pB0, pB1, j + 1); }
  INTERVAL(pB0, pB1, pA0, pA1, NT - 1);
  { EXPS(pB0, 0, pf, 0); EXPS(pB0, 1, pf, 0); EXPS(pB1, 0, pf, 4); EXPS(pB1, 1, pf, 4);
    o[0] = PVMF(pf, o[0], va0_, va1_); o[1] = PVMF(pf, o[1], vc0_, vc1_); o[2] = PVMF(pf, o[2], vd0_, vd1_); o[3] = PVMF(pf, o[3], ve0_, ve1_);
    lacc = __builtin_amdgcn_mfma_scale_f32_16x16x128_f8f6f4(pf, ones, lacc, 0, 0, 0, 0x7f7f7f7f, 0, 0x7f7f7f7f); }
  asm volatile("s_waitcnt vmcnt(0)" ::: "memory");
#undef INTERVAL
#undef VREADS
#undef PIN
#undef ROWMAX_A
#undef ROWMAX_B
#undef DMA_TILE
#undef WAITB
  float rli[16];
  if ((lane & 15) < 2) {
#pragma unroll
    for (int r = 0; r < 4; ++r) ws[16 * (lane & 15) + 4 * (lane >> 4) + r] = lacc[r]; }
  asm volatile("s_waitcnt lgkmcnt(0)" ::: "memory");
#pragma unroll
  for (int r = 0; r < 16; ++r) rli[r] = __builtin_amdgcn_rcpf(ws[crow(r, hi)]);
  __syncthreads();
  int zz = 0; asm volatile("" : "+v"(zz));
  float* EX = (float*)lds;
  const int eb = wq * 4096 + lane + zz;
  if constexpr (MAP == 1) {
#pragma unroll
    for (int d0 = 0; d0 < 4; ++d0)
#pragma unroll
      for (int r = 0; r < 16; ++r) EX[eb + (d0 * 16 + r) * 64] = -lam * o[d0][r] * rli[r];
  }
  __syncthreads();
  if constexpr (MAP == 0) {
    float ss[16];
#pragma unroll
    for (int r = 0; r < 16; ++r) ss[r] = 0.f;
#pragma unroll
    for (int d0 = 0; d0 < 4; ++d0)
#pragma unroll
      for (int r = 0; r < 16; ++r) { const float v = o[d0][r] * rli[r] + EX[eb + (d0 * 16 + r) * 64]; o[d0][r] = v; ss[r] += v * v; }
#pragma unroll
    for (int r = 0; r < 16; ++r) { float s = ss[r]; s += __shfl_xor(s, 1); s += __shfl_xor(s, 2); s += __shfl_xor(s, 4); s += __shfl_xor(s, 8); s += __shfl_xor(s, 16);
      ss[r] = gsc / sqrtf(s * (1.0f / 128.0f) + EPS); }
    bf16* Ow = Ob + (long)(wq * 32 + 4 * hi) * 1024 + r32 + zz;
#pragma unroll
    for (int d0 = 0; d0 < 4; ++d0) { const float gv = gn[d0 * 32 + r32];
#pragma unroll
      for (int r = 0; r < 16; ++r) Ow[((r & 3) + 8 * (r >> 2)) * 1024 + d0 * 32] = (bf16)(cvt_pk_bf16(o[d0][r] * ss[r] * gv, 0.f) & 0xffffu); }
  }
  __syncthreads();
#undef RESC
#undef LDSV
#undef CAT8
#undef QKMF
#undef PVMF
#undef EXPS
#undef EXPW
#undef EXPB1
}
#undef MX3
#undef SBAR
}
#ifdef PROBE_SUB
#define SUB_T0 const unsigned long long sub_t0_ = __builtin_amdgcn_s_memrealtime()
#define SUB_SPIN(id) do { if (PROBE_SUB == (id)) { const unsigned long long t1_ = __builtin_amdgcn_s_memrealtime(), d_ = 9ull * (t1_ - sub_t0_); while (__builtin_amdgcn_s_memrealtime() - t1_ < d_) __builtin_amdgcn_s_sleep(8); } } while (0)
#else
#define SUB_T0 do {} while (0)
#define SUB_SPIN(id) do {} while (0)
#endif
__device__ __forceinline__ void ph_mix_even(Frame& F, int i) {
    SUB_T0;
    if (!(F.A->mode & 4)) for (int it = F.bid; it < 256; it += F.G) { LAUNDER(F);
#ifndef NO_RET
        if (it < 128) ret_item(F, i, it >> 4, (it >> 2) & 3, (it >> 1) & 1, it & 1);
#endif
#ifndef NO_LRU
        if (it >= 128) { const int j = it - 128; lru_item(F, i, j >> 4, (j >> 3) & 1, j & 7); }
#endif
        __syncthreads();
    }
    SUB_SPIN(3);
#ifdef PROBE_SUB
    if (F.bid < 128) { SUB_SPIN(5); } else { SUB_SPIN(6); }
#endif
}
__device__ __forceinline__ void ph_mix_odd(Frame& F, int l, int ctx_out) {
    const int i = l >> 1;
    { SUB_T0;
#ifndef NO_S5
    if (!(F.A->mode & 1)) for (int it = F.bid; it < 256; it += F.G) { LAUNDER(F); s5_item(F, i, it >> 5, (it >> 4) & 1, it & 15); __syncthreads(); }
#endif
    SUB_SPIN(1); }
    SUB_T0;
    const float* lp = INP(30) + (size_t)i * 256;
    const float s01 = wave_sum(lp[F.lane] * lp[64 + F.lane]), s23 = wave_sum(lp[128 + F.lane] * lp[192 + F.lane]);
    const float lam_init = 0.8f - 0.6f * expf(-0.3f * (float)l), lam = expf(s01) - expf(s23) + lam_init, gsc = 1.0f - lam_init;
    const bf16* Z = (const bf16*)FBIG; const float* gn = INP(31) + (size_t)i * 768;
    const int vcu = (F.G % 8 == 0) ? (F.bid % 8) * (F.G / 8) + F.bid / 8 : F.bid;
    const int nx = NB * 6 * 64, nc = ctx_out ? NB * 6 * 2 : 0;
    if (!(F.A->mode & 2)) for (int u = vcu; u < nx + nc; u += F.G) { LAUNDER(F);
        int bh, qb, row0, seq;
        if (u < nx) { bh = u >> 6; qb = u & 63; row0 = (bh / 6) * TB + CTXL + 128 * qb; seq = TB; }
        else { const int v = u - nx; bh = v >> 1; qb = v & 1; row0 = (bh / 6) * TB + 128 * qb; seq = CTXL; }
        const int b = bh / 6, h = bh % 6;
#ifndef NO_ATTN
        if (F.wave < 4) att::unit<0>(FBIG + Q8_OFF, (size_t)row0, h * 128, FYB + K8_OFF, (size_t)b * TB, FYB + VT_OFF, (unsigned)((size_t)bh * 132 * 8192),
                  FH + (size_t)row0 * D + 256 + h * 128, seq, (char*)F.lds, lam, gsc, gn + h * 128, F.tid);
        else att::unit<1>(FBIG + Q8_OFF, (size_t)row0, h * 128, FYB + K8_OFF, (size_t)b * TB, FYB + VT_OFF, (unsigned)((size_t)bh * 132 * 8192),
                  FH + (size_t)row0 * D + 256 + h * 128, seq, (char*)F.lds, lam, gsc, gn + h * 128, F.tid);
#endif
    }
    SUB_SPIN(2);
}

constexpr int PH_PER_LAYER = 18, PH_TOTAL = 2 + NLAYER * PH_PER_LAYER;
#define IN(k) (lo <= (k) && (k) < hi)
#ifndef PROBE_PARITY
#define PROBE_PARITY (-1)
#endif
#ifdef PROBE_SPIN_KINDS
#define PH0 const unsigned long long ph_t0_ = __builtin_amdgcn_s_memrealtime()
#define SEAM(k) do { if (IN((k) + 1)) xcd_barrier(bar, LEAD0(F)); { const int kk_ = ((k) - 1) % PH_PER_LAYER; if (((k) > 0) && ((PROBE_SPIN_KINDS >> kk_) & 1) && (PROBE_PARITY < 0 || ((((k) - 1) / PH_PER_LAYER) & 1) == PROBE_PARITY)) { const unsigned long long t1_ = __builtin_amdgcn_s_memrealtime(), d_ = 9ull * (t1_ - ph_t0_); \
        while (__builtin_amdgcn_s_memrealtime() - t1_ < d_) __builtin_amdgcn_s_sleep(8); } } } while (0)
#else
#define PH0 do {} while (0)
#define SEAM(k) do { if (IN((k) + 1)) xcd_barrier(bar, LEAD0(F)); } while (0)
#endif
template <int l> __device__ __forceinline__ void run_layer(Frame& F, const XcdBarrier& bar, const int lo, const int hi) {
        constexpr int P = 1 + PH_PER_LAYER * l, i = l >> 1; constexpr bool odd = l & 1; constexpr int ctx_out = l < NLAYER - 1;
        const float* MODl = FMOD + (size_t)l * 9 * 6144; const float* ng = INP(6) + (size_t)l * 4 * 1024;
        if (IN(P + 0)) { LAUNDER(F); PH0;
            ph_convert(F, l);
#ifdef PROBE_CONVERT
            __syncthreads(); ph_convert(F, l);
#endif
            NormArgs a{}; a.xin_input = (l == 0); a.has_y = (l > 0); a.two = (l > 0) && ((l - 1) & 1); a.write_x = (l > 0); a.final_ = 0; a.do_h = 1; a.do_route = 0;
            if (l > 0) { a.gate = FMOD + (size_t)(l - 1) * 9 * 6144 + 5 * 1024; a.gy = INP(6) + (size_t)(l - 1) * 4 * 1024 + 3 * 1024; }
            a.gh = ng; a.shift = MODl; a.scale = MODl + 1024;
            __syncthreads(); ph_norm(F, a); SEAM(P + 0);
        }
        if (IN(P + 1)) { LAUNDER(F); PH0;
            constexpr int N = odd ? OD_IN : EV_IN, HD = odd ? 32 : 64;
            pg8::Gemm g{FH, FWB + W_IN / 2, M, N, D}; pg8::StaticOrder S; S.init(M, N, F.G, F.bid);
            pg8::EpiWin<HD> E{(bf16*)FBIG, N, (const float*)(WSG + (odd ? WS_ROPE_D : WS_ROPE_R)), odd ? 1 : 4, odd ? 4 : 6, odd ? 4 : 6, odd ? 7 : 8, odd ? 4.0f * 0.125f * 1.4426950408889634f : 1.0f, odd ? 1.0f : 0.08838834764831845f,
                                 odd ? FBIG + Q8_OFF : (unsigned char*)nullptr, odd ? FYB + K8_OFF : (unsigned char*)nullptr, 256, 1024};
            pg8::gemm_phase<pg8::EpiWin<HD>, pg8::StaticOrder, true, true>(F.lds, g, S, E, F.tid);
            if (odd) { SEAM(P + 1); } else { SEAM(P + 2); }
        }
        if (odd && IN(P + 2)) { LAUNDER(F); PH0; ph_vt(F); SEAM(P + 2); }
        if (IN(P + 3)) { LAUNDER(F); PH0;
            if (!odd) { ph_mix_even(F, i); }
            else ph_mix_odd(F, l, ctx_out);
            SEAM(P + 3); }
        if (IN(P + 4)) { LAUNDER(F); PH0; if (!odd) ph_merge_even(F, i); else ph_zpass(F, i); SEAM(P + 4); }
        if (odd && IN(P + 5)) { LAUNDER(F); PH0;
            int kglu = 256; asm volatile("" : "+s"(kglu));
            pg8::Gemm g{(const bf16*)(FYB + 2 * T_QUART), FWB + W_GLU / 2, M, 256, kglu}; pg8::StaticOrder S; S.init(M, 256, F.G, F.bid);
            pg8::EpiGLU E{FH, D, (const bf16*)(FYB + 2 * T_QUART), 256, INP(29) + (size_t)i * 256};
            pg8::gemm_phase<pg8::EpiGLU, pg8::StaticOrder, true, true>(F.lds, g, S, E, F.tid);
            SEAM(P + 5);
        }
        if (IN(P + 6)) { LAUNDER(F); PH0;
            pg8::Gemm g{FH, FWB + W_OUT / 2, M, D, D}; pg8::StaticOrder S; S.init(M, D, F.G, F.bid);
            pg8::EpiPlain E{(bf16*)FYB, D, 1.0f};
            pg8::gemm_phase<pg8::EpiPlain, pg8::StaticOrder, true, true>(F.lds, g, S, E, F.tid);
            if (!odd) { const int tw = ((M / 256) * (D / 256)) % F.G; if (tw == 0 || F.bid >= tw) { __syncthreads(); ph_convert_moe(F, i, tw, F.G - tw, 0, 3); } }
            SEAM(P + 6);
        }
        if (IN(P + 7)) { LAUNDER(F); PH0;
            NormArgs a{}; a.xin_input = (l == 0); a.has_y = 1; a.two = 0; a.write_x = 1; a.final_ = 0; a.do_h = 1; a.do_route = odd; a.h8 = 1;
            a.gate = MODl + 2 * 1024; a.gy = ng + 1024; a.gh = ng + 2 * 1024; a.shift = MODl + 3 * 1024; a.scale = MODl + 4 * 1024;
            a.rw = INP(33) + (size_t)i * 8192; a.rb = INP(34) + (size_t)i * 8;
            ph_norm(F, a); SEAM(P + 7);
        }
        if (!odd) {
            if (IN(P + 9)) { LAUNDER(F); PH0;
                int k8 = D / 2; asm volatile("" : "+s"(k8));
                pg8::Gemm g{FH, (const bf16*)((const unsigned char*)FWB + W_GU), M, 2 * DFF, k8}; pg8::StaticOrder S; S.init(M, 2 * DFF, F.G, F.bid);
                pg8::EpiSwiGLU8 E{FBIG + BIG_ACT, DFF, W8_INV};
                pg8::gemm_phase<pg8::EpiSwiGLU8, pg8::StaticOrder, true, true, true>(F.lds, g, S, E, F.tid);
                SEAM(P + 9);
            }
            if (IN(P + 10)) { LAUNDER(F); PH0;
                int k8 = DFF / 2; asm volatile("" : "+s"(k8));
                pg8::Gemm g{(const bf16*)(FBIG + BIG_ACT), (const bf16*)((const unsigned char*)FWB + W_DN), M, D, k8}; pg8::StaticOrder S; S.init(M, D, F.G, F.bid);
                pg8::EpiPlain E{(bf16*)FYB, D, W8_INV};
                pg8::gemm_phase<pg8::EpiPlain, pg8::StaticOrder, true, true, true>(F.lds, g, S, E, F.tid);
                { const int tw = ((M / 256) * (D / 256)) % F.G; if (tw == 0 || F.bid >= tw) { __syncthreads(); ph_convert_moe(F, i, tw, F.G - tw, 3, NE); } }
                SEAM(P + 10);
            }
        } else {
            if (IN(P + 8)) { LAUNDER(F); PH0; ph_assign(F); SEAM(P + 8); }
#pragma nounroll
            for (int w = 0; w < 2; ++w) {
                const int* PE = (const int*)(WSG + WS_PEXP);
                if (IN(P + 9 + 3 * w)) { LAUNDER(F); PH0; const int np = PE[MAXP], p0 = min(np, 256 * w), p1 = (w == 0) ? min(np, 256) : np; ph_gather(F, p0, p1); SEAM(P + 9 + 3 * w); }
                if (IN(P + 10 + 3 * w)) { LAUNDER(F); PH0; const int np = PE[MAXP], p0 = min(np, 256 * w), p1 = (w == 0) ? min(np, 256) : np;
                    int k8 = D / 2; asm volatile("" : "+s"(k8));
                    pg8::Gemm g{(const bf16*)(FBIG + BIG_HG), (const bf16*)(WSG + WS_W2 + W2_MGU), (p1 - p0) * 256, 2 * DFF, k8};
                    pg8::ExpertOrder S; S.init((p1 - p0) * 256, 2 * DFF, F.G, F.bid); S.pexp = PE + p0; S.estride = (size_t)7168 * 1024; S.tab = (LAS int*)(F.lds + RING_BYTES); __syncthreads(); S.fill(F.tid); __syncthreads();
                    pg8::EpiSwiGLU8 E{FBIG + BIG_ACT, DFF, W8_INV};
                    pg8::gemm_phase<pg8::EpiSwiGLU8, pg8::ExpertOrder, true, true, true>(F.lds, g, S, E, F.tid);
                    SEAM(P + 10 + 3 * w); }
                if (IN(P + 11 + 3 * w)) { LAUNDER(F); PH0; const int np = PE[MAXP], p0 = min(np, 256 * w), p1 = (w == 0) ? min(np, 256) : np;
                    int k8 = DFF / 2; asm volatile("" : "+s"(k8));
                    pg8::Gemm g{(const bf16*)(FBIG + BIG_ACT), (const bf16*)(WSG + WS_W2 + W2_MDN), (p1 - p0) * 256, D, k8};
                    pg8::ExpertOrder S; S.init((p1 - p0) * 256, D, F.G, F.bid); S.pexp = PE + p0; S.estride = (size_t)1024 * 3584; S.tab = (LAS int*)(F.lds + RING_BYTES); __syncthreads(); S.fill(F.tid); __syncthreads();
                    pg8::EpiScatter E{(const RouteEnt*)(WSG + WS_LIST) + (size_t)p0 * 256, (bf16*)FYB, (size_t)M * 1024, D, W8_INV};
                    pg8::gemm_phase<pg8::EpiScatter, pg8::ExpertOrder, true, true, true>(F.lds, g, S, E, F.tid);
                    if (w == 0) { SEAM(P + 11); } else { if (IN(P + PH_PER_LAYER)) xcd_barrier(bar, LEAD0(F)); } }
            }
        }
    }
#undef IN
#undef SEAM
__global__ void __launch_bounds__(512, 2) hybrid_fwd(Args args) {
    extern __shared__ __attribute__((aligned(16))) unsigned char lds_raw[];
    Frame F;
    F.lds = (LAS unsigned char*)lds_raw;
    F.tid = threadIdx.x; F.lane = F.tid & 63; F.wave = __builtin_amdgcn_readfirstlane(F.tid >> 6); F.G = gridDim.x; F.bid = blockIdx.x;
    F.A = (KArgs*)__builtin_amdgcn_kernarg_segment_ptr(); F.wsi = F.A->ws;
    volatile LAS unsigned* MISC = (volatile LAS unsigned*)(F.lds + MISC_OFF);
    for (int u = F.tid; u < (LDS_BYTES - LDSCTL_OFF) / 4; u += 512) ((LAS unsigned*)(F.lds + LDSCTL_OFF))[u] = 0u;
    __syncthreads();
    const int lo = args.ph_lo, hi = args.ph_hi;
    const bool multi = (hi - lo) > 1;
    unsigned* ctl = (unsigned*)(WSG + WS_CTL);
    XcdBarrier bar; bar.bar = ctl + CW_BAR; bar.x = 0; bar.st = nullptr;
    if (multi) bar = xcd_barrier_post(ctl + CW_BAR, MISC + 8);
#define IN(k) (lo <= (k) && (k) < hi)
#ifdef PROBE_SPIN_KINDS
#define PH0 const unsigned long long ph_t0_ = __builtin_amdgcn_s_memrealtime()
#define SEAM(k) do { if (IN((k) + 1)) xcd_barrier(bar, LEAD0(F)); { const int kk_ = ((k) - 1) % PH_PER_LAYER; if (((k) > 0) && ((PROBE_SPIN_KINDS >> kk_) & 1) && (PROBE_PARITY < 0 || ((((k) - 1) / PH_PER_LAYER) & 1) == PROBE_PARITY)) { const unsigned long long t1_ = __builtin_amdgcn_s_memrealtime(), d_ = 9ull * (t1_ - ph_t0_); \
        while (__builtin_amdgcn_s_memrealtime() - t1_ < d_) __builtin_amdgcn_s_sleep(8); } } } while (0)
#else
#define PH0 do {} while (0)
#define SEAM(k) do { if (IN((k) + 1)) xcd_barrier(bar, LEAD0(F)); } while (0)
#endif
#if defined(UBENCH) && UBENCH == 6
    { typedef int ub_v8i __attribute__((ext_vector_type(8)));
      ub_v8i ua = {(int)F.tid, 1, 2, 3, 4, 5, 6, 7}, ub = {7, 6, 5, 4, 3, 2, 1, (int)F.tid}; f32x16 c0 = {}, c1 = {}, c2 = {}, c3 = {};
      for (int i = 0; i < UB_N; ++i) { asm volatile("" : "+v"(ua), "+v"(ub));
        c0 = __builtin_amdgcn_mfma_scale_f32_32x32x64_f8f6f4(ua, ub, c0, 0, 0, 0, 0x7f7f7f7f, 0, 0x7f7f7f7f); c1 = __builtin_amdgcn_mfma_scale_f32_32x32x64_f8f6f4(ua, ub, c1, 0, 0, 0, 0x7f7f7f7f, 0, 0x7f7f7f7f);
        c2 = __builtin_amdgcn_mfma_scale_f32_32x32x64_f8f6f4(ua, ub, c2, 0, 0, 0, 0x7f7f7f7f, 0, 0x7f7f7f7f); c3 = __builtin_amdgcn_mfma_scale_f32_32x32x64_f8f6f4(ua, ub, c3, 0, 0, 0, 0x7f7f7f7f, 0, 0x7f7f7f7f); }
      asm volatile("" :: "v"(c0), "v"(c1), "v"(c2), "v"(c3)); }
#elif defined(UBENCH) && UBENCH == 7
    { typedef int ub_v8i __attribute__((ext_vector_type(8)));
      ub_v8i ua = {(int)F.tid, 1, 2, 3, 4, 5, 6, 7}, ub = {7, 6, 5, 4, 3, 2, 1, (int)F.tid}; f32x16 c0 = {}, c1 = {}, c2 = {}, c3 = {};
      float a0 = (float)F.tid, a1 = a0 + 1.f, a2 = a0 + 2.f, a3 = a0 + 3.f, a4 = a0 + 4.f, a5 = a0 + 5.f, a6 = a0 + 6.f;
#define UBF(r) "v_fma_f32 " r ", " r ", " r ", " r "\n\t"
#define UBF14 UBF("%0") UBF("%1") UBF("%2") UBF("%3") UBF("%4") UBF("%5") UBF("%6") UBF("%0") UBF("%1") UBF("%2") UBF("%3") UBF("%4") UBF("%5") UBF("%6")
#define UBV() asm volatile(UBF14 : "+v"(a0), "+v"(a1), "+v"(a2), "+v"(a3), "+v"(a4), "+v"(a5), "+v"(a6))
      for (int i = 0; i < UB_N; ++i) { asm volatile("" : "+v"(ua), "+v"(ub));
        c0 = __builtin_amdgcn_mfma_scale_f32_32x32x64_f8f6f4(ua, ub, c0, 0, 0, 0, 0x7f7f7f7f, 0, 0x7f7f7f7f); asm volatile("" : "+v"(c0)); UBV();
        c1 = __builtin_amdgcn_mfma_scale_f32_32x32x64_f8f6f4(ua, ub, c1, 0, 0, 0, 0x7f7f7f7f, 0, 0x7f7f7f7f); asm volatile("" : "+v"(c1)); UBV();
        c2 = __builtin_amdgcn_mfma_scale_f32_32x32x64_f8f6f4(ua, ub, c2, 0, 0, 0, 0x7f7f7f7f, 0, 0x7f7f7f7f); asm volatile("" : "+v"(c2)); UBV();
        c3 = __builtin_amdgcn_mfma_scale_f32_32x32x64_f8f6f4(ua, ub, c3, 0, 0, 0, 0x7f7f7f7f, 0, 0x7f7f7f7f); asm volatile("" : "+v"(c3)); UBV(); }
      asm volatile("" :: "v"(c0), "v"(c1), "v"(c2), "v"(c3), "v"(a0), "v"(a1), "v"(a2), "v"(a3), "v"(a4), "v"(a5), "v"(a6)); }
#elif defined(UBENCH)
    { float a0 = (float)F.tid, a1 = a0 + 1.f, a2 = a0 + 2.f, a3 = a0 + 3.f, a4 = a0 + 4.f, a5 = a0 + 5.f, a6 = a0 + 6.f, a7 = a0 + 7.f;
#if UBENCH == 1
#define UB1(r) "v_fma_f32 " r ", " r ", " r ", " r "\n\t"
#elif UBENCH == 2
#define UB1(r) "v_cvt_u32_f32 " r ", " r "\n\t"
#elif UBENCH == 3
#define UB1(r) "v_cvt_pk_fp8_f32 " r ", " r ", " r "\n\t"
#elif UBENCH == 4
#define UB1(r) "v_exp_f32 " r ", " r "\n\t"
#elif UBENCH == 10
#define UB1(r) "v_cvt_pk_u8_f32 " r ", " r ", 1, " r "\n\t"
#elif UBENCH == 9
#define UB1(r) "v_fma_f32 %0, %0, %0, %0\n\t"
#elif UBENCH == 5
#define UB1(r) "v_max3_f32 " r ", " r ", " r ", " r "\n\t"
#endif
#define UB8 UB1("%0") UB1("%1") UB1("%2") UB1("%3") UB1("%4") UB1("%5") UB1("%6") UB1("%7")
      for (int i = 0; i < UB_N; ++i) asm volatile(UB8 UB8 UB8 UB8 : "+v"(a0), "+v"(a1), "+v"(a2), "+v"(a3), "+v"(a4), "+v"(a5), "+v"(a6), "+v"(a7));
      asm volatile("" :: "v"(a0), "v"(a1), "v"(a2), "v"(a3), "v"(a4), "v"(a5), "v"(a6), "v"(a7)); }
#endif
    if (IN(0)) { LAUNDER(F); PH0; ph_prologue(F); SEAM(0); }
    run_layer<0>(F, bar, lo, hi); run_layer<1>(F, bar, lo, hi); run_layer<2>(F, bar, lo, hi); run_layer<3>(F, bar, lo, hi);
    if (IN(PH_TOTAL - 1)) { LAUNDER(F); PH0;
        NormArgs a{}; a.xin_input = 0; a.has_y = 1; a.two = 1; a.write_x = 1; a.final_ = 1; a.do_h = 0; a.do_route = 0;
        a.gate = FMOD + (size_t)3 * 9 * 6144 + 5 * 1024; a.gy = INP(6) + (size_t)3 * 4 * 1024 + 3 * 1024;
        ph_norm(F, a);
    }
#undef IN
#undef SEAM
}


#ifndef DBG_SCAN
#define DBG_SCAN 0
#endif
#if DBG_SCAN
constexpr int CW_DBG = 2048;
__global__ void __launch_bounds__(256) dbg_scan(unsigned char* ws, const float* out, int phase) {
    unsigned* flag = (unsigned*)(ws + WS_CTL) + CW_DBG; bool bad = false;
    const size_t gt = (size_t)blockIdx.x * 256 + threadIdx.x, gs = (size_t)gridDim.x * 256;
    { const uint4* p = (const uint4*)(ws + WS_W); const size_t n = (WS_END - WS_W) / 16;
      for (size_t i = gt; i < n; i += gs) { const uint4 v = p[i]; const unsigned w[4] = {v.x, v.y, v.z, v.w};
#pragma unroll
          for (int k = 0; k < 4; ++k) { if ((w[k] & 0x7F80u) == 0x7F80u || (w[k] & 0x7F800000u) == 0x7F800000u) bad = true; } } }
    { const uint4* p = (const uint4*)(ws + WS_MOD); const size_t n = 4 * 9 * 6144 / 4;
      for (size_t i = gt; i < n; i += gs) { const uint4 v = p[i]; if ((v.x & 0x7F800000u) == 0x7F800000u || (v.y & 0x7F800000u) == 0x7F800000u || (v.z & 0x7F800000u) == 0x7F800000u || (v.w & 0x7F800000u) == 0x7F800000u) bad = true; } }
    { const uint4* p = (const uint4*)out; const size_t n = (size_t)NB * SEQ * D / 4;
      for (size_t i = gt; i < n; i += gs) { const uint4 v = p[i]; if ((v.x & 0x7F800000u) == 0x7F800000u || (v.y & 0x7F800000u) == 0x7F800000u || (v.z & 0x7F800000u) == 0x7F800000u || (v.w & 0x7F800000u) == 0x7F800000u) bad = true; } }
    { const unsigned* p = (const unsigned*)(ws + WS_MOD); const size_t n = 4 * 9 * 6144;
      for (size_t i = gt; i < n; i += gs) if ((p[i] & 0x7F800000u) == 0x7F800000u) bad = true; }
    if (bad) atomicMax(flag, 1000u - (unsigned)phase);
}
__global__ void __launch_bounds__(256) dbg_emit(unsigned char* ws, float* out) {
    const unsigned f = ((const unsigned*)(ws + WS_CTL))[CW_DBG], f2 = ((const unsigned*)(ws + WS_CTL))[CW_DBG + 1]; if (f == 0u && f2 == 0u) return;
    const int p = f2 ? 40 + (100 - (int)f2) : 1000 - (int)f;
    const size_t n = (size_t)NB * SEQ * D;
    for (size_t i = (size_t)blockIdx.x * 256 + threadIdx.x; i < n; i += (size_t)gridDim.x * 256) out[i] = (i == 0) ? ldexpf(1.0f, 14 + p) : 0.f;
}
#endif
static bool phase_exists(int ph) {
    if (ph == 0 || ph == PH_TOTAL - 1) return true;
    const int l = (ph - 1) / PH_PER_LAYER, k = (ph - 1) % PH_PER_LAYER; const bool odd = l & 1;
    if (k == 2) return odd;
    if (odd) return k <= 14;
    return k <= 1 || k == 3 || k == 4 || k == 6 || k == 7 || k == 9 || k == 10;
}
#ifndef MK_ONE_LAUNCH
#define MK_ONE_LAUNCH 1
#endif
extern "C" void kernel_launch(void* const* d_in, const int* in_sizes, int n_in, void* d_out, int out_size, void* d_ws, size_t ws_size, hipStream_t stream) {
    static int grid = 0;
    if (grid == 0) {
        if (n_in != 38 || in_sizes[0] != NB * SEQ * D || out_size != NB * SEQ * D || ws_size < WS_END) { fprintf(stderr, "kernel_launch: unexpected shapes / workspace (%d inputs, ws %zu)\n", n_in, ws_size); grid = -1; return; }
        int dev = 0, cus = 0, per_cu = 0;
        if (hipGetDevice(&dev) != hipSuccess || hipDeviceGetAttribute(&cus, hipDeviceAttributeMultiprocessorCount, dev) != hipSuccess) { grid = -1; return; }
        if (hipFuncSetAttribute((const void*)hybrid_fwd, hipFuncAttributeMaxDynamicSharedMemorySize, LDS_BYTES) != hipSuccess) { fprintf(stderr, "kernel_launch: hipFuncSetAttribute failed\n"); grid = -1; return; }
        if (hipOccupancyMaxActiveBlocksPerMultiprocessor(&per_cu, (const void*)hybrid_fwd, 512, LDS_BYTES) != hipSuccess || per_cu < 1) fprintf(stderr, "kernel_launch: occupancy query reports %d workgroups per CU\n", per_cu);
        (void)hipGetLastError();
        grid = cus;
    }
    if (grid < 0) return;
    if (hipMemsetAsync((char*)d_ws + WS_CTL, 0, CTL_ZERO_BYTES, stream) != hipSuccess) return;
#if DBG_SCAN
    (void)hipMemsetAsync(d_ws, 0, WS_END, stream); (void)hipMemsetAsync(d_out, 0, (size_t)out_size * 4, stream);
#endif
    Args a{};
    for (int i = 0; i < 38; ++i) a.in[i] = (const float*)d_in[i];
    a.out = (float*)d_out; a.ws = (unsigned char*)d_ws;
    if (MK_ONE_LAUNCH) { a.ph_lo = 0; a.ph_hi = PH_TOTAL; hipLaunchKernelGGL(hybrid_fwd, dim3(grid), dim3(512), LDS_BYTES, stream, a); }
    else for (int ph = 0; ph < PH_TOTAL; ++ph) { if (!phase_exists(ph)) continue; a.ph_lo = ph; a.ph_hi = ph + 1;
        int reps = 1;
#ifdef PROBE_REPEAT
        if (ph > 0 && ph < PH_TOTAL - 1) { const int k = (ph - 1) % PH_PER_LAYER; if ((PROBE_REPEAT >> k) & 1) reps = 2; }
#endif
        for (int rp = 0; rp < reps; ++rp) {
#ifdef PROBE_MODE
            a.mode = rp ? PROBE_MODE : 0;
#endif
            hipLaunchKernelGGL(hybrid_fwd, dim3(grid), dim3(512), LDS_BYTES, stream, a); }
        a.mode = 0;
#if DBG_SCAN
        hipLaunchKernelGGL(dbg_scan, dim3(2048), dim3(256), 0, stream, (unsigned char*)d_ws, (const float*)d_out, ph);
#endif
    }
#if DBG_SCAN
    hipLaunchKernelGGL(dbg_emit, dim3(2048), dim3(256), 0, stream, (unsigned char*)d_ws, (float*)d_out);
#endif
    const hipError_t le = hipPeekAtLastError();
    if (le != hipSuccess) fprintf(stderr, "kernel_launch: launch failed: %s\n", hipGetErrorName(le));
}
```
